# Optimizing an MI355X kernel written in HIP

```python
import jax, jax.numpy as jnp
from jax import lax
import numpy as np


D_MODEL = 1024
BATCH = 8
SEQ = 2048
DEPTH = 2

HEAD_DIM = 64
N_HEADS = D_MODEL // HEAD_DIM
N_MIXERS = 2
N_RWKV = (DEPTH + 1) // 2
N_FOX = DEPTH // 2
RWKV_DECAY_LORA = 64
RWKV_AAA_LORA = 64
RWKV_GATE_LORA = 128
GN_EPS = 64e-5
Q_BLOCK = 128
N_EXPERTS = 16
N_GROUPS = 4
EXPERTS_PER_GROUP = N_EXPERTS // N_GROUPS
TOP_K = 2
D_EXPERT = 512
EXPERT_BLOCK = 128
LN_EPS = 1e-5
ALPHA = (2 * DEPTH) ** 0.25
BETA = (8 * DEPTH) ** -0.25

kernel_name = "hybrid_rwkv7_fox_sharedrouter_moe_deepnorm"


def layer_norm(x, g, b):
    xf = x.astype(jnp.float32)
    mu = jnp.mean(xf, -1, keepdims=True)
    var = jnp.mean(jnp.square(xf - mu), -1, keepdims=True)
    return ((xf - mu) * lax.rsqrt(var + LN_EPS)).astype(x.dtype) * g + b


def rwkv7_step(S, inp):
    r_t, w_t, k_t, v_t, kk_t, a_t = inp
    sa = jnp.einsum('bhij,bhj->bhi', S, kk_t)
    S = (S * w_t[:, :, None, :]
         - sa[..., :, None] * (kk_t * a_t)[..., None, :]
         + v_t[..., :, None] * k_t[..., None, :])
    y = jnp.einsum('bhij,bhj->bhi', S, r_t)
    return S, y


def rwkv7_time_mix(x, mix, wr, wk, wv, wo, w0, w1, w2, a0, a1, a2, g1, g2,
                   k_k, k_a, r_k, gn_g, gn_b):
    B, T, D = x.shape
    H, N = N_HEADS, HEAD_DIM
    xx = jnp.pad(x, ((0, 0), (1, 0), (0, 0)))[:, :T] - x
    xr, xw, xk, xv, xa, xg = (x + xx * mix[j] for j in range(6))
    r = xr @ wr
    k = xk @ wk
    v = xv @ wv
    w = -jax.nn.softplus(-(w0 + jnp.tanh(xw @ w1) @ w2)) - 0.5
    decay = jnp.exp(-jnp.exp(w.astype(jnp.float32))).astype(x.dtype)
    a = jax.nn.sigmoid(a0 + (xa @ a1) @ a2)
    g = jax.nn.sigmoid(xg @ g1) @ g2
    kk = (k * k_k).reshape(B, T, H, N)
    kk_norm = jnp.sqrt(jnp.sum(jnp.square(kk.astype(jnp.float32)), -1, keepdims=True))
    kk = kk / jnp.maximum(kk_norm, 1e-12).astype(x.dtype)
    k = k * (1 + (a - 1) * k_a)
    heads = lambda t: t.reshape(B, T, H, N)
    seq_first = lambda t: jnp.swapaxes(t, 0, 1)
    r_h, k_h, v_h = heads(r), heads(k), heads(v)
    S0 = jnp.zeros((B, H, N, N), x.dtype)
    scan_in = tuple(seq_first(t) for t in (r_h, heads(decay), k_h, v_h, kk, heads(a)))
    _, y = lax.scan(rwkv7_step, S0, scan_in)
    y = jnp.swapaxes(y, 0, 1)
    yf = y.astype(jnp.float32)
    mu = jnp.mean(yf, -1, keepdims=True)
    var = jnp.mean(jnp.square(yf - mu), -1, keepdims=True)
    yn = ((yf - mu) * lax.rsqrt(var + GN_EPS)).astype(x.dtype).reshape(B, T, D) * gn_g + gn_b
    bonus = jnp.sum(r_h * k_h * r_k, -1, keepdims=True) * v_h
    y = yn + bonus.reshape(B, T, D)
    return (y * g) @ wo


def forgetting_attention(x, w_in, b_f, wo):
    B, T, D = x.shape
    H, N = N_HEADS, HEAD_DIM
    proj = x @ w_in
    q, k, v = proj[..., :D], proj[..., D:2 * D], proj[..., 2 * D:3 * D]
    log_f = jax.nn.log_sigmoid((proj[..., 3 * D:] + b_f).astype(jnp.float32))
    c = jnp.swapaxes(jnp.cumsum(log_f, axis=1), 1, 2)
    to_heads = lambda t: t.reshape(B, T, H, N).transpose(0, 2, 1, 3)
    q, k, v = to_heads(q), to_heads(k), to_heads(v)
    nb = T // Q_BLOCK
    qb = q.reshape(B, H, nb, Q_BLOCK, N).transpose(2, 0, 1, 3, 4)
    cb = c.reshape(B, H, nb, Q_BLOCK).transpose(2, 0, 1, 3)
    kpos = jnp.arange(T)
    scale = HEAD_DIM ** -0.5

    def attend(args):
        q_blk, c_blk, i = args
        qpos = i * Q_BLOCK + jnp.arange(Q_BLOCK)
        s = jnp.einsum('bhqd,bhkd->bhqk', q_blk, k).astype(jnp.float32) * scale
        s = s + c_blk[..., :, None] - c[:, :, None, :]
        s = jnp.where(kpos[None, :] <= qpos[:, None], s, -jnp.inf)
        p = jax.nn.softmax(s, axis=-1).astype(v.dtype)
        return jnp.einsum('bhqk,bhkd->bhqd', p, v)

    o = lax.map(attend, (qb, cb, jnp.arange(nb)))
    o = o.transpose(1, 0, 3, 2, 4).reshape(B, T, D)
    return o @ wo


def shared_router_moe(h, router_w, router_bias, w_gate, w_up, w_down):
    B, T, D = h.shape
    n_tok = B * T
    xt = h.reshape(n_tok, D)
    s = jax.nn.sigmoid((xt @ router_w).astype(jnp.float32))
    s_sel = (s + router_bias.astype(jnp.float32)).reshape(n_tok, N_GROUPS, EXPERTS_PER_GROUP)
    grp_score = jnp.sum(lax.top_k(s_sel, 2)[0], -1)
    g_star = jnp.argmax(grp_score, -1)
    in_grp = jnp.take_along_axis(s_sel, g_star[:, None, None], axis=1)[:, 0]
    _, loc = lax.top_k(in_grp, TOP_K)
    e_idx = (g_star[:, None] * EXPERTS_PER_GROUP + loc).astype(jnp.int32)
    gate = jnp.take_along_axis(s, e_idx, axis=1)
    gate = (gate / jnp.sum(gate, -1, keepdims=True)).astype(h.dtype)

    n_assign = n_tok * TOP_K
    e_flat = e_idx.reshape(n_assign)
    tok = jnp.arange(n_assign, dtype=jnp.int32) // TOP_K
    order = jnp.argsort(e_flat)
    e_sorted = e_flat[order]
    counts = jnp.zeros((N_EXPERTS,), jnp.int32).at[e_flat].add(1)
    padded = (counts + EXPERT_BLOCK - 1) // EXPERT_BLOCK * EXPERT_BLOCK
    start = jnp.cumsum(counts) - counts
    pend = jnp.cumsum(padded)
    pstart = pend - padded
    dest = pstart[e_sorted] + jnp.arange(n_assign, dtype=jnp.int32) - start[e_sorted]
    n_blocks = (n_assign + N_EXPERTS * (EXPERT_BLOCK - 1) + EXPERT_BLOCK - 1) // EXPERT_BLOCK
    n_rows = n_blocks * EXPERT_BLOCK
    row_tok = jnp.full((n_rows,), n_tok, jnp.int32).at[dest].set(tok[order])
    row_gate = jnp.zeros((n_rows,), h.dtype).at[dest].set(gate.reshape(n_assign)[order])
    block_exp = jnp.minimum(
        jnp.searchsorted(pend, jnp.arange(n_blocks, dtype=jnp.int32) * EXPERT_BLOCK, side='right'),
        N_EXPERTS - 1)
    x_pad = jnp.concatenate([xt, jnp.zeros((1, D), h.dtype)], axis=0)
    xs = x_pad[row_tok].reshape(n_blocks, EXPERT_BLOCK, D)

    def expert_block(args):
        xb, e = args
        hid = jax.nn.silu(xb @ w_gate[e]) * (xb @ w_up[e])
        return hid @ w_down[e]

    ys = lax.map(expert_block, (xs, block_exp)).reshape(n_rows, D)
    out = jax.ops.segment_sum(ys * row_gate[:, None], row_tok, num_segments=n_tok + 1)[:n_tok]
    return out.reshape(B, T, D)


def setup_inputs(seed: int = 0) -> dict:
    key = jax.random.key(seed)
    ks = jax.random.split(key, 32)
    D, H, N, L_A, L_B = D_MODEL, N_HEADS, HEAD_DIM, N_RWKV, N_FOX
    nrm = lambda i, shape, sc: jax.random.normal(ks[i], shape, jnp.float32) * sc
    unif = lambda i, shape: jax.random.uniform(ks[i], shape, jnp.float32)
    inv = D ** -0.5
    v_cols = jnp.concatenate([jnp.ones((2 * D,)), jnp.full((D,), BETA), jnp.ones((H,))]).astype(jnp.float32)
    return {
        "x": nrm(0, (BATCH, SEQ, D), 1.0),
        "rw_mix": unif(1, (L_A, 6, D)),
        "rw_wr": nrm(2, (L_A, D, D), inv),
        "rw_wk": nrm(3, (L_A, D, D), inv),
        "rw_wv": nrm(4, (L_A, D, D), inv * BETA),
        "rw_wo": nrm(5, (L_A, D, D), inv * BETA),
        "rw_w0": -6.0 + 5.0 * unif(6, (L_A, D)),
        "rw_w1": nrm(7, (L_A, D, RWKV_DECAY_LORA), inv),
        "rw_w2": nrm(8, (L_A, RWKV_DECAY_LORA, D), 0.1 * RWKV_DECAY_LORA ** -0.5),
        "rw_a0": nrm(9, (L_A, D), 0.1),
        "rw_a1": nrm(10, (L_A, D, RWKV_AAA_LORA), inv),
        "rw_a2": nrm(11, (L_A, RWKV_AAA_LORA, D), 0.1 * RWKV_AAA_LORA ** -0.5),
        "rw_g1": nrm(12, (L_A, D, RWKV_GATE_LORA), inv),
        "rw_g2": nrm(13, (L_A, RWKV_GATE_LORA, D), RWKV_GATE_LORA ** -0.5),
        "rw_kk": 0.85 + nrm(14, (L_A, D), 0.05),
        "rw_ka": 1.0 + nrm(15, (L_A, D), 0.05),
        "rw_rk": nrm(16, (L_A, H, N), 0.1),
        "rw_gn_g": 1.0 + nrm(17, (L_A, D), 0.02),
        "rw_gn_b": nrm(18, (L_A, D), 0.02),
        "fx_w_in": nrm(19, (L_B, D, 3 * D + H), inv) * v_cols,
        "fx_b_f": 3.0 + nrm(20, (L_B, H), 0.5),
        "fx_wo": nrm(21, (L_B, D, D), inv * BETA),
        "router_w": nrm(22, (D, N_EXPERTS), inv),
        "router_bias": nrm(23, (N_EXPERTS,), 0.01),
        "moe_w_gate": nrm(24, (DEPTH, N_EXPERTS, D, D_EXPERT), inv * BETA),
        "moe_w_up": nrm(25, (DEPTH, N_EXPERTS, D, D_EXPERT), inv * BETA),
        "moe_w_down": nrm(26, (DEPTH, N_EXPERTS, D_EXPERT, D), D_EXPERT ** -0.5 * BETA),
        "ln_g": 1.0 + nrm(27, (DEPTH, 2, D), 0.02),
        "ln_b": nrm(28, (DEPTH, 2, D), 0.02),
    }


def reference(x, rw_mix, rw_wr, rw_wk, rw_wv, rw_wo, rw_w0, rw_w1, rw_w2, rw_a0, rw_a1,
              rw_a2, rw_g1, rw_g2, rw_kk, rw_ka, rw_rk, rw_gn_g, rw_gn_b,
              fx_w_in, fx_b_f, fx_wo, router_w, router_bias,
              moe_w_gate, moe_w_up, moe_w_down, ln_g, ln_b):
    h = x
    for i in range(DEPTH):
        j = i // N_MIXERS
        if i % N_MIXERS == 0:
            mixed = rwkv7_time_mix(h, rw_mix[j], rw_wr[j], rw_wk[j], rw_wv[j], rw_wo[j],
                                   rw_w0[j], rw_w1[j], rw_w2[j], rw_a0[j], rw_a1[j], rw_a2[j],
                                   rw_g1[j], rw_g2[j], rw_kk[j], rw_ka[j], rw_rk[j],
                                   rw_gn_g[j], rw_gn_b[j])
        else:
            mixed = forgetting_attention(h, fx_w_in[j], fx_b_f[j], fx_wo[j])
        h = layer_norm(ALPHA * h + mixed, ln_g[i, 0], ln_b[i, 0])
        ffn = shared_router_moe(h, router_w, router_bias, moe_w_gate[i], moe_w_up[i], moe_w_down[i])
        h = layer_norm(ALPHA * h + ffn, ln_g[i, 1], ln_b[i, 1])
    return h
```

```cpp
#include <hip/hip_runtime.h>
#include <stdint.h>
#include <stdio.h>

typedef unsigned short bf16;
typedef short bf16x8 __attribute__((ext_vector_type(8)));
typedef float f32x4 __attribute__((ext_vector_type(4)));
typedef unsigned u32x4 __attribute__((ext_vector_type(4)));
typedef unsigned u32x2 __attribute__((ext_vector_type(2)));

constexpr int NB = 8, T = 2048, D = 1024, H = 16, HD = 64, M = NB * T;
constexpr int NE = 16, DE = 512, CAP = 16384, MAXROWS = 36864;
constexpr int NW_IN = 3 * D + H;
constexpr float ALPHA = 1.4142135623730951f;
constexpr float LN_EPS = 1e-5f, GN_EPS = 64e-5f;
constexpr float LOG2E = 1.4426950408889634f;

constexpr size_t MiB = 1u << 20;
constexpr size_t WS_CTL = 0;
constexpr size_t CTL_BYTES = 4096;
constexpr size_t WS_RTOK = 1 * MiB;
constexpr size_t WS_RGATE = 2 * MiB;
constexpr size_t WS_SLOT = 3 * MiB;
constexpr size_t WS_HB = 4 * MiB;
constexpr size_t WS_R = 36 * MiB;
constexpr size_t WS_K = 68 * MiB;
constexpr size_t WS_V = 100 * MiB;
constexpr size_t WS_LW = 132 * MiB;
constexpr size_t WS_AA = 196 * MiB;
constexpr size_t WS_G = 228 * MiB;
constexpr size_t WS_L1 = 260 * MiB;
constexpr size_t WS_LOGF = 276 * MiB;
constexpr size_t WS_CUM = 277 * MiB;
constexpr size_t WS_END = 278 * MiB;
constexpr size_t WS_Y = 36 * MiB;
constexpr size_t WS_HID = 132 * MiB;

__device__ __forceinline__ unsigned f2bf(float f) { unsigned u = __float_as_uint(f); return (u + 0x7fffu + ((u >> 16) & 1u)) >> 16; }
__device__ __forceinline__ float bf2f(unsigned b) { return __uint_as_float(b << 16); }
__device__ __forceinline__ unsigned pk2(float lo, float hi) { return f2bf(lo) | (f2bf(hi) << 16); }
__device__ __forceinline__ float sigmoidf_(float x) { return 1.0f / (1.0f + __expf(-x)); }
__device__ __forceinline__ float softplusf_(float x) { return fmaxf(x, 0.f) + log1pf(__expf(-fabsf(x))); }
__device__ __forceinline__ float wave_sum(float v) {
#pragma unroll
    for (int o = 1; o < 64; o <<= 1) v += __shfl_xor(v, o);
    return v;
}

constexpr int GBM = 128, GBN = 64, GBK = 64, GLD = 72;

template <class P>
__global__ void __launch_bounds__(512) k_gemm(P p) {
    __shared__ __attribute__((aligned(16))) bf16 sA[GBM * GLD];
    __shared__ __attribute__((aligned(16))) bf16 sB[(P::DUAL ? 2 : 1) * GBN * GLD];
    const int tid = threadIdx.x, lane = tid & 63, w = tid >> 6, fr = lane & 15, fq = lane >> 4;
    const int ntl = p.ntiles();
    for (int tile = blockIdx.x; tile < ntl; tile += gridDim.x) {
        typename P::Ctx c;
        if (!p.setup(tile, c)) continue;
        f32x4 acc[2][4];
#pragma unroll
        for (int d = 0; d < 2; ++d)
#pragma unroll
            for (int n = 0; n < 4; ++n) acc[d][n] = (f32x4){0.f, 0.f, 0.f, 0.f};
        const int K = p.K;
        for (int k0 = 0; k0 < K; k0 += GBK) {
            {
                const int r = tid >> 2, ks = (tid & 3) * 16;
                float a[16];
                p.loadA(c, r, k0 + ks, a);
                u32x4 lo, hi;
                lo.x = pk2(a[0], a[1]); lo.y = pk2(a[2], a[3]); lo.z = pk2(a[4], a[5]); lo.w = pk2(a[6], a[7]);
                hi.x = pk2(a[8], a[9]); hi.y = pk2(a[10], a[11]); hi.z = pk2(a[12], a[13]); hi.w = pk2(a[14], a[15]);
                *(u32x4*)&sA[r * GLD + ks] = lo; *(u32x4*)&sA[r * GLD + ks + 8] = hi;
            }
#pragma unroll
            for (int d = 0; d < (P::DUAL ? 2 : 1); ++d) {
                const int kk = tid >> 3, ns = (tid & 7) * 8;
                const float* src = p.Bptr(c, d) + (size_t)(k0 + kk) * p.ldb + ns;
                const f32x4 v0 = *(const f32x4*)src, v1 = *(const f32x4*)(src + 4);
                bf16* dst = &sB[d * GBN * GLD + ns * GLD + kk];
                dst[0 * GLD] = (bf16)f2bf(v0.x); dst[1 * GLD] = (bf16)f2bf(v0.y); dst[2 * GLD] = (bf16)f2bf(v0.z); dst[3 * GLD] = (bf16)f2bf(v0.w);
                dst[4 * GLD] = (bf16)f2bf(v1.x); dst[5 * GLD] = (bf16)f2bf(v1.y); dst[6 * GLD] = (bf16)f2bf(v1.z); dst[7 * GLD] = (bf16)f2bf(v1.w);
            }
            __syncthreads();
#pragma unroll
            for (int kk = 0; kk < 2; ++kk) {
                const bf16x8 a = *(const bf16x8*)&sA[(16 * w + fr) * GLD + kk * 32 + 8 * fq];
#pragma unroll
                for (int d = 0; d < (P::DUAL ? 2 : 1); ++d)
#pragma unroll
                    for (int n = 0; n < 4; ++n) {
                        const bf16x8 b = *(const bf16x8*)&sB[d * GBN * GLD + (16 * n + fr) * GLD + kk * 32 + 8 * fq];
                        acc[d][n] = __builtin_amdgcn_mfma_f32_16x16x32_bf16(a, b, acc[d][n], 0, 0, 0);
                    }
            }
            __syncthreads();
        }
#pragma unroll
        for (int n = 0; n < 4; ++n)
#pragma unroll
            for (int i = 0; i < 4; ++i) p.epi(c, 16 * w + 4 * fq + i, 16 * n + fr, acc[0][n][i], acc[1][n][i]);
    }
}

struct Ctx2 { int row0, col0; };

__device__ __forceinline__ void load_mix16(const float* x, const float* mix, int row, int k, float* a) {
    const float* cur = x + (size_t)row * D + k;
    const bool has_prev = (row & (T - 1)) != 0;
#pragma unroll
    for (int q = 0; q < 4; ++q) {
        const f32x4 c4 = *(const f32x4*)(cur + 4 * q);
        f32x4 p4 = (f32x4){0.f, 0.f, 0.f, 0.f};
        if (has_prev) p4 = *(const f32x4*)(cur - D + 4 * q);
        const f32x4 m4 = *(const f32x4*)(mix + k + 4 * q);
        a[4 * q + 0] = c4.x + (p4.x - c4.x) * m4.x; a[4 * q + 1] = c4.y + (p4.y - c4.y) * m4.y;
        a[4 * q + 2] = c4.z + (p4.z - c4.z) * m4.z; a[4 * q + 3] = c4.w + (p4.w - c4.w) * m4.w;
    }
}
__device__ __forceinline__ void load_bf16_16(const bf16* p, float* a) {
    const u32x4 v0 = *(const u32x4*)p, v1 = *(const u32x4*)(p + 8);
    a[0] = bf2f(v0.x & 0xffff); a[1] = bf2f(v0.x >> 16); a[2] = bf2f(v0.y & 0xffff); a[3] = bf2f(v0.y >> 16);
    a[4] = bf2f(v0.z & 0xffff); a[5] = bf2f(v0.z >> 16); a[6] = bf2f(v0.w & 0xffff); a[7] = bf2f(v0.w >> 16);
    a[8] = bf2f(v1.x & 0xffff); a[9] = bf2f(v1.x >> 16); a[10] = bf2f(v1.y & 0xffff); a[11] = bf2f(v1.y >> 16);
    a[12] = bf2f(v1.z & 0xffff); a[13] = bf2f(v1.z >> 16); a[14] = bf2f(v1.w & 0xffff); a[15] = bf2f(v1.w >> 16);
}

struct PMix {
    static constexpr bool DUAL = false; typedef Ctx2 Ctx;
    const float* x; const float* mix; const float* W; bf16* outb; float* outf;
    int K, ldb, N, act, ldo, ooff;
    __device__ int ntiles() const { return (M / GBM) * (N / GBN); }
    __device__ bool setup(int t, Ctx& c) const { const int nn = N / GBN; c.row0 = (t / nn) * GBM; c.col0 = (t % nn) * GBN; return true; }
    __device__ void loadA(const Ctx& c, int r, int k, float* a) const { load_mix16(x, mix, c.row0 + r, k, a); }
    __device__ const float* Bptr(const Ctx& c, int) const { return W + c.col0; }
    __device__ void epi(const Ctx& c, int r, int cc, float v, float) const {
        const int row = c.row0 + r, col = c.col0 + cc;
        if (act == 0) outb[(size_t)row * D + col] = (bf16)f2bf(v);
        else { float o = v; if (act == 1) o = tanhf(v); else if (act == 3) o = sigmoidf_(v); outf[(size_t)row * ldo + ooff + col] = o; }
    }
};
struct PLora2 {
    static constexpr bool DUAL = false; typedef Ctx2 Ctx;
    const float* L1; const float* W; const float* bias; float* outf; bf16* outb;
    int K, ldb, aoff, mode;
    __device__ int ntiles() const { return (M / GBM) * (D / GBN); }
    __device__ bool setup(int t, Ctx& c) const { const int nn = D / GBN; c.row0 = (t / nn) * GBM; c.col0 = (t % nn) * GBN; return true; }
    __device__ void loadA(const Ctx& c, int r, int k, float* a) const {
        const float* s = L1 + (size_t)(c.row0 + r) * 256 + aoff + k;
#pragma unroll
        for (int q = 0; q < 4; ++q) { const f32x4 v = *(const f32x4*)(s + 4 * q); a[4 * q] = v.x; a[4 * q + 1] = v.y; a[4 * q + 2] = v.z; a[4 * q + 3] = v.w; }
    }
    __device__ const float* Bptr(const Ctx& c, int) const { return W + c.col0; }
    __device__ void epi(const Ctx& c, int r, int cc, float v, float) const {
        const int row = c.row0 + r, col = c.col0 + cc; const size_t o = (size_t)row * D + col;
        if (mode == 0) { const float z = bias[col] + v; const float wv = -softplusf_(-z) - 0.5f; outf[o] = -__expf(wv); }
        else if (mode == 1) outb[o] = (bf16)f2bf(sigmoidf_(bias[col] + v));
        else outb[o] = (bf16)f2bf(v);
    }
};
struct PProj {
    static constexpr bool DUAL = false; typedef Ctx2 Ctx;
    const bf16* A; const float* W; const float* hin; float* outf; bf16* q; bf16* k; bf16* v;
    int K, ldb, N, mode;
    __device__ int ntiles() const { return (M / GBM) * (N / GBN); }
    __device__ bool setup(int t, Ctx& c) const { const int nn = N / GBN; c.row0 = (t / nn) * GBM; c.col0 = (t % nn) * GBN; return true; }
    __device__ void loadA(const Ctx& c, int r, int kk, float* a) const { load_bf16_16(A + (size_t)(c.row0 + r) * K + kk, a); }
    __device__ const float* Bptr(const Ctx& c, int) const { return W + c.col0; }
    __device__ void epi(const Ctx& c, int r, int cc, float val, float) const {
        const int row = c.row0 + r, col = c.col0 + cc;
        if (mode == 0) { const size_t o = (size_t)row * D + col; outf[o] = ALPHA * hin[o] + val; }
        else { bf16* dst = col < D ? q : (col < 2 * D ? k : v); dst[(size_t)row * D + (col & (D - 1))] = (bf16)f2bf(val); }
    }
};
struct MoeCtx { int e, r0, nvalid, crow0, col0; };
__device__ __forceinline__ bool moe_map(const int* counts, int rtile, MoeCtx& m) {
    int acc = 0;
    for (int e = 0; e < NE; ++e) {
        const int c = counts[e], nt = (c + 127) >> 7;
        if (rtile < acc + nt) { m.e = e; m.r0 = (rtile - acc) * 128; m.nvalid = min(128, c - m.r0); m.crow0 = rtile * 128; return true; }
        acc += nt;
    }
    return false;
}
constexpr int MAXRT = 272;
struct PMoeGU {
    static constexpr bool DUAL = true; typedef MoeCtx Ctx;
    const bf16* hb; const int* rtok; const int* counts; const float* wg; const float* wu; bf16* hid;
    int K, ldb;
    __device__ int ntiles() const { return MAXRT * (DE / GBN); }
    __device__ bool setup(int t, Ctx& c) const { const int nn = DE / GBN; c.col0 = (t % nn) * GBN; return moe_map(counts, t / nn, c); }
    __device__ void loadA(const Ctx& c, int r, int kk, float* a) const {
        if (r < c.nvalid) { const int tok = rtok[c.e * CAP + c.r0 + r]; load_bf16_16(hb + (size_t)tok * D + kk, a); }
        else {
#pragma unroll
            for (int i = 0; i < 16; ++i) a[i] = 0.f;
        }
    }
    __device__ const float* Bptr(const Ctx& c, int d) const { return (d == 0 ? wg : wu) + (size_t)c.e * D * DE + c.col0; }
    __device__ void epi(const Ctx& c, int r, int cc, float g, float u) const {
        const float hval = (g * sigmoidf_(g)) * u;
        hid[(size_t)(c.crow0 + r) * DE + c.col0 + cc] = (bf16)f2bf(hval);
    }
};
struct PMoeDN {
    static constexpr bool DUAL = false; typedef MoeCtx Ctx;
    const bf16* hid; const float* rgate; const int* counts; const float* wd; bf16* y;
    int K, ldb;
    __device__ int ntiles() const { return MAXRT * (D / GBN); }
    __device__ bool setup(int t, Ctx& c) const { const int nn = D / GBN; c.col0 = (t % nn) * GBN; return moe_map(counts, t / nn, c); }
    __device__ void loadA(const Ctx& c, int r, int kk, float* a) const { load_bf16_16(hid + (size_t)(c.crow0 + r) * DE + kk, a); }
    __device__ const float* Bptr(const Ctx& c, int) const { return wd + (size_t)c.e * DE * D + c.col0; }
    __device__ void epi(const Ctx& c, int r, int cc, float v, float) const {
        if (r < c.nvalid) { const float gt = rgate[c.e * CAP + c.r0 + r]; y[(size_t)(c.crow0 + r) * D + c.col0 + cc] = (bf16)f2bf(gt * v); }
    }
};

__device__ __forceinline__ void ln_rows(f32x4 (&v)[4], const float* g, const float* b, int lane) {
    float s = 0.f;
#pragma unroll
    for (int j = 0; j < 4; ++j) s += (v[j].x + v[j].y) + (v[j].z + v[j].w);
    const float mean = wave_sum(s) * (1.f / D);
    float s2 = 0.f;
#pragma unroll
    for (int j = 0; j < 4; ++j) { v[j] = v[j] - mean; s2 += (v[j].x * v[j].x + v[j].y * v[j].y) + (v[j].z * v[j].z + v[j].w * v[j].w); }
    const float rstd = rsqrtf(wave_sum(s2) * (1.f / D) + LN_EPS);
#pragma unroll
    for (int j = 0; j < 4; ++j) {
        const f32x4 gg = *(const f32x4*)(g + 4 * lane + 256 * j), bb = *(const f32x4*)(b + 4 * lane + 256 * j);
        v[j] = v[j] * rstd * gg + bb;
    }
}
__device__ __forceinline__ void row_dot16(const f32x4 (&v)[4], const float* Wm, int ldw, int lane, float (&out)[16]) {
#pragma unroll
    for (int e = 0; e < 16; ++e) out[e] = 0.f;
#pragma unroll
    for (int j = 0; j < 4; ++j) {
        const float vv[4] = {v[j].x, v[j].y, v[j].z, v[j].w};
#pragma unroll
        for (int q = 0; q < 4; ++q) {
            const float* wr = Wm + (size_t)(4 * lane + 256 * j + q) * ldw;
#pragma unroll
            for (int e4 = 0; e4 < 4; ++e4) {
                const f32x4 w4 = *(const f32x4*)(wr + 4 * e4);
                out[4 * e4 + 0] += vv[q] * w4.x; out[4 * e4 + 1] += vv[q] * w4.y; out[4 * e4 + 2] += vv[q] * w4.z; out[4 * e4 + 3] += vv[q] * w4.w;
            }
        }
    }
#pragma unroll
    for (int e = 0; e < 16; ++e) out[e] = wave_sum(out[e]);
}
__device__ __forceinline__ void store_row(f32x4 (&v)[4], float* hrow, bf16* hbrow, int lane) {
#pragma unroll
    for (int j = 0; j < 4; ++j) {
        *(f32x4*)(hrow + 4 * lane + 256 * j) = v[j];
        u32x2 o; o.x = pk2(v[j].x, v[j].y); o.y = pk2(v[j].z, v[j].w);
        *(u32x2*)(hbrow + 4 * lane + 256 * j) = o;
    }
}

struct LnRouteP { float* h; bf16* hb; const float* g; const float* b; const float* rw; const float* rbias; int* counts; int* rtok; float* rgate; int* slot; };
__global__ void __launch_bounds__(512) k_ln_route(LnRouteP p) {
    const int lane = threadIdx.x & 63, wv = threadIdx.x >> 6;
    for (int tok = blockIdx.x * 8 + wv; tok < M; tok += gridDim.x * 8) {
        float* hrow = p.h + (size_t)tok * D;
        f32x4 v[4];
#pragma unroll
        for (int j = 0; j < 4; ++j) v[j] = *(const f32x4*)(hrow + 4 * lane + 256 * j);
        ln_rows(v, p.g, p.b, lane);
        store_row(v, hrow, p.hb + (size_t)tok * D, lane);
        float lg[16];
        row_dot16(v, p.rw, NE, lane, lg);
        float s[16], ss[16];
#pragma unroll
        for (int e = 0; e < 16; ++e) { s[e] = sigmoidf_(lg[e]); ss[e] = s[e] + p.rbias[e]; }
        int gbest = 0; float gscore = -INFINITY; int l1b = 0, l2b = 1;
#pragma unroll
        for (int g = 0; g < 4; ++g) {
            float v1 = ss[4 * g], v2 = -INFINITY; int i1 = 0, i2 = -1;
#pragma unroll
            for (int i = 1; i < 4; ++i) {
                const float x = ss[4 * g + i];
                if (x > v1) { v2 = v1; i2 = i1; v1 = x; i1 = i; }
                else if (x > v2) { v2 = x; i2 = i; }
            }
            const float sc = v1 + v2;
            if (sc > gscore) { gscore = sc; gbest = g; l1b = i1; l2b = i2; }
        }
        const int e0 = 4 * gbest + l1b, e1 = 4 * gbest + l2b;
        float s0 = 0.f, s1 = 0.f;
#pragma unroll
        for (int e = 0; e < 16; ++e) { s0 = (e == e0) ? s[e] : s0; s1 = (e == e1) ? s[e] : s1; }
        const float inv = 1.0f / (s0 + s1);
        if (lane == 0) {
            const int r0 = atomicAdd(p.counts + e0, 1), r1 = atomicAdd(p.counts + e1, 1);
            p.rtok[e0 * CAP + r0] = tok; p.rgate[e0 * CAP + r0] = s0 * inv;
            p.rtok[e1 * CAP + r1] = tok; p.rgate[e1 * CAP + r1] = s1 * inv;
            p.slot[2 * tok] = e0 * CAP + r0; p.slot[2 * tok + 1] = e1 * CAP + r1;
        }
    }
}

struct LnCombP { float* h; bf16* hb; const bf16* y; const int* slot; const int* counts; const float* g; const float* b; const float* wf; const float* bf; float* logf; float* outp; int do_f; int pad; };
__global__ void __launch_bounds__(512) k_ln_comb(LnCombP p) {
    const int lane = threadIdx.x & 63, wv = threadIdx.x >> 6;
    __shared__ int pstart[NE];
    if (threadIdx.x == 0) { int acc = 0; for (int e = 0; e < NE; ++e) { pstart[e] = acc; acc += ((p.counts[e] + 127) >> 7) * 128; } }
    __syncthreads();
    for (int tok = blockIdx.x * 8 + wv; tok < M; tok += gridDim.x * 8) {
        const int sl0 = p.slot[2 * tok], sl1 = p.slot[2 * tok + 1];
        const int c0 = pstart[sl0 / CAP] + (sl0 % CAP), c1 = pstart[sl1 / CAP] + (sl1 % CAP);
        const float* hrow = p.h + (size_t)tok * D;
        const bf16* y0 = p.y + (size_t)c0 * D; const bf16* y1 = p.y + (size_t)c1 * D;
        f32x4 v[4];
#pragma unroll
        for (int j = 0; j < 4; ++j) {
            const f32x4 hv = *(const f32x4*)(hrow + 4 * lane + 256 * j);
            const u32x2 a = *(const u32x2*)(y0 + 4 * lane + 256 * j), bq = *(const u32x2*)(y1 + 4 * lane + 256 * j);
            v[j].x = ALPHA * hv.x + (bf2f(a.x & 0xffff) + bf2f(bq.x & 0xffff));
            v[j].y = ALPHA * hv.y + (bf2f(a.x >> 16) + bf2f(bq.x >> 16));
            v[j].z = ALPHA * hv.z + (bf2f(a.y & 0xffff) + bf2f(bq.y & 0xffff));
            v[j].w = ALPHA * hv.w + (bf2f(a.y >> 16) + bf2f(bq.y >> 16));
        }
        ln_rows(v, p.g, p.b, lane);
        store_row(v, p.outp + (size_t)tok * D, p.hb + (size_t)tok * D, lane);
        if (p.do_f) {
            float f[16];
            row_dot16(v, p.wf, NW_IN, lane, f);
            if (lane < 16) {
                float fv = 0.f;
#pragma unroll
                for (int e = 0; e < 16; ++e) fv = (e == lane) ? f[e] : fv;
                p.logf[(size_t)tok * 16 + lane] = -softplusf_(-(fv + p.bf[lane]));
            }
        }
    }
}

struct ScanP { const bf16* r; const bf16* k; const bf16* v; const float* lw; const bf16* a; const bf16* g; bf16* yg;
               const float* kk; const float* ka; const float* rk; const float* gng; const float* gnb; };
__global__ void __launch_bounds__(512) k_scan(ScanP p) {
    __shared__ __attribute__((aligned(16))) float s_r[32][64], s_kk[32][64], s_b[32][64], s_w[32][64], s_k[32][64], s_v[32][64], s_y[32][64];
    __shared__ float s_bonus[32];
    const int tid = threadIdx.x;
    const int i = tid >> 3, jq = tid & 7;
    const int lt = tid >> 4, c4 = (tid & 15) * 4;
    for (int unit = blockIdx.x; unit < NB * H; unit += gridDim.x) {
        const int b = unit / H, h = unit % H;
        float S[8];
#pragma unroll
        for (int j = 0; j < 8; ++j) S[j] = 0.f;
        const f32x4 kkp = *(const f32x4*)(p.kk + h * HD + c4), kap = *(const f32x4*)(p.ka + h * HD + c4), rkp = *(const f32x4*)(p.rk + h * HD + c4);
        const f32x4 gng = *(const f32x4*)(p.gng + h * HD + c4), gnb = *(const f32x4*)(p.gnb + h * HD + c4);
        for (int blk = 0; blk < T / 32; ++blk) {
            const size_t base = (size_t)(b * T + blk * 32 + lt) * D + h * HD + c4;
            {
                const u32x2 r2 = *(const u32x2*)(p.r + base), k2 = *(const u32x2*)(p.k + base), v2 = *(const u32x2*)(p.v + base), a2 = *(const u32x2*)(p.a + base);
                const f32x4 lw4 = *(const f32x4*)(p.lw + base);
                const f32x4 rr = {bf2f(r2.x & 0xffff), bf2f(r2.x >> 16), bf2f(r2.y & 0xffff), bf2f(r2.y >> 16)};
                const f32x4 kr = {bf2f(k2.x & 0xffff), bf2f(k2.x >> 16), bf2f(k2.y & 0xffff), bf2f(k2.y >> 16)};
                const f32x4 vv = {bf2f(v2.x & 0xffff), bf2f(v2.x >> 16), bf2f(v2.y & 0xffff), bf2f(v2.y >> 16)};
                const f32x4 aa = {bf2f(a2.x & 0xffff), bf2f(a2.x >> 16), bf2f(a2.y & 0xffff), bf2f(a2.y >> 16)};
                const f32x4 kkn = kr * kkp;
                float ss = (kkn.x * kkn.x + kkn.y * kkn.y) + (kkn.z * kkn.z + kkn.w * kkn.w);
                ss += __shfl_xor(ss, 1); ss += __shfl_xor(ss, 2); ss += __shfl_xor(ss, 4); ss += __shfl_xor(ss, 8);
                const float inv = 1.0f / fmaxf(sqrtf(ss), 1e-12f);
                const f32x4 kkv = kkn * inv;
                const f32x4 km = kr * (1.0f + (aa - 1.0f) * kap);
                const f32x4 bb = kkv * aa;
                f32x4 wd; wd.x = __expf(lw4.x); wd.y = __expf(lw4.y); wd.z = __expf(lw4.z); wd.w = __expf(lw4.w);
                const f32x4 bt = rr * km * rkp;
                float bo = (bt.x + bt.y) + (bt.z + bt.w);
                bo += __shfl_xor(bo, 1); bo += __shfl_xor(bo, 2); bo += __shfl_xor(bo, 4); bo += __shfl_xor(bo, 8);
                *(f32x4*)&s_r[lt][c4] = rr; *(f32x4*)&s_kk[lt][c4] = kkv; *(f32x4*)&s_b[lt][c4] = bb; *(f32x4*)&s_w[lt][c4] = wd;
                *(f32x4*)&s_k[lt][c4] = km; *(f32x4*)&s_v[lt][c4] = vv;
                if ((tid & 15) == 0) s_bonus[lt] = bo;
            }
            __syncthreads();
            for (int tt = 0; tt < 32; ++tt) {
                const f32x4 k0 = *(const f32x4*)&s_kk[tt][8 * jq], k1 = *(const f32x4*)&s_kk[tt][8 * jq + 4];
                const f32x4 w0 = *(const f32x4*)&s_w[tt][8 * jq], w1 = *(const f32x4*)&s_w[tt][8 * jq + 4];
                const f32x4 b0 = *(const f32x4*)&s_b[tt][8 * jq], b1 = *(const f32x4*)&s_b[tt][8 * jq + 4];
                const f32x4 q0 = *(const f32x4*)&s_k[tt][8 * jq], q1 = *(const f32x4*)&s_k[tt][8 * jq + 4];
                const f32x4 r0 = *(const f32x4*)&s_r[tt][8 * jq], r1 = *(const f32x4*)&s_r[tt][8 * jq + 4];
                const float vi = s_v[tt][i];
                float sa = (S[0] * k0.x + S[1] * k0.y) + (S[2] * k0.z + S[3] * k0.w) + (S[4] * k1.x + S[5] * k1.y) + (S[6] * k1.z + S[7] * k1.w);
                sa += __shfl_xor(sa, 1); sa += __shfl_xor(sa, 2); sa += __shfl_xor(sa, 4);
                S[0] = S[0] * w0.x - sa * b0.x + vi * q0.x; S[1] = S[1] * w0.y - sa * b0.y + vi * q0.y;
                S[2] = S[2] * w0.z - sa * b0.z + vi * q0.z; S[3] = S[3] * w0.w - sa * b0.w + vi * q0.w;
                S[4] = S[4] * w1.x - sa * b1.x + vi * q1.x; S[5] = S[5] * w1.y - sa * b1.y + vi * q1.y;
                S[6] = S[6] * w1.z - sa * b1.z + vi * q1.z; S[7] = S[7] * w1.w - sa * b1.w + vi * q1.w;
                float y = (S[0] * r0.x + S[1] * r0.y) + (S[2] * r0.z + S[3] * r0.w) + (S[4] * r1.x + S[5] * r1.y) + (S[6] * r1.z + S[7] * r1.w);
                y += __shfl_xor(y, 1); y += __shfl_xor(y, 2); y += __shfl_xor(y, 4);
                if (jq == 0) s_y[tt][i] = y;
            }
            __syncthreads();
            {
                const f32x4 y4 = *(const f32x4*)&s_y[lt][c4];
                float sm = (y4.x + y4.y) + (y4.z + y4.w);
                sm += __shfl_xor(sm, 1); sm += __shfl_xor(sm, 2); sm += __shfl_xor(sm, 4); sm += __shfl_xor(sm, 8);
                const float mu = sm * (1.f / 64.f);
                const f32x4 dd = y4 - mu;
                float vs = (dd.x * dd.x + dd.y * dd.y) + (dd.z * dd.z + dd.w * dd.w);
                vs += __shfl_xor(vs, 1); vs += __shfl_xor(vs, 2); vs += __shfl_xor(vs, 4); vs += __shfl_xor(vs, 8);
                const float rstd = rsqrtf(vs * (1.f / 64.f) + GN_EPS);
                const f32x4 vv = *(const f32x4*)&s_v[lt][c4];
                const float bo = s_bonus[lt];
                const u32x2 g2 = *(const u32x2*)(p.g + base);
                const f32x4 gg = {bf2f(g2.x & 0xffff), bf2f(g2.x >> 16), bf2f(g2.y & 0xffff), bf2f(g2.y >> 16)};
                const f32x4 o = (dd * rstd * gng + gnb + bo * vv) * gg;
                u32x2 ob; ob.x = pk2(o.x, o.y); ob.y = pk2(o.z, o.w);
                *(u32x2*)(p.yg + base) = ob;
            }
            __syncthreads();
        }
    }
}

__global__ void __launch_bounds__(512) k_cumsum(const float* logf, float* cum) {
    const int lane = threadIdx.x & 63, wv = threadIdx.x >> 6;
    for (int seq = blockIdx.x * 8 + wv; seq < NB * H; seq += gridDim.x * 8) {
        const int b = seq / H, h = seq % H;
        float loc[32]; float run = 0.f;
#pragma unroll
        for (int q = 0; q < 32; ++q) { run += logf[(size_t)(b * T + lane * 32 + q) * 16 + h]; loc[q] = run; }
        float incl = run;
#pragma unroll
        for (int o = 1; o < 64; o <<= 1) { const float t = __shfl_up(incl, o); if (lane >= o) incl += t; }
        const float excl = incl - run;
#pragma unroll
        for (int q = 0; q < 32; ++q) cum[(size_t)(b * T + lane * 32 + q) * 16 + h] = excl + loc[q];
    }
}
struct AttnP { const bf16* q; const bf16* k; const bf16* v; const float* cum; bf16* o; };
__global__ void __launch_bounds__(512) k_attn(AttnP p) {
    __shared__ __attribute__((aligned(16))) float sK[64][64], sV[64][64];
    __shared__ float sC[64];
    const int tid = threadIdx.x;
    for (int unit = blockIdx.x; unit < NB * H * 4; unit += gridDim.x) {
        const int qblk = 3 - (unit / (NB * H)), bh = unit % (NB * H), b = bh / H, h = bh % H;
        const int qpos = qblk * 512 + tid;
        const size_t qrow = (size_t)(b * T + qpos);
        float q[64], o[64];
        {
            const bf16* qp = p.q + qrow * D + h * HD;
#pragma unroll
            for (int c = 0; c < 8; ++c) {
                const u32x4 v4 = *(const u32x4*)(qp + 8 * c);
                const float sc = 0.125f * LOG2E;
                q[8 * c + 0] = bf2f(v4.x & 0xffff) * sc; q[8 * c + 1] = bf2f(v4.x >> 16) * sc; q[8 * c + 2] = bf2f(v4.y & 0xffff) * sc; q[8 * c + 3] = bf2f(v4.y >> 16) * sc;
                q[8 * c + 4] = bf2f(v4.z & 0xffff) * sc; q[8 * c + 5] = bf2f(v4.z >> 16) * sc; q[8 * c + 6] = bf2f(v4.w & 0xffff) * sc; q[8 * c + 7] = bf2f(v4.w >> 16) * sc;
            }
        }
#pragma unroll
        for (int d = 0; d < 64; ++d) o[d] = 0.f;
        const float ci = p.cum[qrow * 16 + h] * LOG2E;
        float mrun = -INFINITY, lrun = 0.f;
        const int wave_qmax = qblk * 512 + (tid | 63);
        const int ntile = (qblk * 512 + 512) / 64;
        for (int kt = 0; kt < ntile; ++kt) {
            __syncthreads();
            {
                const int kr = tid >> 3, d8 = (tid & 7) * 8;
                const size_t krow = (size_t)(b * T + kt * 64 + kr);
                const u32x4 k4 = *(const u32x4*)(p.k + krow * D + h * HD + d8), v4 = *(const u32x4*)(p.v + krow * D + h * HD + d8);
                float* kd = &sK[kr][d8]; float* vd = &sV[kr][d8];
                kd[0] = bf2f(k4.x & 0xffff); kd[1] = bf2f(k4.x >> 16); kd[2] = bf2f(k4.y & 0xffff); kd[3] = bf2f(k4.y >> 16);
                kd[4] = bf2f(k4.z & 0xffff); kd[5] = bf2f(k4.z >> 16); kd[6] = bf2f(k4.w & 0xffff); kd[7] = bf2f(k4.w >> 16);
                vd[0] = bf2f(v4.x & 0xffff); vd[1] = bf2f(v4.x >> 16); vd[2] = bf2f(v4.y & 0xffff); vd[3] = bf2f(v4.y >> 16);
                vd[4] = bf2f(v4.z & 0xffff); vd[5] = bf2f(v4.z >> 16); vd[6] = bf2f(v4.w & 0xffff); vd[7] = bf2f(v4.w >> 16);
                if (tid < 64) sC[tid] = p.cum[(size_t)(b * T + kt * 64 + tid) * 16 + h] * LOG2E;
            }
            __syncthreads();
            if (kt * 64 > wave_qmax) continue;
            for (int j = 0; j < 64; ++j) {
                float s0 = 0.f, s1 = 0.f, s2 = 0.f, s3 = 0.f;
#pragma unroll
                for (int d = 0; d < 64; d += 4) {
                    const f32x4 kk = *(const f32x4*)&sK[j][d];
                    s0 += q[d] * kk.x; s1 += q[d + 1] * kk.y; s2 += q[d + 2] * kk.z; s3 += q[d + 3] * kk.w;
                }
                float s = ((s0 + s1) + (s2 + s3)) + (ci - sC[j]);
                if (kt * 64 + j > qpos) s = -INFINITY;
                const float mn = fmaxf(mrun, s);
                const float al = exp2f(mrun - mn), pj = exp2f(s - mn);
                mrun = mn; lrun = lrun * al + pj;
#pragma unroll
                for (int d = 0; d < 64; d += 4) {
                    const f32x4 vv = *(const f32x4*)&sV[j][d];
                    o[d] = o[d] * al + pj * vv.x; o[d + 1] = o[d + 1] * al + pj * vv.y; o[d + 2] = o[d + 2] * al + pj * vv.z; o[d + 3] = o[d + 3] * al + pj * vv.w;
                }
            }
        }
        const float il = 1.0f / lrun;
        bf16* op = p.o + qrow * D + h * HD;
#pragma unroll
        for (int c = 0; c < 8; ++c) {
            u32x4 w; w.x = pk2(o[8 * c] * il, o[8 * c + 1] * il); w.y = pk2(o[8 * c + 2] * il, o[8 * c + 3] * il);
            w.z = pk2(o[8 * c + 4] * il, o[8 * c + 5] * il); w.w = pk2(o[8 * c + 6] * il, o[8 * c + 7] * il);
            *(u32x4*)(op + 8 * c) = w;
        }
    }
}

enum { I_X = 0, I_MIX, I_WR, I_WK, I_WV, I_WO, I_W0, I_W1, I_W2, I_A0, I_A1, I_A2, I_G1, I_G2, I_KK, I_KA, I_RK, I_GNG, I_GNB,
       I_FWIN, I_FBF, I_FWO, I_RW, I_RB, I_MG, I_MU, I_MD, I_LNG, I_LNB, N_IN };

extern "C" void kernel_launch(void* const* d_in, const int* in_sizes, int n_in, void* d_out, int out_size, void* d_ws, size_t ws_size, hipStream_t stream) {
    if (n_in != N_IN || out_size != M * D || ws_size < WS_END) { fprintf(stderr, "kernel_launch: unexpected problem (n_in %d out %d ws %zu)\n", n_in, out_size, ws_size); return; }
    const float* in[N_IN];
    for (int i = 0; i < N_IN; ++i) in[i] = (const float*)d_in[i];
    char* ws = (char*)d_ws;
    float* hbuf = (float*)d_out;
    int* counts0 = (int*)(ws + WS_CTL); int* counts1 = counts0 + 16;
    int* rtok = (int*)(ws + WS_RTOK); float* rgate = (float*)(ws + WS_RGATE); int* slot = (int*)(ws + WS_SLOT);
    bf16* HB = (bf16*)(ws + WS_HB); bf16* R = (bf16*)(ws + WS_R); bf16* KB = (bf16*)(ws + WS_K); bf16* VB = (bf16*)(ws + WS_V);
    float* LW = (float*)(ws + WS_LW); bf16* AA = (bf16*)(ws + WS_AA); bf16* G = (bf16*)(ws + WS_G); float* L1 = (float*)(ws + WS_L1);
    float* LOGF = (float*)(ws + WS_LOGF); float* CUM = (float*)(ws + WS_CUM); bf16* Y = (bf16*)(ws + WS_Y); bf16* HID = (bf16*)(ws + WS_HID);
    (void)hipMemsetAsync(ws + WS_CTL, 0, CTL_BYTES, stream);
    const dim3 grid(1024), blk(512);
    for (int j = 0; j < 3; ++j) {
        PMix p{}; p.x = in[I_X]; p.mix = in[I_MIX] + (j == 0 ? 0 : (j == 1 ? 2 : 3)) * D; p.W = in[j == 0 ? I_WR : (j == 1 ? I_WK : I_WV)];
        p.outb = j == 0 ? R : (j == 1 ? KB : VB); p.outf = nullptr; p.K = D; p.ldb = D; p.N = D; p.act = 0; p.ldo = 0; p.ooff = 0;
        hipLaunchKernelGGL(k_gemm<PMix>, grid, blk, 0, stream, p);
    }
    {
        PMix p{}; p.x = in[I_X]; p.outb = nullptr; p.outf = L1; p.K = D; p.ldo = 256;
        p.mix = in[I_MIX] + 1 * D; p.W = in[I_W1]; p.ldb = 64; p.N = 64; p.act = 1; p.ooff = 0; hipLaunchKernelGGL(k_gemm<PMix>, grid, blk, 0, stream, p);
        p.mix = in[I_MIX] + 4 * D; p.W = in[I_A1]; p.ldb = 64; p.N = 64; p.act = 2; p.ooff = 64; hipLaunchKernelGGL(k_gemm<PMix>, grid, blk, 0, stream, p);
        p.mix = in[I_MIX] + 5 * D; p.W = in[I_G1]; p.ldb = 128; p.N = 128; p.act = 3; p.ooff = 128; hipLaunchKernelGGL(k_gemm<PMix>, grid, blk, 0, stream, p);
    }
    {
        PLora2 p{}; p.L1 = L1; p.ldb = D;
        p.W = in[I_W2]; p.bias = in[I_W0]; p.outf = LW; p.outb = nullptr; p.K = 64; p.aoff = 0; p.mode = 0; hipLaunchKernelGGL(k_gemm<PLora2>, grid, blk, 0, stream, p);
        p.W = in[I_A2]; p.bias = in[I_A0]; p.outf = nullptr; p.outb = AA; p.K = 64; p.aoff = 64; p.mode = 1; hipLaunchKernelGGL(k_gemm<PLora2>, grid, blk, 0, stream, p);
        p.W = in[I_G2]; p.bias = nullptr; p.outf = nullptr; p.outb = G; p.K = 128; p.aoff = 128; p.mode = 2; hipLaunchKernelGGL(k_gemm<PLora2>, grid, blk, 0, stream, p);
    }
    {   ScanP p{}; p.r = R; p.k = KB; p.v = VB; p.lw = LW; p.a = AA; p.g = G; p.yg = R; p.kk = in[I_KK]; p.ka = in[I_KA]; p.rk = in[I_RK]; p.gng = in[I_GNG]; p.gnb = in[I_GNB];
        hipLaunchKernelGGL(k_scan, dim3(NB * H), blk, 0, stream, p); }
    {   PProj p{}; p.A = R; p.W = in[I_WO]; p.hin = in[I_X]; p.outf = hbuf; p.q = p.k = p.v = nullptr; p.K = D; p.ldb = D; p.N = D; p.mode = 0;
        hipLaunchKernelGGL(k_gemm<PProj>, grid, blk, 0, stream, p); }
    for (int layer = 0; layer < 2; ++layer) {
        if (layer == 1) {
            {   PProj p{}; p.A = HB; p.W = in[I_FWIN]; p.hin = nullptr; p.outf = nullptr; p.q = R; p.k = KB; p.v = VB; p.K = D; p.ldb = NW_IN; p.N = 3 * D; p.mode = 1;
                hipLaunchKernelGGL(k_gemm<PProj>, grid, blk, 0, stream, p); }
            hipLaunchKernelGGL(k_cumsum, dim3(16), blk, 0, stream, (const float*)LOGF, CUM);
            {   AttnP p{}; p.q = R; p.k = KB; p.v = VB; p.cum = CUM; p.o = R; hipLaunchKernelGGL(k_attn, dim3(512), blk, 0, stream, p); }
            {   PProj p{}; p.A = R; p.W = in[I_FWO]; p.hin = hbuf; p.outf = hbuf; p.q = p.k = p.v = nullptr; p.K = D; p.ldb = D; p.N = D; p.mode = 0;
                hipLaunchKernelGGL(k_gemm<PProj>, grid, blk, 0, stream, p); }
        }
        int* counts = layer == 0 ? counts0 : counts1;
        {   LnRouteP p{}; p.h = hbuf; p.hb = HB; p.g = in[I_LNG] + (layer * 2 + 0) * D; p.b = in[I_LNB] + (layer * 2 + 0) * D; p.rw = in[I_RW]; p.rbias = in[I_RB];
            p.counts = counts; p.rtok = rtok; p.rgate = rgate; p.slot = slot;
            hipLaunchKernelGGL(k_ln_route, grid, blk, 0, stream, p); }
        {   PMoeGU p{}; p.hb = HB; p.rtok = rtok; p.counts = counts; p.wg = in[I_MG] + (size_t)layer * NE * D * DE; p.wu = in[I_MU] + (size_t)layer * NE * D * DE; p.hid = HID; p.K = D; p.ldb = DE;
            hipLaunchKernelGGL(k_gemm<PMoeGU>, grid, blk, 0, stream, p); }
        {   PMoeDN p{}; p.hid = HID; p.rgate = rgate; p.counts = counts; p.wd = in[I_MD] + (size_t)layer * NE * DE * D; p.y = Y; p.K = DE; p.ldb = D;
            hipLaunchKernelGGL(k_gemm<PMoeDN>, grid, blk, 0, stream, p); }
        {   LnCombP p{}; p.h = hbuf; p.hb = HB; p.y = Y; p.slot = slot; p.counts = counts; p.g = in[I_LNG] + (layer * 2 + 1) * D; p.b = in[I_LNB] + (layer * 2 + 1) * D;
            p.wf = in[I_FWIN] + 3 * D; p.bf = in[I_FBF]; p.logf = LOGF; p.outp = hbuf; p.do_f = (layer == 0) ? 1 : 0; p.pad = 0;
            hipLaunchKernelGGL(k_ln_comb, grid, blk, 0, stream, p); }
    }
}
```

```cpp
#include <hip/hip_runtime.h>
#include <stdint.h>
#include <stdio.h>

typedef unsigned short bf16;
typedef short bf16x8 __attribute__((ext_vector_type(8)));
typedef float f32x4 __attribute__((ext_vector_type(4)));
typedef unsigned u32x4 __attribute__((ext_vector_type(4)));
typedef unsigned u32x2 __attribute__((ext_vector_type(2)));

constexpr int NB = 8, T = 2048, D = 1024, H = 16, HD = 64, M = NB * T;
constexpr int NE = 16, DE = 512, CAP = 16384, MAXROWS = 36864;
constexpr int NW_IN = 3 * D + H;
constexpr float ALPHA = 1.4142135623730951f;
constexpr float LN_EPS = 1e-5f, GN_EPS = 64e-5f;
constexpr float LOG2E = 1.4426950408889634f;

constexpr size_t MiB = 1u << 20;
constexpr size_t WS_CTL = 0;
constexpr size_t CTL_BYTES = 65536;
constexpr size_t WS_RTOK = 1 * MiB;
constexpr size_t WS_RGATE = 2 * MiB;
constexpr size_t WS_SLOT = 3 * MiB;
constexpr size_t WS_HB = 4 * MiB;
constexpr size_t WS_R = 36 * MiB;
constexpr size_t WS_K = 68 * MiB;
constexpr size_t WS_V = 100 * MiB;
constexpr size_t WS_LW = 132 * MiB;
constexpr size_t WS_AA = 196 * MiB;
constexpr size_t WS_G = 228 * MiB;
constexpr size_t WS_L1 = 260 * MiB;
constexpr size_t WS_LOGF = 276 * MiB;
constexpr size_t WS_CUM = 277 * MiB;
constexpr size_t WS_END = 278 * MiB;
constexpr size_t WS_Y = 36 * MiB;
constexpr size_t WS_HID = 132 * MiB;

__device__ __forceinline__ unsigned f2bf(float f) { unsigned u = __float_as_uint(f); return (u + 0x7fffu + ((u >> 16) & 1u)) >> 16; }
__device__ __forceinline__ float bf2f(unsigned b) { return __uint_as_float(b << 16); }
__device__ __forceinline__ unsigned pk2(float lo, float hi) { return f2bf(lo) | (f2bf(hi) << 16); }
__device__ __forceinline__ float sigmoidf_(float x) { return 1.0f / (1.0f + __expf(-x)); }
__device__ __forceinline__ float softplusf_(float x) { return fmaxf(x, 0.f) + log1pf(__expf(-fabsf(x))); }
__device__ __forceinline__ float wave_sum(float v) {
#pragma unroll
    for (int o = 1; o < 64; o <<= 1) v += __shfl_xor(v, o);
    return v;
}

__device__ __forceinline__ int opaque_tid() { int t = threadIdx.x; asm volatile("" : "+v"(t)); return t; }

constexpr int GBM = 128, GBN = 64, GBK = 64, GLD = 72;

template <class P>
__device__ __forceinline__ void gemm_run(const P& p, unsigned char* lds) {
    bf16* sA = (bf16*)lds;
    bf16* sB = sA + GBM * GLD;
    const int tid = opaque_tid(), lane = tid & 63, w = tid >> 6, fr = lane & 15, fq = lane >> 4;
    const int ntl = p.ntiles();
    for (int tile = blockIdx.x; tile < ntl; tile += gridDim.x) {
        typename P::Ctx c;
        if (!p.setup(tile, c)) continue;
        f32x4 acc[2][4];
#pragma unroll
        for (int d = 0; d < 2; ++d)
#pragma unroll
            for (int n = 0; n < 4; ++n) acc[d][n] = (f32x4){0.f, 0.f, 0.f, 0.f};
        const int K = p.K;
        for (int k0 = 0; k0 < K; k0 += GBK) {
            {
                const int r = tid >> 2, ks = (tid & 3) * 16;
                float a[16];
                p.loadA(c, r, k0 + ks, a);
                u32x4 lo, hi;
                lo.x = pk2(a[0], a[1]); lo.y = pk2(a[2], a[3]); lo.z = pk2(a[4], a[5]); lo.w = pk2(a[6], a[7]);
                hi.x = pk2(a[8], a[9]); hi.y = pk2(a[10], a[11]); hi.z = pk2(a[12], a[13]); hi.w = pk2(a[14], a[15]);
                *(u32x4*)&sA[r * GLD + ks] = lo; *(u32x4*)&sA[r * GLD + ks + 8] = hi;
            }
#pragma unroll
            for (int d = 0; d < (P::DUAL ? 2 : 1); ++d) {
                const int kk = tid >> 3, ns = (tid & 7) * 8;
                const float* src = p.Bptr(c, d) + (size_t)(k0 + kk) * p.ldb + ns;
                const f32x4 v0 = *(const f32x4*)src, v1 = *(const f32x4*)(src + 4);
                bf16* dst = &sB[d * GBN * GLD + ns * GLD + kk];
                dst[0 * GLD] = (bf16)f2bf(v0.x); dst[1 * GLD] = (bf16)f2bf(v0.y); dst[2 * GLD] = (bf16)f2bf(v0.z); dst[3 * GLD] = (bf16)f2bf(v0.w);
                dst[4 * GLD] = (bf16)f2bf(v1.x); dst[5 * GLD] = (bf16)f2bf(v1.y); dst[6 * GLD] = (bf16)f2bf(v1.z); dst[7 * GLD] = (bf16)f2bf(v1.w);
            }
            __syncthreads();
#pragma unroll
            for (int kk = 0; kk < 2; ++kk) {
                const bf16x8 a = *(const bf16x8*)&sA[(16 * w + fr) * GLD + kk * 32 + 8 * fq];
#pragma unroll
                for (int d = 0; d < (P::DUAL ? 2 : 1); ++d)
#pragma unroll
                    for (int n = 0; n < 4; ++n) {
                        const bf16x8 b = *(const bf16x8*)&sB[d * GBN * GLD + (16 * n + fr) * GLD + kk * 32 + 8 * fq];
                        acc[d][n] = __builtin_amdgcn_mfma_f32_16x16x32_bf16(a, b, acc[d][n], 0, 0, 0);
                    }
            }
            __syncthreads();
        }
#pragma unroll
        for (int n = 0; n < 4; ++n)
#pragma unroll
            for (int i = 0; i < 4; ++i) p.epi(c, 16 * w + 4 * fq + i, 16 * n + fr, acc[0][n][i], acc[1][n][i]);
    }
}

struct Ctx2 { int row0, col0; };

__device__ __forceinline__ void load_mix16(const float* x, const float* mix, int row, int k, float* a) {
    const float* cur = x + (size_t)row * D + k;
    const bool has_prev = (row & (T - 1)) != 0;
#pragma unroll
    for (int q = 0; q < 4; ++q) {
        const f32x4 c4 = *(const f32x4*)(cur + 4 * q);
        f32x4 p4 = (f32x4){0.f, 0.f, 0.f, 0.f};
        if (has_prev) p4 = *(const f32x4*)(cur - D + 4 * q);
        const f32x4 m4 = *(const f32x4*)(mix + k + 4 * q);
        a[4 * q + 0] = c4.x + (p4.x - c4.x) * m4.x; a[4 * q + 1] = c4.y + (p4.y - c4.y) * m4.y;
        a[4 * q + 2] = c4.z + (p4.z - c4.z) * m4.z; a[4 * q + 3] = c4.w + (p4.w - c4.w) * m4.w;
    }
}
__device__ __forceinline__ void load_bf16_16(const bf16* p, float* a) {
    const u32x4 v0 = *(const u32x4*)p, v1 = *(const u32x4*)(p + 8);
    a[0] = bf2f(v0.x & 0xffff); a[1] = bf2f(v0.x >> 16); a[2] = bf2f(v0.y & 0xffff); a[3] = bf2f(v0.y >> 16);
    a[4] = bf2f(v0.z & 0xffff); a[5] = bf2f(v0.z >> 16); a[6] = bf2f(v0.w & 0xffff); a[7] = bf2f(v0.w >> 16);
    a[8] = bf2f(v1.x & 0xffff); a[9] = bf2f(v1.x >> 16); a[10] = bf2f(v1.y & 0xffff); a[11] = bf2f(v1.y >> 16);
    a[12] = bf2f(v1.z & 0xffff); a[13] = bf2f(v1.z >> 16); a[14] = bf2f(v1.w & 0xffff); a[15] = bf2f(v1.w >> 16);
}

struct PMix {
    static constexpr bool DUAL = false; typedef Ctx2 Ctx;
    const float* x; const float* mix; const float* W; bf16* outb; float* outf;
    int K, ldb, N, act, ldo, ooff;
    __device__ int ntiles() const { return (M / GBM) * (N / GBN); }
    __device__ bool setup(int t, Ctx& c) const { const int nn = N / GBN; c.row0 = (t / nn) * GBM; c.col0 = (t % nn) * GBN; return true; }
    __device__ void loadA(const Ctx& c, int r, int k, float* a) const { load_mix16(x, mix, c.row0 + r, k, a); }
    __device__ const float* Bptr(const Ctx& c, int) const { return W + c.col0; }
    __device__ void epi(const Ctx& c, int r, int cc, float v, float) const {
        const int row = c.row0 + r, col = c.col0 + cc;
        if (act == 0) outb[(size_t)row * D + col] = (bf16)f2bf(v);
        else { float o = v; if (act == 1) o = tanhf(v); else if (act == 3) o = sigmoidf_(v); outf[(size_t)row * ldo + ooff + col] = o; }
    }
};
struct PLora2 {
    static constexpr bool DUAL = false; typedef Ctx2 Ctx;
    const float* L1; const float* W; const float* bias; float* outf; bf16* outb;
    int K, ldb, aoff, mode;
    __device__ int ntiles() const { return (M / GBM) * (D / GBN); }
    __device__ bool setup(int t, Ctx& c) const { const int nn = D / GBN; c.row0 = (t / nn) * GBM; c.col0 = (t % nn) * GBN; return true; }
    __device__ void loadA(const Ctx& c, int r, int k, float* a) const {
        const float* s = L1 + (size_t)(c.row0 + r) * 256 + aoff + k;
#pragma unroll
        for (int q = 0; q < 4; ++q) { const f32x4 v = *(const f32x4*)(s + 4 * q); a[4 * q] = v.x; a[4 * q + 1] = v.y; a[4 * q + 2] = v.z; a[4 * q + 3] = v.w; }
    }
    __device__ const float* Bptr(const Ctx& c, int) const { return W + c.col0; }
    __device__ void epi(const Ctx& c, int r, int cc, float v, float) const {
        const int row = c.row0 + r, col = c.col0 + cc; const size_t o = (size_t)row * D + col;
        if (mode == 0) { const float z = bias[col] + v; const float wv = -softplusf_(-z) - 0.5f; outf[o] = -__expf(wv); }
        else if (mode == 1) outb[o] = (bf16)f2bf(sigmoidf_(bias[col] + v));
        else outb[o] = (bf16)f2bf(v);
    }
};
struct PProj {
    static constexpr bool DUAL = false; typedef Ctx2 Ctx;
    const bf16* A; const float* W; const float* hin; float* outf; bf16* q; bf16* k; bf16* v;
    int K, ldb, N, mode;
    __device__ int ntiles() const { return (M / GBM) * (N / GBN); }
    __device__ bool setup(int t, Ctx& c) const { const int nn = N / GBN; c.row0 = (t / nn) * GBM; c.col0 = (t % nn) * GBN; return true; }
    __device__ void loadA(const Ctx& c, int r, int kk, float* a) const { load_bf16_16(A + (size_t)(c.row0 + r) * K + kk, a); }
    __device__ const float* Bptr(const Ctx& c, int) const { return W + c.col0; }
    __device__ void epi(const Ctx& c, int r, int cc, float val, float) const {
        const int row = c.row0 + r, col = c.col0 + cc;
        if (mode == 0) { const size_t o = (size_t)row * D + col; outf[o] = ALPHA * hin[o] + val; }
        else { q[(size_t)(col >> 10) * ((size_t)M * D) + (size_t)row * D + (col & (D - 1))] = (bf16)f2bf(val); }
    }
};
struct MoeCtx { int e, r0, nvalid, crow0, col0; };
__device__ __forceinline__ bool moe_map(const int* counts, int rtile, MoeCtx& m) {
    int acc = 0;
    for (int e = 0; e < NE; ++e) {
        const int c = counts[e], nt = (c + 127) >> 7;
        if (rtile < acc + nt) { m.e = e; m.r0 = (rtile - acc) * 128; m.nvalid = min(128, c - m.r0); m.crow0 = rtile * 128; return true; }
        acc += nt;
    }
    return false;
}
constexpr int MAXRT = 272;
struct PMoeGU {
    static constexpr bool DUAL = true; typedef MoeCtx Ctx;
    const bf16* hb; const int* rtok; const int* counts; const float* wg; const float* wu; bf16* hid;
    int K, ldb;
    __device__ int ntiles() const { return MAXRT * (DE / GBN); }
    __device__ bool setup(int t, Ctx& c) const { const int nn = DE / GBN; c.col0 = (t % nn) * GBN; return moe_map(counts, t / nn, c); }
    __device__ void loadA(const Ctx& c, int r, int kk, float* a) const {
        if (r < c.nvalid) { const int tok = rtok[c.e * CAP + c.r0 + r]; load_bf16_16(hb + (size_t)tok * D + kk, a); }
        else {
#pragma unroll
            for (int i = 0; i < 16; ++i) a[i] = 0.f;
        }
    }
    __device__ const float* Bptr(const Ctx& c, int d) const { return (d == 0 ? wg : wu) + (size_t)c.e * D * DE + c.col0; }
    __device__ void epi(const Ctx& c, int r, int cc, float g, float u) const {
        const float hval = (g * sigmoidf_(g)) * u;
        hid[(size_t)(c.crow0 + r) * DE + c.col0 + cc] = (bf16)f2bf(hval);
    }
};
struct PMoeDN {
    static constexpr bool DUAL = false; typedef MoeCtx Ctx;
    const bf16* hid; const float* rgate; const int* counts; const float* wd; bf16* y;
    int K, ldb;
    __device__ int ntiles() const { return MAXRT * (D / GBN); }
    __device__ bool setup(int t, Ctx& c) const { const int nn = D / GBN; c.col0 = (t % nn) * GBN; return moe_map(counts, t / nn, c); }
    __device__ void loadA(const Ctx& c, int r, int kk, float* a) const { load_bf16_16(hid + (size_t)(c.crow0 + r) * DE + kk, a); }
    __device__ const float* Bptr(const Ctx& c, int) const { return wd + (size_t)c.e * DE * D + c.col0; }
    __device__ void epi(const Ctx& c, int r, int cc, float v, float) const {
        if (r < c.nvalid) { const float gt = rgate[c.e * CAP + c.r0 + r]; y[(size_t)(c.crow0 + r) * D + c.col0 + cc] = (bf16)f2bf(gt * v); }
    }
};

__device__ __forceinline__ void ln_rows(f32x4 (&v)[4], const float* g, const float* b, int lane) {
    float s = 0.f;
#pragma unroll
    for (int j = 0; j < 4; ++j) s += (v[j].x + v[j].y) + (v[j].z + v[j].w);
    const float mean = wave_sum(s) * (1.f / D);
    float s2 = 0.f;
#pragma unroll
    for (int j = 0; j < 4; ++j) { v[j] = v[j] - mean; s2 += (v[j].x * v[j].x + v[j].y * v[j].y) + (v[j].z * v[j].z + v[j].w * v[j].w); }
    const float rstd = rsqrtf(wave_sum(s2) * (1.f / D) + LN_EPS);
#pragma unroll
    for (int j = 0; j < 4; ++j) {
        const f32x4 gg = *(const f32x4*)(g + 4 * lane + 256 * j), bb = *(const f32x4*)(b + 4 * lane + 256 * j);
        v[j] = v[j] * rstd * gg + bb;
    }
}
__device__ __forceinline__ void row_dot16(const f32x4 (&v)[4], const float* Wm, int ldw, int lane, float (&out)[16]) {
#pragma unroll
    for (int e = 0; e < 16; ++e) out[e] = 0.f;
#pragma unroll
    for (int j = 0; j < 4; ++j) {
        const float vv[4] = {v[j].x, v[j].y, v[j].z, v[j].w};
#pragma unroll
        for (int q = 0; q < 4; ++q) {
            const float* wr = Wm + (size_t)(4 * lane + 256 * j + q) * ldw;
#pragma unroll
            for (int e4 = 0; e4 < 4; ++e4) {
                const f32x4 w4 = *(const f32x4*)(wr + 4 * e4);
                out[4 * e4 + 0] += vv[q] * w4.x; out[4 * e4 + 1] += vv[q] * w4.y; out[4 * e4 + 2] += vv[q] * w4.z; out[4 * e4 + 3] += vv[q] * w4.w;
            }
        }
    }
#pragma unroll
    for (int e = 0; e < 16; ++e) out[e] = wave_sum(out[e]);
}
__device__ __forceinline__ void store_row(f32x4 (&v)[4], float* hrow, bf16* hbrow, int lane) {
#pragma unroll
    for (int j = 0; j < 4; ++j) {
        *(f32x4*)(hrow + 4 * lane + 256 * j) = v[j];
        u32x2 o; o.x = pk2(v[j].x, v[j].y); o.y = pk2(v[j].z, v[j].w);
        *(u32x2*)(hbrow + 4 * lane + 256 * j) = o;
    }
}

struct LnRouteP { float* h; bf16* hb; const float* g; const float* b; const float* rw; const float* rbias; int* counts; int* rtok; float* rgate; int* slot; };
__device__ __forceinline__ void ph_ln_route(const LnRouteP& p) {
    const int tid_ = opaque_tid(); const int lane = tid_ & 63, wv = tid_ >> 6;
    for (int tok = blockIdx.x * 8 + wv; tok < M; tok += gridDim.x * 8) {
        float* hrow = p.h + (size_t)tok * D;
        f32x4 v[4];
#pragma unroll
        for (int j = 0; j < 4; ++j) v[j] = *(const f32x4*)(hrow + 4 * lane + 256 * j);
        ln_rows(v, p.g, p.b, lane);
        store_row(v, hrow, p.hb + (size_t)tok * D, lane);
        float lg[16];
        row_dot16(v, p.rw, NE, lane, lg);
        float s[16], ss[16];
#pragma unroll
        for (int e = 0; e < 16; ++e) { s[e] = sigmoidf_(lg[e]); ss[e] = s[e] + p.rbias[e]; }
        int gbest = 0; float gscore = -INFINITY; int l1b = 0, l2b = 1;
#pragma unroll
        for (int g = 0; g < 4; ++g) {
            float v1 = ss[4 * g], v2 = -INFINITY; int i1 = 0, i2 = -1;
#pragma unroll
            for (int i = 1; i < 4; ++i) {
                const float x = ss[4 * g + i];
                if (x > v1) { v2 = v1; i2 = i1; v1 = x; i1 = i; }
                else if (x > v2) { v2 = x; i2 = i; }
            }
            const float sc = v1 + v2;
            if (sc > gscore) { gscore = sc; gbest = g; l1b = i1; l2b = i2; }
        }
        const int e0 = 4 * gbest + l1b, e1 = 4 * gbest + l2b;
        float s0 = 0.f, s1 = 0.f;
#pragma unroll
        for (int e = 0; e < 16; ++e) { s0 = (e == e0) ? s[e] : s0; s1 = (e == e1) ? s[e] : s1; }
        const float inv = 1.0f / (s0 + s1);
        if (lane == 0) {
            const int r0 = atomicAdd(p.counts + e0, 1), r1 = atomicAdd(p.counts + e1, 1);
            p.rtok[e0 * CAP + r0] = tok; p.rgate[e0 * CAP + r0] = s0 * inv;
            p.rtok[e1 * CAP + r1] = tok; p.rgate[e1 * CAP + r1] = s1 * inv;
            p.slot[2 * tok] = e0 * CAP + r0; p.slot[2 * tok + 1] = e1 * CAP + r1;
        }
    }
}

struct LnCombP { float* h; bf16* hb; const bf16* y; const int* slot; const int* counts; const float* g; const float* b; const float* wf; const float* bf; float* logf; float* outp; int do_f; int pad; };
__device__ __forceinline__ void ph_ln_comb(const LnCombP& p, unsigned char* lds) {
    const int tid_ = opaque_tid(); const int lane = tid_ & 63, wv = tid_ >> 6;
    int* pstart = (int*)lds;
    if (tid_ == 0) { int acc = 0; for (int e = 0; e < NE; ++e) { pstart[e] = acc; acc += ((p.counts[e] + 127) >> 7) * 128; } }
    __syncthreads();
    for (int tok = blockIdx.x * 8 + wv; tok < M; tok += gridDim.x * 8) {
        const int sl0 = p.slot[2 * tok], sl1 = p.slot[2 * tok + 1];
        const int c0 = pstart[sl0 / CAP] + (sl0 % CAP), c1 = pstart[sl1 / CAP] + (sl1 % CAP);
        const float* hrow = p.h + (size_t)tok * D;
        const bf16* y0 = p.y + (size_t)c0 * D; const bf16* y1 = p.y + (size_t)c1 * D;
        f32x4 v[4];
#pragma unroll
        for (int j = 0; j < 4; ++j) {
            const f32x4 hv = *(const f32x4*)(hrow + 4 * lane + 256 * j);
            const u32x2 a = *(const u32x2*)(y0 + 4 * lane + 256 * j), bq = *(const u32x2*)(y1 + 4 * lane + 256 * j);
            v[j].x = ALPHA * hv.x + (bf2f(a.x & 0xffff) + bf2f(bq.x & 0xffff));
            v[j].y = ALPHA * hv.y + (bf2f(a.x >> 16) + bf2f(bq.x >> 16));
            v[j].z = ALPHA * hv.z + (bf2f(a.y & 0xffff) + bf2f(bq.y & 0xffff));
            v[j].w = ALPHA * hv.w + (bf2f(a.y >> 16) + bf2f(bq.y >> 16));
        }
        ln_rows(v, p.g, p.b, lane);
        store_row(v, p.outp + (size_t)tok * D, p.hb + (size_t)tok * D, lane);
        if (p.do_f) {
            float f[16];
            row_dot16(v, p.wf, NW_IN, lane, f);
            if (lane < 16) {
                float fv = 0.f;
#pragma unroll
                for (int e = 0; e < 16; ++e) fv = (e == lane) ? f[e] : fv;
                p.logf[(size_t)tok * 16 + lane] = -softplusf_(-(fv + p.bf[lane]));
            }
        }
    }
}

struct ScanP { const bf16* r; const bf16* k; const bf16* v; const float* lw; const bf16* a; const bf16* g; bf16* yg;
               const float* kk; const float* ka; const float* rk; const float* gng; const float* gnb; };
__device__ __forceinline__ void ph_scan(const ScanP& p, unsigned char* lds) {
    typedef float (*arr64)[64];
    arr64 s_r = (arr64)lds, s_kk = (arr64)(lds + 8192), s_b = (arr64)(lds + 16384), s_w = (arr64)(lds + 24576), s_k = (arr64)(lds + 32768), s_v = (arr64)(lds + 40960), s_y = (arr64)(lds + 49152);
    float* s_bonus = (float*)(lds + 57344);
    const int tid = opaque_tid();
    const int i = tid >> 3, jq = tid & 7;
    const int lt = tid >> 4, c4 = (tid & 15) * 4;
    for (int unit = blockIdx.x; unit < NB * H; unit += gridDim.x) {
        const int b = unit / H, h = unit % H;
        float S[8];
#pragma unroll
        for (int j = 0; j < 8; ++j) S[j] = 0.f;
        const f32x4 kkp = *(const f32x4*)(p.kk + h * HD + c4), kap = *(const f32x4*)(p.ka + h * HD + c4), rkp = *(const f32x4*)(p.rk + h * HD + c4);
        const f32x4 gng = *(const f32x4*)(p.gng + h * HD + c4), gnb = *(const f32x4*)(p.gnb + h * HD + c4);
        for (int blk = 0; blk < T / 32; ++blk) {
            const size_t base = (size_t)(b * T + blk * 32 + lt) * D + h * HD + c4;
            {
                const u32x2 r2 = *(const u32x2*)(p.r + base), k2 = *(const u32x2*)(p.k + base), v2 = *(const u32x2*)(p.v + base), a2 = *(const u32x2*)(p.a + base);
                const f32x4 lw4 = *(const f32x4*)(p.lw + base);
                const f32x4 rr = {bf2f(r2.x & 0xffff), bf2f(r2.x >> 16), bf2f(r2.y & 0xffff), bf2f(r2.y >> 16)};
                const f32x4 kr = {bf2f(k2.x & 0xffff), bf2f(k2.x >> 16), bf2f(k2.y & 0xffff), bf2f(k2.y >> 16)};
                const f32x4 vv = {bf2f(v2.x & 0xffff), bf2f(v2.x >> 16), bf2f(v2.y & 0xffff), bf2f(v2.y >> 16)};
                const f32x4 aa = {bf2f(a2.x & 0xffff), bf2f(a2.x >> 16), bf2f(a2.y & 0xffff), bf2f(a2.y >> 16)};
                const f32x4 kkn = kr * kkp;
                float ss = (kkn.x * kkn.x + kkn.y * kkn.y) + (kkn.z * kkn.z + kkn.w * kkn.w);
                ss += __shfl_xor(ss, 1); ss += __shfl_xor(ss, 2); ss += __shfl_xor(ss, 4); ss += __shfl_xor(ss, 8);
                const float inv = 1.0f / fmaxf(sqrtf(ss), 1e-12f);
                const f32x4 kkv = kkn * inv;
                const f32x4 km = kr * (1.0f + (aa - 1.0f) * kap);
                const f32x4 bb = kkv * aa;
                f32x4 wd; wd.x = __expf(lw4.x); wd.y = __expf(lw4.y); wd.z = __expf(lw4.z); wd.w = __expf(lw4.w);
                const f32x4 bt = rr * km * rkp;
                float bo = (bt.x + bt.y) + (bt.z + bt.w);
                bo += __shfl_xor(bo, 1); bo += __shfl_xor(bo, 2); bo += __shfl_xor(bo, 4); bo += __shfl_xor(bo, 8);
                *(f32x4*)&s_r[lt][c4] = rr; *(f32x4*)&s_kk[lt][c4] = kkv; *(f32x4*)&s_b[lt][c4] = bb; *(f32x4*)&s_w[lt][c4] = wd;
                *(f32x4*)&s_k[lt][c4] = km; *(f32x4*)&s_v[lt][c4] = vv;
                if ((tid & 15) == 0) s_bonus[lt] = bo;
            }
            __syncthreads();
            for (int tt = 0; tt < 32; ++tt) {
                const f32x4 k0 = *(const f32x4*)&s_kk[tt][8 * jq], k1 = *(const f32x4*)&s_kk[tt][8 * jq + 4];
                const f32x4 w0 = *(const f32x4*)&s_w[tt][8 * jq], w1 = *(const f32x4*)&s_w[tt][8 * jq + 4];
                const f32x4 b0 = *(const f32x4*)&s_b[tt][8 * jq], b1 = *(const f32x4*)&s_b[tt][8 * jq + 4];
                const f32x4 q0 = *(const f32x4*)&s_k[tt][8 * jq], q1 = *(const f32x4*)&s_k[tt][8 * jq + 4];
                const f32x4 r0 = *(const f32x4*)&s_r[tt][8 * jq], r1 = *(const f32x4*)&s_r[tt][8 * jq + 4];
                const float vi = s_v[tt][i];
                float sa = (S[0] * k0.x + S[1] * k0.y) + (S[2] * k0.z + S[3] * k0.w) + (S[4] * k1.x + S[5] * k1.y) + (S[6] * k1.z + S[7] * k1.w);
                sa += __shfl_xor(sa, 1); sa += __shfl_xor(sa, 2); sa += __shfl_xor(sa, 4);
                S[0] = S[0] * w0.x - sa * b0.x + vi * q0.x; S[1] = S[1] * w0.y - sa * b0.y + vi * q0.y;
                S[2] = S[2] * w0.z - sa * b0.z + vi * q0.z; S[3] = S[3] * w0.w - sa * b0.w + vi * q0.w;
                S[4] = S[4] * w1.x - sa * b1.x + vi * q1.x; S[5] = S[5] * w1.y - sa * b1.y + vi * q1.y;
                S[6] = S[6] * w1.z - sa * b1.z + vi * q1.z; S[7] = S[7] * w1.w - sa * b1.w + vi * q1.w;
                float y = (S[0] * r0.x + S[1] * r0.y) + (S[2] * r0.z + S[3] * r0.w) + (S[4] * r1.x + S[5] * r1.y) + (S[6] * r1.z + S[7] * r1.w);
                y += __shfl_xor(y, 1); y += __shfl_xor(y, 2); y += __shfl_xor(y, 4);
                if (jq == 0) s_y[tt][i] = y;
            }
            __syncthreads();
            {
                const f32x4 y4 = *(const f32x4*)&s_y[lt][c4];
                float sm = (y4.x + y4.y) + (y4.z + y4.w);
                sm += __shfl_xor(sm, 1); sm += __shfl_xor(sm, 2); sm += __shfl_xor(sm, 4); sm += __shfl_xor(sm, 8);
                const float mu = sm * (1.f / 64.f);
                const f32x4 dd = y4 - mu;
                float vs = (dd.x * dd.x + dd.y * dd.y) + (dd.z * dd.z + dd.w * dd.w);
                vs += __shfl_xor(vs, 1); vs += __shfl_xor(vs, 2); vs += __shfl_xor(vs, 4); vs += __shfl_xor(vs, 8);
                const float rstd = rsqrtf(vs * (1.f / 64.f) + GN_EPS);
                const f32x4 vv = *(const f32x4*)&s_v[lt][c4];
                const float bo = s_bonus[lt];
                const u32x2 g2 = *(const u32x2*)(p.g + base);
                const f32x4 gg = {bf2f(g2.x & 0xffff), bf2f(g2.x >> 16), bf2f(g2.y & 0xffff), bf2f(g2.y >> 16)};
                const f32x4 o = (dd * rstd * gng + gnb + bo * vv) * gg;
                u32x2 ob; ob.x = pk2(o.x, o.y); ob.y = pk2(o.z, o.w);
                *(u32x2*)(p.yg + base) = ob;
            }
            __syncthreads();
        }
    }
}

__device__ __forceinline__ void ph_cumsum(const float* logf, float* cum) {
    const int tid_ = opaque_tid(); const int lane = tid_ & 63, wv = tid_ >> 6;
    for (int seq = blockIdx.x * 8 + wv; seq < NB * H; seq += gridDim.x * 8) {
        const int b = seq / H, h = seq % H;
        float loc[32]; float run = 0.f;
#pragma unroll
        for (int q = 0; q < 32; ++q) { run += logf[(size_t)(b * T + lane * 32 + q) * 16 + h]; loc[q] = run; }
        float incl = run;
#pragma unroll
        for (int o = 1; o < 64; o <<= 1) { const float t = __shfl_up(incl, o); if (lane >= o) incl += t; }
        const float excl = incl - run;
#pragma unroll
        for (int q = 0; q < 32; ++q) cum[(size_t)(b * T + lane * 32 + q) * 16 + h] = excl + loc[q];
    }
}
struct AttnP { const bf16* q; const bf16* k; const bf16* v; const float* cum; bf16* o; };
__device__ __forceinline__ void ph_attn(const AttnP& p, unsigned char* lds) {
    typedef float (*arr64)[64];
    arr64 sK = (arr64)lds, sV = (arr64)(lds + 16384);
    float* sC = (float*)(lds + 32768);
    const int tid = opaque_tid();
    for (int unit = blockIdx.x; unit < NB * H * 4; unit += gridDim.x) {
        const int ug = unit / (NB * H), qblk = (ug == 0) ? 3 : (ug == 1) ? 2 : (ug == 2) ? 0 : 1, bh = unit % (NB * H), b = bh / H, h = bh % H;
        const int qpos = qblk * 512 + tid;
        const size_t qrow = (size_t)(b * T + qpos);
        float q[64], o[64];
        {
            const bf16* qp = p.q + qrow * D + h * HD;
#pragma unroll
            for (int c = 0; c < 8; ++c) {
                const u32x4 v4 = *(const u32x4*)(qp + 8 * c);
                const float sc = 0.125f * LOG2E;
                q[8 * c + 0] = bf2f(v4.x & 0xffff) * sc; q[8 * c + 1] = bf2f(v4.x >> 16) * sc; q[8 * c + 2] = bf2f(v4.y & 0xffff) * sc; q[8 * c + 3] = bf2f(v4.y >> 16) * sc;
                q[8 * c + 4] = bf2f(v4.z & 0xffff) * sc; q[8 * c + 5] = bf2f(v4.z >> 16) * sc; q[8 * c + 6] = bf2f(v4.w & 0xffff) * sc; q[8 * c + 7] = bf2f(v4.w >> 16) * sc;
            }
        }
#pragma unroll
        for (int d = 0; d < 64; ++d) o[d] = 0.f;
        const float ci = p.cum[qrow * 16 + h] * LOG2E;
        float mrun = -INFINITY, lrun = 0.f;
        const int wave_qmax = qblk * 512 + (tid | 63);
        const int ntile = (qblk * 512 + 512) / 64;
        for (int kt = 0; kt < ntile; ++kt) {
            __syncthreads();
            {
                const int kr = tid >> 3, d8 = (tid & 7) * 8;
                const size_t krow = (size_t)(b * T + kt * 64 + kr);
                const u32x4 k4 = *(const u32x4*)(p.k + krow * D + h * HD + d8), v4 = *(const u32x4*)(p.v + krow * D + h * HD + d8);
                float* kd = &sK[kr][d8]; float* vd = &sV[kr][d8];
                kd[0] = bf2f(k4.x & 0xffff); kd[1] = bf2f(k4.x >> 16); kd[2] = bf2f(k4.y & 0xffff); kd[3] = bf2f(k4.y >> 16);
                kd[4] = bf2f(k4.z & 0xffff); kd[5] = bf2f(k4.z >> 16); kd[6] = bf2f(k4.w & 0xffff); kd[7] = bf2f(k4.w >> 16);
                vd[0] = bf2f(v4.x & 0xffff); vd[1] = bf2f(v4.x >> 16); vd[2] = bf2f(v4.y & 0xffff); vd[3] = bf2f(v4.y >> 16);
                vd[4] = bf2f(v4.z & 0xffff); vd[5] = bf2f(v4.z >> 16); vd[6] = bf2f(v4.w & 0xffff); vd[7] = bf2f(v4.w >> 16);
                if (tid < 64) sC[tid] = p.cum[(size_t)(b * T + kt * 64 + tid) * 16 + h] * LOG2E;
            }
            __syncthreads();
            if (kt * 64 > wave_qmax) continue;
            for (int j = 0; j < 64; ++j) {
                float s0 = 0.f, s1 = 0.f, s2 = 0.f, s3 = 0.f;
#pragma unroll
                for (int d = 0; d < 64; d += 4) {
                    const f32x4 kk = *(const f32x4*)&sK[j][d];
                    s0 += q[d] * kk.x; s1 += q[d + 1] * kk.y; s2 += q[d + 2] * kk.z; s3 += q[d + 3] * kk.w;
                }
                float s = ((s0 + s1) + (s2 + s3)) + (ci - sC[j]);
                if (kt * 64 + j > qpos) s = -INFINITY;
                const float mn = fmaxf(mrun, s);
                const float al = exp2f(mrun - mn), pj = exp2f(s - mn);
                mrun = mn; lrun = lrun * al + pj;
#pragma unroll
                for (int d = 0; d < 64; d += 4) {
                    const f32x4 vv = *(const f32x4*)&sV[j][d];
                    o[d] = o[d] * al + pj * vv.x; o[d + 1] = o[d + 1] * al + pj * vv.y; o[d + 2] = o[d + 2] * al + pj * vv.z; o[d + 3] = o[d + 3] * al + pj * vv.w;
                }
            }
        }
        const float il = 1.0f / lrun;
        bf16* op = p.o + qrow * D + h * HD;
#pragma unroll
        for (int c = 0; c < 8; ++c) {
            u32x4 w; w.x = pk2(o[8 * c] * il, o[8 * c + 1] * il); w.y = pk2(o[8 * c + 2] * il, o[8 * c + 3] * il);
            w.z = pk2(o[8 * c + 4] * il, o[8 * c + 5] * il); w.w = pk2(o[8 * c + 6] * il, o[8 * c + 7] * il);
            *(u32x4*)(op + 8 * c) = w;
        }
    }
}

#define XB_TMO      128
#define XB_XCNT(j)  (256  + 64 * (j))
#define XB_XSUB(j)  (1280 + 64 * (j))
#define XB_XGEN(j)  (2304 + 64 * (j))
#define XB_TOP      3328
#define XB_TOPGEN   3392
#define XCD_BAR_WORDS 3456
#define XB_SPIN_CAP (1u << 18)
#define LAS __attribute__((address_space(3)))

__device__ __forceinline__ unsigned xb_ld(unsigned* p)              { return __hip_atomic_load(p, __ATOMIC_RELAXED, __HIP_MEMORY_SCOPE_AGENT); }
__device__ __forceinline__ unsigned xb_add(unsigned* p, unsigned v) { return __hip_atomic_fetch_add(p, v, __ATOMIC_RELAXED, __HIP_MEMORY_SCOPE_AGENT); }
__device__ __forceinline__ unsigned xb_xcc_id() { return (unsigned)__builtin_amdgcn_s_getreg((3 << 11) | 20) & 0xFu; }
#define XB_SPIN(cond, bar) do { unsigned _sp = 0; while (cond) { __builtin_amdgcn_s_sleep(1); \
    if ((++_sp & 255u) == 0u) { if (xb_ld(&(bar)[XB_TMO])) break; if (_sp > XB_SPIN_CAP) { atomicAdd(&(bar)[XB_TMO], 1u); break; } } } } while (0)

struct XcdBarrier { unsigned* bar; unsigned x; volatile LAS unsigned* st; };

__device__ __forceinline__ XcdBarrier xcd_barrier_post(unsigned* bar, volatile LAS unsigned* st) {
    XcdBarrier b; b.bar = bar; b.x = xb_xcc_id(); b.st = st;
    if (threadIdx.x == 0) (void)xb_add(&bar[XB_XCNT(b.x)], 1u);
    return b;
}
__device__ __forceinline__ void xcd_barrier_complete(unsigned* bar, unsigned x, unsigned& nloc, unsigned& nx) {
    const unsigned G = gridDim.x * gridDim.y * gridDim.z;
    unsigned sum, cnt, mine, sp = 0u;
    for (;;) {
        sum = 0u; cnt = 0u; mine = 0u;
#pragma unroll
        for (unsigned j = 0; j < 16; ++j) { const unsigned c = xb_ld(&bar[XB_XCNT(j)]); sum += c; cnt += (c > 0u) ? 1u : 0u; mine = (j == x) ? c : mine; }
        if (sum == G) break;
        __builtin_amdgcn_s_sleep(1);
        if ((++sp & 255u) == 0u) { if (xb_ld(&bar[XB_TMO])) break; if (sp > XB_SPIN_CAP) { atomicAdd(&bar[XB_TMO], 1u); break; } }
    }
    nloc = mine > 0u ? mine : 1u; nx = cnt > 0u ? cnt : 1u;
}
__device__ __forceinline__ void xcd_barrier(const XcdBarrier& b) {
    asm volatile("s_waitcnt vmcnt(0)" ::: "memory");
    __syncthreads();
    if (threadIdx.x == 0) {
        unsigned* bar = b.bar;
        __builtin_amdgcn_s_waitcnt(0);
        unsigned nloc = b.st[0], nx = b.st[1];
        if (nloc == 0u) { xcd_barrier_complete(bar, b.x, nloc, nx); b.st[0] = nloc; b.st[1] = nx; }
        const unsigned old = xb_add(&bar[XB_XSUB(b.x)], 1u);
        const unsigned gen = old / nloc;
        if (old + 1u == (gen + 1u) * nloc) {
            __builtin_amdgcn_fence(__ATOMIC_RELEASE, "agent");
            asm volatile("s_waitcnt vmcnt(0)" ::: "memory");
            const unsigned og = xb_add(&bar[XB_TOP], 1u);
            const unsigned tg = og / nx;
            if (og + 1u == (tg + 1u) * nx) xb_add(&bar[XB_TOPGEN], 1u);
            else XB_SPIN(xb_ld(&bar[XB_TOPGEN]) == tg, bar);
            __builtin_amdgcn_fence(__ATOMIC_ACQUIRE, "agent");
            xb_add(&bar[XB_XGEN(b.x)], 1u);
            asm volatile("s_waitcnt vmcnt(0)" ::: "memory");
        } else {
            XB_SPIN(xb_ld(&bar[XB_XGEN(b.x)]) == gen, bar);
            __builtin_amdgcn_fence(__ATOMIC_ACQUIRE, "agent");
            asm volatile("s_waitcnt vmcnt(0)" ::: "memory");
        }
    }
    __syncthreads();
}

enum { I_X = 0, I_MIX, I_WR, I_WK, I_WV, I_WO, I_W0, I_W1, I_W2, I_A0, I_A1, I_A2, I_G1, I_G2, I_KK, I_KA, I_RK, I_GNG, I_GNB,
       I_FWIN, I_FBF, I_FWO, I_RW, I_RB, I_MG, I_MU, I_MD, I_LNG, I_LNB, N_IN };
constexpr int LDS_BYTES = 147456;
constexpr int LDS_MISC = LDS_BYTES - 64;
constexpr size_t CTL_BAR_OFF = 4096;
static_assert(CTL_BAR_OFF + XCD_BAR_WORDS * 4 <= 65536, "ctl block");

struct Params { const float* in[N_IN]; float* out; unsigned char* ws; };

__global__ void __launch_bounds__(512, 2) fwd(Params P) {
    extern __shared__ __attribute__((aligned(16))) unsigned char lds[];
    volatile LAS unsigned* misc = (volatile LAS unsigned*)((LAS unsigned char*)lds + LDS_MISC);
    if (threadIdx.x < 16) misc[threadIdx.x] = 0u;
    __syncthreads();
    unsigned char* ws = P.ws;
    XcdBarrier bar = xcd_barrier_post((unsigned*)(ws + WS_CTL + CTL_BAR_OFF), misc);
    float* hbuf = P.out;
    int* counts0 = (int*)(ws + WS_CTL);
    int* rtok = (int*)(ws + WS_RTOK); float* rgate = (float*)(ws + WS_RGATE); int* slot = (int*)(ws + WS_SLOT);
    bf16* HB = (bf16*)(ws + WS_HB); bf16* R = (bf16*)(ws + WS_R); bf16* KB = (bf16*)(ws + WS_K); bf16* VB = (bf16*)(ws + WS_V);
    float* LW = (float*)(ws + WS_LW); bf16* AA = (bf16*)(ws + WS_AA); bf16* G = (bf16*)(ws + WS_G); float* L1 = (float*)(ws + WS_L1);
    float* LOGF = (float*)(ws + WS_LOGF); float* CUM = (float*)(ws + WS_CUM); bf16* Y = (bf16*)(ws + WS_Y); bf16* HID = (bf16*)(ws + WS_HID);

    for (int j = 0; j < 6; ++j) {
        PMix p; p.x = P.in[I_X]; p.K = D; p.outb = nullptr; p.outf = L1; p.ldo = 256;
        if (j == 0)      { p.mix = P.in[I_MIX] + 0 * D; p.W = P.in[I_WR]; p.outb = R;  p.ldb = D; p.N = D; p.act = 0; p.ooff = 0; }
        else if (j == 1) { p.mix = P.in[I_MIX] + 2 * D; p.W = P.in[I_WK]; p.outb = KB; p.ldb = D; p.N = D; p.act = 0; p.ooff = 0; }
        else if (j == 2) { p.mix = P.in[I_MIX] + 3 * D; p.W = P.in[I_WV]; p.outb = VB; p.ldb = D; p.N = D; p.act = 0; p.ooff = 0; }
        else if (j == 3) { p.mix = P.in[I_MIX] + 1 * D; p.W = P.in[I_W1]; p.ldb = 64;  p.N = 64;  p.act = 1; p.ooff = 0; }
        else if (j == 4) { p.mix = P.in[I_MIX] + 4 * D; p.W = P.in[I_A1]; p.ldb = 64;  p.N = 64;  p.act = 2; p.ooff = 64; }
        else             { p.mix = P.in[I_MIX] + 5 * D; p.W = P.in[I_G1]; p.ldb = 128; p.N = 128; p.act = 3; p.ooff = 128; }
        gemm_run(p, lds);
    }
    xcd_barrier(bar);
    for (int j = 0; j < 3; ++j) {
        PLora2 p; p.L1 = L1; p.ldb = D; p.outf = LW; p.outb = AA;
        if (j == 0)      { p.W = P.in[I_W2]; p.bias = P.in[I_W0]; p.K = 64;  p.aoff = 0;   p.mode = 0; }
        else if (j == 1) { p.W = P.in[I_A2]; p.bias = P.in[I_A0]; p.K = 64;  p.aoff = 64;  p.mode = 1; }
        else             { p.W = P.in[I_G2]; p.bias = P.in[I_A0]; p.outb = G; p.K = 128; p.aoff = 128; p.mode = 2; }
        gemm_run(p, lds);
    }
    xcd_barrier(bar);
    {   ScanP p; p.r = R; p.k = KB; p.v = VB; p.lw = LW; p.a = AA; p.g = G; p.yg = R; p.kk = P.in[I_KK]; p.ka = P.in[I_KA]; p.rk = P.in[I_RK]; p.gng = P.in[I_GNG]; p.gnb = P.in[I_GNB];
        ph_scan(p, lds); }
    xcd_barrier(bar);
    {   PProj p; p.A = R; p.W = P.in[I_WO]; p.hin = P.in[I_X]; p.outf = hbuf; p.q = p.k = p.v = nullptr; p.K = D; p.ldb = D; p.N = D; p.mode = 0;
        gemm_run(p, lds); }
    xcd_barrier(bar);
    for (int layer = 0; layer < 2; ++layer) {
        if (layer == 1) {
            ph_cumsum(LOGF, CUM);
            {   PProj p; p.A = HB; p.W = P.in[I_FWIN]; p.hin = nullptr; p.outf = nullptr; p.q = R; p.k = KB; p.v = VB; p.K = D; p.ldb = NW_IN; p.N = 3 * D; p.mode = 1;
                gemm_run(p, lds); }
            xcd_barrier(bar);
            {   AttnP p; p.q = R; p.k = KB; p.v = VB; p.cum = CUM; p.o = R; ph_attn(p, lds); }
            xcd_barrier(bar);
            {   PProj p; p.A = R; p.W = P.in[I_FWO]; p.hin = hbuf; p.outf = hbuf; p.q = p.k = p.v = nullptr; p.K = D; p.ldb = D; p.N = D; p.mode = 0;
                gemm_run(p, lds); }
            xcd_barrier(bar);
        }
        int* counts = counts0 + 16 * layer;
        {   LnRouteP p; p.h = hbuf; p.hb = HB; p.g = P.in[I_LNG] + (layer * 2 + 0) * D; p.b = P.in[I_LNB] + (layer * 2 + 0) * D; p.rw = P.in[I_RW]; p.rbias = P.in[I_RB];
            p.counts = counts; p.rtok = rtok; p.rgate = rgate; p.slot = slot;
            ph_ln_route(p); }
        xcd_barrier(bar);
        {   PMoeGU p; p.hb = HB; p.rtok = rtok; p.counts = counts; p.wg = P.in[I_MG] + (size_t)layer * NE * D * DE; p.wu = P.in[I_MU] + (size_t)layer * NE * D * DE; p.hid = HID; p.K = D; p.ldb = DE;
            gemm_run(p, lds); }
        xcd_barrier(bar);
        {   PMoeDN p; p.hid = HID; p.rgate = rgate; p.counts = counts; p.wd = P.in[I_MD] + (size_t)layer * NE * DE * D; p.y = Y; p.K = DE; p.ldb = D;
            gemm_run(p, lds); }
        xcd_barrier(bar);
        {   LnCombP p; p.h = hbuf; p.hb = HB; p.y = Y; p.slot = slot; p.counts = counts; p.g = P.in[I_LNG] + (layer * 2 + 1) * D; p.b = P.in[I_LNB] + (layer * 2 + 1) * D;
            p.wf = P.in[I_FWIN] + 3 * D; p.bf = P.in[I_FBF]; p.logf = LOGF; p.outp = hbuf; p.do_f = (layer == 0) ? 1 : 0; p.pad = 0;
            ph_ln_comb(p, lds); }
        if (layer == 0) xcd_barrier(bar);
    }
}

extern "C" void kernel_launch(void* const* d_in, const int* in_sizes, int n_in, void* d_out, int out_size, void* d_ws, size_t ws_size, hipStream_t stream) {
    static int grid = 0;
    if (grid == 0) {
        if (n_in != N_IN || out_size != M * D || ws_size < WS_END) { fprintf(stderr, "kernel_launch: unexpected problem (n_in %d out %d ws %zu)\n", n_in, out_size, ws_size); grid = -1; return; }
        int dev = 0, cus = 0;
        if (hipGetDevice(&dev) != hipSuccess || hipDeviceGetAttribute(&cus, hipDeviceAttributeMultiprocessorCount, dev) != hipSuccess) { grid = -1; return; }
        if (hipFuncSetAttribute((const void*)fwd, hipFuncAttributeMaxDynamicSharedMemorySize, LDS_BYTES) != hipSuccess) { fprintf(stderr, "kernel_launch: hipFuncSetAttribute failed\n"); grid = -1; return; }
        int per_cu = 0;
        if (hipOccupancyMaxActiveBlocksPerMultiprocessor(&per_cu, (const void*)fwd, 512, LDS_BYTES) != hipSuccess || per_cu < 1) { fprintf(stderr, "kernel_launch: occupancy query says %d\n", per_cu); (void)hipGetLastError(); }
        grid = cus;
    }
    if (grid < 0) return;
    (void)hipMemsetAsync((char*)d_ws + WS_CTL, 0, 65536, stream);
    Params P{};
    for (int i = 0; i < N_IN; ++i) P.in[i] = (const float*)d_in[i];
    P.out = (float*)d_out; P.ws = (unsigned char*)d_ws;
    hipLaunchKernelGGL(fwd, dim3(grid), dim3(512), LDS_BYTES, stream, P);
}
```

```cpp
#include <hip/hip_runtime.h>
#include <stdint.h>
#include <stdio.h>

typedef unsigned short bf16;
typedef short bf16x8 __attribute__((ext_vector_type(8)));
typedef float f32x4 __attribute__((ext_vector_type(4)));
typedef float f32x2 __attribute__((ext_vector_type(2)));
typedef unsigned u32x4 __attribute__((ext_vector_type(4)));
typedef unsigned u32x2 __attribute__((ext_vector_type(2)));
#define LAS __attribute__((address_space(3)))

constexpr int NB = 8, T = 2048, D = 1024, H = 16, HD = 64, M = NB * T;
constexpr int NE = 16, DE = 512, CAP = 16384, MAXROWS = 36864;
constexpr int NW_IN = 3 * D + H;
constexpr float ALPHA = 1.4142135623730951f;
constexpr float LN_EPS = 1e-5f, GN_EPS = 64e-5f;
constexpr float LOG2E = 1.4426950408889634f;

constexpr size_t MiB = 1u << 20;
constexpr size_t WS_CTL = 0;
constexpr size_t CTL_BYTES = 65536;
constexpr size_t CTL_BAR_OFF = 16384;
constexpr size_t WS_RTOK = 1 * MiB;
constexpr size_t WS_RGATE = 3 * MiB;
constexpr size_t WS_SLOT = 5 * MiB;
constexpr size_t WS_WRKV = 6 * MiB;
constexpr size_t WS_WO = 12 * MiB;
constexpr size_t WS_B1T = 14 * MiB;
constexpr size_t WS_B2T = 15 * MiB;
constexpr size_t WS_WIN = 17 * MiB;
constexpr size_t WS_FWO = 23 * MiB;
constexpr size_t WS_X0 = 25 * MiB;
constexpr size_t WS_XCAT = WS_X0;
constexpr size_t WS_XR = WS_X0 + 64 * MiB;
constexpr size_t WS_MOEW = WS_X0;
constexpr size_t WS_DNT = WS_MOEW + 32 * MiB;
constexpr size_t WS_LW = WS_X0 + 48 * MiB;
constexpr size_t WS_HB = WS_X0 + 48 * MiB;
constexpr size_t WS_AA = WS_X0 + 80 * MiB;
constexpr size_t WS_G = WS_X0 + 112 * MiB;
constexpr size_t WS_DNT1 = WS_X0 + 144 * MiB;
constexpr size_t WS_HID = WS_X0 + 80 * MiB;
constexpr size_t WS_R = WS_X0 + 160 * MiB;
constexpr size_t WS_K = WS_R + 32 * MiB;
constexpr size_t WS_V = WS_R + 64 * MiB;
constexpr size_t WS_Y = WS_R;
constexpr size_t WS_L1 = WS_R + 96 * MiB;
constexpr size_t WS_LOGF = WS_L1;
constexpr size_t WS_CUM = WS_L1 + 1 * MiB;
constexpr size_t WS_WF = WS_L1 + 4 * MiB;
constexpr size_t WF_STRIDE = 65536 + 256;
constexpr size_t WS_END = WS_L1 + 8 * MiB;
static_assert(WS_END == 289 * MiB, "map");

__device__ __forceinline__ unsigned f2bf(float f) { unsigned u = __float_as_uint(f); return (u + 0x7fffu + ((u >> 16) & 1u)) >> 16; }
__device__ __forceinline__ float bf2f(unsigned b) { return __uint_as_float(b << 16); }
typedef __bf16 bf16x2_t_ __attribute__((ext_vector_type(2)));
__device__ __forceinline__ unsigned pk2(float lo, float hi) { const f32x2 v = {lo, hi}; const bf16x2_t_ b = __builtin_convertvector(v, bf16x2_t_); return __builtin_bit_cast(unsigned, b); }
__device__ __forceinline__ float sigmoidf_(float x) { return 1.0f / (1.0f + __expf(-x)); }
__device__ __forceinline__ float sigmoid_fast(float x) { return __builtin_amdgcn_rcpf(1.0f + __expf(-x)); }
__device__ __forceinline__ float tanh_fast(float x) { return 2.0f * sigmoid_fast(2.0f * x) - 1.0f; }
__device__ __forceinline__ float softplusf_(float x) { return fmaxf(x, 0.f) + __logf(1.0f + __expf(-fabsf(x))); }
__device__ __forceinline__ float shx(float v, int o, int lane) { return __int_as_float(__builtin_amdgcn_ds_bpermute((lane ^ o) << 2, __float_as_int(v))); }
__device__ __forceinline__ float wave_sum(float v, int lane) {
#pragma unroll
    for (int o = 1; o < 64; o <<= 1) v += shx(v, o, lane);
    return v;
}
__device__ __forceinline__ int opaque_tid(int wv_s) { int l; asm volatile("v_mbcnt_lo_u32_b32 %0, -1, 0\n\tv_mbcnt_hi_u32_b32 %0, -1, %0" : "=v"(l)); return wv_s * 64 + l; }

namespace pg8 {
constexpr int BM = 256, BK = 64, HALF = 128, HTB = HALF * BK * 2, STAGE_BYTES = 8 * HTB, NXCD = 8, WGM = 8;
__host__ __device__ __forceinline__ int lds_byte(int r, int c) { const int st = (r >> 4) * 2 + (c >> 5), rr = r & 15, cc = c & 31, ob = rr * 64 + cc * 2; return st * 1024 + (ob ^ (((ob >> 9) & 1) << 5)); }
__host__ __device__ __forceinline__ void stage_rc(int b, int& R, int& C) { const int st = b / 1024, sb = b % 1024, swz = sb ^ (((sb >> 9) & 1) << 5); R = (st >> 1) * 16 + swz / 64; C = (st & 1) * 32 + (swz % 64) / 2; }
__host__ __device__ __forceinline__ int perm32(int rho) { const int n = rho >> 4, i = rho & 15; return 8 * (i >> 2) + 4 * n + (i & 3); }

struct Unit { int pm, pn; const char* A; const char* B; int e, r0, nvalid, pad; };

typedef __bf16 bf16x2_cv __attribute__((ext_vector_type(2)));
__device__ __forceinline__ unsigned cvt_pk_bf16(float lo, float hi) { const f32x2 v = {lo, hi}; const bf16x2_cv b = __builtin_convertvector(v, bf16x2_cv); return __builtin_bit_cast(unsigned, b); }

template <class Epi, class Sched, bool ALIGN_EPI, bool GATHER>
__device__ __forceinline__ void gemm_phase(LAS unsigned char* lds, const int K_in, const Sched& S, const Epi& E, const int wv_s) {
    int K = K_in; asm volatile("" : "+s"(K));
    const int tid = opaque_tid(wv_s), wid = wv_s, lane = tid & 63, wr = wid >> 2, wc = wid & 3, fr = lane & 15, fq = lane >> 4;
    const int nt = K / BK;
    int Rr[2], Cc[2]; unsigned voffB[2];
#pragma unroll
    for (int i = 0; i < 2; ++i) { int R, C; stage_rc(tid * 16 + i * 8192, R, C); Rr[i] = R; Cc[i] = C; const int Rb = Epi::PERM ? ((R & ~31) + perm32(R & 31)) : R; voffB[i] = (unsigned)(Rb * K + C) * 2u; }
    const size_t kstep = (size_t)(BK * 2);
    const size_t kstepA = S.kstepA();
    const size_t hstep = (size_t)HALF * K * 2;
    const unsigned ldsw = (unsigned)wid * 1024u;
    const int aoff = lds_byte(wr * 64 + fr, fq * 8), boff = lds_byte(wc * 32 + fr, fq * 8);
#define PG8_SA(b, h) (((b) * 2 + (h)) * HTB)
#define PG8_SB(b, h) ((4 + (b) * 2 + (h)) * HTB)
#define PG8_STAGE(bufoff, gbase, voff) do { _Pragma("unroll") for (int _i = 0; _i < 2; ++_i) \
        __builtin_amdgcn_global_load_lds((const unsigned*)((const char*)(gbase) + (voff)[_i]), (LAS unsigned*)(lds + (bufoff) + ldsw + _i * 8192), 16, 0, 0); } while (0)
#define PG8_LDA(dst, b, h) do { _Pragma("unroll") for (int m = 0; m < 4; ++m) _Pragma("unroll") for (int k = 0; k < 2; ++k) dst[m][k] = *(const LAS bf16x8*)(lds + PG8_SA(b, h) + aoff + m * 2048 + k * 1024); } while (0)
#define PG8_LDB(dst, b, h) do { _Pragma("unroll") for (int n = 0; n < 2; ++n) _Pragma("unroll") for (int k = 0; k < 2; ++k) dst[n][k] = *(const LAS bf16x8*)(lds + PG8_SB(b, h) + boff + n * 2048 + k * 1024); } while (0)
#define PG8_MMA(ai, bj, At, Bt) do { __builtin_amdgcn_s_setprio(1); _Pragma("unroll") for (int m = 0; m < 4; ++m) _Pragma("unroll") for (int n = 0; n < 2; ++n) _Pragma("unroll") for (int k = 0; k < 2; ++k) \
        acc[ai][bj][m][n] = __builtin_amdgcn_mfma_f32_16x16x32_bf16(Bt[n][k], At[m][k], acc[ai][bj][m][n], 0, 0, 0); __builtin_amdgcn_s_setprio(0); } while (0)
#define PG8_WAIT_V(n) asm volatile("s_waitcnt vmcnt(" #n ")" ::: "memory")
#define PG8_WAIT_L(n) asm volatile("s_waitcnt lgkmcnt(" #n ")" ::: "memory")
#define PG8_BAR __builtin_amdgcn_s_barrier()
#define PG8_SCHED __builtin_amdgcn_sched_barrier(0)
    Unit cur, nxt; int ui = 0;
    if (!S.next(0, cur)) return;
    f32x4 acc[2][2][4][2];
#pragma unroll
    for (int a = 0; a < 2; ++a)
#pragma unroll
        for (int b = 0; b < 2; ++b)
#pragma unroll
            for (int m = 0; m < 4; ++m)
#pragma unroll
                for (int n = 0; n < 2; ++n) acc[a][b][m][n] = (f32x4){0.f, 0.f, 0.f, 0.f};
    bf16x8 At[4][2], B0[2][2], B1[2][2];
    unsigned cv[2][2], nv[2][2];
    S.fill(cur, Rr, Cc, K, cv);
    const char* cA = cur.A; const char* cB = cur.B;
    PG8_STAGE(PG8_SB(0, 0), cB, voffB); PG8_STAGE(PG8_SB(0, 1), cB + hstep, voffB); PG8_STAGE(PG8_SA(0, 0), cA, cv[0]); PG8_STAGE(PG8_SA(0, 1), cA, cv[1]);
    if (wr == 1) PG8_BAR;
    PG8_WAIT_V(2); PG8_BAR;
    PG8_STAGE(PG8_SB(1, 0), cB + kstep, voffB); PG8_STAGE(PG8_SA(1, 0), cA + kstepA, cv[0]); PG8_STAGE(PG8_SB(1, 1), cB + hstep + kstep, voffB);
    PG8_WAIT_V(6); PG8_BAR;
    for (;;) {
        const bool has_next = S.next(ui + 1, nxt);
        const char* nA = has_next ? nxt.A : cA; const char* nB = has_next ? nxt.B : cB;
        if (GATHER) { if (has_next) S.fill(nxt, Rr, Cc, K, nv); else { nv[0][0] = cv[0][0]; nv[0][1] = cv[0][1]; nv[1][0] = cv[1][0]; nv[1][1] = cv[1][1]; } }
        for (int t = 0; t < nt; t += 2) {
            const bool last = (t == nt - 2);
            const char* a1 = cA + (size_t)(t + 1) * kstepA;
            const char* a2 = last ? nA : cA + (size_t)(t + 2) * kstepA; const char* b2 = last ? nB : cB + (size_t)(t + 2) * kstep;
            const char* a3 = a2 + kstepA; const char* b3 = b2 + kstep;
            unsigned v2[2][2];
            if (GATHER) { v2[0][0] = last ? nv[0][0] : cv[0][0]; v2[0][1] = last ? nv[0][1] : cv[0][1]; v2[1][0] = last ? nv[1][0] : cv[1][0]; v2[1][1] = last ? nv[1][1] : cv[1][1]; }
            else { v2[0][0] = cv[0][0]; v2[0][1] = cv[0][1]; v2[1][0] = cv[1][0]; v2[1][1] = cv[1][1]; }
            PG8_LDB(B0, 0, 0); PG8_LDB(B1, 0, 1); PG8_SCHED; PG8_LDA(At, 0, 0); PG8_STAGE(PG8_SA(1, 1), a1, cv[1]);
            PG8_WAIT_V(8); PG8_WAIT_L(0); PG8_BAR; PG8_MMA(0, 0, At, B0); PG8_MMA(0, 1, At, B1); PG8_BAR; PG8_SCHED;
            PG8_LDA(At, 0, 1); PG8_STAGE(PG8_SB(0, 0), b2, voffB); PG8_STAGE(PG8_SB(0, 1), b2 + hstep, voffB); PG8_STAGE(PG8_SA(0, 0), a2, v2[0]);
            PG8_WAIT_V(8); PG8_WAIT_L(0); PG8_BAR; PG8_MMA(1, 0, At, B0); PG8_MMA(1, 1, At, B1); PG8_BAR; PG8_SCHED;
            PG8_LDB(B0, 1, 0); PG8_LDB(B1, 1, 1); PG8_SCHED; PG8_LDA(At, 1, 0); PG8_STAGE(PG8_SA(0, 1), a2, v2[1]);
            PG8_WAIT_V(8); PG8_WAIT_L(0); PG8_BAR; PG8_MMA(0, 0, At, B0); PG8_MMA(0, 1, At, B1); PG8_BAR; PG8_SCHED;
            PG8_LDA(At, 1, 1); PG8_STAGE(PG8_SB(1, 0), b3, voffB); PG8_STAGE(PG8_SB(1, 1), b3 + hstep, voffB); PG8_STAGE(PG8_SA(1, 0), a3, v2[0]);
            PG8_WAIT_V(8); PG8_WAIT_L(0); PG8_BAR; PG8_MMA(1, 0, At, B0); PG8_MMA(1, 1, At, B1); PG8_BAR; PG8_SCHED;
        }
        if constexpr (ALIGN_EPI) { if (wr == 0) PG8_BAR; }
        { int fr_ = fr, fq_ = fq; asm volatile("" : "+v"(fr_), "+v"(fq_));
          E(acc, cur, wr, wc, fr_, fq_); }
        if (!has_next) break;
#pragma unroll
        for (int a = 0; a < 2; ++a)
#pragma unroll
            for (int b = 0; b < 2; ++b)
#pragma unroll
                for (int m = 0; m < 4; ++m)
#pragma unroll
                    for (int n = 0; n < 2; ++n) acc[a][b][m][n] = (f32x4){0.f, 0.f, 0.f, 0.f};
        cur = nxt; cA = nA; cB = nB; ++ui;
        if (GATHER) { cv[0][0] = nv[0][0]; cv[0][1] = nv[0][1]; cv[1][0] = nv[1][0]; cv[1][1] = nv[1][1]; }
        if constexpr (ALIGN_EPI) { if (wr == 1) PG8_BAR; }
    }
    PG8_WAIT_V(0);
    if constexpr (!ALIGN_EPI) { if (wr == 0) PG8_BAR; }
    PG8_BAR;
#undef PG8_SA
#undef PG8_SB
#undef PG8_STAGE
#undef PG8_LDA
#undef PG8_LDB
#undef PG8_MMA
#undef PG8_WAIT_V
#undef PG8_WAIT_L
#undef PG8_BAR
#undef PG8_SCHED
}

struct DenseOrder {
    int nM, nN, nwg, G, c, K;
    const char* A; const char* B; size_t asel_stride; int asel_div, ascan;
    __device__ void init(int M_, int N_, int K_, int G_, int c_, const void* A_, const void* B_, int asel_div_, size_t asel_stride_) {
        nM = M_ / BM; nN = N_ / BM; nwg = nM * nN; G = G_; c = c_; K = K_; A = (const char*)A_; B = (const char*)B_; asel_div = asel_div_; asel_stride = asel_stride_; ascan = 0; }
    __device__ __forceinline__ bool next(int i, Unit& u) const {
        if (c < 0 || c >= G) return false;
        const long L = (long)i * G + c; if (L >= nwg) return false;
        int wgid = (int)L; { const int q = nwg / NXCD, r = nwg % NXCD, xcd = wgid % NXCD, off = wgid / NXCD; wgid = (xcd < r ? xcd * (q + 1) : r * (q + 1) + (xcd - r) * q) + off; }
        const int nig = WGM * nN, gid = wgid / nig, fm = gid * WGM, gsz = (nM - fm) < WGM ? (nM - fm) : WGM;
        u.pm = fm + ((wgid % nig) % gsz); u.pn = (wgid % nig) / gsz;
        u.A = ascan ? A + 2 * ((size_t)(u.pm >> 3) * 2097152 + (size_t)((u.pm * 4) & 31) * 4096) : A + (size_t)(u.pn / asel_div) * asel_stride + (size_t)u.pm * BM * K * 2;
        u.B = B + (size_t)u.pn * BM * K * 2;
        u.e = 0; u.r0 = 0; u.nvalid = BM; u.pad = 0; return true;
    }
    __device__ __forceinline__ void fill(const Unit&, const int (&R)[2], const int (&C)[2], int K_, unsigned (&v)[2][2]) const {
#pragma unroll
        for (int h = 0; h < 2; ++h)
#pragma unroll
            for (int i = 0; i < 2; ++i) { const int lr = h * HALF + R[i]; v[h][i] = ascan ? (unsigned)((lr >> 6) * 4096 + (lr & 63) * 8 + (C[i] >> 3) * 512) * 2u : (unsigned)(lr * K_ + C[i]) * 2u; }
    }
    __device__ __forceinline__ size_t kstepA() const { return ascan ? (size_t)262144 : (size_t)(BK * 2); }
};
struct MoeOrder {
    const int* counts; const int* rtok; const char* A; const char* B; size_t bexp_stride;
    int nN, K, gather, base, stride, hi;
    __device__ __forceinline__ bool next(int i, Unit& u) const {
        const int L = base + i * stride; if (L >= hi) return false;
        const int rt = L / nN; int acc = 0;
        for (int e = 0; e < NE; ++e) {
            const int cnt = counts[e * 64], ntile = (cnt + 255) >> 8;
            if (rt < acc + ntile) {
                u.pm = rt; u.pn = L % nN; u.e = e; u.r0 = (rt - acc) * 256; u.nvalid = min(256, cnt - u.r0); u.pad = 0;
                u.A = gather ? A : A + (size_t)rt * BM * K * 2; u.B = B + (size_t)e * bexp_stride + (size_t)u.pn * BM * K * 2; return true;
            }
            acc += ntile;
        }
        return false;
    }
    __device__ __forceinline__ void fill(const Unit& u, const int (&R)[2], const int (&C)[2], int K_, unsigned (&v)[2][2]) const {
#pragma unroll
        for (int h = 0; h < 2; ++h)
#pragma unroll
            for (int i = 0; i < 2; ++i) {
                const int rl = h * HALF + R[i];
                if (gather) { const int tok = (rl < u.nvalid) ? rtok[u.e * CAP + u.r0 + rl] : 0; v[h][i] = (unsigned)(tok * K_ + C[i]) * 2u; }
                else v[h][i] = (unsigned)(rl * K_ + C[i]) * 2u;
            }
    }
    __device__ __forceinline__ size_t kstepA() const { return (size_t)(BK * 2); }
};

__device__ __forceinline__ size_t scan_idx(int row, int col) { return ((size_t)((((row >> 11) * H + (col >> 6)) * 32 + ((row >> 6) & 31)) * 8 + ((col >> 3) & 7)) * 64 + (row & 63)) * 8 + (col & 7); }
struct EpiBf16 {
    static constexpr bool PERM = true;
    bf16* O; int ldc, split_div; size_t split_stride; float scale0; int act, scanlay;
    __device__ __forceinline__ void operator()(const f32x4 (&acc)[2][2][4][2], const Unit& u, int wr, int wc, int fr, int fq) const {
        const int t = u.pn / split_div; bf16* base = O + (size_t)t * split_stride;
        const int colt = (u.pn - t * split_div) * BM;
        const float sc = (t == 0) ? scale0 : 1.f;
        const int row0 = u.pm * BM + wr * 64 + fr, col0 = colt + wc * 32 + 8 * fq;
#pragma unroll
        for (int ai = 0; ai < 2; ++ai)
#pragma unroll
            for (int m = 0; m < 4; ++m) { const int row = row0 + ai * HALF + m * 16; bf16* rowp = base + (size_t)row * ldc + col0;
#pragma unroll
                for (int bj = 0; bj < 2; ++bj) { f32x4 v0 = acc[ai][bj][m][0] * sc, v1 = acc[ai][bj][m][1] * sc;
                    if (act == 1) {
                        if (bj == 0 && wc < 2) { v0.x = tanh_fast(v0.x); v0.y = tanh_fast(v0.y); v0.z = tanh_fast(v0.z); v0.w = tanh_fast(v0.w); v1.x = tanh_fast(v1.x); v1.y = tanh_fast(v1.y); v1.z = tanh_fast(v1.z); v1.w = tanh_fast(v1.w); }
                        else if (bj == 1) { v0.x = sigmoid_fast(v0.x); v0.y = sigmoid_fast(v0.y); v0.z = sigmoid_fast(v0.z); v0.w = sigmoid_fast(v0.w); v1.x = sigmoid_fast(v1.x); v1.y = sigmoid_fast(v1.y); v1.z = sigmoid_fast(v1.z); v1.w = sigmoid_fast(v1.w); }
                    }
                    u32x4 w; w.x = cvt_pk_bf16(v0[0], v0[1]); w.y = cvt_pk_bf16(v0[2], v0[3]); w.z = cvt_pk_bf16(v1[0], v1[1]); w.w = cvt_pk_bf16(v1[2], v1[3]);
                    bf16* dst = (scanlay != 0) ? base + scan_idx(row, col0 + bj * HALF) : rowp + bj * HALF;
                    *(u32x4*)dst = w; } }
    }
};
struct EpiLora2 {
    static constexpr bool PERM = true;
    _Float16* LW; bf16* AG; const float* w0; const float* a0;
    __device__ __forceinline__ void operator()(const f32x4 (&acc)[2][2][4][2], const Unit& u, int wr, int wc, int fr, int fq) const {
        const int t = u.pn >> 2, colt = (u.pn & 3) * BM;
        const int row0 = u.pm * BM + wr * 64 + fr, col0 = colt + wc * 32 + 8 * fq;
        if (t == 0) {
#pragma unroll
            for (int bj = 0; bj < 2; ++bj) {
                const f32x4 b0 = *(const f32x4*)(w0 + col0 + bj * HALF), b1 = *(const f32x4*)(w0 + col0 + bj * HALF + 4);
#pragma unroll
                for (int ai = 0; ai < 2; ++ai)
#pragma unroll
                    for (int m = 0; m < 4; ++m) {
                        const size_t o = scan_idx(row0 + ai * HALF + m * 16, col0 + bj * HALF);
                        const f32x4 v0 = acc[ai][bj][m][0] + b0, v1 = acc[ai][bj][m][1] + b1;
                        typedef _Float16 h8 __attribute__((ext_vector_type(8)));
                        h8 hv;
                        hv[0] = (_Float16)(-0.87503877f * sigmoid_fast(v0.x)); hv[1] = (_Float16)(-0.87503877f * sigmoid_fast(v0.y));
                        hv[2] = (_Float16)(-0.87503877f * sigmoid_fast(v0.z)); hv[3] = (_Float16)(-0.87503877f * sigmoid_fast(v0.w));
                        hv[4] = (_Float16)(-0.87503877f * sigmoid_fast(v1.x)); hv[5] = (_Float16)(-0.87503877f * sigmoid_fast(v1.y));
                        hv[6] = (_Float16)(-0.87503877f * sigmoid_fast(v1.z)); hv[7] = (_Float16)(-0.87503877f * sigmoid_fast(v1.w));
                        *(h8*)(LW + o) = hv;
                    }
            }
        } else if (t == 1) {
#pragma unroll
            for (int bj = 0; bj < 2; ++bj) {
                const f32x4 b0 = *(const f32x4*)(a0 + col0 + bj * HALF), b1 = *(const f32x4*)(a0 + col0 + bj * HALF + 4);
#pragma unroll
                for (int ai = 0; ai < 2; ++ai)
#pragma unroll
                    for (int m = 0; m < 4; ++m) {
                        const size_t o = scan_idx(row0 + ai * HALF + m * 16, col0 + bj * HALF);
                        const f32x4 v0 = acc[ai][bj][m][0] + b0, v1 = acc[ai][bj][m][1] + b1;
                        u32x4 w; w.x = cvt_pk_bf16(sigmoid_fast(v0.x), sigmoid_fast(v0.y)); w.y = cvt_pk_bf16(sigmoid_fast(v0.z), sigmoid_fast(v0.w));
                        w.z = cvt_pk_bf16(sigmoid_fast(v1.x), sigmoid_fast(v1.y)); w.w = cvt_pk_bf16(sigmoid_fast(v1.z), sigmoid_fast(v1.w));
                        *(u32x4*)(AG + o) = w;
                    }
            }
        } else {
#pragma unroll
            for (int bj = 0; bj < 2; ++bj)
#pragma unroll
                for (int ai = 0; ai < 2; ++ai)
#pragma unroll
                    for (int m = 0; m < 4; ++m) {
                        const size_t o = (size_t)M * D + (size_t)(row0 + ai * HALF + m * 16) * D + col0 + bj * HALF;
                        const f32x4 v0 = acc[ai][bj][m][0], v1 = acc[ai][bj][m][1];
                        u32x4 w; w.x = cvt_pk_bf16(v0.x, v0.y); w.y = cvt_pk_bf16(v0.z, v0.w); w.z = cvt_pk_bf16(v1.x, v1.y); w.w = cvt_pk_bf16(v1.z, v1.w);
                        *(u32x4*)(AG + o) = w;
                    }
        }
    }
};
struct EpiPre {
    static constexpr bool PERM = true;
    const float* hin32; const bf16* hin16; bf16* out;
    __device__ __forceinline__ void operator()(const f32x4 (&acc)[2][2][4][2], const Unit& u, int wr, int wc, int fr, int fq) const {
        const int row0 = u.pm * BM + wr * 64 + fr, col0 = u.pn * BM + wc * 32 + 8 * fq;
#pragma unroll
        for (int ai = 0; ai < 2; ++ai)
#pragma unroll
            for (int m = 0; m < 4; ++m) { const size_t ro = (size_t)(row0 + ai * HALF + m * 16) * D + col0;
#pragma unroll
                for (int bj = 0; bj < 2; ++bj) { const size_t o = ro + bj * HALF;
                    f32x4 h0, h1;
                    if (hin32) { h0 = *(const f32x4*)(hin32 + o); h1 = *(const f32x4*)(hin32 + o + 4); }
                    else { const u32x4 hv = *(const u32x4*)(hin16 + o); h0 = (f32x4){bf2f(hv.x & 0xffff), bf2f(hv.x >> 16), bf2f(hv.y & 0xffff), bf2f(hv.y >> 16)}; h1 = (f32x4){bf2f(hv.z & 0xffff), bf2f(hv.z >> 16), bf2f(hv.w & 0xffff), bf2f(hv.w >> 16)}; }
                    const f32x4 v0 = h0 * ALPHA + acc[ai][bj][m][0], v1 = h1 * ALPHA + acc[ai][bj][m][1];
                    u32x4 w; w.x = cvt_pk_bf16(v0[0], v0[1]); w.y = cvt_pk_bf16(v0[2], v0[3]); w.z = cvt_pk_bf16(v1[0], v1[1]); w.w = cvt_pk_bf16(v1[2], v1[3]);
                    *(u32x4*)(out + o) = w; } }
    }
};
struct EpiGU {
    static constexpr bool PERM = true;
    bf16* hid;
    __device__ __forceinline__ void operator()(const f32x4 (&acc)[2][2][4][2], const Unit& u, int wr, int wc, int fr, int fq) const {
        const int row0 = u.pm * BM + wr * 64 + fr, col0 = u.pn * 128 + wc * 16 + 4 * fq;
#pragma unroll
        for (int ai = 0; ai < 2; ++ai)
#pragma unroll
            for (int m = 0; m < 4; ++m) { bf16* rowp = hid + (size_t)(row0 + ai * HALF + m * 16) * DE + col0;
#pragma unroll
                for (int bj = 0; bj < 2; ++bj) { const f32x4 g = acc[ai][bj][m][0], uu = acc[ai][bj][m][1];
                    u32x2 w; w.x = cvt_pk_bf16(g.x * sigmoid_fast(g.x) * uu.x, g.y * sigmoid_fast(g.y) * uu.y); w.y = cvt_pk_bf16(g.z * sigmoid_fast(g.z) * uu.z, g.w * sigmoid_fast(g.w) * uu.w);
                    *(u32x2*)(rowp + bj * 64) = w; } }
    }
};
struct EpiDN {
    static constexpr bool PERM = true;
    bf16* y; const float* rgate;
    __device__ __forceinline__ void operator()(const f32x4 (&acc)[2][2][4][2], const Unit& u, int wr, int wc, int fr, int fq) const {
        const int col0 = u.pn * BM + wc * 32 + 8 * fq;
#pragma unroll
        for (int ai = 0; ai < 2; ++ai)
#pragma unroll
            for (int m = 0; m < 4; ++m) { const int rl = ai * HALF + wr * 64 + m * 16 + fr;
                if (rl < u.nvalid) { const float gt = rgate[u.e * CAP + u.r0 + rl]; bf16* rowp = y + (size_t)(u.pm * BM + rl) * D + col0;
#pragma unroll
                    for (int bj = 0; bj < 2; ++bj) { const f32x4 v0 = acc[ai][bj][m][0] * gt, v1 = acc[ai][bj][m][1] * gt;
                        u32x4 w; w.x = cvt_pk_bf16(v0[0], v0[1]); w.y = cvt_pk_bf16(v0[2], v0[3]); w.z = cvt_pk_bf16(v1[0], v1[1]); w.w = cvt_pk_bf16(v1[2], v1[3]);
                        *(u32x4*)(rowp + bj * HALF) = w; } } }
    }
};
}

__device__ __forceinline__ void tr_load(const float* W, int ld, int k0, int n0, float (&v)[32], int lane) {
#pragma unroll
    for (int i = 0; i < 32; ++i) v[i] = W[(size_t)(k0 + 2 * i + (lane >> 5)) * ld + n0 + (lane & 31)];
}
__device__ __forceinline__ void tr_put(const float (&v)[32], int k0, int n0, const float* kscale, bf16* WT, int Kd, int koff, int drow0, int mode, LAS float* scr, int lane) {
#pragma unroll
    for (int i = 0; i < 32; ++i) { const int kk = 2 * i + (lane >> 5); float x = v[i]; if (kscale) x *= kscale[k0 + kk]; scr[kk * 33 + (lane & 31)] = x; }
    asm volatile("s_waitcnt lgkmcnt(0)" ::: "memory");
    const int c = lane & 7;
#pragma unroll
    for (int j = 0; j < 4; ++j) { const int n = (lane >> 3) + 8 * j; const LAS float* s = scr + (8 * c) * 33 + n;
        u32x4 o; o.x = pk2(s[0 * 33], s[1 * 33]); o.y = pk2(s[2 * 33], s[3 * 33]); o.z = pk2(s[4 * 33], s[5 * 33]); o.w = pk2(s[6 * 33], s[7 * 33]);
        const int nn = n0 + n; const int drow = (mode == 0) ? (drow0 + nn) : (drow0 + 8 * (nn >> 2) + (nn & 3) + (mode == 2 ? 4 : 0));
        *(u32x4*)(WT + (size_t)drow * Kd + koff + k0 + 8 * c) = o; }
    asm volatile("s_waitcnt lgkmcnt(0)" ::: "memory");
}
__device__ __forceinline__ void tr_item(const float* W, int ld, int k0, int n0, const float* kscale, bf16* WT, int Kd, int koff, int drow0, int mode, LAS float* scr, int lane) {
    float v[32]; tr_load(W, ld, k0, n0, v, lane); tr_put(v, k0, n0, kscale, WT, Kd, koff, drow0, mode, scr, lane);
}
__device__ __forceinline__ int tr_matrix(int item_base, int gw, int NGW, const float* W, int ld, int Ks, int Ns, const float* kscale, bf16* WT, int Kd, int koff, int drow0, int mode, LAS float* scr, int lane) {
    const int nblk = Ns / 32, nit = (Ks / 64) * nblk;
    int first = gw - (item_base % NGW); if (first < 0) first += NGW;
    for (int it = first; it < nit; it += NGW) tr_item(W, ld, 64 * (it / nblk), 32 * (it % nblk), kscale, WT, Kd, koff, drow0, mode, scr, lane);
    return item_base + nit;
}
struct MoeItem { const float* W; bf16* WT; int ld, k0, n0, Kd, mode; };
__device__ __forceinline__ MoeItem moe_item(int it, const float* wg, const float* wu, const float* wd, bf16* gut, bf16* dnt) {
    const int e = it / 768, r = it % 768; MoeItem m;
    if (r < 512) { const int q = r & 255; m.W = (r < 256 ? wg : wu) + (size_t)e * D * DE; m.ld = DE; m.k0 = 64 * (q / 16); m.n0 = 32 * (q % 16); m.WT = gut + (size_t)e * D * D; m.Kd = D; m.mode = r < 256 ? 1 : 2; }
    else { const int q = r - 512; m.W = wd + (size_t)e * DE * D; m.ld = D; m.k0 = 64 * (q / 32); m.n0 = 32 * (q % 32); m.WT = dnt + (size_t)e * D * DE; m.Kd = DE; m.mode = 0; }
    return m;
}
__device__ __forceinline__ void convert_moe(const float* wg, const float* wu, const float* wd, bf16* gut, bf16* dnt, int gw, int NGW, LAS float* scr, int lane) {
    float va[32], vb[32];
    int it = gw;
    if (it < NE * 768) { const MoeItem m = moe_item(it, wg, wu, wd, gut, dnt); tr_load(m.W, m.ld, m.k0, m.n0, va, lane); }
    while (it < NE * 768) {
        const MoeItem ma = moe_item(it, wg, wu, wd, gut, dnt);
        const int itb = it + NGW;
        if (itb < NE * 768) { const MoeItem m = moe_item(itb, wg, wu, wd, gut, dnt); tr_load(m.W, m.ld, m.k0, m.n0, vb, lane); }
        tr_put(va, ma.k0, ma.n0, nullptr, ma.WT, ma.Kd, 0, 0, ma.mode, scr, lane);
        if (itb >= NE * 768) break;
        const MoeItem mb = moe_item(itb, wg, wu, wd, gut, dnt);
        const int itc = itb + NGW;
        if (itc < NE * 768) { const MoeItem m = moe_item(itc, wg, wu, wd, gut, dnt); tr_load(m.W, m.ld, m.k0, m.n0, va, lane); }
        tr_put(vb, mb.k0, mb.n0, nullptr, mb.WT, mb.Kd, 0, 0, mb.mode, scr, lane);
        it = itc;
    }
}
constexpr int CNT_STRIDE = 64;
constexpr int RT = 2;
template <int CTRL> __device__ __forceinline__ float dppx(float v) { return __int_as_float(__builtin_amdgcn_update_dpp(0, __float_as_int(v), CTRL, 0xF, 0xF, false)); }
__device__ __forceinline__ float red8(float v) { v += dppx<0xB1>(v); v += dppx<0x4E>(v); v += dppx<0x141>(v); return v; }
__device__ __forceinline__ float red16(float v) { v = red8(v); v += dppx<0x140>(v); return v; }
__device__ __forceinline__ float red64(float v, int lane) { v = red16(v); v += shx(v, 16, lane); v += shx(v, 32, lane); return v; }
__device__ __forceinline__ void ln_rowsN(f32x4 (&v)[RT][4], const float* g, const float* b, int lane) {
    float s[RT];
#pragma unroll
    for (int t = 0; t < RT; ++t) { s[t] = 0.f;
#pragma unroll
        for (int j = 0; j < 4; ++j) s[t] += (v[t][j].x + v[t][j].y) + (v[t][j].z + v[t][j].w); }
#pragma unroll
    for (int t = 0; t < RT; ++t) s[t] = red64(s[t], lane);
    float s2[RT];
#pragma unroll
    for (int t = 0; t < RT; ++t) { const float mean = s[t] * (1.f / D); s2[t] = 0.f;
#pragma unroll
        for (int j = 0; j < 4; ++j) { v[t][j] = v[t][j] - mean; s2[t] += (v[t][j].x * v[t][j].x + v[t][j].y * v[t][j].y) + (v[t][j].z * v[t][j].z + v[t][j].w * v[t][j].w); } }
#pragma unroll
    for (int t = 0; t < RT; ++t) s2[t] = red64(s2[t], lane);
#pragma unroll
    for (int j = 0; j < 4; ++j) {
        const f32x4 gg = *(const f32x4*)(g + 4 * lane + 256 * j), bb = *(const f32x4*)(b + 4 * lane + 256 * j);
#pragma unroll
        for (int t = 0; t < RT; ++t) { const float rstd = rsqrtf(s2[t] * (1.f / D) + LN_EPS); v[t][j] = v[t][j] * rstd * gg + bb; }
    }
}
__device__ __forceinline__ void stage_w16(const float* Wm, int ldw, f32x4* wl, int tid) {
    for (int i = tid; i < 4096; i += 512) { const int c = i >> 2, e4 = i & 3, jq = (c >> 8) * 4 + (c & 3), ln = (c & 255) >> 2;
        wl[(jq * 4 + e4) * 64 + ln] = *(const f32x4*)(Wm + (size_t)c * ldw + 4 * e4); }
}
__device__ __forceinline__ float rowsN_dot16(const f32x4 (&v)[RT][4], const f32x4* wl, int lane) {
    float a[RT * 16];
#pragma unroll
    for (int i = 0; i < RT * 16; ++i) a[i] = 0.f;
    int lw = lane;
#pragma unroll
    for (int idx = 0; idx < 16; ++idx) {
        const int j = idx >> 2, q = idx & 3;
        if ((idx & 3) == 0) {
#pragma unroll
            for (int t = 0; t < RT; ++t)
                asm volatile("" : "+v"(lw), "+v"(a[t * 16 + 0]), "+v"(a[t * 16 + 1]), "+v"(a[t * 16 + 2]), "+v"(a[t * 16 + 3]), "+v"(a[t * 16 + 4]), "+v"(a[t * 16 + 5]), "+v"(a[t * 16 + 6]), "+v"(a[t * 16 + 7]),
                             "+v"(a[t * 16 + 8]), "+v"(a[t * 16 + 9]), "+v"(a[t * 16 + 10]), "+v"(a[t * 16 + 11]), "+v"(a[t * 16 + 12]), "+v"(a[t * 16 + 13]), "+v"(a[t * 16 + 14]), "+v"(a[t * 16 + 15]));
        }
        const f32x4 w0 = wl[(idx * 4 + 0) * 64 + lw], w1 = wl[(idx * 4 + 1) * 64 + lw], w2 = wl[(idx * 4 + 2) * 64 + lw], w3 = wl[(idx * 4 + 3) * 64 + lw];
#pragma unroll
        for (int t = 0; t < RT; ++t) {
            const float hv = q == 0 ? v[t][j].x : (q == 1 ? v[t][j].y : (q == 2 ? v[t][j].z : v[t][j].w));
            a[t * 16 + 0] += hv * w0.x; a[t * 16 + 1] += hv * w0.y; a[t * 16 + 2] += hv * w0.z; a[t * 16 + 3] += hv * w0.w;
            a[t * 16 + 4] += hv * w1.x; a[t * 16 + 5] += hv * w1.y; a[t * 16 + 6] += hv * w1.z; a[t * 16 + 7] += hv * w1.w;
            a[t * 16 + 8] += hv * w2.x; a[t * 16 + 9] += hv * w2.y; a[t * 16 + 10] += hv * w2.z; a[t * 16 + 11] += hv * w2.w;
            a[t * 16 + 12] += hv * w3.x; a[t * 16 + 13] += hv * w3.y; a[t * 16 + 14] += hv * w3.z; a[t * 16 + 15] += hv * w3.w;
        }
    }
#define TRED(o, n) do { const bool up_ = (lane & (o)) != 0; _Pragma("unroll") for (int i = 0; i < (n); ++i) { const float keep_ = up_ ? a[i + (n)] : a[i]; const float send_ = up_ ? a[i] : a[i + (n)]; a[i] = keep_ + shx(send_, (o), lane); } } while (0)
#pragma unroll
    for (int i = 0; i < RT * 16; ++i) a[i] += shx(a[i], 32, lane);
    if constexpr (RT == 1) {
#pragma unroll
        for (int i = 0; i < 16; ++i) a[i] += shx(a[i], 16, lane);
    } else { TRED(16, 16); }
    TRED(8, 8); TRED(4, 4); TRED(2, 2); TRED(1, 1);
#undef TRED
    return a[0];
}
__device__ __forceinline__ void store_rowsN(const f32x4 (&v)[RT][4], float* h, bf16* hb, int tok0, int lane) {
#pragma unroll
    for (int t = 0; t < RT; ++t)
#pragma unroll
        for (int j = 0; j < 4; ++j) {
            if (h) *(f32x4*)(h + (size_t)(tok0 + t) * D + 4 * lane + 256 * j) = v[t][j];
            if (hb) { u32x2 o; o.x = pk2(v[t][j].x, v[t][j].y); o.y = pk2(v[t][j].z, v[t][j].w);
                *(u32x2*)(hb + (size_t)(tok0 + t) * D + 4 * lane + 256 * j) = o; }
        }
}
__device__ __forceinline__ f32x4 ld_bf4(const bf16* p) { const u32x2 a = *(const u32x2*)p; return (f32x4){bf2f(a.x & 0xffff), bf2f(a.x >> 16), bf2f(a.y & 0xffff), bf2f(a.y >> 16)}; }

struct LnRouteP { const bf16* pin; bf16* hb; const float* g; const float* b; const unsigned char* wfg; const float* rbias; int* counts; int* rtok; float* rgate; int* slot; };
__device__ __forceinline__ void build_router_frags(const float* g, const float* b, const float* rw, unsigned char* out, unsigned char* lds, int tid) {
    float* prt = (float*)(lds + 6400);
    u32x4* WFo = (u32x4*)out; float* csc0 = (float*)(out + 65536);
    __syncthreads();
    for (int f = tid; f < 2048; f += 512) { const int kk = f >> 6, l = f & 63, e = l & 15, k0 = 32 * kk + 8 * (l >> 4);
        float wv8[8]; unsigned hi[4], lo[4];
#pragma unroll
        for (int q = 0; q < 8; ++q) wv8[q] = g[k0 + q] * rw[(size_t)(k0 + q) * NE + e];
#pragma unroll
        for (int q = 0; q < 4; ++q) { hi[q] = pk2(wv8[2 * q], wv8[2 * q + 1]); lo[q] = pk2(wv8[2 * q] - bf2f(hi[q] & 0xffff), wv8[2 * q + 1] - bf2f(hi[q] >> 16)); }
        u32x4 h4 = {hi[0], hi[1], hi[2], hi[3]}, l4 = {lo[0], lo[1], lo[2], lo[3]};
        WFo[(kk * 2 + 0) * 64 + l] = h4; WFo[(kk * 2 + 1) * 64 + l] = l4; }
    {   const int e = tid & 15, part = tid >> 4; float a0 = 0.f, a1 = 0.f;
#pragma unroll 8
        for (int q = 0; q < 32; ++q) { const int k = 32 * part + q; const float r = rw[(size_t)k * NE + e]; a0 += g[k] * r; a1 += b[k] * r; }
        prt[part * 16 + e] = a0; prt[512 + part * 16 + e] = a1; }
    __syncthreads();
    if (tid < 32) { const int e = tid & 15, which = tid >> 4; float a = 0.f;
#pragma unroll 8
        for (int q = 0; q < 32; ++q) a += prt[which * 512 + q * 16 + e];
        csc0[which * 16 + e] = a; }
    __syncthreads();
}
__device__ __forceinline__ void ph_ln_route(const LnRouteP& p, unsigned char* lds, const int wv_s) {
    const int tid = opaque_tid(wv_s); const int lane = tid & 63, wv = tid >> 6;
    int* sel_e = (int*)lds;
    float* sel_g = (float*)(lds + 512);
    int* lrank = (int*)(lds + 1024);
    int* lcnt = (int*)(lds + 1536);
    int* lbase = (int*)(lds + 1600);
    float* cs = (float*)(lds + 1664);
    float* c0 = (float*)(lds + 1728);
    float* st = (float*)(lds + 1792);
    float* lg = (float*)(lds + 2304);
    float* prt = (float*)(lds + 6400);
    bf16x8* WF = (bf16x8*)(lds + 16384);
    {
        const u32x4* wsrc = (const u32x4*)p.wfg; u32x4 tmp[8];
#pragma unroll
        for (int i = 0; i < 8; ++i) tmp[i] = wsrc[tid + 512 * i];
#pragma unroll
        for (int i = 0; i < 8; ++i) *(u32x4*)&WF[tid + 512 * i] = tmp[i];
        if (tid < 32) { const float x = ((const float*)(p.wfg + 65536))[tid]; if (tid < 16) cs[tid] = x; else c0[tid - 16] = x; }
        __syncthreads();
    }
    for (int tb = blockIdx.x * 64; tb < M; tb += gridDim.x * 64) {
        { const int tid0 = opaque_tid(wv_s); if (tid0 < 16) lcnt[tid0] = 0; }
        u32x2 raw[64 / (8 * RT)][RT][4];
#pragma unroll
        for (int rd = 0; rd < 64 / (8 * RT); ++rd)
#pragma unroll
            for (int t = 0; t < RT; ++t)
#pragma unroll
                for (int j = 0; j < 4; ++j) raw[rd][t][j] = *(const u32x2*)(p.pin + (size_t)(tb + rd * 8 * RT + wv * RT + t) * D + 4 * lane + 256 * j);
#pragma unroll
        for (int rd = 0; rd < 64 / (8 * RT); ++rd) {
            const int tl0 = rd * 8 * RT + wv * RT, tok0 = tb + tl0;
            int lane_r = lane; asm volatile("" : "+v"(lane_r));
            f32x4 v[RT][4];
#pragma unroll
            for (int t = 0; t < RT; ++t)
#pragma unroll
                for (int j = 0; j < 4; ++j) { const u32x2 a = raw[rd][t][j]; v[t][j] = (f32x4){bf2f(a.x & 0xffff), bf2f(a.x >> 16), bf2f(a.y & 0xffff), bf2f(a.y >> 16)}; }
            float s1[RT], s2[RT];
#pragma unroll
            for (int t = 0; t < RT; ++t) { float a = 0.f;
#pragma unroll
                for (int j = 0; j < 4; ++j) a += (v[t][j].x + v[t][j].y) + (v[t][j].z + v[t][j].w);
                s1[t] = red64(a, lane_r) * (1.f / D); }
#pragma unroll
            for (int t = 0; t < RT; ++t) { float a = 0.f;
#pragma unroll
                for (int j = 0; j < 4; ++j) { v[t][j] = v[t][j] - s1[t]; a += (v[t][j].x * v[t][j].x + v[t][j].y * v[t][j].y) + (v[t][j].z * v[t][j].z + v[t][j].w * v[t][j].w); }
                s2[t] = rsqrtf(red64(a, lane_r) * (1.f / D) + LN_EPS); }
#pragma unroll
            for (int j = 0; j < 4; ++j) {
                const f32x4 gg = *(const f32x4*)(p.g + 4 * lane_r + 256 * j), bb = *(const f32x4*)(p.b + 4 * lane_r + 256 * j);
#pragma unroll
                for (int t = 0; t < RT; ++t) v[t][j] = v[t][j] * s2[t] * gg + bb;
            }
            store_rowsN(v, nullptr, p.hb, tok0, lane_r);
            if (lane_r == 0) {
#pragma unroll
                for (int t = 0; t < RT; ++t) { st[2 * (tl0 + t)] = s1[t]; st[2 * (tl0 + t) + 1] = s2[t]; } }
        }
        if (wv < 4) {
            int lane_r = lane; asm volatile("" : "+v"(lane_r));
            const int fr = lane_r & 15, fq = lane_r >> 4;
            const bf16* arow = p.pin + (size_t)(tb + 16 * wv + fr) * D + 8 * fq;
            f32x4 acc = (f32x4){0.f, 0.f, 0.f, 0.f};
#pragma unroll 8
            for (int kk = 0; kk < 32; ++kk) {
                const bf16x8 a = *(const bf16x8*)(arow + 32 * kk);
                acc = __builtin_amdgcn_mfma_f32_16x16x32_bf16(a, WF[(kk * 2 + 0) * 64 + lane_r], acc, 0, 0, 0);
                acc = __builtin_amdgcn_mfma_f32_16x16x32_bf16(a, WF[(kk * 2 + 1) * 64 + lane_r], acc, 0, 0, 0);
            }
#pragma unroll
            for (int i = 0; i < 4; ++i) lg[(16 * wv + 4 * fq + i) * 16 + fr] = acc[i];
        }
        __syncthreads();
        {
            const int tid2 = opaque_tid(wv_s);
            if (tid2 < 64) {
                const float mu = st[2 * tid2], rstd = st[2 * tid2 + 1];
                float s[16], ss[16];
#pragma unroll
                for (int e4 = 0; e4 < 4; ++e4) { const f32x4 raw = *(const f32x4*)&lg[tid2 * 16 + 4 * e4];
#pragma unroll
                    for (int q = 0; q < 4; ++q) { const int e = 4 * e4 + q; const float r = q == 0 ? raw.x : (q == 1 ? raw.y : (q == 2 ? raw.z : raw.w));
                        const float lgt = rstd * (r - mu * cs[e]) + c0[e]; s[e] = sigmoidf_(lgt); ss[e] = s[e] + p.rbias[e]; } }
                int gbest = 0; float gscore = -INFINITY; int l1b = 0, l2b = 1;
#pragma unroll
                for (int g = 0; g < 4; ++g) {
                    float v1 = ss[4 * g], v2 = -INFINITY; int i1 = 0, i2 = -1;
#pragma unroll
                    for (int i = 1; i < 4; ++i) {
                        const float x = ss[4 * g + i];
                        if (x > v1) { v2 = v1; i2 = i1; v1 = x; i1 = i; }
                        else if (x > v2) { v2 = x; i2 = i; }
                    }
                    const float sc = v1 + v2;
                    if (sc > gscore) { gscore = sc; gbest = g; l1b = i1; l2b = i2; }
                }
                const int e0 = 4 * gbest + l1b, e1 = 4 * gbest + l2b;
                float s0 = 0.f, s1v = 0.f;
#pragma unroll
                for (int e = 0; e < 16; ++e) { s0 = (e == e0) ? s[e] : s0; s1v = (e == e1) ? s[e] : s1v; }
                const float inv = 1.0f / (s0 + s1v);
                sel_e[2 * tid2] = e0; sel_e[2 * tid2 + 1] = e1; sel_g[2 * tid2] = s0 * inv; sel_g[2 * tid2 + 1] = s1v * inv;
                lrank[2 * tid2] = atomicAdd(&lcnt[e0], 1); lrank[2 * tid2 + 1] = atomicAdd(&lcnt[e1], 1);
            }
            __syncthreads();
            if (tid2 < 16) lbase[tid2] = atomicAdd(p.counts + tid2 * CNT_STRIDE, lcnt[tid2]);
            __syncthreads();
            if (tid2 < 128) {
                const int tl = tid2 >> 1, k = tid2 & 1, e = sel_e[2 * tl + k], r = lbase[e] + lrank[2 * tl + k];
                p.rtok[e * CAP + r] = tb + tl; p.rgate[e * CAP + r] = sel_g[2 * tl + k]; p.slot[2 * (tb + tl) + k] = e * CAP + r;
            }
            __syncthreads();
        }
    }
}

struct LnCombP { bf16* hb; const bf16* y; const int* slot; const int* counts; const float* g; const float* b; const float* wf; const float* bf; float* logf; float* outp; int do_f; int pad; };
__device__ __forceinline__ void ph_ln_comb(const LnCombP& p, unsigned char* lds, const int wv_s) {
    const int tid = opaque_tid(wv_s); const int lane = tid & 63, wv = tid >> 6;
    int* pstart = (int*)lds;
    f32x4* wl = (f32x4*)(lds + 2048);
    if (p.do_f) stage_w16(p.wf, NW_IN, wl, tid);
    if (tid == 0) { int acc = 0; for (int e = 0; e < NE; ++e) { pstart[e] = acc; acc += ((p.counts[e * CNT_STRIDE] + 255) >> 8) * 256; } }
    __syncthreads();
    u32x2 hr[RT][4], ya[RT][4], yb[RT][4];
#define LC_ISSUE(tk_, ln_) do { _Pragma("unroll") for (int t = 0; t < RT; ++t) { \
        const int sl0 = p.slot[2 * ((tk_) + t)], sl1 = p.slot[2 * ((tk_) + t) + 1]; \
        const int c0 = pstart[sl0 / CAP] + (sl0 % CAP), c1 = pstart[sl1 / CAP] + (sl1 % CAP); \
        _Pragma("unroll") for (int j = 0; j < 4; ++j) { hr[t][j] = *(const u32x2*)(p.hb + (size_t)((tk_) + t) * D + 4 * (ln_) + 256 * j); \
            ya[t][j] = *(const u32x2*)(p.y + (size_t)c0 * D + 4 * (ln_) + 256 * j); yb[t][j] = *(const u32x2*)(p.y + (size_t)c1 * D + 4 * (ln_) + 256 * j); } } } while (0)
    const int tok_first = (blockIdx.x * 8 + wv) * RT, tok_step = gridDim.x * 8 * RT;
    if (tok_first < M) LC_ISSUE(tok_first, lane);
#pragma unroll 1
    for (int tok0 = tok_first; tok0 < M; tok0 += tok_step) {
        int lane_r = lane; asm volatile("" : "+v"(lane_r));
        f32x4 v[RT][4];
#pragma unroll
        for (int t = 0; t < RT; ++t)
#pragma unroll
            for (int j = 0; j < 4; ++j) { const u32x2 h2 = hr[t][j], a = ya[t][j], bq = yb[t][j];
                v[t][j].x = ALPHA * bf2f(h2.x & 0xffff) + (bf2f(a.x & 0xffff) + bf2f(bq.x & 0xffff));
                v[t][j].y = ALPHA * bf2f(h2.x >> 16) + (bf2f(a.x >> 16) + bf2f(bq.x >> 16));
                v[t][j].z = ALPHA * bf2f(h2.y & 0xffff) + (bf2f(a.y & 0xffff) + bf2f(bq.y & 0xffff));
                v[t][j].w = ALPHA * bf2f(h2.y >> 16) + (bf2f(a.y >> 16) + bf2f(bq.y >> 16)); }
        if (tok0 + tok_step < M) LC_ISSUE(tok0 + tok_step, lane_r);
        ln_rowsN(v, p.g, p.b, lane_r);
        store_rowsN(v, p.outp, p.outp ? nullptr : p.hb, tok0, lane_r);
        if (p.do_f) {
            const float f = rowsN_dot16(v, wl, lane_r);
            if (lane_r < 16 * RT) p.logf[(size_t)(tok0 + (lane_r >> 4)) * 16 + (lane_r & 15)] = -softplusf_(-(f + p.bf[lane_r & 15]));
        }
    }
#undef LC_ISSUE
}

struct ScanP { const bf16* r; const bf16* k; const bf16* v; const _Float16* lw; const bf16* a; const bf16* g; bf16* yg;
               const float* kk; const float* ka; const float* rk; const float* gng; const float* gnb; };
__device__ __forceinline__ void ph_scan(const ScanP& p, unsigned char* lds, int nscan, const int wv_s) {
    typedef float (*arr64)[64];
    arr64 s_r = (arr64)lds, s_kk = (arr64)(lds + 8192), s_b = (arr64)(lds + 16384), s_w = (arr64)(lds + 24576), s_k = (arr64)(lds + 32768), s_v = (arr64)(lds + 40960), s_y = (arr64)(lds + 49152);
    float* s_bonus = (float*)(lds + 57344);
    const int tid = opaque_tid(wv_s);
    const int i = tid >> 3, jq = tid & 7;
    const int lt = tid >> 4, c4 = (tid & 15) * 4;
    for (int unit = blockIdx.x; unit < NB * H; unit += nscan) {
        const int b = unit / H, h = unit % H;
        f32x2 S[4];
#pragma unroll
        for (int j = 0; j < 4; ++j) S[j] = (f32x2){0.f, 0.f};
        const f32x4 kkp = *(const f32x4*)(p.kk + h * HD + c4), kap = *(const f32x4*)(p.ka + h * HD + c4), rkp = *(const f32x4*)(p.rk + h * HD + c4);
        const f32x4 gng = *(const f32x4*)(p.gng + h * HD + c4), gnb = *(const f32x4*)(p.gnb + h * HD + c4);
        typedef _Float16 h4 __attribute__((ext_vector_type(4)));
        size_t base = (size_t)(b * T + lt) * D + h * HD + c4;
        u32x2 r2 = *(const u32x2*)(p.r + base), k2 = *(const u32x2*)(p.k + base), v2 = *(const u32x2*)(p.v + base), a2 = *(const u32x2*)(p.a + base), g2 = *(const u32x2*)(p.g + base);
        h4 lwh = *(const h4*)(p.lw + base);
        for (int blk = 0; blk < T / 32; ++blk) {
            const size_t obase = base;
            const u32x2 g2c = g2;
            {
                const f32x4 lw4 = {(float)lwh[0], (float)lwh[1], (float)lwh[2], (float)lwh[3]};
                const f32x4 rr = {bf2f(r2.x & 0xffff), bf2f(r2.x >> 16), bf2f(r2.y & 0xffff), bf2f(r2.y >> 16)};
                const f32x4 kr = {bf2f(k2.x & 0xffff), bf2f(k2.x >> 16), bf2f(k2.y & 0xffff), bf2f(k2.y >> 16)};
                const f32x4 vv = {bf2f(v2.x & 0xffff), bf2f(v2.x >> 16), bf2f(v2.y & 0xffff), bf2f(v2.y >> 16)};
                const f32x4 aa = {bf2f(a2.x & 0xffff), bf2f(a2.x >> 16), bf2f(a2.y & 0xffff), bf2f(a2.y >> 16)};
                const f32x4 kkn = kr * kkp;
                const float ss = red16((kkn.x * kkn.x + kkn.y * kkn.y) + (kkn.z * kkn.z + kkn.w * kkn.w));
                const float inv = fminf(__builtin_amdgcn_rsqf(ss), 1e12f);
                const f32x4 kkv = kkn * inv;
                const f32x4 km = kr * (1.0f + (aa - 1.0f) * kap);
                const f32x4 bb = kkv * aa;
                f32x4 wd; wd.x = __expf(lw4.x); wd.y = __expf(lw4.y); wd.z = __expf(lw4.z); wd.w = __expf(lw4.w);
                const f32x4 bt = rr * km * rkp;
                const float bo = red16((bt.x + bt.y) + (bt.z + bt.w));
                *(f32x4*)&s_r[lt][c4] = rr; *(f32x4*)&s_kk[lt][c4] = kkv; *(f32x4*)&s_b[lt][c4] = bb; *(f32x4*)&s_w[lt][c4] = wd;
                *(f32x4*)&s_k[lt][c4] = km; *(f32x4*)&s_v[lt][c4] = vv;
                if ((tid & 15) == 0) s_bonus[lt] = bo;
            }
            __syncthreads();
            if (blk + 1 < T / 32) {
                base += (size_t)32 * D;
                r2 = *(const u32x2*)(p.r + base); k2 = *(const u32x2*)(p.k + base); v2 = *(const u32x2*)(p.v + base); a2 = *(const u32x2*)(p.a + base); g2 = *(const u32x2*)(p.g + base);
                lwh = *(const h4*)(p.lw + base);
            }
#define SC_LOAD(X, tt_) do { X##k0 = *(const f32x4*)&s_kk[tt_][8 * jq]; X##k1 = *(const f32x4*)&s_kk[tt_][8 * jq + 4]; X##w0 = *(const f32x4*)&s_w[tt_][8 * jq]; X##w1 = *(const f32x4*)&s_w[tt_][8 * jq + 4]; \
                X##b0 = *(const f32x4*)&s_b[tt_][8 * jq]; X##b1 = *(const f32x4*)&s_b[tt_][8 * jq + 4]; X##q0 = *(const f32x4*)&s_k[tt_][8 * jq]; X##q1 = *(const f32x4*)&s_k[tt_][8 * jq + 4]; \
                X##r0 = *(const f32x4*)&s_r[tt_][8 * jq]; X##r1 = *(const f32x4*)&s_r[tt_][8 * jq + 4]; X##vi = s_v[tt_][i]; } while (0)
#define SC_STEP(X, tt_) do { \
                const f32x2 d_ = S[0] * (f32x2){X##k0.x, X##k0.y} + S[1] * (f32x2){X##k0.z, X##k0.w} + S[2] * (f32x2){X##k1.x, X##k1.y} + S[3] * (f32x2){X##k1.z, X##k1.w}; \
                const float sa_ = red8(d_.x + d_.y); \
                S[0] = S[0] * (f32x2){X##w0.x, X##w0.y} - sa_ * (f32x2){X##b0.x, X##b0.y} + X##vi * (f32x2){X##q0.x, X##q0.y}; \
                S[1] = S[1] * (f32x2){X##w0.z, X##w0.w} - sa_ * (f32x2){X##b0.z, X##b0.w} + X##vi * (f32x2){X##q0.z, X##q0.w}; \
                S[2] = S[2] * (f32x2){X##w1.x, X##w1.y} - sa_ * (f32x2){X##b1.x, X##b1.y} + X##vi * (f32x2){X##q1.x, X##q1.y}; \
                S[3] = S[3] * (f32x2){X##w1.z, X##w1.w} - sa_ * (f32x2){X##b1.z, X##b1.w} + X##vi * (f32x2){X##q1.z, X##q1.w}; \
                const f32x2 e_ = S[0] * (f32x2){X##r0.x, X##r0.y} + S[1] * (f32x2){X##r0.z, X##r0.w} + S[2] * (f32x2){X##r1.x, X##r1.y} + S[3] * (f32x2){X##r1.z, X##r1.w}; \
                const float y_ = red8(e_.x + e_.y); \
                if (jq == 0) s_y[tt_][i] = y_; } while (0)
            f32x4 Ak0, Ak1, Aw0, Aw1, Ab0, Ab1, Aq0, Aq1, Ar0, Ar1, Bk0, Bk1, Bw0, Bw1, Bb0, Bb1, Bq0, Bq1, Br0, Br1; float Avi, Bvi;
            SC_LOAD(A, 0);
            for (int tt = 0; tt < 32; tt += 2) {
                SC_LOAD(B, tt + 1);
                SC_STEP(A, tt);
                { const int tn = (tt + 2) & 31; SC_LOAD(A, tn); }
                SC_STEP(B, tt + 1);
            }
#undef SC_LOAD
#undef SC_STEP
            __syncthreads();
            {
                const f32x4 y4 = *(const f32x4*)&s_y[lt][c4];
                const float mu = red16((y4.x + y4.y) + (y4.z + y4.w)) * (1.f / 64.f);
                const f32x4 dd = y4 - mu;
                const float rstd = rsqrtf(red16((dd.x * dd.x + dd.y * dd.y) + (dd.z * dd.z + dd.w * dd.w)) * (1.f / 64.f) + GN_EPS);
                const f32x4 vv = *(const f32x4*)&s_v[lt][c4];
                const float bo = s_bonus[lt];
                const f32x4 gg = {bf2f(g2c.x & 0xffff), bf2f(g2c.x >> 16), bf2f(g2c.y & 0xffff), bf2f(g2c.y >> 16)};
                const f32x4 o = (dd * rstd * gng + gnb + bo * vv) * gg;
                u32x2 ob; ob.x = pk2(o.x, o.y); ob.y = pk2(o.z, o.w);
                *(u32x2*)(p.yg + obase) = ob;
            }
            __syncthreads();
        }
    }
}

namespace sc {
constexpr int GLD = 64;
__device__ __forceinline__ int swz(int row, int col) { return row * GLD + ((((col >> 3) ^ row) & 7) << 3) + (col & 7); }
constexpr int BUFB = 64 * GLD * 2;
constexpr int B_KKD = 0, B_RD = 1, B_BINV = 2, B_KINV = 3, B_VT = 4, B_KDT = 5, B_NBDT = 6, B_SB = 7, B_M = 8, B_NQ = 9;
constexpr int B_XT = B_KKD, B_N = B_BINV, B_P = B_KINV;
constexpr int MS = 68;
constexpr int F_M = 10 * BUFB, F_R = F_M + 64 * MS * 4, PART = F_R + 64 * 65 * 4, GT = PART + 2 * 8 * 64 * 4, BON = GT + 256, SCR = BON + 256, END = SCR + 4 * 4096;
constexpr int LD16 = 24, O_XR = 0, O_XT = 768, O_TR = 1536, O_RT = 2304, O_TD = 3072;
static_assert(END <= 147392, "scan LDS");
__device__ __forceinline__ bf16* buf(unsigned char* lds, int i) { return (bf16*)(lds + i * BUFB); }
__device__ __forceinline__ bf16* xtb(unsigned char* lds) { return (bf16*)(lds + SCR); }
__device__ __forceinline__ void tile_mma(f32x4& acc, const bf16* A, int arow0, const bf16* Bt, int brow0, int fr, int fq) {
#pragma unroll
    for (int kk = 0; kk < 2; ++kk) {
        const bf16x8 a = *(const bf16x8*)&A[swz(arow0 + fr, kk * 32 + 8 * fq)];
        const bf16x8 b = *(const bf16x8*)&Bt[swz(brow0 + fr, kk * 32 + 8 * fq)];
        acc = __builtin_amdgcn_mfma_f32_16x16x32_bf16(a, b, acc, 0, 0, 0);
    }
}
__device__ __forceinline__ unsigned cvtpk(float lo, float hi);
__device__ __forceinline__ bf16 cvt1(float x);
__device__ __forceinline__ void mm16(f32x4& acc, const bf16* A, const bf16* Bt, int fr, int fq) {
    bf16x8 a = (bf16x8){0, 0, 0, 0, 0, 0, 0, 0}, b = a;
    if (fq < 2) { a = *(const bf16x8*)&A[fr * LD16 + 8 * fq]; b = *(const bf16x8*)&Bt[fr * LD16 + 8 * fq]; }
    acc = __builtin_amdgcn_mfma_f32_16x16x32_bf16(a, b, acc, 0, 0, 0);
}
__device__ __forceinline__ void wr_rm(bf16* R, const f32x4 v, int fr, int fq) {
#pragma unroll
    for (int i = 0; i < 4; ++i) R[(4 * fq + i) * LD16 + fr] = cvt1(v[i]);
}
__device__ __forceinline__ void wr_tr(bf16* Tt, const f32x4 v, int fr, int fq) { u32x2 o; o.x = cvtpk(v[0], v[1]); o.y = cvtpk(v[2], v[3]); *(u32x2*)&Tt[fr * LD16 + 4 * fq] = o; }
#define SC_LWAIT() asm volatile("s_waitcnt lgkmcnt(0)" ::: "memory")
typedef short s16x4 __attribute__((ext_vector_type(4)));
__device__ __forceinline__ s16x4 pk4(const f32x4 v) { u32x2 o; o.x = cvtpk(v[0], v[1]); o.y = cvtpk(v[2], v[3]); return __builtin_bit_cast(s16x4, o); }
__device__ __forceinline__ f32x4 mm16k(const s16x4 a, const s16x4 b, const f32x4 c) { return __builtin_amdgcn_mfma_f32_16x16x16bf16_1k(a, b, c, 0, 0, 0); }
constexpr int MP = 20, MDS = 16 * MP;
constexpr int PRM = F_M + 8192;
__device__ __forceinline__ void cvt8(const u32x4 v, float (&o)[8]) {
    o[0] = bf2f(v.x & 0xffff); o[1] = bf2f(v.x >> 16); o[2] = bf2f(v.y & 0xffff); o[3] = bf2f(v.y >> 16);
    o[4] = bf2f(v.z & 0xffff); o[5] = bf2f(v.z >> 16); o[6] = bf2f(v.w & 0xffff); o[7] = bf2f(v.w >> 16);
}
typedef __bf16 bf16x2_hw __attribute__((ext_vector_type(2)));
__device__ __forceinline__ unsigned cvtpk(float lo, float hi) { const f32x2 v = {lo, hi}; const bf16x2_hw b = __builtin_convertvector(v, bf16x2_hw); return __builtin_bit_cast(unsigned, b); }
__device__ __forceinline__ bf16 cvt1(float x) { return (bf16)(cvtpk(x, x) & 0xffffu); }
__device__ __forceinline__ u32x4 pack8(const float (&x)[8]) { u32x4 o; o.x = cvtpk(x[0], x[1]); o.y = cvtpk(x[2], x[3]); o.z = cvtpk(x[4], x[5]); o.w = cvtpk(x[6], x[7]); return o; }
}

__device__ __forceinline__ void ph_scan_chunk(const ScanP& p, unsigned char* lds, int nscan, const int wv_s) {
    using namespace sc;
    const int w = wv_s;
#define SC_LANES const int tid = opaque_tid(wv_s), lane = tid & 63, fr = lane & 15, fq = lane >> 4; (void)fr; (void)fq; (void)tid
    float* Mf = (float*)(lds + F_M); float* Rf = (float*)(lds + F_R); float* part = (float*)(lds + PART); float* gt = (float*)(lds + GT); float* bon = (float*)(lds + BON);
    typedef _Float16 h8 __attribute__((ext_vector_type(8)));
    for (int unit = blockIdx.x; unit < NB * H; unit += nscan) {
        const int b = unit / H, h = unit % H;
        __syncthreads();
        f32x4 Sreg[2];
        Sreg[0] = Sreg[1] = (f32x4){0.f, 0.f, 0.f, 0.f};
        size_t base;
        { SC_LANES; base = (size_t)(b * T + lane) * D + h * HD + 8 * w;
        for (int z = tid; z < BUFB / 4; z += 512) ((unsigned*)buf(lds, B_SB))[z] = 0u;
        }
        float* prm = (float*)(lds + PRM);
        size_t ob;
        { SC_LANES; const int n8 = (tid & 7) * 8;
          if (tid < 64) { prm[tid] = p.kk[h * HD + tid]; prm[64 + tid] = p.ka[h * HD + tid]; prm[128 + tid] = p.rk[h * HD + tid]; prm[192 + tid] = p.gng[h * HD + tid]; prm[256 + tid] = p.gnb[h * HD + tid]; }
          ob = (size_t)(b * T + (tid >> 3)) * D + h * HD + n8; }
        u32x4 vg, gg8;
        u32x4 r8 = *(const u32x4*)(p.r + base), k8 = *(const u32x4*)(p.k + base), v8 = *(const u32x4*)(p.v + base), a8 = *(const u32x4*)(p.a + base);
        h8 lw8 = *(const h8*)(p.lw + base);
        __syncthreads();
        for (int ch = 0; ch < T / 64; ++ch) {
            {   SC_LANES;
            float rr[8], kr[8], aa[8], lwf[8];
            cvt8(r8, rr); cvt8(k8, kr); cvt8(a8, aa);
#pragma unroll
            for (int q = 0; q < 8; ++q) lwf[q] = (float)lw8[q];
            float kkn[8], km[8]; float ssp = 0.f, bop = 0.f;
#pragma unroll
            for (int q = 0; q < 8; ++q) { const float kkp = prm[8 * w + q], kap = prm[64 + 8 * w + q], rkp = prm[128 + 8 * w + q];
                kkn[q] = kr[q] * kkp; ssp += kkn[q] * kkn[q]; km[q] = kr[q] * (1.0f + (aa[q] - 1.0f) * kap); bop += rr[q] * km[q] * rkp; }
            part[w * 64 + lane] = ssp; part[512 + w * 64 + lane] = bop;
            float cum[8];
#pragma unroll
            for (int q = 0; q < 8; ++q) cum[q] = lwf[q];
#define SC_DPP8(ctl) "v_add_f32_dpp %0, %0, %0 " ctl "\n\tv_add_f32_dpp %1, %1, %1 " ctl "\n\tv_add_f32_dpp %2, %2, %2 " ctl "\n\tv_add_f32_dpp %3, %3, %3 " ctl "\n\t" \
                     "v_add_f32_dpp %4, %4, %4 " ctl "\n\tv_add_f32_dpp %5, %5, %5 " ctl "\n\tv_add_f32_dpp %6, %6, %6 " ctl "\n\tv_add_f32_dpp %7, %7, %7 " ctl "\n\t"
            asm volatile("s_nop 1\n\t"
                         SC_DPP8("row_shr:1 row_mask:0xf bank_mask:0xf bound_ctrl:1") SC_DPP8("row_shr:2 row_mask:0xf bank_mask:0xf bound_ctrl:1")
                         SC_DPP8("row_shr:4 row_mask:0xf bank_mask:0xf bound_ctrl:1") SC_DPP8("row_shr:8 row_mask:0xf bank_mask:0xf bound_ctrl:1")
                         SC_DPP8("row_bcast:15 row_mask:0xa bank_mask:0xf") SC_DPP8("row_bcast:31 row_mask:0xc bank_mask:0xf")
                         : "+v"(cum[0]), "+v"(cum[1]), "+v"(cum[2]), "+v"(cum[3]), "+v"(cum[4]), "+v"(cum[5]), "+v"(cum[6]), "+v"(cum[7]));
#undef SC_DPP8
            __syncthreads();
            float ss = 0.f, bo = 0.f;
#pragma unroll
            for (int q = 0; q < 8; ++q) { ss += part[q * 64 + lane]; bo += part[512 + q * 64 + lane]; }
            const float inv = fminf(__builtin_amdgcn_rsqf(ss), 1e12f);
            {
                float o_kkd[8], o_rd[8], o_binv[8], o_kinv[8];
                bf16* bVT = buf(lds, B_VT); bf16* bKDT = buf(lds, B_KDT); bf16* bNBDT = buf(lds, B_NBDT);
#pragma unroll
                for (int q = 0; q < 8; ++q) {
                    const float kkv = kkn[q] * inv, bb = kkv * aa[q];
                    const float e_c = __builtin_amdgcn_exp2f(cum[q]), e_n = __builtin_amdgcn_exp2f(-cum[q]);
                    const float e_tot = __int_as_float(__builtin_amdgcn_readlane(__float_as_int(e_c), 63));
                    const float e_x = __int_as_float(__builtin_amdgcn_update_dpp(0x3f800000, __float_as_int(e_c), 0x138, 0xF, 0xF, false));
                    const float e_t = e_tot * e_n;
                    o_kkd[q] = kkv * e_x; o_rd[q] = rr[q] * e_c; o_binv[q] = bb * e_n; o_kinv[q] = km[q] * e_n;
                    bVT[swz(8 * w + q, lane)] = (bf16)((q & 1) ? (v8[q >> 1] >> 16) : (v8[q >> 1] & 0xffffu));
                    const unsigned kb = cvtpk(km[q] * e_t, -bb * e_t);
                    bKDT[swz(8 * w + q, lane)] = (bf16)(kb & 0xffffu);
                    bNBDT[swz(8 * w + q, lane)] = (bf16)(kb >> 16);
                    if (lane == 0) gt[8 * w + q] = e_tot;
                }
                *(u32x4*)&buf(lds, B_KKD)[swz(lane, 8 * w)] = pack8(o_kkd); *(u32x4*)&buf(lds, B_RD)[swz(lane, 8 * w)] = pack8(o_rd);
                *(u32x4*)&buf(lds, B_BINV)[swz(lane, 8 * w)] = pack8(o_binv); *(u32x4*)&buf(lds, B_KINV)[swz(lane, 8 * w)] = pack8(o_kinv);
                if (w == 0) bon[lane] = bo;
            }
            }
            __syncthreads();
            {   SC_LANES;
                const int m = w >> 1;
                const bf16* A = buf(lds, (m & 1) ? B_KINV : B_BINV); const bf16* Bt = buf(lds, m < 2 ? B_KKD : B_RD);
                f32x4 acc[8];
#pragma unroll
                for (int q = 0; q < 8; ++q) { const int tt = (w & 1) * 2 + (q >> 2), st = q & 3; acc[q] = (f32x4){0.f, 0.f, 0.f, 0.f}; tile_mma(acc[q], A, 16 * st, Bt, 16 * tt, fr, fq); }
                __syncthreads();
                {
                    const float sgn = (m == 2) ? -1.f : 1.f;
                    bf16* dst = buf(lds, m == 0 ? B_M : (m == 1 ? B_N : (m == 2 ? B_NQ : B_P)));
#pragma unroll
                    for (int q = 0; q < 8; ++q) { const int tt = (w & 1) * 2 + (q >> 2), st = q & 3; const int t = 16 * tt + fr, s0 = 16 * st + 4 * fq;
                        f32x4 val;
#pragma unroll
                        for (int i = 0; i < 4; ++i) { const int s = s0 + i; const float keep = (m < 2) ? ((s < t) ? 1.f : 0.f) : ((s <= t) ? sgn : 0.f); val[i] = acc[q][i] * keep; }
                        if (m == 0) { if (st == tt) *(f32x4*)&Mf[tt * MDS + fr * MP + 4 * fq] = val; val = -val; }
                        u32x2 o; o.x = cvtpk(val[0], val[1]); o.y = cvtpk(val[2], val[3]);
                        *(u32x2*)&dst[swz(t, s0)] = o; }
                }
            }
            __syncthreads();
            vg = *(const u32x4*)(p.v + ob); gg8 = *(const u32x4*)(p.g + ob);
            if (ch + 1 < T / 64) { base += (size_t)64 * D; r8 = *(const u32x4*)(p.r + base); k8 = *(const u32x4*)(p.k + base); v8 = *(const u32x4*)(p.v + base); a8 = *(const u32x4*)(p.a + base); lw8 = *(const h8*)(p.lw + base); }
#define SC_LD2(dst, img, row0) { dst[0] = *(const bf16x8*)&(img)[swz((row0) + fr, 8 * fq)]; dst[1] = *(const bf16x8*)&(img)[swz((row0) + fr, 32 + 8 * fq)]; }
#define SC_MM(acc, a, b) acc = __builtin_amdgcn_mfma_f32_16x16x32_bf16(a, b, acc, 0, 0, 0)
            f32x4 yacc[4];
            {   SC_LANES;
                const f32x4 z4 = (f32x4){0.f, 0.f, 0.f, 0.f};
                if (w < 4) {
                    bf16x8 bS[2], bV[2], aK[4][2], aN[4][2];
                    SC_LD2(bS, buf(lds, B_SB), 16 * w); SC_LD2(bV, buf(lds, B_VT), 16 * w);
#pragma unroll
                    for (int mt = 0; mt < 4; ++mt) { SC_LD2(aK[mt], buf(lds, B_KKD), 16 * mt); SC_LD2(aN[mt], buf(lds, B_N), 16 * mt); }
                    f32x4 cX[4], cXt[4], cTt[4];
#pragma unroll
                    for (int d = 0; d < 4; ++d) { const float* Md = Mf + d * MDS; cXt[d] = *(const f32x4*)&Md[fr * MP + 4 * fq];
#pragma unroll
                        for (int i = 0; i < 4; ++i) cX[d][i] = Md[(4 * fq + i) * MP + fr]; }
                    s16x4 nM[6];
#pragma unroll
                    for (int e = 0; e < 6; ++e) { const int bc = e < 3 ? 0 : (e < 5 ? 1 : 2), br = e < 3 ? e + 1 : (e < 5 ? e - 1 : 3);
                        nM[e] = *(const s16x4*)&buf(lds, B_M)[swz(16 * br + fr, 16 * bc + 4 * fq)]; }
                    SC_LWAIT();
                    f32x4 racc[4];
#pragma unroll
                    for (int mt = 0; mt < 4; ++mt) { racc[mt] = z4; SC_MM(racc[mt], aK[mt][0], bS[0]); }
#pragma unroll
                    for (int mt = 0; mt < 4; ++mt) SC_MM(racc[mt], aK[mt][1], bS[1]);
#pragma unroll
                    for (int mt = 0; mt < 4; ++mt) SC_MM(racc[mt], aN[mt][0], bV[0]);
#pragma unroll
                    for (int mt = 0; mt < 4; ++mt) SC_MM(racc[mt], aN[mt][1], bV[1]);
                    s16x4 pA[4], pAt[4], TT[4];
                    f32x4 XA[4], XB[4];
#pragma unroll
                    for (int d = 0; d < 4; ++d) { pA[d] = pk4(cX[d]); pAt[d] = pk4(cXt[d]);
#pragma unroll
                        for (int i = 0; i < 4; ++i) cTt[d][i] = ((4 * fq + i) == fr ? 1.f : 0.f) - cXt[d][i]; }
#pragma unroll
                    for (int st = 0; st < 3; ++st) {
#pragma unroll
                        for (int d = 0; d < 4; ++d) XA[d] = mm16k(pAt[d], pA[d], z4);
                        if (st < 2) {
#pragma unroll
                            for (int d = 0; d < 4; ++d) XB[d] = mm16k(pA[d], pAt[d], z4);
                        }
#pragma unroll
                        for (int d = 0; d < 4; ++d) TT[d] = pk4(cTt[d]);
#pragma unroll
                        for (int d = 0; d < 4; ++d) pA[d] = pk4(XA[d]);
#pragma unroll
                        for (int d = 0; d < 4; ++d) cTt[d] = mm16k(pA[d], TT[d], cTt[d]);
                        if (st < 2) {
#pragma unroll
                            for (int d = 0; d < 4; ++d) pAt[d] = pk4(XB[d]);
                        }
                    }
#pragma unroll
                    for (int d = 0; d < 4; ++d) TT[d] = pk4(cTt[d]);
#pragma unroll
                    for (int blk = 0; blk < 4; ++blk) {
                        const f32x4 xx = mm16k(TT[blk], pk4(racc[blk]), z4);
                        const s16x4 pxx = pk4(xx);
                        *(s16x4*)&xtb(lds)[swz(16 * w + fr, 16 * blk + 4 * fq)] = pxx;
#pragma unroll
                        for (int br = blk + 1; br < 4; ++br) { const int e = blk == 0 ? br - 1 : (blk == 1 ? br + 1 : 5); racc[br] = mm16k(nM[e], pxx, racc[br]); }
                    }
                } else {
                    const int mt = w - 4;
                    bf16x8 aR[2], aP[2], bS[4][2], bV[4][2];
                    SC_LD2(aR, buf(lds, B_RD), 16 * mt); SC_LD2(aP, buf(lds, B_P), 16 * mt);
#pragma unroll
                    for (int nt = 0; nt < 4; ++nt) { SC_LD2(bS[nt], buf(lds, B_SB), 16 * nt); SC_LD2(bV[nt], buf(lds, B_VT), 16 * nt); }
                    asm volatile("s_waitcnt lgkmcnt(0)" : "+v"(aR[0]), "+v"(aR[1]), "+v"(aP[0]), "+v"(aP[1]), "+v"(bS[0][0]), "+v"(bS[0][1]), "+v"(bS[1][0]), "+v"(bS[1][1]), "+v"(bS[2][0]), "+v"(bS[2][1]),
                                 "+v"(bS[3][0]), "+v"(bS[3][1]), "+v"(bV[0][0]), "+v"(bV[0][1]), "+v"(bV[1][0]), "+v"(bV[1][1]), "+v"(bV[2][0]), "+v"(bV[2][1]), "+v"(bV[3][0]), "+v"(bV[3][1]) :: "memory");
#pragma unroll
                    for (int nt = 0; nt < 4; ++nt) { yacc[nt] = z4; SC_MM(yacc[nt], aR[0], bS[nt][0]); }
#pragma unroll
                    for (int nt = 0; nt < 4; ++nt) SC_MM(yacc[nt], aR[1], bS[nt][1]);
#pragma unroll
                    for (int nt = 0; nt < 4; ++nt) SC_MM(yacc[nt], aP[0], bV[nt][0]);
#pragma unroll
                    for (int nt = 0; nt < 4; ++nt) SC_MM(yacc[nt], aP[1], bV[nt][1]);
                }
            }
            __syncthreads();
            {   SC_LANES;
                const int mt6 = w >> 1, nt6 = 2 * (w & 1);
                bf16x8 aV[2], aX[2], bK[2][2], bB[2][2], aQ[2], bX[4][2];
                SC_LD2(aV, buf(lds, B_VT), 16 * mt6); SC_LD2(aX, xtb(lds), 16 * mt6);
#pragma unroll
                for (int q = 0; q < 2; ++q) { SC_LD2(bK[q], buf(lds, B_KDT), 16 * (nt6 + q)); SC_LD2(bB[q], buf(lds, B_NBDT), 16 * (nt6 + q)); }
                const float g0 = gt[16 * nt6 + fr], g1 = gt[16 * nt6 + 16 + fr];
                if (w >= 4) {
                    SC_LD2(aQ, buf(lds, B_NQ), 16 * (w - 4));
#pragma unroll
                    for (int nt = 0; nt < 4; ++nt) SC_LD2(bX[nt], xtb(lds), 16 * nt);
                }
                SC_LWAIT();
                if (w >= 4) {
#pragma unroll
                    for (int nt = 0; nt < 4; ++nt) SC_MM(yacc[nt], aQ[0], bX[nt][0]);
#pragma unroll
                    for (int nt = 0; nt < 4; ++nt) SC_MM(yacc[nt], aQ[1], bX[nt][1]);
                }
                f32x4 s0 = Sreg[0] * g0, s1 = Sreg[1] * g1;
                SC_MM(s0, aV[0], bK[0][0]); SC_MM(s1, aV[0], bK[1][0]); SC_MM(s0, aV[1], bK[0][1]); SC_MM(s1, aV[1], bK[1][1]);
                SC_MM(s0, aX[0], bB[0][0]); SC_MM(s1, aX[0], bB[1][0]); SC_MM(s0, aX[1], bB[0][1]); SC_MM(s1, aX[1], bB[1][1]);
                Sreg[0] = s0; Sreg[1] = s1;
                if (w >= 4) {
#pragma unroll
                    for (int nt = 0; nt < 4; ++nt) {
#pragma unroll
                        for (int i = 0; i < 4; ++i) Rf[(16 * (w - 4) + 4 * fq + i) * 65 + 16 * nt + fr] = yacc[nt][i]; }
                }
#pragma unroll
                for (int i = 0; i < 4; ++i) { buf(lds, B_SB)[swz(16 * mt6 + 4 * fq + i, 16 * nt6 + fr)] = cvt1(s0[i]); buf(lds, B_SB)[swz(16 * mt6 + 4 * fq + i, 16 * nt6 + 16 + fr)] = cvt1(s1[i]); }
            }
            __syncthreads();
#undef SC_LD2
#undef SC_MM
            {   SC_LANES;
                const int t = tid >> 3, n8 = (tid & 7) * 8;
                float y[8], vf[8], gf[8]; cvt8(vg, vf); cvt8(gg8, gf);
                float sm = 0.f;
#pragma unroll
                for (int q = 0; q < 8; ++q) { y[q] = Rf[t * 65 + n8 + q]; sm += y[q]; }
                const float mu = red8(sm) * (1.f / 64.f);
                float vs = 0.f;
#pragma unroll
                for (int q = 0; q < 8; ++q) { y[q] -= mu; vs += y[q] * y[q]; }
                const float rstd = rsqrtf(red8(vs) * (1.f / 64.f) + GN_EPS);
                const float bo2 = bon[t];
                float o[8];
#pragma unroll
                for (int q = 0; q < 8; ++q) o[q] = (y[q] * rstd * prm[192 + n8 + q] + prm[256 + n8 + q] + bo2 * vf[q]) * gf[q];
                *(u32x4*)(p.yg + ob) = pack8(o);
                ob += (size_t)64 * D;
            }
        }
    }
#undef SC_LANES
}
namespace sc2 {
using namespace sc;
constexpr int IMG = 8192;
constexpr int O_KKD = 0, O_RD = 1, O_N = 2, O_P = 3, O_VT = 4, O_KDT = 5, O_NBDT = 6, O_NQ = 7;
constexpr int O_MC = 8 * IMG, O_TT = O_MC + 3072, O_GT = O_TT + 2048, O_BON = O_GT + 256, SETB = O_BON + 256;
constexpr int RFP = 68;
constexpr int RF = 2 * SETB, PARTO = RF + 64 * RFP * 4, PRMO = PARTO + 2048, END2 = PRMO + 1280;
constexpr int SYNCO = END2;
static_assert(SYNCO + 64 <= 163776, "scan LDS");
__device__ __forceinline__ bf16* img(unsigned char* lds, int setb, int i) { return (bf16*)(lds + setb + i * IMG); }
__device__ __forceinline__ bf16x8 ld128(const bf16* im, int row, int col) { return *(const bf16x8*)&im[swz(row, col)]; }
__device__ __forceinline__ s16x4 ld64(const bf16* im, int row, int col) { return *(const s16x4*)&im[swz(row, col)]; }
__device__ __forceinline__ f32x4 mm32(const bf16x8 a, const bf16x8 b, const f32x4 c) { return __builtin_amdgcn_mfma_f32_16x16x32_bf16(a, b, c, 0, 0, 0); }
__device__ __forceinline__ void grp_sync(LAS unsigned* cnt, unsigned target, int lane) {
    asm volatile("s_waitcnt lgkmcnt(0)" ::: "memory");
    if (lane == 0) (void)__hip_atomic_fetch_add(cnt, 1u, __ATOMIC_RELAXED, __HIP_MEMORY_SCOPE_WORKGROUP);
    while ((unsigned)__builtin_amdgcn_readfirstlane((int)__hip_atomic_load(cnt, __ATOMIC_RELAXED, __HIP_MEMORY_SCOPE_WORKGROUP)) < target) __builtin_amdgcn_s_sleep(1);
    asm volatile("" ::: "memory");
}
}

__device__ __forceinline__ void pc_out(const ScanP& p, const float* Rf, const float* prm, const float bo2, const u32x4 (&vg)[2], const u32x4 (&gg)[2], size_t ob, int w, int lane) {
    using namespace sc2;
    const int tc = w * 64 + lane, t = tc >> 2, qd = tc & 3;
    float y[2][8], vf[2][8], gf[2][8]; cvt8(vg[0], vf[0]); cvt8(vg[1], vf[1]); cvt8(gg[0], gf[0]); cvt8(gg[1], gf[1]);
    float sm = 0.f;
#pragma unroll
    for (int j = 0; j < 4; ++j) { const f32x4 yy = *(const f32x4*)&Rf[t * RFP + 16 * qd + 4 * j]; y[j >> 1][4 * (j & 1)] = yy[0]; y[j >> 1][4 * (j & 1) + 1] = yy[1]; y[j >> 1][4 * (j & 1) + 2] = yy[2]; y[j >> 1][4 * (j & 1) + 3] = yy[3];
        sm += (yy[0] + yy[1]) + (yy[2] + yy[3]); }
    sm += dppx<0xB1>(sm); sm += dppx<0x4E>(sm);
    const float mu = sm * (1.f / 64.f);
    float vs = 0.f;
#pragma unroll
    for (int q = 0; q < 16; ++q) { y[q >> 3][q & 7] -= mu; vs += y[q >> 3][q & 7] * y[q >> 3][q & 7]; }
    vs += dppx<0xB1>(vs); vs += dppx<0x4E>(vs);
    const float rstd = rsqrtf(vs * (1.f / 64.f) + GN_EPS);
    float o[2][8];
#pragma unroll
    for (int q = 0; q < 16; ++q) o[q >> 3][q & 7] = (y[q >> 3][q & 7] * rstd * prm[192 + 16 * qd + q] + prm[256 + 16 * qd + q] + bo2 * vf[q >> 3][q & 7]) * gf[q >> 3][q & 7];
    *(u32x4*)(p.yg + ob) = pack8(o[0]); *(u32x4*)(p.yg + ob + 512) = pack8(o[1]);
}

__device__ __forceinline__ void ph_scan_pc(const ScanP& p, unsigned char* lds, int nscan, const int wv_s) {
    using namespace sc2;
    const int w = wv_s;
#define SC_LANES const int tid = opaque_tid(wv_s), lane = tid & 63, fr = lane & 15, fq = lane >> 4; (void)fr; (void)fq; (void)tid
    typedef _Float16 h8 __attribute__((ext_vector_type(8)));
    float* Rf = (float*)(lds + RF); float* part = (float*)(lds + PARTO); float* prm = (float*)(lds + PRMO);
    const f32x4 z4 = (f32x4){0.f, 0.f, 0.f, 0.f};
    for (int unit = blockIdx.x; unit < NB * H; unit += nscan) {
        const int b = unit / H, h = unit % H;
        __syncthreads();
        { SC_LANES; if (tid == 0) { ((LAS unsigned*)(lds + SYNCO))[0] = 0u; ((LAS unsigned*)(lds + SYNCO))[1] = 0u; }
          if (tid < 64) { prm[tid] = p.kk[h * HD + tid]; prm[64 + tid] = p.ka[h * HD + tid]; prm[128 + tid] = p.rk[h * HD + tid]; prm[192 + tid] = p.gng[h * HD + tid]; prm[256 + tid] = p.gnb[h * HD + tid]; } }
        f32x4 ST[4]; ST[0] = ST[1] = ST[2] = ST[3] = z4;
        s16x4 pxx[4];
        u32x4 vg[2], gg[2];
        float bo_out = 0.f;
        u32x4 r8[2], k8[2], v8[2], a8[2]; h8 lw8[2];
        size_t pbase = 0, sbase = 0, ob = 0, vb = 0, yb = 0;
        { SC_LANES;
          if (w >= 4) { pbase = (size_t)(b * T + lane) * D + h * HD + 16 * (w - 4);
              sbase = pg8::scan_idx(b * T + lane, h * HD + 16 * (w - 4));
#pragma unroll
              for (int o = 0; o < 2; ++o) { r8[o] = *(const u32x4*)(p.r + sbase + 512 * o); k8[o] = *(const u32x4*)(p.k + sbase + 512 * o); v8[o] = *(const u32x4*)(p.v + sbase + 512 * o);
                  a8[o] = *(const u32x4*)(p.a + sbase + 512 * o); lw8[o] = *(const h8*)(p.lw + sbase + 512 * o); } }
          else { ob = (size_t)(b * T + ((w * 64 + lane) >> 2)) * D + h * HD + 16 * (lane & 3); vb = pg8::scan_idx(b * T + ((w * 64 + lane) >> 2), h * HD + 16 * (lane & 3)); yb = vb; } }
        __syncthreads();
        for (int ch = -1; ch < T / 64; ++ch) {
            if (w >= 4) {
                if (ch + 1 < T / 64) {
                    const int pw = w - 4, setb = ((ch + 1) & 1) * SETB;
                    float rr[2][8], aa[2][8], kkn[2][8], km[2][8], cum[2][8];
                    {   SC_LANES;
                        float ssp = 0.f, bop = 0.f;
#pragma unroll
                        for (int o = 0; o < 2; ++o) {
                            float kr[8]; cvt8(r8[o], rr[o]); cvt8(k8[o], kr); cvt8(a8[o], aa[o]);
#pragma unroll
                            for (int q = 0; q < 8; ++q) { const int c = 16 * pw + 8 * o + q; const float kkp = prm[c], kap = prm[64 + c], rkp = prm[128 + c];
                                kkn[o][q] = kr[q] * kkp; ssp += kkn[o][q] * kkn[o][q]; km[o][q] = kr[q] * (1.0f + (aa[o][q] - 1.0f) * kap); bop += rr[o][q] * km[o][q] * rkp; cum[o][q] = (float)lw8[o][q]; }
                        }
                        part[pw * 64 + lane] = ssp; part[256 + pw * 64 + lane] = bop;
                        if (ch + 2 < T / 64) { pbase += (size_t)64 * D; sbase += 4096;
#pragma unroll
                            for (int o = 0; o < 2; ++o) { r8[o] = *(const u32x4*)(p.r + sbase + 512 * o); k8[o] = *(const u32x4*)(p.k + sbase + 512 * o);
                                a8[o] = *(const u32x4*)(p.a + sbase + 512 * o); lw8[o] = *(const h8*)(p.lw + sbase + 512 * o); } }
#define SC_DPP8(ctl) "v_add_f32_dpp %0, %0, %0 " ctl "\n\tv_add_f32_dpp %1, %1, %1 " ctl "\n\tv_add_f32_dpp %2, %2, %2 " ctl "\n\tv_add_f32_dpp %3, %3, %3 " ctl "\n\t" \
                     "v_add_f32_dpp %4, %4, %4 " ctl "\n\tv_add_f32_dpp %5, %5, %5 " ctl "\n\tv_add_f32_dpp %6, %6, %6 " ctl "\n\tv_add_f32_dpp %7, %7, %7 " ctl "\n\t"
#pragma unroll
                        for (int o = 0; o < 2; ++o)
                            asm volatile("s_nop 1\n\t"
                                         SC_DPP8("row_shr:1 row_mask:0xf bank_mask:0xf bound_ctrl:1") SC_DPP8("row_shr:2 row_mask:0xf bank_mask:0xf bound_ctrl:1")
                                         SC_DPP8("row_shr:4 row_mask:0xf bank_mask:0xf bound_ctrl:1") SC_DPP8("row_shr:8 row_mask:0xf bank_mask:0xf bound_ctrl:1")
                                         SC_DPP8("row_bcast:15 row_mask:0xa bank_mask:0xf") SC_DPP8("row_bcast:31 row_mask:0xc bank_mask:0xf")
                                         : "+v"(cum[o][0]), "+v"(cum[o][1]), "+v"(cum[o][2]), "+v"(cum[o][3]), "+v"(cum[o][4]), "+v"(cum[o][5]), "+v"(cum[o][6]), "+v"(cum[o][7]));
#undef SC_DPP8
                    }
                    { SC_LANES; grp_sync((LAS unsigned*)(lds + SYNCO), 4u * (3u * (unsigned)(ch + 1) + 1u), lane); }
                    {   SC_LANES;
                        float ss = 0.f, bo = 0.f;
#pragma unroll
                        for (int q = 0; q < 4; ++q) { ss += part[q * 64 + lane]; bo += part[256 + q * 64 + lane]; }
                        const float inv = fminf(__builtin_amdgcn_rsqf(ss), 1e12f);
                        bf16* bVT = img(lds, setb, O_VT); bf16* bKDT = img(lds, setb, O_KDT); bf16* bNBDT = img(lds, setb, O_NBDT);
                        float* gt = (float*)(lds + setb + O_GT); float* bon = (float*)(lds + setb + O_BON);
#pragma unroll
                        for (int o = 0; o < 2; ++o) {
                            const int cb = 16 * pw + 8 * o;
                            float o_kkd[8], o_rd[8], o_binv[8], o_kinv[8];
#pragma unroll
                            for (int q = 0; q < 8; ++q) {
                                const float kkv = kkn[o][q] * inv, bb = kkv * aa[o][q];
                                const float e_c = __builtin_amdgcn_exp2f(cum[o][q]), e_n = __builtin_amdgcn_exp2f(-cum[o][q]);
                                const float e_tot = __int_as_float(__builtin_amdgcn_readlane(__float_as_int(e_c), 63));
                                const float e_x = __int_as_float(__builtin_amdgcn_update_dpp(0x3f800000, __float_as_int(e_c), 0x138, 0xF, 0xF, false));
                                const float e_t = e_tot * e_n;
                                o_kkd[q] = kkv * e_x; o_rd[q] = rr[o][q] * e_c; o_binv[q] = bb * e_n; o_kinv[q] = km[o][q] * e_n;
                                bVT[swz(cb + q, lane)] = (bf16)((q & 1) ? (v8[o][q >> 1] >> 16) : (v8[o][q >> 1] & 0xffffu));
                                const unsigned kb2 = cvtpk(km[o][q] * e_t, -bb * e_t);
                                bKDT[swz(cb + q, lane)] = (bf16)(kb2 & 0xffffu);
                                bNBDT[swz(cb + q, lane)] = (bf16)(kb2 >> 16);
                                if (lane == 0) gt[cb + q] = e_tot;
                            }
                            *(u32x4*)&img(lds, setb, O_KKD)[swz(lane, cb)] = pack8(o_kkd); *(u32x4*)&img(lds, setb, O_RD)[swz(lane, cb)] = pack8(o_rd);
                            *(u32x4*)&img(lds, setb, O_N)[swz(lane, cb)] = pack8(o_binv); *(u32x4*)&img(lds, setb, O_P)[swz(lane, cb)] = pack8(o_kinv);
                        }
                        if (pw == 0) bon[lane] = bo;
                        if (ch + 2 < T / 64) { v8[0] = *(const u32x4*)(p.v + sbase); v8[1] = *(const u32x4*)(p.v + sbase + 512); }
                    }
                    { SC_LANES; grp_sync((LAS unsigned*)(lds + SYNCO), 4u * (3u * (unsigned)(ch + 1) + 2u), lane); }
                    f32x4 acc[10], cX, cXt;
                    {   SC_LANES;
                        const bf16* A = img(lds, setb, (pw & 1) ? O_P : O_N); const bf16* Bt = img(lds, setb, pw < 2 ? O_KKD : O_RD);
                        bf16x8 fa[4][2], fb[4][2], dB[2], dK[2];
#pragma unroll
                        for (int x = 0; x < 4; ++x) {
#pragma unroll
                            for (int kk = 0; kk < 2; ++kk) { fa[x][kk] = ld128(A, 16 * x + fr, 32 * kk + 8 * fq); fb[x][kk] = ld128(Bt, 16 * x + fr, 32 * kk + 8 * fq); } }
#pragma unroll
                        for (int kk = 0; kk < 2; ++kk) { dB[kk] = ld128(img(lds, setb, O_N), 16 * pw + fr, 32 * kk + 8 * fq); dK[kk] = ld128(img(lds, setb, O_KKD), 16 * pw + fr, 32 * kk + 8 * fq); }
                        int idx = 0;
#pragma unroll
                        for (int tt = 0; tt < 4; ++tt) {
#pragma unroll
                            for (int st = 0; st <= tt; ++st) { acc[idx] = mm32(fa[st][0], fb[tt][0], z4); acc[idx] = mm32(fa[st][1], fb[tt][1], acc[idx]); ++idx; } }
                        cXt = mm32(dB[0], dK[0], z4); cXt = mm32(dB[1], dK[1], cXt);
                        cX = mm32(dK[0], dB[0], z4); cX = mm32(dK[1], dB[1], cX);
                    }
                    { SC_LANES; grp_sync((LAS unsigned*)(lds + SYNCO), 4u * (3u * (unsigned)(ch + 1) + 3u), lane); }
                    {   SC_LANES;
                        f32x4 mk; const bool strict = pw < 2;
#pragma unroll
                        for (int i = 0; i < 4; ++i) { const int d = 4 * fq + i - fr; mk[i] = (strict ? (d < 0) : (d <= 0)) ? 1.f : 0.f; }
                        const unsigned sx = (pw == 0 || pw == 2) ? 0x80008000u : 0u;
                        if (pw == 0) {
#pragma unroll
                            for (int e = 0; e < 6; ++e) { const int ix = e == 0 ? 1 : (e == 1 ? 3 : (e == 2 ? 6 : (e == 3 ? 4 : (e == 4 ? 7 : 8))));
                                u32x2 o; o.x = cvtpk(acc[ix][0], acc[ix][1]) ^ sx; o.y = cvtpk(acc[ix][2], acc[ix][3]) ^ sx;
                                *(u32x2*)(lds + setb + O_MC + (e * 64 + lane) * 8) = o; }
                        } else {
                            bf16* dst = img(lds, setb, pw == 1 ? O_N : (pw == 2 ? O_NQ : O_P));
                            int idx = 0;
#pragma unroll
                            for (int tt = 0; tt < 4; ++tt) {
#pragma unroll
                                for (int st = 0; st < 4; ++st) {
                                    u32x2 o = (u32x2){0u, 0u};
                                    if (st <= tt) {
                                        f32x4 val = acc[idx]; ++idx;
                                        if (st == tt) val = val * mk;
                                        o.x = cvtpk(val[0], val[1]) ^ sx; o.y = cvtpk(val[2], val[3]) ^ sx;
                                    }
                                    *(u32x2*)&dst[swz(16 * tt + fr, 16 * st + 4 * fq)] = o;
                                } }
                        }
                        f32x4 cTt;
#pragma unroll
                        for (int i = 0; i < 4; ++i) { const int d = 4 * fq + i - fr; cXt[i] = d < 0 ? cXt[i] : 0.f; cX[i] = d > 0 ? cX[i] : 0.f; cTt[i] = (d == 0 ? 1.f : 0.f) - cXt[i]; }
                        s16x4 pA = pk4(cX), pAt = pk4(cXt);
#pragma unroll
                        for (int st = 0; st < 3; ++st) {
                            const f32x4 XA = mm16k(pAt, pA, z4);
                            f32x4 XB = z4; if (st < 2) XB = mm16k(pA, pAt, z4);
                            const s16x4 pT = pk4(cTt);
                            pA = pk4(XA);
                            cTt = mm16k(pA, pT, cTt);
                            if (st < 2) pAt = pk4(XB);
                        }
                        *(s16x4*)(lds + setb + O_TT + (pw * 64 + lane) * 8) = pk4(cTt);
                    }
                    __syncthreads();
                } else { __syncthreads(); }
            } else {
                if (ch >= 0) {
                    const int setb = (ch & 1) * SETB;
                    {   SC_LANES;
                        if (ch > 0) {
                            pc_out(p, Rf, prm, bo_out, vg, gg, yb, w, lane);
                            ob += (size_t)64 * D; yb += 4096;
                            grp_sync((LAS unsigned*)(lds + SYNCO) + 1, 4u * (unsigned)ch, lane);
                        }
                        vg[0] = *(const u32x4*)(p.v + vb); vg[1] = *(const u32x4*)(p.v + vb + 512); gg[0] = *(const u32x4*)(p.g + ob); gg[1] = *(const u32x4*)(p.g + ob + 8);
                        vb += 4096;
                        bo_out = ((const float*)(lds + setb + O_BON))[(w * 64 + lane) >> 2];
                    }
                    s16x4 pST[4]; bf16x8 bV[2];
                    {   SC_LANES;
#pragma unroll
                        for (int kb = 0; kb < 4; ++kb) pST[kb] = pk4(ST[kb]);
                        const bf16* iK = img(lds, setb, O_KKD); const bf16* iN = img(lds, setb, O_N);
                        bV[0] = ld128(img(lds, setb, O_VT), 16 * w + fr, 8 * fq); bV[1] = ld128(img(lds, setb, O_VT), 16 * w + fr, 32 + 8 * fq);
                        s16x4 aK[4][4]; bf16x8 aN[6]; s16x4 TT[4], nM[6];
#pragma unroll
                        for (int mt = 0; mt < 4; ++mt) {
#pragma unroll
                            for (int kb = 0; kb < 4; ++kb) aK[mt][kb] = ld64(iK, 16 * mt + fr, 16 * kb + 4 * fq); }
                        aN[0] = ld128(iN, fr, 8 * fq); aN[1] = ld128(iN, 16 + fr, 8 * fq); aN[2] = ld128(iN, 32 + fr, 8 * fq); aN[3] = ld128(iN, 32 + fr, 32 + 8 * fq); aN[4] = ld128(iN, 48 + fr, 8 * fq); aN[5] = ld128(iN, 48 + fr, 32 + 8 * fq);
#pragma unroll
                        for (int d = 0; d < 4; ++d) TT[d] = *(const s16x4*)(lds + setb + O_TT + (d * 64 + lane) * 8);
#pragma unroll
                        for (int e = 0; e < 6; ++e) nM[e] = *(const s16x4*)(lds + setb + O_MC + (e * 64 + lane) * 8);
                        f32x4 racc[4];
#pragma unroll
                        for (int mt = 0; mt < 4; ++mt) { racc[mt] = z4;
#pragma unroll
                            for (int kb = 0; kb < 4; ++kb) racc[mt] = mm16k(aK[mt][kb], pST[kb], racc[mt]); }
                        {
                            f32x4 r2[4];
                            r2[0] = mm32(aN[0], bV[0], z4); r2[1] = mm32(aN[1], bV[0], z4);
                            r2[2] = mm32(aN[2], bV[0], z4); r2[2] = mm32(aN[3], bV[1], r2[2]); r2[3] = mm32(aN[4], bV[0], z4); r2[3] = mm32(aN[5], bV[1], r2[3]);
#pragma unroll
                            for (int mt = 0; mt < 4; ++mt) racc[mt] = racc[mt] + r2[mt];
                        }
#pragma unroll
                        for (int blk = 0; blk < 4; ++blk) {
                            const f32x4 xx = mm16k(TT[blk], pk4(racc[blk]), z4);
                            pxx[blk] = pk4(xx);
#pragma unroll
                            for (int br = blk + 1; br < 4; ++br) { const int e = blk == 0 ? br - 1 : (blk == 1 ? br + 1 : 5); racc[br] = mm16k(nM[e], pxx[blk], racc[br]); }
                        }
                    }
                    {   SC_LANES;
                        const bf16* iR = img(lds, setb, O_RD); const bf16* iP = img(lds, setb, O_P); const bf16* iQ = img(lds, setb, O_NQ);
                        s16x4 aR[4][4], aQ[10]; bf16x8 aP[6];
#pragma unroll
                        for (int mt = 0; mt < 4; ++mt) {
#pragma unroll
                            for (int kb = 0; kb < 4; ++kb) aR[mt][kb] = ld64(iR, 16 * mt + fr, 16 * kb + 4 * fq); }
                        aP[0] = ld128(iP, fr, 8 * fq); aP[1] = ld128(iP, 16 + fr, 8 * fq); aP[2] = ld128(iP, 32 + fr, 8 * fq); aP[3] = ld128(iP, 32 + fr, 32 + 8 * fq); aP[4] = ld128(iP, 48 + fr, 8 * fq); aP[5] = ld128(iP, 48 + fr, 32 + 8 * fq);
                        { int ix = 0;
#pragma unroll
                          for (int mt = 0; mt < 4; ++mt) {
#pragma unroll
                              for (int blk = 0; blk <= mt; ++blk) { aQ[ix] = ld64(iQ, 16 * mt + fr, 16 * blk + 4 * fq); ++ix; } } }
                        f32x4 yacc[4];
#pragma unroll
                        for (int mt = 0; mt < 4; ++mt) { yacc[mt] = z4;
#pragma unroll
                            for (int kb = 0; kb < 4; ++kb) yacc[mt] = mm16k(aR[mt][kb], pST[kb], yacc[mt]); }
                        { int ix = 0;
#pragma unroll
                          for (int mt = 0; mt < 4; ++mt) {
#pragma unroll
                              for (int blk = 0; blk <= mt; ++blk) { yacc[mt] = mm16k(aQ[ix], pxx[blk], yacc[mt]); ++ix; } } }
                        {   f32x4 y2[4];
                            y2[0] = mm32(aP[0], bV[0], z4); y2[1] = mm32(aP[1], bV[0], z4);
                            y2[2] = mm32(aP[2], bV[0], z4); y2[2] = mm32(aP[3], bV[1], y2[2]); y2[3] = mm32(aP[4], bV[0], z4); y2[3] = mm32(aP[5], bV[1], y2[3]);
#pragma unroll
                            for (int mt = 0; mt < 4; ++mt) yacc[mt] = yacc[mt] + y2[mt];
                        }
#pragma unroll
                        for (int mt = 0; mt < 4; ++mt) {
#pragma unroll
                            for (int i = 0; i < 4; ++i) Rf[(16 * mt + 4 * fq + i) * RFP + 16 * w + fr] = yacc[mt][i]; }
                    }
                    {   SC_LANES;
                        const bf16* iKd = img(lds, setb, O_KDT); const bf16* iBd = img(lds, setb, O_NBDT); const float* gt = (const float*)(lds + setb + O_GT);
                        bf16x8 aKd[4][2]; s16x4 aB[4][4]; f32x4 g4[4];
#pragma unroll
                        for (int kb = 0; kb < 4; ++kb) { aKd[kb][0] = ld128(iKd, 16 * kb + fr, 8 * fq); aKd[kb][1] = ld128(iKd, 16 * kb + fr, 32 + 8 * fq); g4[kb] = *(const f32x4*)&gt[16 * kb + 4 * fq];
#pragma unroll
                            for (int blk = 0; blk < 4; ++blk) aB[kb][blk] = ld64(iBd, 16 * kb + fr, 16 * blk + 4 * fq); }
#pragma unroll
                        for (int kb = 0; kb < 4; ++kb) {
                            f32x4 s2 = mm32(aKd[kb][0], bV[0], z4); s2 = mm32(aKd[kb][1], bV[1], s2);
                            f32x4 s = z4;
#pragma unroll
                            for (int blk = 0; blk < 4; ++blk) s = mm16k(aB[kb][blk], pxx[blk], s);
                            ST[kb] = ST[kb] * g4[kb] + s2 + s; }
                    }
                    __syncthreads();
                } else { __syncthreads(); }
            }
        }
        if (w < 4) {
            SC_LANES;
            pc_out(p, Rf, prm, bo_out, vg, gg, yb, w, lane);
        }
    }
#undef SC_LANES
}
__device__ __forceinline__ void ph_cumsum(const float* logf, float* cum, const int wv_s) {
    const int tid_ = opaque_tid(wv_s); const int lane = tid_ & 63, wv = tid_ >> 6;
    for (int seq = blockIdx.x * 8 + wv; seq < NB * H; seq += gridDim.x * 8) {
        const int b = seq / H, h = seq % H;
        float loc[32]; float run = 0.f;
#pragma unroll
        for (int q = 0; q < 32; ++q) { run += logf[(size_t)(b * T + lane * 32 + q) * 16 + h]; loc[q] = run; }
        float incl = run;
#pragma unroll
        for (int o = 1; o < 64; o <<= 1) { const float t = __int_as_float(__builtin_amdgcn_ds_bpermute((lane >= o ? lane - o : lane) << 2, __float_as_int(incl))); if (lane >= o) incl += t; }
        const float excl = incl - run;
#pragma unroll
        for (int q = 0; q < 32; ++q) cum[(size_t)seq * T + lane * 32 + q] = -(excl + loc[q]) * LOG2E;
    }
}
#include <hip/hip_bf16.h>
#include <cmath>
namespace attn_body {
using bf16=__hip_bfloat16;
using bf16x8=__attribute__((ext_vector_type(8)))short;
using s16x4=__attribute__((ext_vector_type(4)))short;
using f32x16=__attribute__((ext_vector_type(16)))float;
using u32x4=__attribute__((ext_vector_type(4)))unsigned;
constexpr int BATCH=8,NHEAD=16,SEQ=2048,D=64,DM=NHEAD*D;
constexpr int NW=8,QBLK=32,QB=QBLK*NW,KVBLK=64,NQB=SEQ/QB;
constexpr int ATTN_PITCH=DM, ATTN_UNIT_ROWS=QB;
__device__ __forceinline__ int crow(int r,int hi){return (r&3)+8*(r>>2)+4*hi;}
#define SBAR() __builtin_amdgcn_sched_barrier(0)
__device__ __forceinline__ void cmask(f32x16&p0,f32x16&p1,int jb,int qrel,int hi){
  const float NEG=-INFINITY; int kb=64*jb+4*hi;
  #pragma unroll
  for(int r=0;r<16;++r){int kv=kb+(r&3)+8*(r>>2); if(kv>qrel)p0[r]=NEG; if(kv+32>qrel)p1[r]=NEG;}
}

constexpr int NSLOT=3, SLOTB=8192;
constexpr int LDS_K=0, LDS_V=NSLOT*SLOTB, LDS_WS=2*NSLOT*SLOTB, LDS_OST=LDS_WS+NW*64*4, LDS_BYTES=LDS_OST+NW*4096;
constexpr float C2=0.125f*1.4426950408889634f;
__device__ __forceinline__ void glds16(const void*gsrc,unsigned lds_dst){unsigned keep;
  asm volatile("s_mov_b32 %0, m0\n\ts_mov_b32 m0, %2\n\ts_nop 0\n\tglobal_load_lds_dwordx4 %1, off\n\ts_mov_b32 m0, %0":"=&s"(keep):"v"(gsrc),"s"(lds_dst):"memory");}
__device__ __forceinline__ float max3f(float a,float b,float c){float r;asm("v_max3_f32 %0, %1, %2, %3":"=v"(r):"v"(a),"v"(b),"v"(c));return r;}
__device__ __forceinline__ float max2f(float a,float b){float r;asm("v_max_f32_e32 %0, %1, %2":"=v"(r):"v"(a),"v"(b));return r;}
__device__ __forceinline__ float fadd_s(float a,float b){float r;asm("v_add_f32_e32 %0, %1, %2":"=v"(r):"v"(a),"v"(b));return r;}
__device__ __forceinline__ float fsub_s(float a,float b){float r;asm("v_sub_f32_e32 %0, %1, %2":"=v"(r):"v"(a),"v"(b));return r;}
typedef float f32x2_t __attribute__((ext_vector_type(2))); typedef __bf16 bf16x2_t __attribute__((ext_vector_type(2)));
__device__ __forceinline__ unsigned cvtpk_s(float lo,float hi){f32x2_t v={lo,hi};bf16x2_t b=__builtin_convertvector(v,bf16x2_t);return __builtin_bit_cast(unsigned,b);}
#define WAIT_BAR(N) asm volatile("s_waitcnt vmcnt(" #N ") lgkmcnt(0)\n\ts_barrier":::"memory")

__device__ __forceinline__ void qkt(f32x16&p0,f32x16&p1,const char*Kslot,const bf16x8*qr,const f32x16&negm,int r32,int hi){
  const char*kb=Kslot+hi*1024+r32*16;
  #pragma unroll
  for(int d0=0;d0<4;++d0){
    const bf16x8 b0=*reinterpret_cast<const bf16x8*>(kb+d0*2048);
    const bf16x8 b1=*reinterpret_cast<const bf16x8*>(kb+d0*2048+512);
    if(d0==0){p0=__builtin_amdgcn_mfma_f32_32x32x16_bf16(b0,qr[0],negm,0,0,0);p1=__builtin_amdgcn_mfma_f32_32x32x16_bf16(b1,qr[0],negm,0,0,0);}
    else{p0=__builtin_amdgcn_mfma_f32_32x32x16_bf16(b0,qr[d0],p0,0,0,0);p1=__builtin_amdgcn_mfma_f32_32x32x16_bf16(b1,qr[d0],p1,0,0,0);}}
}
typedef __attribute__((address_space(3))) const char* lds_cptr;
typedef short v4i16_t __attribute__((ext_vector_type(4)));
__device__ __forceinline__ void kload8(bf16x8*kf,lds_cptr kp){
  kf[0]=*(const __attribute__((address_space(3))) bf16x8*)(kp);      kf[1]=*(const __attribute__((address_space(3))) bf16x8*)(kp+512);
  kf[2]=*(const __attribute__((address_space(3))) bf16x8*)(kp+2048); kf[3]=*(const __attribute__((address_space(3))) bf16x8*)(kp+2560);
  kf[4]=*(const __attribute__((address_space(3))) bf16x8*)(kp+4096); kf[5]=*(const __attribute__((address_space(3))) bf16x8*)(kp+4608);
  kf[6]=*(const __attribute__((address_space(3))) bf16x8*)(kp+6144); kf[7]=*(const __attribute__((address_space(3))) bf16x8*)(kp+6656);
}
__device__ __forceinline__ void kload2(bf16x8*kf,lds_cptr kp,int j){ kf[2*j]=*(const __attribute__((address_space(3))) bf16x8*)(kp+j*2048); kf[2*j+1]=*(const __attribute__((address_space(3))) bf16x8*)(kp+j*2048+512); }
__device__ __forceinline__ s16x4 vtr(lds_cptr p){ return __builtin_bit_cast(s16x4,__builtin_amdgcn_ds_read_tr16_b64_v4i16((__attribute__((address_space(3))) v4i16_t*)p)); }
__device__ __forceinline__ float rowmax(const f32x16&p0,const f32x16&p1){
  float a=max3f(p0[0],p0[1],p1[0]),b=max3f(p0[2],p0[3],p1[1]);a=max3f(a,p1[2],p1[3]);
  #pragma unroll
  for(int r=4;r<16;r+=4){a=max3f(a,p0[r],p0[r+1]);b=max3f(b,p0[r+2],p0[r+3]);a=max3f(a,p1[r],p1[r+1]);b=max3f(b,p1[r+2],p1[r+3]);}
  const float m=max2f(a,b);
  auto rr=__builtin_amdgcn_permlane32_swap(__float_as_uint(m),__float_as_uint(m),false,false);
  return max2f(__uint_as_float(rr[0]),__uint_as_float(rr[1]));
}
__device__ __forceinline__ void pv(f32x16*o,int vb,bf16x8 pa0,bf16x8 pa1,bf16x8 pa2,bf16x8 pa3){
  #pragma unroll
  for(int d0=0;d0<2;++d0){s16x4 lo[4],hi[4];
    #pragma unroll
    for(int ks=0;ks<4;++ks){
      asm volatile("ds_read_b64_tr_b16 %0,%1 offset:%c2":"=&v"(lo[ks]):"v"(vb),"i"(d0*4096+ks*1024):"memory");
      asm volatile("ds_read_b64_tr_b16 %0,%1 offset:%c2":"=&v"(hi[ks]):"v"(vb),"i"(d0*4096+ks*1024+512):"memory");}
    asm volatile("s_waitcnt lgkmcnt(0)":::"memory");SBAR();
    #define PK(k) (bf16x8){lo[k][0],lo[k][1],lo[k][2],lo[k][3],hi[k][0],hi[k][1],hi[k][2],hi[k][3]}
    o[d0]=__builtin_amdgcn_mfma_f32_32x32x16_bf16(pa0,PK(0),o[d0],0,0,0);
    o[d0]=__builtin_amdgcn_mfma_f32_32x32x16_bf16(pa1,PK(1),o[d0],0,0,0);
    o[d0]=__builtin_amdgcn_mfma_f32_32x32x16_bf16(pa2,PK(2),o[d0],0,0,0);
    o[d0]=__builtin_amdgcn_mfma_f32_32x32x16_bf16(pa3,PK(3),o[d0],0,0,0);
    #undef PK
  }
}

#ifndef ATTN_STORE16
#define ATTN_STORE16(p,v) (*(u32x4*)(p)=(v))
#endif
typedef __attribute__((address_space(3))) const float* lds_cfptr;
typedef float f32x4b __attribute__((ext_vector_type(4)));
#define BIAS(C0,C1,t) do{ const lds_cfptr nb_=nbt+(t)*64+4*hi; \
    _Pragma("unroll") for(int g_=0;g_<4;++g_){ const f32x4b b0_=*(const __attribute__((address_space(3))) f32x4b*)(nb_+8*g_); const f32x4b b1_=*(const __attribute__((address_space(3))) f32x4b*)(nb_+32+8*g_); \
      C0[4*g_]+=b0_.x; C0[4*g_+1]+=b0_.y; C0[4*g_+2]+=b0_.z; C0[4*g_+3]+=b0_.w; C1[4*g_]+=b1_.x; C1[4*g_+1]+=b1_.y; C1[4*g_+2]+=b1_.z; C1[4*g_+3]+=b1_.w; } }while(0)
template<int THRL> __device__ __forceinline__ void attn_unit(int b,int h,int qb,const bf16*Q,const bf16*__restrict__ K,const bf16*__restrict__ V,bf16*O,char*shm,lds_cfptr nbt,const int wv_s){
  const int tid=::opaque_tid(wv_s),lane=tid&63,r32=lane&31,hi=lane>>5; const int wid=wv_s;
  const long rowbase=(long)b*SEQ; const int q0=qb*QB;
  const bf16*Qw=Q+(rowbase+q0+wid*QBLK)*DM+h*D;
  const bf16*Kh=K+rowbase*DM+h*D,*Vh=V+rowbase*DM+h*D;
  const unsigned lds0=(unsigned)(uintptr_t)shm;
  float*wsf=(float*)(shm+LDS_WS)+wid*64;
  const bf16*ksrc=Kh+(long)lane*DM+wid*8;
  const bf16*vsrc=Vh+(long)(16*(wid&3)+(lane>>2))*DM+(wid>>2)*32+(lane&3)*8;
  const unsigned kdst=lds0+LDS_K+wid*1024, vdst=lds0+LDS_V+wid*1024;
  #define DMA_K(t,slot) glds16(ksrc+(long)(t)*KVBLK*DM,(unsigned)__builtin_amdgcn_readfirstlane(kdst+(slot)))
  #define DMA_V(t,slot) glds16(vsrc+(long)(t)*KVBLK*DM,(unsigned)__builtin_amdgcn_readfirstlane(vdst+(slot)))
  const int vb0=(int)(lds0+LDS_V)+((lane>>4)&1)*32+(lane&3)*8+(4*hi+((lane&15)>>2))*64;
  const char*Kbase=shm+LDS_K; bf16x8 kf[8];
  const lds_cptr shm3=(lds_cptr)shm; const lds_cptr kp0=shm3+LDS_K+hi*1024+r32*16; const lds_cptr vp0=shm3+LDS_V+((lane>>4)&1)*32+(lane&3)*8+(4*hi+((lane&15)>>2))*64;
  const int NT=(q0+QB)/KVBLK;
  DMA_K(0,0);DMA_V(0,0);DMA_K(1,SLOTB);
  bf16x8 qr[4];
  #pragma unroll
  for(int d0=0;d0<4;++d0)qr[d0]=*reinterpret_cast<const bf16x8*>(&Qw[(long)r32*DM+d0*16+hi*8]);
  float mhat=0.f,l_reg=0.f;f32x16 o[2];o[0]=f32x16{};o[1]=f32x16{};f32x16 negm=f32x16{};asm volatile("":"+v"(negm));
  const int qrel=wid*QBLK+r32;
  #define CMASK(P0,P1,t) do{int jb_=(t)-(NT-4); if(jb_>=0)cmask(P0,P1,jb_,qrel,hi);}while(0)
  bool resc=false;
  #define START(P0,P1) do{ const float rm=rowmax(P0,P1); resc=false; \
    { const float dl=rm; mhat=fadd_s(mhat,dl); \
      _Pragma("unroll") for(int r=0;r<16;++r){P0[r]=fsub_s(P0[r],dl);P1[r]=fsub_s(P1[r],dl);} \
      _Pragma("unroll") for(int r=0;r<16;++r)negm[r]=-mhat; asm volatile("":"+v"(negm)); } \
    _Pragma("unroll") for(int r=0;r<16;++r)P0[r]=__builtin_amdgcn_exp2f(P0[r]); }while(0)
  #define RESC() do{ if(resc){ asm volatile("s_waitcnt lgkmcnt(0)":::"memory"); \
      _Pragma("unroll") for(int d_=0;d_<2;++d_) _Pragma("unroll") for(int r=0;r<16;++r)o[d_][r]*=wsf[crow(r,hi)]; } }while(0)
  f32x16 pA0,pA1,pB0,pB1;
  int sl_prev=0,sl_cur=0,sl_next=SLOTB;
  #define ROT() do{sl_prev=sl_cur;sl_cur=sl_next;sl_next=(sl_next==(NSLOT-1)*SLOTB)?0:sl_next+SLOTB;}while(0)
  DMA_K(2,2*SLOTB);
  WAIT_BAR(3);
  qkt(pA0,pA1,Kbase,qr,negm,r32,hi);asm volatile("s_nop 15\n\ts_nop 7":"+v"(pA0),"+v"(pA1));BIAS(pA0,pA1,0);CMASK(pA0,pA1,0);
  START(pA0,pA1);
  _Pragma("unroll") for(int r=0;r<16;++r)pA1[r]=__builtin_amdgcn_exp2f(pA1[r]);
  WAIT_BAR(0);
  DMA_K(3,0);DMA_V(1,SLOTB);
  ROT();
  kload8(kf,kp0+sl_cur);
  WAIT_BAR(2);
  s16x4 vlo[8],vhi[8]; u32x4 pw0,pw1,pw2,pw3;
  #define PKW(P,B) cvtpk_s(P[B],P[B+1])
  #define PAF(k) __builtin_bit_cast(bf16x8,pw##k)
  #define VFR(i) (bf16x8){vlo[i][0],vlo[i][1],vlo[i][2],vlo[i][3],vhi[i][0],vhi[i][1],vhi[i][2],vhi[i][3]}
  #define PIN(x) asm volatile("":"+v"(x))
  #define MX3(a,b,c) __builtin_fmaxf(__builtin_fmaxf((a),(b)),(c))
  #define GAPA(MF,A0,A1,A2,A3,W0,W1,PW) do{ MF; sacc+=A0; sacc+=A1; sacc+=A2; sacc+=A3; PIN(sacc); W0; W1; PIN(PW); SBAR(); }while(0)
  #define EX(v) __builtin_amdgcn_exp2f(v)
  #define GAPB(MF,X,B) do{ MF; X[B]=EX(X[B]); X[B+1]=EX(X[B+1]); X[B+2]=EX(X[B+2]); X[B+3]=EX(X[B+3]); PIN(X); SBAR(); }while(0)
  #define VRD(i) do{ vlo[i]=vtr(vp_+(((i)>>2)*4096+((i)&3)*1024)); vhi[i]=vtr(vp_+(((i)>>2)*4096+((i)&3)*1024+512)); }while(0)
  #define KRD(G,j) do{ if(G){ kload2(kf,kp0+sl_next,j); SBAR(); } }while(0)
  #define STEP(C0,C1,P0,P1,t,GK,GV,GL) do{ SBAR(); \
    const lds_cptr vp_=vp0+sl_prev; \
    VRD(0); SBAR(); float sacc=(P0[0]+P0[1]); \
    GAPA(C0=__builtin_amdgcn_mfma_f32_32x32x16_bf16(kf[0],qr[0],negm,0,0,0), P0[2],P0[3],P0[4],P0[5],     pw0[0]=PKW(P0,0), pw0[1]=PKW(P0,2), pw0); \
    VRD(4); SBAR(); GAPA(C1=__builtin_amdgcn_mfma_f32_32x32x16_bf16(kf[1],qr[0],negm,0,0,0), P0[6],P0[7],P0[8],P0[9],     pw0[2]=PKW(P0,4), pw0[3]=PKW(P0,6), pw0); \
    VRD(1); SBAR(); GAPA(C0=__builtin_amdgcn_mfma_f32_32x32x16_bf16(kf[2],qr[1],C0,0,0,0),   P0[10],P0[11],P0[12],P0[13], pw1[0]=PKW(P0,8), pw1[1]=PKW(P0,10), pw1); \
    VRD(5); SBAR(); GAPA(C1=__builtin_amdgcn_mfma_f32_32x32x16_bf16(kf[3],qr[1],C1,0,0,0),   P0[14],P0[15],P1[0],P1[1],   pw1[2]=PKW(P0,12),pw1[3]=PKW(P0,14), pw1); \
    VRD(2); SBAR(); GAPA(C0=__builtin_amdgcn_mfma_f32_32x32x16_bf16(kf[4],qr[2],C0,0,0,0),   P1[2],P1[3],P1[4],P1[5],     pw2[0]=PKW(P1,0), pw2[1]=PKW(P1,2), pw2); \
    VRD(6); SBAR(); GAPA(C1=__builtin_amdgcn_mfma_f32_32x32x16_bf16(kf[5],qr[2],C1,0,0,0),   P1[6],P1[7],P1[8],P1[9],     pw2[2]=PKW(P1,4), pw2[3]=PKW(P1,6), pw2); \
    VRD(3); SBAR(); GAPA(C0=__builtin_amdgcn_mfma_f32_32x32x16_bf16(kf[6],qr[3],C0,0,0,0),   P1[10],P1[11],P1[12],P1[13], pw3[0]=PKW(P1,8), pw3[1]=PKW(P1,10), pw3); \
    VRD(7); SBAR(); GAPA(C1=__builtin_amdgcn_mfma_f32_32x32x16_bf16(kf[7],qr[3],C1,0,0,0),   P1[14],P1[15],0.f,0.f,       pw3[2]=PKW(P1,12),pw3[3]=PKW(P1,14), pw3); \
    l_reg+=sacc; \
    if(GK){DMA_K((t)+3,sl_cur);} if(GV){DMA_V((t)+1,sl_next);} \
    BIAS(C0,C1,t); CMASK(C0,C1,t); \
    { float a=MX3(C0[0],C0[1],C1[0]),b=MX3(C0[2],C0[3],C1[1]); a=MX3(a,C1[2],C1[3]); \
      _Pragma("unroll") for(int r=4;r<16;r+=4){a=MX3(a,C0[r],C0[r+1]);b=MX3(b,C0[r+2],C0[r+3]);a=MX3(a,C1[r],C1[r+1]);b=MX3(b,C1[r+2],C1[r+3]);} \
      float rm=__builtin_fmaxf(a,b); { auto rr=__builtin_amdgcn_permlane32_swap(__float_as_uint(rm),__float_as_uint(rm),false,false); rm=__builtin_fmaxf(__uint_as_float(rr[0]),__uint_as_float(rr[1])); } \
      resc=false; \
      if(__builtin_expect(__any(rm>(float)THRL),0)){ const float dl=__builtin_fmaxf(rm,0.f); mhat+=dl; \
        _Pragma("unroll") for(int r=0;r<16;++r){C0[r]-=dl;C1[r]-=dl;} \
        _Pragma("unroll") for(int r=0;r<16;++r)negm[r]=-mhat; asm volatile("":"+v"(negm)); \
        const float f=__builtin_amdgcn_exp2f(-dl); l_reg*=f; if(hi==0)wsf[r32]=f; resc=true; } } \
    SBAR(); \
    GAPB(o[0]=__builtin_amdgcn_mfma_f32_32x32x16_bf16(PAF(0),VFR(0),o[0],0,0,0), C0,0); \
    GAPB(o[1]=__builtin_amdgcn_mfma_f32_32x32x16_bf16(PAF(0),VFR(4),o[1],0,0,0), C0,4); \
    KRD(GL,0); GAPB(o[0]=__builtin_amdgcn_mfma_f32_32x32x16_bf16(PAF(1),VFR(1),o[0],0,0,0), C0,8); \
    KRD(GL,1); GAPB(o[1]=__builtin_amdgcn_mfma_f32_32x32x16_bf16(PAF(1),VFR(5),o[1],0,0,0), C0,12); \
    KRD(GL,2); GAPB(o[0]=__builtin_amdgcn_mfma_f32_32x32x16_bf16(PAF(2),VFR(2),o[0],0,0,0), C1,0); \
    KRD(GL,3); GAPB(o[1]=__builtin_amdgcn_mfma_f32_32x32x16_bf16(PAF(2),VFR(6),o[1],0,0,0), C1,4); \
    GAPB(o[0]=__builtin_amdgcn_mfma_f32_32x32x16_bf16(PAF(3),VFR(3),o[0],0,0,0), C1,8); \
    GAPB(o[1]=__builtin_amdgcn_mfma_f32_32x32x16_bf16(PAF(3),VFR(7),o[1],0,0,0), C1,12); \
    }while(0)
  int t=1;
  #undef CMASK
  #define CMASK(P0,P1,t) do{}while(0)
  for(;t+5<NT;t+=2){
    STEP(pB0,pB1,pA0,pA1,t,true,true,true);     WAIT_BAR(2); RESC(); ROT();
    STEP(pA0,pA1,pB0,pB1,t+1,true,true,true);   WAIT_BAR(2); RESC(); ROT();
  }
  #undef CMASK
  #define CMASK(P0,P1,t) do{int jb_=(t)-(NT-4); if(jb_>=0)cmask(P0,P1,jb_,qrel,hi);}while(0)
  #define ENDW(tt) do{ if((tt)+3<NT){WAIT_BAR(2);} else if((tt)+2<NT){WAIT_BAR(1);} else {WAIT_BAR(0);} }while(0)
  for(;t+1<NT;t+=2){
    STEP(pB0,pB1,pA0,pA1,t,(t+3<NT),(t+1<NT),(t+1<NT));       ENDW(t);   RESC(); ROT();
    STEP(pA0,pA1,pB0,pB1,t+1,(t+4<NT),(t+2<NT),(t+2<NT));     ENDW(t+1); RESC(); ROT();
  }
  STEP(pB0,pB1,pA0,pA1,NT-1,false,false,false); RESC();
  { float sacc=pB0[0]+pB0[1]; _Pragma("unroll") for(int r=2;r<16;++r)sacc+=pB0[r]; _Pragma("unroll") for(int r=0;r<16;++r)sacc+=pB1[r]; l_reg+=sacc;
    pw0=(u32x4){PKW(pB0,0),PKW(pB0,2),PKW(pB0,4),PKW(pB0,6)};pw1=(u32x4){PKW(pB0,8),PKW(pB0,10),PKW(pB0,12),PKW(pB0,14)};pw2=(u32x4){PKW(pB1,0),PKW(pB1,2),PKW(pB1,4),PKW(pB1,6)};pw3=(u32x4){PKW(pB1,8),PKW(pB1,10),PKW(pB1,12),PKW(pB1,14)};
    SBAR(); pv(o,vb0+sl_cur,PAF(0),PAF(1),PAF(2),PAF(3)); }
  #undef PKW
  #undef PAF
  #undef VFR
  #undef PIN
  #undef MX3
  #undef GAPA
  #undef GAPB
  #undef EX
  #undef VRD
  #undef KRD
  #undef STEP
  #undef ENDW
  {auto rr=__builtin_amdgcn_permlane32_swap(__float_as_uint(l_reg),__float_as_uint(l_reg),false,false);l_reg=__uint_as_float(rr[0])+__uint_as_float(rr[1]);}
  if(hi==0)wsf[32+r32]=l_reg;asm volatile("s_waitcnt lgkmcnt(0)":::"memory");
  float rli[16];
  #pragma unroll
  for(int r=0;r<16;++r)rli[r]=__builtin_amdgcn_rcpf(wsf[32+crow(r,hi)]);
  bf16*Ow=O+(rowbase+q0+wid*QBLK)*DM+h*D;
  { bf16*stg=(bf16*)(shm+LDS_OST)+wid*2048;
    #pragma unroll
    for(int r=0;r<16;++r){const int orow=crow(r,hi);
      #pragma unroll
      for(int d0=0;d0<2;++d0)stg[orow*64+d0*32+r32]=__float2bfloat16(o[d0][r]*rli[r]);}
    asm volatile("s_waitcnt lgkmcnt(0)":::"memory");
    #pragma unroll
    for(int i=0;i<4;++i){const int row=i*8+(lane>>3),ch=lane&7; const u32x4 v=*(const u32x4*)(stg+row*64+ch*8); ATTN_STORE16(Ow+(long)row*DM+ch*8,v);} }
  asm volatile("s_waitcnt lgkmcnt(0)\n\ts_barrier":::"memory");
  #undef DMA_K
  #undef DMA_V
  #undef CMASK
  #undef START
  #undef RESC
  #undef ROT
}
constexpr int ATTN_LDS_BYTES=LDS_BYTES;
struct AttnTensors { const bf16* Q; const bf16* K; const bf16* V; bf16* O; };
struct AttnUnit { int bh; int qb; };
struct StaticOrder {
  int vcu, G;
  __device__ __forceinline__ explicit StaticOrder(int grid,int block):vcu((grid%8==0)?(block%8)*(grid/8)+block/8:block),G(grid){}
  __device__ __forceinline__ bool next(int i,AttnUnit&u)const{ if(G!=256||i>=4)return false; const int s=vcu&1; u.bh=vcu>>1; u.qb=(i==0)?s:(i==1)?7-s:(i==2)?3-s:4+s; return true; }
  __device__ __forceinline__ void a_ready(const AttnUnit&)const{}
  __device__ __forceinline__ void done(const AttnUnit&)const{}
};
template<class Sched,int THRL=8> __device__ __forceinline__ void attn_phase(char*lds,const AttnTensors&T,const float*nbias,const Sched&S,const int wv_s){
  AttnUnit u;
  if(!S.next(0,u))return;
  { float*tab=(float*)(lds+LDS_BYTES); const float*src=nbias+(long)u.bh*SEQ;
    for(int k=::opaque_tid(wv_s);k<SEQ;k+=NW*64)tab[k]=src[k];
    asm volatile("s_waitcnt vmcnt(0) lgkmcnt(0)\n\ts_barrier":::"memory"); }
  const lds_cfptr nbt=(lds_cfptr)(lds+LDS_BYTES);
  for(int i=0;S.next(i,u);++i){ S.a_ready(u); attn_unit<THRL>(u.bh/NHEAD,u.bh%NHEAD,u.qb,T.Q,T.K,T.V,T.O,lds,nbt,wv_s); S.done(u); }
}
#undef BIAS
#undef SBAR
#undef WAIT_BAR
}
#define XB_TMO      128
#define XB_XCNT(j)  (256  + 64 * (j))
#define XB_XSUB(j)  (1280 + 64 * (j))
#define XB_XGEN(j)  (2304 + 64 * (j))
#define XB_TOP      3328
#define XB_TOPGEN   3392
#define XCD_BAR_WORDS 3456
#define XB_SPIN_CAP (1u << 18)


__device__ __forceinline__ unsigned xb_ld(unsigned* p)              { return __hip_atomic_load(p, __ATOMIC_RELAXED, __HIP_MEMORY_SCOPE_AGENT); }
__device__ __forceinline__ unsigned xb_add(unsigned* p, unsigned v) { return __hip_atomic_fetch_add(p, v, __ATOMIC_RELAXED, __HIP_MEMORY_SCOPE_AGENT); }
__device__ __forceinline__ unsigned xb_xcc_id() { return (unsigned)__builtin_amdgcn_s_getreg((3 << 11) | 20) & 0xFu; }
#define XB_SPIN(cond, bar) do { unsigned _sp = 0; while (cond) { __builtin_amdgcn_s_sleep(1); \
    if ((++_sp & 255u) == 0u) { if (xb_ld(&(bar)[XB_TMO])) break; if (_sp > XB_SPIN_CAP) { atomicAdd(&(bar)[XB_TMO], 1u); break; } } } } while (0)

struct XcdBarrier { unsigned* bar; unsigned x; volatile LAS unsigned* st; };

__device__ __forceinline__ XcdBarrier xcd_barrier_post(unsigned* bar, volatile LAS unsigned* st) {
    XcdBarrier b; b.bar = bar; b.x = xb_xcc_id(); b.st = st;
    if (threadIdx.x == 0) (void)xb_add(&bar[XB_XCNT(b.x)], 1u);
    return b;
}
__device__ __forceinline__ void xcd_barrier_complete(unsigned* bar, unsigned x, unsigned& nloc, unsigned& nx) {
    const unsigned G = gridDim.x * gridDim.y * gridDim.z;
    unsigned sum, cnt, mine, sp = 0u;
    for (;;) {
        sum = 0u; cnt = 0u; mine = 0u;
#pragma unroll
        for (unsigned j = 0; j < 16; ++j) { const unsigned c = xb_ld(&bar[XB_XCNT(j)]); sum += c; cnt += (c > 0u) ? 1u : 0u; mine = (j == x) ? c : mine; }
        if (sum == G) break;
        __builtin_amdgcn_s_sleep(1);
        if ((++sp & 255u) == 0u) { if (xb_ld(&bar[XB_TMO])) break; if (sp > XB_SPIN_CAP) { atomicAdd(&bar[XB_TMO], 1u); break; } }
    }
    nloc = mine > 0u ? mine : 1u; nx = cnt > 0u ? cnt : 1u;
}
__device__ __forceinline__ void xcd_barrier(const XcdBarrier& b) {
    asm volatile("s_waitcnt vmcnt(0)" ::: "memory");
    __syncthreads();
    if (threadIdx.x == 0) {
        unsigned* bar = b.bar; unsigned bx = b.x; asm volatile("" : "+s"(bx));
        __builtin_amdgcn_s_waitcnt(0);
        unsigned nloc = b.st[0], nx = b.st[1];
        if (nloc == 0u) { xcd_barrier_complete(bar, bx, nloc, nx); b.st[0] = nloc; b.st[1] = nx; }
        const unsigned old = xb_add(&bar[XB_XSUB(bx)], 1u);
        const unsigned gen = old / nloc;
        if (old + 1u == (gen + 1u) * nloc) {
            __builtin_amdgcn_fence(__ATOMIC_RELEASE, "agent");
            asm volatile("s_waitcnt vmcnt(0)" ::: "memory");
            const unsigned og = xb_add(&bar[XB_TOP], 1u);
            const unsigned tg = og / nx;
            if (og + 1u == (tg + 1u) * nx) xb_add(&bar[XB_TOPGEN], 1u);
            else XB_SPIN(xb_ld(&bar[XB_TOPGEN]) == tg, bar);
            __builtin_amdgcn_fence(__ATOMIC_ACQUIRE, "agent");
            xb_add(&bar[XB_XGEN(bx)], 1u);
            asm volatile("s_waitcnt vmcnt(0)" ::: "memory");
        } else {
            XB_SPIN(xb_ld(&bar[XB_XGEN(bx)]) == gen, bar);
            __builtin_amdgcn_fence(__ATOMIC_ACQUIRE, "agent");
            asm volatile("s_waitcnt vmcnt(0)" ::: "memory");
        }
    }
    __syncthreads();
}

enum { I_X = 0, I_MIX, I_WR, I_WK, I_WV, I_WO, I_W0, I_W1, I_W2, I_A0, I_A1, I_A2, I_G1, I_G2, I_KK, I_KA, I_RK, I_GNG, I_GNB,
       I_FWIN, I_FBF, I_FWO, I_RW, I_RB, I_MG, I_MU, I_MD, I_LNG, I_LNB, N_IN };
constexpr int LDS_BYTES = 163840;
constexpr int LDS_MISC = LDS_BYTES - 64;
static_assert(CTL_BAR_OFF + XCD_BAR_WORDS * 4 <= CTL_BYTES, "ctl block");

struct Params { const float* in[N_IN]; float* out; unsigned char* ws; };

__device__ __forceinline__ void ph_xmix(const float* x, const float* mix, bf16* xcat, bf16* xr3, int gw, int NGW, int lane) {
    f32x4 mr[4], mk[4], mv[4];
#pragma unroll
    for (int j = 0; j < 4; ++j) { mr[j] = *(const f32x4*)(mix + 0 * D + 4 * lane + 256 * j); mk[j] = *(const f32x4*)(mix + 2 * D + 4 * lane + 256 * j); mv[j] = *(const f32x4*)(mix + 3 * D + 4 * lane + 256 * j); }
    for (int row = gw; row < M; row += NGW) {
        const bool hp = (row & (T - 1)) != 0;
#pragma unroll
        for (int j = 0; j < 4; ++j) {
            const int col = 4 * lane + 256 * j;
            const f32x4 c4 = *(const f32x4*)(x + (size_t)row * D + col);
            f32x4 p4 = (f32x4){0.f, 0.f, 0.f, 0.f};
            if (hp) p4 = *(const f32x4*)(x + (size_t)(row - 1) * D + col);
            const f32x4 xx = p4 - c4;
            u32x2 o;
            o.x = pk2(c4.x, c4.y); o.y = pk2(c4.z, c4.w); *(u32x2*)(xcat + (size_t)row * 2048 + col) = o;
            o.x = pk2(xx.x, xx.y); o.y = pk2(xx.z, xx.w); *(u32x2*)(xcat + (size_t)row * 2048 + 1024 + col) = o;
            f32x4 v = c4 + xx * mr[j]; o.x = pk2(v.x, v.y); o.y = pk2(v.z, v.w); *(u32x2*)(xr3 + (size_t)row * D + col) = o;
            v = c4 + xx * mk[j]; o.x = pk2(v.x, v.y); o.y = pk2(v.z, v.w); *(u32x2*)(xr3 + (size_t)M * D + (size_t)row * D + col) = o;
            v = c4 + xx * mv[j]; o.x = pk2(v.x, v.y); o.y = pk2(v.z, v.w); *(u32x2*)(xr3 + 2 * (size_t)M * D + (size_t)row * D + col) = o;
        }
    }
}

__global__ void __launch_bounds__(512, 2) fwd(Params P) {
    extern __shared__ __attribute__((aligned(16))) unsigned char lds[];
    LAS unsigned char* lds3 = (LAS unsigned char*)lds;
    volatile LAS unsigned* misc = (volatile LAS unsigned*)(lds3 + LDS_MISC);
    if (threadIdx.x < 16) misc[threadIdx.x] = 0u;
    const int wv_s = __builtin_amdgcn_readfirstlane(threadIdx.x >> 6);
    __syncthreads();
    unsigned char* ws = P.ws;
    XcdBarrier bar = xcd_barrier_post((unsigned*)(ws + WS_CTL + CTL_BAR_OFF), misc);
    const int G = gridDim.x, bid = blockIdx.x;
    float* hbuf = P.out;
    bf16* PRE = (bf16*)P.out;
    int* counts0 = (int*)(ws + WS_CTL);
    bf16* HB = (bf16*)(ws + WS_HB); bf16* R = (bf16*)(ws + WS_R); bf16* KB = (bf16*)(ws + WS_K); bf16* VB = (bf16*)(ws + WS_V);
    _Float16* LW = (_Float16*)(ws + WS_LW); bf16* AA = (bf16*)(ws + WS_AA); bf16* GG = (bf16*)(ws + WS_G); bf16* L1 = (bf16*)(ws + WS_L1);
    float* LOGF = (float*)(ws + WS_LOGF); float* CUM = (float*)(ws + WS_CUM); bf16* Y = (bf16*)(ws + WS_Y); bf16* HID = (bf16*)(ws + WS_HID);
    bf16* GUT = (bf16*)(ws + WS_MOEW); bf16* DNT = (bf16*)(ws + WS_DNT);
    bf16* GUT1 = (bf16*)((unsigned char*)P.out + 32 * MiB); bf16* DNT1 = (bf16*)(ws + WS_DNT1);
    const size_t BIG = (size_t)1 << 20;

    {
        const int tid = opaque_tid(wv_s), lane = tid & 63, wave = tid >> 6;
        const int gw = bid * 8 + wave, NGW = G * 8;
        LAS float* scr = (LAS float*)(lds3 + wave * 16384);
        bf16* WRKV = (bf16*)(ws + WS_WRKV); bf16* WO = (bf16*)(ws + WS_WO); bf16* B1T = (bf16*)(ws + WS_B1T); bf16* B2T = (bf16*)(ws + WS_B2T);
        bf16* WIN = (bf16*)(ws + WS_WIN); bf16* FWO = (bf16*)(ws + WS_FWO);
        const float* mix = P.in[I_MIX];
        int ib = 0;
        ib = tr_matrix(ib, gw, NGW, P.in[I_WR], D, D, D, nullptr, WRKV, D, 0, 0, 0, scr, lane);
        ib = tr_matrix(ib, gw, NGW, P.in[I_WK], D, D, D, nullptr, WRKV, D, 0, D, 0, scr, lane);
        ib = tr_matrix(ib, gw, NGW, P.in[I_WV], D, D, D, nullptr, WRKV, D, 0, 2 * D, 0, scr, lane);
        ib = tr_matrix(ib, gw, NGW, P.in[I_W1], 64, D, 64, nullptr, B1T, 2048, 0, 0, 0, scr, lane);
        ib = tr_matrix(ib, gw, NGW, P.in[I_W1], 64, D, 64, mix + 1 * D, B1T, 2048, 1024, 0, 0, scr, lane);
        ib = tr_matrix(ib, gw, NGW, P.in[I_A1], 64, D, 64, nullptr, B1T, 2048, 0, 64, 0, scr, lane);
        ib = tr_matrix(ib, gw, NGW, P.in[I_A1], 64, D, 64, mix + 4 * D, B1T, 2048, 1024, 64, 0, scr, lane);
        ib = tr_matrix(ib, gw, NGW, P.in[I_G1], 128, D, 128, nullptr, B1T, 2048, 0, 128, 0, scr, lane);
        ib = tr_matrix(ib, gw, NGW, P.in[I_G1], 128, D, 128, mix + 5 * D, B1T, 2048, 1024, 128, 0, scr, lane);
        ib = tr_matrix(ib, gw, NGW, P.in[I_W2], D, 64, D, nullptr, B2T, 256, 0, 0, 0, scr, lane);
        ib = tr_matrix(ib, gw, NGW, P.in[I_A2], D, 64, D, nullptr, B2T, 256, 64, 1024, 0, scr, lane);
        ib = tr_matrix(ib, gw, NGW, P.in[I_G2], D, 128, D, nullptr, B2T, 256, 128, 2048, 0, scr, lane);
        for (int ch = bid * 512 + tid; ch < 3072 * 32; ch += G * 512) {
            const int row = ch >> 5, c8 = ch & 31;
            const bool covered = row < 1024 ? (c8 < 8) : (row < 2048 ? (c8 >= 8 && c8 < 16) : (c8 >= 16));
            if (!covered) *(u32x4*)(B2T + (size_t)row * 256 + c8 * 8) = (u32x4){0u, 0u, 0u, 0u};
        }
        ph_xmix(P.in[I_X], mix, (bf16*)(ws + WS_XCAT), (bf16*)(ws + WS_XR), gw, NGW, lane);
    }
    xcd_barrier(bar);
    {
        const int G1 = G / 4, G2 = G - G1;
        pg8::DenseOrder S1; S1.init(M, 256, 2048, G1, bid < G1 ? bid : -1, ws + WS_XCAT, ws + WS_B1T, 1 << 20, 0);
        pg8::EpiBf16 E1; E1.O = L1; E1.ldc = 256; E1.split_div = 1; E1.split_stride = 0; E1.scale0 = 1.f; E1.act = 1; E1.scanlay = 0;
        pg8::gemm_phase<pg8::EpiBf16, pg8::DenseOrder, true, false>(lds3, 2048, S1, E1, wv_s);
        pg8::DenseOrder S2; S2.init(M, 3 * D, D, G2, bid >= G1 ? bid - G1 : -1, ws + WS_XR, ws + WS_WRKV, 4, (size_t)M * D * 2);
        pg8::EpiBf16 E2; E2.O = R; E2.ldc = D; E2.split_div = 4; E2.split_stride = (size_t)M * D; E2.scale0 = 1.f; E2.act = 0; E2.scanlay = 1;
        pg8::gemm_phase<pg8::EpiBf16, pg8::DenseOrder, true, false>(lds3, D, S2, E2, wv_s);
    }
    xcd_barrier(bar);
    {
        pg8::DenseOrder S; S.init(M, 3 * D, 256, G, bid, L1, ws + WS_B2T, 1 << 20, 0);
        pg8::EpiLora2 E; E.LW = LW; E.AG = AA; E.w0 = P.in[I_W0]; E.a0 = P.in[I_A0];
        pg8::gemm_phase<pg8::EpiLora2, pg8::DenseOrder, true, false>(lds3, 256, S, E, wv_s);
    }
    xcd_barrier(bar);
    {
        const bool split = G >= 256;
        if (!split || bid < NB * H) {
            ScanP p; p.r = R; p.k = KB; p.v = VB; p.lw = LW; p.a = AA; p.g = GG; p.yg = R; p.kk = P.in[I_KK]; p.ka = P.in[I_KA]; p.rk = P.in[I_RK]; p.gng = P.in[I_GNG]; p.gnb = P.in[I_GNB];
            ph_scan_pc(p, lds, split ? NB * H : G, wv_s);
        }
        if (!split || bid >= NB * H) {
            const int tid = opaque_tid(wv_s), lane = tid & 63, wave = tid >> 6;
            __syncthreads();
            if (bid == G - 1) {
                build_router_frags(P.in[I_LNG] + 0 * D, P.in[I_LNB] + 0 * D, P.in[I_RW], ws + WS_WF, lds, tid);
                build_router_frags(P.in[I_LNG] + 2 * D, P.in[I_LNB] + 2 * D, P.in[I_RW], ws + WS_WF + WF_STRIDE, lds, tid);
            }
            {
                const int gw = split ? (bid - NB * H) * 8 + wave : bid * 8 + wave, NGW = split ? (G - NB * H) * 8 : G * 8; LAS float* scr = (LAS float*)(lds3 + wave * 16384); int ib = 0;
                ib = tr_matrix(ib, gw, NGW, P.in[I_WO], D, D, D, nullptr, (bf16*)(ws + WS_WO), D, 0, 0, 0, scr, lane);
                ib = tr_matrix(ib, gw, NGW, P.in[I_FWIN], NW_IN, D, 3 * D, nullptr, (bf16*)(ws + WS_WIN), D, 0, 0, 0, scr, lane);
                ib = tr_matrix(ib, gw, NGW, P.in[I_FWO], D, D, D, nullptr, (bf16*)(ws + WS_FWO), D, 0, 0, 0, scr, lane);
            }
            convert_moe(P.in[I_MG], P.in[I_MU], P.in[I_MD], GUT, DNT, split ? (bid - NB * H) * 8 + wave : bid * 8 + wave, split ? (G - NB * H) * 8 : G * 8, (LAS float*)(lds3 + wave * 16384), lane);
            convert_moe(P.in[I_MG] + (size_t)NE * D * DE, P.in[I_MU] + (size_t)NE * D * DE, P.in[I_MD] + (size_t)NE * DE * D, GUT1, DNT1, split ? (bid - NB * H) * 8 + wave : bid * 8 + wave, split ? (G - NB * H) * 8 : G * 8, (LAS float*)(lds3 + wave * 16384), lane);
        }
    }
    xcd_barrier(bar);
    {
        pg8::DenseOrder S; S.init(M, D, D, G, bid, R, ws + WS_WO, 1 << 20, 0); S.ascan = 1;
        pg8::EpiPre E; E.hin32 = P.in[I_X]; E.hin16 = nullptr; E.out = PRE;
        pg8::gemm_phase<pg8::EpiPre, pg8::DenseOrder, true, false>(lds3, D, S, E, wv_s);
    }
    xcd_barrier(bar);
    for (int layer = 0; layer < 2; ++layer) {
        if (layer == 1) {
            ph_cumsum(LOGF, CUM, wv_s);
            {
                pg8::DenseOrder S; S.init(M, 3 * D, D, G, bid, HB, ws + WS_WIN, 1 << 20, 0);
                pg8::EpiBf16 E; E.O = R; E.ldc = D; E.split_div = 4; E.split_stride = (size_t)M * D; E.scale0 = attn_body::C2; E.act = 0; E.scanlay = 0;
                pg8::gemm_phase<pg8::EpiBf16, pg8::DenseOrder, true, false>(lds3, D, S, E, wv_s);
            }
            xcd_barrier(bar);
            {   const attn_body::AttnTensors AT{(const attn_body::bf16*)R, (const attn_body::bf16*)KB, (const attn_body::bf16*)VB, (attn_body::bf16*)R};
                const attn_body::StaticOrder S(G, bid);
                attn_body::attn_phase<attn_body::StaticOrder, 30>((char*)lds, AT, CUM, S, wv_s); }
            xcd_barrier(bar);
            {
                pg8::DenseOrder S; S.init(M, D, D, G, bid, R, ws + WS_FWO, 1 << 20, 0);
                pg8::EpiPre E; E.hin32 = nullptr; E.hin16 = HB; E.out = PRE;
                pg8::gemm_phase<pg8::EpiPre, pg8::DenseOrder, true, false>(lds3, D, S, E, wv_s);
            }
            xcd_barrier(bar);
        }
        int* counts = counts0 + 16 * CNT_STRIDE * layer;
        int* rtok = (int*)(ws + WS_RTOK) + (size_t)layer * NE * CAP; float* rgate = (float*)(ws + WS_RGATE) + (size_t)layer * NE * CAP; int* slot = (int*)(ws + WS_SLOT) + (size_t)layer * M * 2;
        {   LnRouteP p; p.pin = PRE; p.hb = HB; p.g = P.in[I_LNG] + (layer * 2 + 0) * D; p.b = P.in[I_LNB] + (layer * 2 + 0) * D; p.wfg = ws + WS_WF + (size_t)layer * WF_STRIDE; p.rbias = P.in[I_RB];
            p.counts = counts; p.rtok = rtok; p.rgate = rgate; p.slot = slot;
            ph_ln_route(p, lds, wv_s); }
        xcd_barrier(bar);
        {
            int total = 0; for (int e = 0; e < NE; ++e) total += (counts[e * CNT_STRIDE] + 255) >> 8;
            total *= 4;
            const int n3 = total > 512 ? total - 512 : 0, early = total < 512 ? total : 512;
            unsigned* gu3 = (unsigned*)(ws + WS_CTL + 36864) + 64 * layer;
            pg8::EpiGU EG; EG.hid = HID;
            pg8::EpiDN ED; ED.y = Y; ED.rgate = rgate;
            pg8::MoeOrder SG; SG.counts = counts; SG.rtok = rtok; SG.A = (const char*)HB; SG.B = (const char*)(layer == 0 ? GUT : GUT1); SG.bexp_stride = (size_t)D * D * 2; SG.nN = 4; SG.K = D; SG.gather = 1;
            pg8::MoeOrder SD; SD.counts = counts; SD.rtok = rtok; SD.A = (const char*)HID; SD.B = (const char*)(layer == 0 ? DNT : DNT1); SD.bexp_stride = (size_t)D * DE * 2; SD.nN = 4; SD.K = DE; SD.gather = 0;
            SG.base = bid; SG.stride = G; SG.hi = early;
            pg8::gemm_phase<pg8::EpiGU, pg8::MoeOrder, true, true>(lds3, D, SG, EG, wv_s);
            xcd_barrier(bar);
            int late_idx = -1;
            if (bid < n3) {
                SG.base = 512 + bid; SG.stride = 1 << 20; SG.hi = total;
                pg8::gemm_phase<pg8::EpiGU, pg8::MoeOrder, true, true>(lds3, D, SG, EG, wv_s);
                __syncthreads();
                if (opaque_tid(wv_s) == 0) { __builtin_amdgcn_fence(__ATOMIC_RELEASE, "agent"); asm volatile("s_waitcnt vmcnt(0)" ::: "memory"); __hip_atomic_fetch_add(gu3, 1u, __ATOMIC_RELAXED, __HIP_MEMORY_SCOPE_AGENT); }
                SD.base = bid; SD.stride = 1 << 20; SD.hi = early;
            } else {
                const int d = bid - n3, W = G - n3;
                SD.base = n3 + d; SD.stride = W; SD.hi = early;
                int idx = n3 + d; while (idx < 512) idx += W;
                if (idx < total) late_idx = idx;
            }
            pg8::gemm_phase<pg8::EpiDN, pg8::MoeOrder, true, false>(lds3, DE, SD, ED, wv_s);
            if (late_idx >= 0) {
                if (opaque_tid(wv_s) == 0) {
                    unsigned sp = 0; while (__hip_atomic_load(gu3, __ATOMIC_RELAXED, __HIP_MEMORY_SCOPE_AGENT) < (unsigned)n3) { __builtin_amdgcn_s_sleep(2); if (++sp > (1u << 22)) break; }
                    __builtin_amdgcn_fence(__ATOMIC_ACQUIRE, "agent"); asm volatile("s_waitcnt vmcnt(0)" ::: "memory");
                }
                __syncthreads();
                SD.base = late_idx; SD.stride = 1 << 20; SD.hi = total;
                pg8::gemm_phase<pg8::EpiDN, pg8::MoeOrder, true, false>(lds3, DE, SD, ED, wv_s);
            }
        }
        xcd_barrier(bar);
        {   LnCombP p; p.hb = HB; p.y = Y; p.slot = slot; p.counts = counts; p.g = P.in[I_LNG] + (layer * 2 + 1) * D; p.b = P.in[I_LNB] + (layer * 2 + 1) * D;
            p.wf = P.in[I_FWIN] + 3 * D; p.bf = P.in[I_FBF]; p.logf = LOGF; p.outp = (layer == 1) ? hbuf : nullptr; p.do_f = (layer == 0) ? 1 : 0; p.pad = 0;
            ph_ln_comb(p, lds, wv_s); }
        if (layer == 0) {
            xcd_barrier(bar);
        }
    }
}

extern "C" void kernel_launch(void* const* d_in, const int* in_sizes, int n_in, void* d_out, int out_size, void* d_ws, size_t ws_size, hipStream_t stream) {
    static int grid = 0;
    if (grid == 0) {
        if (n_in != N_IN || out_size != M * D || ws_size < WS_END) { fprintf(stderr, "kernel_launch: unexpected problem (n_in %d out %d ws %zu, need %zu)\n", n_in, out_size, ws_size, (size_t)WS_END); grid = -1; return; }
        int dev = 0, cus = 0;
        if (hipGetDevice(&dev) != hipSuccess || hipDeviceGetAttribute(&cus, hipDeviceAttributeMultiprocessorCount, dev) != hipSuccess) { grid = -1; return; }
        if (hipFuncSetAttribute((const void*)fwd, hipFuncAttributeMaxDynamicSharedMemorySize, LDS_BYTES) != hipSuccess) { fprintf(stderr, "kernel_launch: hipFuncSetAttribute failed\n"); grid = -1; return; }
        int per_cu = 0;
        if (hipOccupancyMaxActiveBlocksPerMultiprocessor(&per_cu, (const void*)fwd, 512, LDS_BYTES) != hipSuccess || per_cu < 1) { fprintf(stderr, "kernel_launch: occupancy query says %d\n", per_cu); (void)hipGetLastError(); }
        grid = cus;
    }
    if (grid < 0) return;
    (void)hipMemsetAsync((char*)d_ws + WS_CTL, 0, CTL_BYTES, stream);
    Params P{};
    for (int i = 0; i < N_IN; ++i) P.in[i] = (const float*)d_in[i];
    P.out = (float*)d_out; P.ws = (unsigned char*)d_ws;
    hipLaunchKernelGGL(fwd, dim3(grid), dim3(512), LDS_BYTES, stream, P);
}
```

```cpp
#include <hip/hip_runtime.h>
#include <stdint.h>
#include <stdio.h>

typedef unsigned short bf16;
typedef short bf16x8 __attribute__((ext_vector_type(8)));
typedef float f32x4 __attribute__((ext_vector_type(4)));
typedef float f32x2 __attribute__((ext_vector_type(2)));
typedef unsigned u32x4 __attribute__((ext_vector_type(4)));
typedef unsigned u32x2 __attribute__((ext_vector_type(2)));
#define LAS __attribute__((address_space(3)))

constexpr int NB = 8, T = 2048, D = 1024, H = 16, HD = 64, M = NB * T;
constexpr int NE = 16, DE = 512, CAP = 16384, MAXROWS = 36864;
constexpr int NW_IN = 3 * D + H;
constexpr float ALPHA = 1.4142135623730951f;
constexpr float LN_EPS = 1e-5f, GN_EPS = 64e-5f;
constexpr float LOG2E = 1.4426950408889634f;

constexpr size_t MiB = 1u << 20;
constexpr size_t WS_CTL = 0;
constexpr size_t CTL_BYTES = 65536;
constexpr size_t CTL_BAR_OFF = 16384;
constexpr size_t WS_RTOK = 1 * MiB;
constexpr size_t WS_RGATE = 3 * MiB;
constexpr size_t WS_SLOT = 5 * MiB;
constexpr size_t WS_WRKV = 6 * MiB;
constexpr size_t WS_WO = 12 * MiB;
constexpr size_t WS_B1T = 14 * MiB;
constexpr size_t WS_B2T = 15 * MiB;
constexpr size_t WS_WIN = 17 * MiB;
constexpr size_t WS_FWO = 23 * MiB;
constexpr size_t WS_X0 = 25 * MiB;
constexpr size_t WS_XCAT = WS_X0;
constexpr size_t WS_XR = WS_X0 + 64 * MiB;
constexpr size_t WS_MOEW = WS_X0;
constexpr size_t WS_DNT = WS_MOEW + 32 * MiB;
constexpr size_t WS_LW = WS_X0 + 48 * MiB;
constexpr size_t WS_HB = WS_X0 + 48 * MiB;
constexpr size_t WS_AA = WS_X0 + 80 * MiB;
constexpr size_t WS_G = WS_X0 + 112 * MiB;
constexpr size_t WS_DNT1 = WS_X0 + 144 * MiB;
constexpr size_t WS_HID = WS_X0 + 80 * MiB;
constexpr size_t WS_R = WS_X0 + 160 * MiB;
constexpr size_t WS_K = WS_R + 32 * MiB;
constexpr size_t WS_V = WS_R + 64 * MiB;
constexpr size_t WS_Y = WS_R;
constexpr size_t WS_L1 = WS_R + 96 * MiB;
constexpr size_t WS_LOGF = WS_L1;
constexpr size_t WS_CUM = WS_L1 + 1 * MiB;
constexpr size_t WS_WF = WS_L1 + 4 * MiB;
constexpr size_t WF_STRIDE = 65536 + 256;
constexpr size_t WS_END = WS_L1 + 8 * MiB;
static_assert(WS_END == 289 * MiB, "map");

__device__ __forceinline__ unsigned f2bf(float f) { unsigned u = __float_as_uint(f); return (u + 0x7fffu + ((u >> 16) & 1u)) >> 16; }
__device__ __forceinline__ float bf2f(unsigned b) { return __uint_as_float(b << 16); }
typedef __bf16 bf16x2_t_ __attribute__((ext_vector_type(2)));
__device__ __forceinline__ unsigned pk2(float lo, float hi) { const f32x2 v = {lo, hi}; const bf16x2_t_ b = __builtin_convertvector(v, bf16x2_t_); return __builtin_bit_cast(unsigned, b); }
__device__ __forceinline__ float sigmoidf_(float x) { return 1.0f / (1.0f + __expf(-x)); }
__device__ __forceinline__ float sigmoid_fast(float x) { return __builtin_amdgcn_rcpf(1.0f + __expf(-x)); }
__device__ __forceinline__ float tanh_fast(float x) { return 2.0f * sigmoid_fast(2.0f * x) - 1.0f; }
__device__ __forceinline__ float softplusf_(float x) { return fmaxf(x, 0.f) + __logf(1.0f + __expf(-fabsf(x))); }
__device__ __forceinline__ float shx(float v, int o, int lane) { return __int_as_float(__builtin_amdgcn_ds_bpermute((lane ^ o) << 2, __float_as_int(v))); }
__device__ __forceinline__ float wave_sum(float v, int lane) {
#pragma unroll
    for (int o = 1; o < 64; o <<= 1) v += shx(v, o, lane);
    return v;
}
__device__ __forceinline__ int opaque_tid(int wv_s) { int l; asm volatile("v_mbcnt_lo_u32_b32 %0, -1, 0\n\tv_mbcnt_hi_u32_b32 %0, -1, %0" : "=v"(l)); return wv_s * 64 + l; }

namespace pg8 {
constexpr int BM = 256, BK = 64, HALF = 128, HTB = HALF * BK * 2, STAGE_BYTES = 8 * HTB, NXCD = 8, WGM = 8;
__host__ __device__ __forceinline__ int lds_byte(int r, int c) { const int st = (r >> 4) * 2 + (c >> 5), rr = r & 15, cc = c & 31, ob = rr * 64 + cc * 2; return st * 1024 + (ob ^ (((ob >> 9) & 1) << 5)); }
__host__ __device__ __forceinline__ void stage_rc(int b, int& R, int& C) { const int st = b / 1024, sb = b % 1024, swz = sb ^ (((sb >> 9) & 1) << 5); R = (st >> 1) * 16 + swz / 64; C = (st & 1) * 32 + (swz % 64) / 2; }
__host__ __device__ __forceinline__ int perm32(int rho) { const int n = rho >> 4, i = rho & 15; return 8 * (i >> 2) + 4 * n + (i & 3); }

struct Unit { int pm, pn; const char* A; const char* B; int e, r0, nvalid, pad; };

typedef __bf16 bf16x2_cv __attribute__((ext_vector_type(2)));
__device__ __forceinline__ unsigned cvt_pk_bf16(float lo, float hi) { const f32x2 v = {lo, hi}; const bf16x2_cv b = __builtin_convertvector(v, bf16x2_cv); return __builtin_bit_cast(unsigned, b); }

template <class Epi, class Sched, bool ALIGN_EPI, bool GATHER>
__device__ __forceinline__ void gemm_phase(LAS unsigned char* lds, const int K_in, const Sched& S, const Epi& E, const int wv_s) {
    int K = K_in; asm volatile("" : "+s"(K));
    const int tid = opaque_tid(wv_s), wid = wv_s, lane = tid & 63, wr = wid >> 2, wc = wid & 3, fr = lane & 15, fq = lane >> 4;
    const int nt = S.kloop(K) / BK;
    int Rr[2], Cc[2]; unsigned voffB[2];
#pragma unroll
    for (int i = 0; i < 2; ++i) { int R, C; stage_rc(tid * 16 + i * 8192, R, C); Rr[i] = R; Cc[i] = C; const int Rb = Epi::PERM ? ((R & ~31) + perm32(R & 31)) : R; voffB[i] = (unsigned)(Rb * K + C) * 2u; }
    const size_t kstep = (size_t)(BK * 2);
    const size_t kstepA = S.kstepA();
    const size_t hstep = (size_t)HALF * K * 2;
    const unsigned ldsw = (unsigned)wid * 1024u;
    const int aoff = lds_byte(wr * 64 + fr, fq * 8), boff = lds_byte(wc * 32 + fr, fq * 8);
#define PG8_SA(b, h) (((b) * 2 + (h)) * HTB)
#define PG8_SB(b, h) ((4 + (b) * 2 + (h)) * HTB)
#define PG8_STAGE(bufoff, gbase, voff) do { _Pragma("unroll") for (int _i = 0; _i < 2; ++_i) \
        __builtin_amdgcn_global_load_lds((const unsigned*)((const char*)(gbase) + (voff)[_i]), (LAS unsigned*)(lds + (bufoff) + ldsw + _i * 8192), 16, 0, 0); } while (0)
#define PG8_LDA(dst, b, h) do { _Pragma("unroll") for (int m = 0; m < 4; ++m) _Pragma("unroll") for (int k = 0; k < 2; ++k) dst[m][k] = *(const LAS bf16x8*)(lds + PG8_SA(b, h) + aoff + m * 2048 + k * 1024); } while (0)
#define PG8_LDB(dst, b, h) do { _Pragma("unroll") for (int n = 0; n < 2; ++n) _Pragma("unroll") for (int k = 0; k < 2; ++k) dst[n][k] = *(const LAS bf16x8*)(lds + PG8_SB(b, h) + boff + n * 2048 + k * 1024); } while (0)
#define PG8_MMA(ai, bj, At, Bt) do { __builtin_amdgcn_s_setprio(1); _Pragma("unroll") for (int m = 0; m < 4; ++m) _Pragma("unroll") for (int n = 0; n < 2; ++n) _Pragma("unroll") for (int k = 0; k < 2; ++k) \
        acc[ai][bj][m][n] = __builtin_amdgcn_mfma_f32_16x16x32_bf16(Bt[n][k], At[m][k], acc[ai][bj][m][n], 0, 0, 0); __builtin_amdgcn_s_setprio(0); } while (0)
#define PG8_WAIT_V(n) asm volatile("s_waitcnt vmcnt(" #n ")" ::: "memory")
#define PG8_WAIT_L(n) asm volatile("s_waitcnt lgkmcnt(" #n ")" ::: "memory")
#define PG8_BAR __builtin_amdgcn_s_barrier()
#define PG8_SCHED __builtin_amdgcn_sched_barrier(0)
    Unit cur, nxt; int ui = 0;
    if (!S.next(0, cur)) return;
    f32x4 acc[2][2][4][2];
#pragma unroll
    for (int a = 0; a < 2; ++a)
#pragma unroll
        for (int b = 0; b < 2; ++b)
#pragma unroll
            for (int m = 0; m < 4; ++m)
#pragma unroll
                for (int n = 0; n < 2; ++n) acc[a][b][m][n] = (f32x4){0.f, 0.f, 0.f, 0.f};
    bf16x8 At[4][2], B0[2][2], B1[2][2];
    unsigned cv[2][2], nv[2][2];
    S.fill(cur, Rr, Cc, K, cv);
    const char* cA = cur.A; const char* cB = cur.B;
    PG8_STAGE(PG8_SB(0, 0), cB, voffB); PG8_STAGE(PG8_SB(0, 1), cB + hstep, voffB); PG8_STAGE(PG8_SA(0, 0), cA, cv[0]); PG8_STAGE(PG8_SA(0, 1), cA, cv[1]);
    if (wr == 1) PG8_BAR;
    PG8_WAIT_V(2); PG8_BAR;
    PG8_STAGE(PG8_SB(1, 0), cB + kstep, voffB); PG8_STAGE(PG8_SA(1, 0), cA + kstepA, cv[0]); PG8_STAGE(PG8_SB(1, 1), cB + hstep + kstep, voffB);
    PG8_WAIT_V(6); PG8_BAR;
    for (;;) {
        const bool has_next = S.next(ui + 1, nxt);
        const char* nA = has_next ? nxt.A : cA; const char* nB = has_next ? nxt.B : cB;
        if (GATHER) { if (has_next) S.fill(nxt, Rr, Cc, K, nv); else { nv[0][0] = cv[0][0]; nv[0][1] = cv[0][1]; nv[1][0] = cv[1][0]; nv[1][1] = cv[1][1]; } }
        for (int t = 0; t < nt; t += 2) {
            const bool last = (t == nt - 2);
            const char* a1 = cA + (size_t)(t + 1) * kstepA;
            const char* a2 = last ? nA : cA + (size_t)(t + 2) * kstepA; const char* b2 = last ? nB : cB + (size_t)(t + 2) * kstep;
            const char* a3 = a2 + kstepA; const char* b3 = b2 + kstep;
            unsigned v2[2][2];
            if (GATHER) { v2[0][0] = last ? nv[0][0] : cv[0][0]; v2[0][1] = last ? nv[0][1] : cv[0][1]; v2[1][0] = last ? nv[1][0] : cv[1][0]; v2[1][1] = last ? nv[1][1] : cv[1][1]; }
            else { v2[0][0] = cv[0][0]; v2[0][1] = cv[0][1]; v2[1][0] = cv[1][0]; v2[1][1] = cv[1][1]; }
            PG8_LDB(B0, 0, 0); PG8_LDB(B1, 0, 1); PG8_SCHED; PG8_LDA(At, 0, 0); PG8_STAGE(PG8_SA(1, 1), a1, cv[1]);
            PG8_WAIT_V(8); PG8_WAIT_L(0); PG8_BAR; PG8_MMA(0, 0, At, B0); PG8_MMA(0, 1, At, B1); PG8_BAR; PG8_SCHED;
            PG8_LDA(At, 0, 1); PG8_STAGE(PG8_SB(0, 0), b2, voffB); PG8_STAGE(PG8_SB(0, 1), b2 + hstep, voffB); PG8_STAGE(PG8_SA(0, 0), a2, v2[0]);
            PG8_WAIT_V(8); PG8_WAIT_L(0); PG8_BAR; PG8_MMA(1, 0, At, B0); PG8_MMA(1, 1, At, B1); PG8_BAR; PG8_SCHED;
            PG8_LDB(B0, 1, 0); PG8_LDB(B1, 1, 1); PG8_SCHED; PG8_LDA(At, 1, 0); PG8_STAGE(PG8_SA(0, 1), a2, v2[1]);
            PG8_WAIT_V(8); PG8_WAIT_L(0); PG8_BAR; PG8_MMA(0, 0, At, B0); PG8_MMA(0, 1, At, B1); PG8_BAR; PG8_SCHED;
            PG8_LDA(At, 1, 1); PG8_STAGE(PG8_SB(1, 0), b3, voffB); PG8_STAGE(PG8_SB(1, 1), b3 + hstep, voffB); PG8_STAGE(PG8_SA(1, 0), a3, v2[0]);
            PG8_WAIT_V(8); PG8_WAIT_L(0); PG8_BAR; PG8_MMA(1, 0, At, B0); PG8_MMA(1, 1, At, B1); PG8_BAR; PG8_SCHED;
        }
        if constexpr (ALIGN_EPI) { if (wr == 0) PG8_BAR; }
        { int fr_ = fr, fq_ = fq; asm volatile("" : "+v"(fr_), "+v"(fq_));
          E(acc, cur, wr, wc, fr_, fq_); }
        if (!has_next) break;
#pragma unroll
        for (int a = 0; a < 2; ++a)
#pragma unroll
            for (int b = 0; b < 2; ++b)
#pragma unroll
                for (int m = 0; m < 4; ++m)
#pragma unroll
                    for (int n = 0; n < 2; ++n) acc[a][b][m][n] = (f32x4){0.f, 0.f, 0.f, 0.f};
        cur = nxt; cA = nA; cB = nB; ++ui;
        if (GATHER) { cv[0][0] = nv[0][0]; cv[0][1] = nv[0][1]; cv[1][0] = nv[1][0]; cv[1][1] = nv[1][1]; }
        if constexpr (ALIGN_EPI) { if (wr == 1) PG8_BAR; }
    }
    PG8_WAIT_V(0);
    if constexpr (!ALIGN_EPI) { if (wr == 0) PG8_BAR; }
    PG8_BAR;
#undef PG8_SA
#undef PG8_SB
#undef PG8_STAGE
#undef PG8_LDA
#undef PG8_LDB
#undef PG8_MMA
#undef PG8_WAIT_V
#undef PG8_WAIT_L
#undef PG8_BAR
#undef PG8_SCHED
}

struct DenseOrder {
    int nM, nN, nwg, G, c, K;
    int kl, bsel;
    const char* A; const char* B; size_t asel_stride; int asel_div, ascan;
    __device__ void init(int M_, int N_, int K_, int G_, int c_, const void* A_, const void* B_, int asel_div_, size_t asel_stride_) {
        nM = M_ / BM; nN = N_ / BM; nwg = nM * nN; G = G_; c = c_; K = K_; A = (const char*)A_; B = (const char*)B_; asel_div = asel_div_; asel_stride = asel_stride_; ascan = 0; kl = 0; bsel = 0; }
    __device__ __forceinline__ bool next(int i, Unit& u) const {
        if (c < 0 || c >= G) return false;
        const long L = (long)i * G + c; if (L >= nwg) return false;
        int wgid = (int)L; { const int q = nwg / NXCD, r = nwg % NXCD, xcd = wgid % NXCD, off = wgid / NXCD; wgid = (xcd < r ? xcd * (q + 1) : r * (q + 1) + (xcd - r) * q) + off; }
        const int nig = WGM * nN, gid = wgid / nig, fm = gid * WGM, gsz = (nM - fm) < WGM ? (nM - fm) : WGM;
        u.pm = fm + ((wgid % nig) % gsz); u.pn = (wgid % nig) / gsz;
        u.A = ascan ? A + 2 * ((size_t)(u.pm >> 3) * 2097152 + (size_t)((u.pm * 4) & 31) * 4096) : A + (size_t)(u.pn / asel_div) * asel_stride + (size_t)u.pm * BM * K * 2;
        u.B = B + (size_t)u.pn * BM * K * 2 + (bsel ? (size_t)(u.pn / asel_div) * asel_stride : (size_t)0);
        u.e = 0; u.r0 = 0; u.nvalid = BM; u.pad = 0; return true;
    }
    __device__ __forceinline__ void fill(const Unit&, const int (&R)[2], const int (&C)[2], int K_, unsigned (&v)[2][2]) const {
#pragma unroll
        for (int h = 0; h < 2; ++h)
#pragma unroll
            for (int i = 0; i < 2; ++i) { const int lr = h * HALF + R[i]; v[h][i] = ascan ? (unsigned)((lr >> 6) * 4096 + (lr & 63) * 8 + (C[i] >> 3) * 512) * 2u : (unsigned)(lr * K_ + C[i]) * 2u; }
    }
    __device__ __forceinline__ size_t kstepA() const { return ascan ? (size_t)262144 : (size_t)(BK * 2); }
    __device__ __forceinline__ int kloop(int K_) const { return kl ? kl : K_; }
};
struct MoeOrder {
    const int* counts; const int* rtok; const char* A; const char* B; size_t bexp_stride;
    int nN, K, gather, base, stride, hi;
    __device__ __forceinline__ bool next(int i, Unit& u) const {
        const int L = base + i * stride; if (L >= hi) return false;
        const int rt = L / nN; int acc = 0;
        for (int e = 0; e < NE; ++e) {
            const int cnt = counts[e * 64], ntile = (cnt + 255) >> 8;
            if (rt < acc + ntile) {
                u.pm = rt; u.pn = L % nN; u.e = e; u.r0 = (rt - acc) * 256; u.nvalid = min(256, cnt - u.r0); u.pad = 0;
                u.A = gather ? A : A + (size_t)rt * BM * K * 2; u.B = B + (size_t)e * bexp_stride + (size_t)u.pn * BM * K * 2; return true;
            }
            acc += ntile;
        }
        return false;
    }
    __device__ __forceinline__ void fill(const Unit& u, const int (&R)[2], const int (&C)[2], int K_, unsigned (&v)[2][2]) const {
#pragma unroll
        for (int h = 0; h < 2; ++h)
#pragma unroll
            for (int i = 0; i < 2; ++i) {
                const int rl = h * HALF + R[i];
                if (gather) { const int tok = (rl < u.nvalid) ? rtok[u.e * CAP + u.r0 + rl] : 0; v[h][i] = (unsigned)(tok * K_ + C[i]) * 2u; }
                else v[h][i] = (unsigned)(rl * K_ + C[i]) * 2u;
            }
    }
    __device__ __forceinline__ size_t kstepA() const { return (size_t)(BK * 2); }
    __device__ __forceinline__ int kloop(int K_) const { return K_; }
};

__device__ __forceinline__ size_t scan_idx(int row, int col) { return ((size_t)((((row >> 11) * H + (col >> 6)) * 32 + ((row >> 6) & 31)) * 8 + ((col >> 3) & 7)) * 64 + (row & 63)) * 8 + (col & 7); }
struct EpiBf16 {
    static constexpr bool PERM = true;
    bf16* O; int ldc, split_div; size_t split_stride; float scale0; int act, scanlay;
    __device__ __forceinline__ void operator()(const f32x4 (&acc)[2][2][4][2], const Unit& u, int wr, int wc, int fr, int fq) const {
        const int t = u.pn / split_div; bf16* base = O + (size_t)t * split_stride;
        const int colt = (u.pn - t * split_div) * BM;
        const float sc = (t == 0) ? scale0 : 1.f;
        const int row0 = u.pm * BM + wr * 64 + fr, col0 = colt + wc * 32 + 8 * fq;
#pragma unroll
        for (int ai = 0; ai < 2; ++ai)
#pragma unroll
            for (int m = 0; m < 4; ++m) { const int row = row0 + ai * HALF + m * 16; bf16* rowp = base + (size_t)row * ldc + col0;
#pragma unroll
                for (int bj = 0; bj < 2; ++bj) { f32x4 v0 = acc[ai][bj][m][0] * sc, v1 = acc[ai][bj][m][1] * sc;
                    if (act == 1) {
                        if (bj == 0 && wc < 2) { v0.x = tanh_fast(v0.x); v0.y = tanh_fast(v0.y); v0.z = tanh_fast(v0.z); v0.w = tanh_fast(v0.w); v1.x = tanh_fast(v1.x); v1.y = tanh_fast(v1.y); v1.z = tanh_fast(v1.z); v1.w = tanh_fast(v1.w); }
                        else if (bj == 1) { v0.x = sigmoid_fast(v0.x); v0.y = sigmoid_fast(v0.y); v0.z = sigmoid_fast(v0.z); v0.w = sigmoid_fast(v0.w); v1.x = sigmoid_fast(v1.x); v1.y = sigmoid_fast(v1.y); v1.z = sigmoid_fast(v1.z); v1.w = sigmoid_fast(v1.w); }
                    }
                    u32x4 w; w.x = cvt_pk_bf16(v0[0], v0[1]); w.y = cvt_pk_bf16(v0[2], v0[3]); w.z = cvt_pk_bf16(v1[0], v1[1]); w.w = cvt_pk_bf16(v1[2], v1[3]);
                    bf16* dst = (scanlay != 0) ? base + scan_idx(row, col0 + bj * HALF) : rowp + bj * HALF;
                    *(u32x4*)dst = w; } }
    }
};
struct EpiLora2 {
    static constexpr bool PERM = true;
    _Float16* LW; bf16* AG; const float* w0; const float* a0;
    __device__ __forceinline__ void operator()(const f32x4 (&acc)[2][2][4][2], const Unit& u, int wr, int wc, int fr, int fq) const {
        const int t = u.pn >> 2, colt = (u.pn & 3) * BM;
        const int row0 = u.pm * BM + wr * 64 + fr, col0 = colt + wc * 32 + 8 * fq;
        if (t == 0) {
#pragma unroll
            for (int bj = 0; bj < 2; ++bj) {
                const f32x4 b0 = *(const f32x4*)(w0 + col0 + bj * HALF), b1 = *(const f32x4*)(w0 + col0 + bj * HALF + 4);
#pragma unroll
                for (int ai = 0; ai < 2; ++ai)
#pragma unroll
                    for (int m = 0; m < 4; ++m) {
                        const size_t o = scan_idx(row0 + ai * HALF + m * 16, col0 + bj * HALF);
                        const f32x4 v0 = acc[ai][bj][m][0] + b0, v1 = acc[ai][bj][m][1] + b1;
                        typedef _Float16 h8 __attribute__((ext_vector_type(8)));
                        h8 hv;
                        hv[0] = (_Float16)(-0.87503877f * sigmoid_fast(v0.x)); hv[1] = (_Float16)(-0.87503877f * sigmoid_fast(v0.y));
                        hv[2] = (_Float16)(-0.87503877f * sigmoid_fast(v0.z)); hv[3] = (_Float16)(-0.87503877f * sigmoid_fast(v0.w));
                        hv[4] = (_Float16)(-0.87503877f * sigmoid_fast(v1.x)); hv[5] = (_Float16)(-0.87503877f * sigmoid_fast(v1.y));
                        hv[6] = (_Float16)(-0.87503877f * sigmoid_fast(v1.z)); hv[7] = (_Float16)(-0.87503877f * sigmoid_fast(v1.w));
                        *(h8*)(LW + o) = hv;
                    }
            }
        } else if (t == 1) {
#pragma unroll
            for (int bj = 0; bj < 2; ++bj) {
                const f32x4 b0 = *(const f32x4*)(a0 + col0 + bj * HALF), b1 = *(const f32x4*)(a0 + col0 + bj * HALF + 4);
#pragma unroll
                for (int ai = 0; ai < 2; ++ai)
#pragma unroll
                    for (int m = 0; m < 4; ++m) {
                        const size_t o = scan_idx(row0 + ai * HALF + m * 16, col0 + bj * HALF);
                        const f32x4 v0 = acc[ai][bj][m][0] + b0, v1 = acc[ai][bj][m][1] + b1;
                        u32x4 w; w.x = cvt_pk_bf16(sigmoid_fast(v0.x), sigmoid_fast(v0.y)); w.y = cvt_pk_bf16(sigmoid_fast(v0.z), sigmoid_fast(v0.w));
                        w.z = cvt_pk_bf16(sigmoid_fast(v1.x), sigmoid_fast(v1.y)); w.w = cvt_pk_bf16(sigmoid_fast(v1.z), sigmoid_fast(v1.w));
                        *(u32x4*)(AG + o) = w;
                    }
            }
        } else {
#pragma unroll
            for (int bj = 0; bj < 2; ++bj)
#pragma unroll
                for (int ai = 0; ai < 2; ++ai)
#pragma unroll
                    for (int m = 0; m < 4; ++m) {
                        const size_t o = (size_t)M * D + (size_t)(row0 + ai * HALF + m * 16) * D + col0 + bj * HALF;
                        const f32x4 v0 = acc[ai][bj][m][0], v1 = acc[ai][bj][m][1];
                        u32x4 w; w.x = cvt_pk_bf16(v0.x, v0.y); w.y = cvt_pk_bf16(v0.z, v0.w); w.z = cvt_pk_bf16(v1.x, v1.y); w.w = cvt_pk_bf16(v1.z, v1.w);
                        *(u32x4*)(AG + o) = w;
                    }
        }
    }
};
struct EpiPre {
    static constexpr bool PERM = true;
    const float* hin32; const bf16* hin16; bf16* out;
    __device__ __forceinline__ void operator()(const f32x4 (&acc)[2][2][4][2], const Unit& u, int wr, int wc, int fr, int fq) const {
        const int row0 = u.pm * BM + wr * 64 + fr, col0 = u.pn * BM + wc * 32 + 8 * fq;
#pragma unroll
        for (int ai = 0; ai < 2; ++ai)
#pragma unroll
            for (int m = 0; m < 4; ++m) { const size_t ro = (size_t)(row0 + ai * HALF + m * 16) * D + col0;
#pragma unroll
                for (int bj = 0; bj < 2; ++bj) { const size_t o = ro + bj * HALF;
                    f32x4 h0, h1;
                    if (hin32) { h0 = *(const f32x4*)(hin32 + o); h1 = *(const f32x4*)(hin32 + o + 4); }
                    else { const u32x4 hv = *(const u32x4*)(hin16 + o); h0 = (f32x4){bf2f(hv.x & 0xffff), bf2f(hv.x >> 16), bf2f(hv.y & 0xffff), bf2f(hv.y >> 16)}; h1 = (f32x4){bf2f(hv.z & 0xffff), bf2f(hv.z >> 16), bf2f(hv.w & 0xffff), bf2f(hv.w >> 16)}; }
                    const f32x4 v0 = h0 * ALPHA + acc[ai][bj][m][0], v1 = h1 * ALPHA + acc[ai][bj][m][1];
                    u32x4 w; w.x = cvt_pk_bf16(v0[0], v0[1]); w.y = cvt_pk_bf16(v0[2], v0[3]); w.z = cvt_pk_bf16(v1[0], v1[1]); w.w = cvt_pk_bf16(v1[2], v1[3]);
                    *(u32x4*)(out + o) = w; } }
    }
};
struct EpiGU {
    static constexpr bool PERM = true;
    bf16* hid;
    __device__ __forceinline__ void operator()(const f32x4 (&acc)[2][2][4][2], const Unit& u, int wr, int wc, int fr, int fq) const {
        const int row0 = u.pm * BM + wr * 64 + fr, col0 = u.pn * 128 + wc * 16 + 4 * fq;
#pragma unroll
        for (int ai = 0; ai < 2; ++ai)
#pragma unroll
            for (int m = 0; m < 4; ++m) { bf16* rowp = hid + (size_t)(row0 + ai * HALF + m * 16) * DE + col0;
#pragma unroll
                for (int bj = 0; bj < 2; ++bj) { const f32x4 g = acc[ai][bj][m][0], uu = acc[ai][bj][m][1];
                    u32x2 w; w.x = cvt_pk_bf16(g.x * sigmoid_fast(g.x) * uu.x, g.y * sigmoid_fast(g.y) * uu.y); w.y = cvt_pk_bf16(g.z * sigmoid_fast(g.z) * uu.z, g.w * sigmoid_fast(g.w) * uu.w);
                    *(u32x2*)(rowp + bj * 64) = w; } }
    }
};
struct EpiDN {
    static constexpr bool PERM = true;
    bf16* y; const float* rgate;
    __device__ __forceinline__ void operator()(const f32x4 (&acc)[2][2][4][2], const Unit& u, int wr, int wc, int fr, int fq) const {
        const int col0 = u.pn * BM + wc * 32 + 8 * fq;
#pragma unroll
        for (int ai = 0; ai < 2; ++ai)
#pragma unroll
            for (int m = 0; m < 4; ++m) { const int rl = ai * HALF + wr * 64 + m * 16 + fr;
                if (rl < u.nvalid) { const float gt = rgate[u.e * CAP + u.r0 + rl]; bf16* rowp = y + (size_t)(u.pm * BM + rl) * D + col0;
#pragma unroll
                    for (int bj = 0; bj < 2; ++bj) { const f32x4 v0 = acc[ai][bj][m][0] * gt, v1 = acc[ai][bj][m][1] * gt;
                        u32x4 w; w.x = cvt_pk_bf16(v0[0], v0[1]); w.y = cvt_pk_bf16(v0[2], v0[3]); w.z = cvt_pk_bf16(v1[0], v1[1]); w.w = cvt_pk_bf16(v1[2], v1[3]);
                        *(u32x4*)(rowp + bj * HALF) = w; } } }
    }
};
}

__device__ __forceinline__ void tr_load(const float* W, int ld, int k0, int n0, float (&v)[32], int lane) {
#pragma unroll
    for (int i = 0; i < 32; ++i) v[i] = W[(size_t)(k0 + 2 * i + (lane >> 5)) * ld + n0 + (lane & 31)];
}
__device__ __forceinline__ void tr_put(const float (&v)[32], int k0, int n0, const float* kscale, bf16* WT, int Kd, int koff, int drow0, int mode, LAS float* scr, int lane) {
#pragma unroll
    for (int i = 0; i < 32; ++i) { const int kk = 2 * i + (lane >> 5); float x = v[i]; if (kscale) x *= kscale[k0 + kk]; scr[kk * 33 + (lane & 31)] = x; }
    asm volatile("s_waitcnt lgkmcnt(0)" ::: "memory");
    const int c = lane & 7;
#pragma unroll
    for (int j = 0; j < 4; ++j) { const int n = (lane >> 3) + 8 * j; const LAS float* s = scr + (8 * c) * 33 + n;
        u32x4 o; o.x = pk2(s[0 * 33], s[1 * 33]); o.y = pk2(s[2 * 33], s[3 * 33]); o.z = pk2(s[4 * 33], s[5 * 33]); o.w = pk2(s[6 * 33], s[7 * 33]);
        const int nn = n0 + n; const int drow = (mode == 0) ? (drow0 + nn) : (drow0 + 8 * (nn >> 2) + (nn & 3) + (mode == 2 ? 4 : 0));
        *(u32x4*)(WT + (size_t)drow * Kd + koff + k0 + 8 * c) = o; }
    asm volatile("s_waitcnt lgkmcnt(0)" ::: "memory");
}
__device__ __forceinline__ void tr_item(const float* W, int ld, int k0, int n0, const float* kscale, bf16* WT, int Kd, int koff, int drow0, int mode, LAS float* scr, int lane) {
    float v[32]; tr_load(W, ld, k0, n0, v, lane); tr_put(v, k0, n0, kscale, WT, Kd, koff, drow0, mode, scr, lane);
}
__device__ __forceinline__ int tr_matrix(int item_base, int gw, int NGW, const float* W, int ld, int Ks, int Ns, const float* kscale, bf16* WT, int Kd, int koff, int drow0, int mode, LAS float* scr, int lane) {
    const int nblk = Ns / 32, nit = (Ks / 64) * nblk;
    int first = gw - (item_base % NGW); if (first < 0) first += NGW;
    for (int it = first; it < nit; it += NGW) tr_item(W, ld, 64 * (it / nblk), 32 * (it % nblk), kscale, WT, Kd, koff, drow0, mode, scr, lane);
    return item_base + nit;
}
struct MoeItem { const float* W; bf16* WT; int ld, k0, n0, Kd, mode; };
__device__ __forceinline__ MoeItem moe_item(int it, const float* wg, const float* wu, const float* wd, bf16* gut, bf16* dnt) {
    const int e = it / 768, r = it % 768; MoeItem m;
    if (r < 512) { const int q = r & 255; m.W = (r < 256 ? wg : wu) + (size_t)e * D * DE; m.ld = DE; m.k0 = 64 * (q / 16); m.n0 = 32 * (q % 16); m.WT = gut + (size_t)e * D * D; m.Kd = D; m.mode = r < 256 ? 1 : 2; }
    else { const int q = r - 512; m.W = wd + (size_t)e * DE * D; m.ld = D; m.k0 = 64 * (q / 32); m.n0 = 32 * (q % 32); m.WT = dnt + (size_t)e * D * DE; m.Kd = DE; m.mode = 0; }
    return m;
}
__device__ __forceinline__ void convert_moe(const float* wg, const float* wu, const float* wd, bf16* gut, bf16* dnt, int gw, int NGW, LAS float* scr, int lane) {
    float va[32], vb[32];
    int it = gw;
    if (it < NE * 768) { const MoeItem m = moe_item(it, wg, wu, wd, gut, dnt); tr_load(m.W, m.ld, m.k0, m.n0, va, lane); }
    while (it < NE * 768) {
        const MoeItem ma = moe_item(it, wg, wu, wd, gut, dnt);
        const int itb = it + NGW;
        if (itb < NE * 768) { const MoeItem m = moe_item(itb, wg, wu, wd, gut, dnt); tr_load(m.W, m.ld, m.k0, m.n0, vb, lane); }
        tr_put(va, ma.k0, ma.n0, nullptr, ma.WT, ma.Kd, 0, 0, ma.mode, scr, lane);
        if (itb >= NE * 768) break;
        const MoeItem mb = moe_item(itb, wg, wu, wd, gut, dnt);
        const int itc = itb + NGW;
        if (itc < NE * 768) { const MoeItem m = moe_item(itc, wg, wu, wd, gut, dnt); tr_load(m.W, m.ld, m.k0, m.n0, va, lane); }
        tr_put(vb, mb.k0, mb.n0, nullptr, mb.WT, mb.Kd, 0, 0, mb.mode, scr, lane);
        it = itc;
    }
}
constexpr int CNT_STRIDE = 64;
constexpr int RT = 2;
template <int CTRL> __device__ __forceinline__ float dppx(float v) { return __int_as_float(__builtin_amdgcn_update_dpp(0, __float_as_int(v), CTRL, 0xF, 0xF, false)); }
__device__ __forceinline__ float red8(float v) { v += dppx<0xB1>(v); v += dppx<0x4E>(v); v += dppx<0x141>(v); return v; }
__device__ __forceinline__ float red16(float v) { v = red8(v); v += dppx<0x140>(v); return v; }
__device__ __forceinline__ float red64(float v, int lane) { v = red16(v); v += shx(v, 16, lane); v += shx(v, 32, lane); return v; }
__device__ __forceinline__ void ln_rowsN(f32x4 (&v)[RT][4], const float* g, const float* b, int lane) {
    float s[RT];
#pragma unroll
    for (int t = 0; t < RT; ++t) { s[t] = 0.f;
#pragma unroll
        for (int j = 0; j < 4; ++j) s[t] += (v[t][j].x + v[t][j].y) + (v[t][j].z + v[t][j].w); }
#pragma unroll
    for (int t = 0; t < RT; ++t) s[t] = red64(s[t], lane);
    float s2[RT];
#pragma unroll
    for (int t = 0; t < RT; ++t) { const float mean = s[t] * (1.f / D); s2[t] = 0.f;
#pragma unroll
        for (int j = 0; j < 4; ++j) { v[t][j] = v[t][j] - mean; s2[t] += (v[t][j].x * v[t][j].x + v[t][j].y * v[t][j].y) + (v[t][j].z * v[t][j].z + v[t][j].w * v[t][j].w); } }
#pragma unroll
    for (int t = 0; t < RT; ++t) s2[t] = red64(s2[t], lane);
#pragma unroll
    for (int j = 0; j < 4; ++j) {
        const f32x4 gg = *(const f32x4*)(g + 4 * lane + 256 * j), bb = *(const f32x4*)(b + 4 * lane + 256 * j);
#pragma unroll
        for (int t = 0; t < RT; ++t) { const float rstd = rsqrtf(s2[t] * (1.f / D) + LN_EPS); v[t][j] = v[t][j] * rstd * gg + bb; }
    }
}
__device__ __forceinline__ void stage_w16(const float* Wm, int ldw, f32x4* wl, int tid) {
    for (int i = tid; i < 4096; i += 512) { const int c = i >> 2, e4 = i & 3, jq = (c >> 8) * 4 + (c & 3), ln = (c & 255) >> 2;
        wl[(jq * 4 + e4) * 64 + ln] = *(const f32x4*)(Wm + (size_t)c * ldw + 4 * e4); }
}
__device__ __forceinline__ float rowsN_dot16(const f32x4 (&v)[RT][4], const f32x4* wl, int lane) {
    float a[RT * 16];
#pragma unroll
    for (int i = 0; i < RT * 16; ++i) a[i] = 0.f;
    int lw = lane;
#pragma unroll
    for (int idx = 0; idx < 16; ++idx) {
        const int j = idx >> 2, q = idx & 3;
        if ((idx & 3) == 0) {
#pragma unroll
            for (int t = 0; t < RT; ++t)
                asm volatile("" : "+v"(lw), "+v"(a[t * 16 + 0]), "+v"(a[t * 16 + 1]), "+v"(a[t * 16 + 2]), "+v"(a[t * 16 + 3]), "+v"(a[t * 16 + 4]), "+v"(a[t * 16 + 5]), "+v"(a[t * 16 + 6]), "+v"(a[t * 16 + 7]),
                             "+v"(a[t * 16 + 8]), "+v"(a[t * 16 + 9]), "+v"(a[t * 16 + 10]), "+v"(a[t * 16 + 11]), "+v"(a[t * 16 + 12]), "+v"(a[t * 16 + 13]), "+v"(a[t * 16 + 14]), "+v"(a[t * 16 + 15]));
        }
        const f32x4 w0 = wl[(idx * 4 + 0) * 64 + lw], w1 = wl[(idx * 4 + 1) * 64 + lw], w2 = wl[(idx * 4 + 2) * 64 + lw], w3 = wl[(idx * 4 + 3) * 64 + lw];
#pragma unroll
        for (int t = 0; t < RT; ++t) {
            const float hv = q == 0 ? v[t][j].x : (q == 1 ? v[t][j].y : (q == 2 ? v[t][j].z : v[t][j].w));
            a[t * 16 + 0] += hv * w0.x; a[t * 16 + 1] += hv * w0.y; a[t * 16 + 2] += hv * w0.z; a[t * 16 + 3] += hv * w0.w;
            a[t * 16 + 4] += hv * w1.x; a[t * 16 + 5] += hv * w1.y; a[t * 16 + 6] += hv * w1.z; a[t * 16 + 7] += hv * w1.w;
            a[t * 16 + 8] += hv * w2.x; a[t * 16 + 9] += hv * w2.y; a[t * 16 + 10] += hv * w2.z; a[t * 16 + 11] += hv * w2.w;
            a[t * 16 + 12] += hv * w3.x; a[t * 16 + 13] += hv * w3.y; a[t * 16 + 14] += hv * w3.z; a[t * 16 + 15] += hv * w3.w;
        }
    }
#define TRED(o, n) do { const bool up_ = (lane & (o)) != 0; _Pragma("unroll") for (int i = 0; i < (n); ++i) { const float keep_ = up_ ? a[i + (n)] : a[i]; const float send_ = up_ ? a[i] : a[i + (n)]; a[i] = keep_ + shx(send_, (o), lane); } } while (0)
#pragma unroll
    for (int i = 0; i < RT * 16; ++i) a[i] += shx(a[i], 32, lane);
    if constexpr (RT == 1) {
#pragma unroll
        for (int i = 0; i < 16; ++i) a[i] += shx(a[i], 16, lane);
    } else { TRED(16, 16); }
    TRED(8, 8); TRED(4, 4); TRED(2, 2); TRED(1, 1);
#undef TRED
    return a[0];
}
__device__ __forceinline__ void store_rowsN(const f32x4 (&v)[RT][4], float* h, bf16* hb, int tok0, int lane) {
#pragma unroll
    for (int t = 0; t < RT; ++t)
#pragma unroll
        for (int j = 0; j < 4; ++j) {
            if (h) *(f32x4*)(h + (size_t)(tok0 + t) * D + 4 * lane + 256 * j) = v[t][j];
            if (hb) { u32x2 o; o.x = pk2(v[t][j].x, v[t][j].y); o.y = pk2(v[t][j].z, v[t][j].w);
                *(u32x2*)(hb + (size_t)(tok0 + t) * D + 4 * lane + 256 * j) = o; }
        }
}
__device__ __forceinline__ f32x4 ld_bf4(const bf16* p) { const u32x2 a = *(const u32x2*)p; return (f32x4){bf2f(a.x & 0xffff), bf2f(a.x >> 16), bf2f(a.y & 0xffff), bf2f(a.y >> 16)}; }

struct LnRouteP { const bf16* pin; bf16* hb; const float* g; const float* b; const unsigned char* wfg; const float* rbias; int* counts; int* rtok; float* rgate; int* slot; };
__device__ __forceinline__ void build_router_frags(const float* g, const float* b, const float* rw, unsigned char* out, unsigned char* lds, int tid) {
    float* prt = (float*)(lds + 6400);
    u32x4* WFo = (u32x4*)out; float* csc0 = (float*)(out + 65536);
    __syncthreads();
    for (int f = tid; f < 2048; f += 512) { const int kk = f >> 6, l = f & 63, e = l & 15, k0 = 32 * kk + 8 * (l >> 4);
        float wv8[8]; unsigned hi[4], lo[4];
#pragma unroll
        for (int q = 0; q < 8; ++q) wv8[q] = g[k0 + q] * rw[(size_t)(k0 + q) * NE + e];
#pragma unroll
        for (int q = 0; q < 4; ++q) { hi[q] = pk2(wv8[2 * q], wv8[2 * q + 1]); lo[q] = pk2(wv8[2 * q] - bf2f(hi[q] & 0xffff), wv8[2 * q + 1] - bf2f(hi[q] >> 16)); }
        u32x4 h4 = {hi[0], hi[1], hi[2], hi[3]}, l4 = {lo[0], lo[1], lo[2], lo[3]};
        WFo[(kk * 2 + 0) * 64 + l] = h4; WFo[(kk * 2 + 1) * 64 + l] = l4; }
    {   const int e = tid & 15, part = tid >> 4; float a0 = 0.f, a1 = 0.f;
#pragma unroll 8
        for (int q = 0; q < 32; ++q) { const int k = 32 * part + q; const float r = rw[(size_t)k * NE + e]; a0 += g[k] * r; a1 += b[k] * r; }
        prt[part * 16 + e] = a0; prt[512 + part * 16 + e] = a1; }
    __syncthreads();
    if (tid < 32) { const int e = tid & 15, which = tid >> 4; float a = 0.f;
#pragma unroll 8
        for (int q = 0; q < 32; ++q) a += prt[which * 512 + q * 16 + e];
        csc0[which * 16 + e] = a; }
    __syncthreads();
}
__device__ __forceinline__ void ph_ln_route(const LnRouteP& p, unsigned char* lds, const int wv_s) {
    const int tid = opaque_tid(wv_s); const int lane = tid & 63, wv = tid >> 6;
    int* sel_e = (int*)lds;
    float* sel_g = (float*)(lds + 512);
    int* lrank = (int*)(lds + 1024);
    int* lcnt = (int*)(lds + 1536);
    int* lbase = (int*)(lds + 1600);
    float* cs = (float*)(lds + 1664);
    float* c0 = (float*)(lds + 1728);
    float* st = (float*)(lds + 1792);
    float* lg = (float*)(lds + 2304);
    float* prt = (float*)(lds + 6400);
    bf16x8* WF = (bf16x8*)(lds + 16384);
    {
        const u32x4* wsrc = (const u32x4*)p.wfg; u32x4 tmp[8];
#pragma unroll
        for (int i = 0; i < 8; ++i) tmp[i] = wsrc[tid + 512 * i];
#pragma unroll
        for (int i = 0; i < 8; ++i) *(u32x4*)&WF[tid + 512 * i] = tmp[i];
        if (tid < 32) { const float x = ((const float*)(p.wfg + 65536))[tid]; if (tid < 16) cs[tid] = x; else c0[tid - 16] = x; }
        __syncthreads();
    }
    for (int tb = blockIdx.x * 64; tb < M; tb += gridDim.x * 64) {
        { const int tid0 = opaque_tid(wv_s); if (tid0 < 16) lcnt[tid0] = 0; }
        u32x2 raw[64 / (8 * RT)][RT][4];
#pragma unroll
        for (int rd = 0; rd < 64 / (8 * RT); ++rd)
#pragma unroll
            for (int t = 0; t < RT; ++t)
#pragma unroll
                for (int j = 0; j < 4; ++j) raw[rd][t][j] = *(const u32x2*)(p.pin + (size_t)(tb + rd * 8 * RT + wv * RT + t) * D + 4 * lane + 256 * j);
#pragma unroll
        for (int rd = 0; rd < 64 / (8 * RT); ++rd) {
            const int tl0 = rd * 8 * RT + wv * RT, tok0 = tb + tl0;
            int lane_r = lane; asm volatile("" : "+v"(lane_r));
            f32x4 v[RT][4];
#pragma unroll
            for (int t = 0; t < RT; ++t)
#pragma unroll
                for (int j = 0; j < 4; ++j) { const u32x2 a = raw[rd][t][j]; v[t][j] = (f32x4){bf2f(a.x & 0xffff), bf2f(a.x >> 16), bf2f(a.y & 0xffff), bf2f(a.y >> 16)}; }
            float s1[RT], s2[RT];
#pragma unroll
            for (int t = 0; t < RT; ++t) { float a = 0.f;
#pragma unroll
                for (int j = 0; j < 4; ++j) a += (v[t][j].x + v[t][j].y) + (v[t][j].z + v[t][j].w);
                s1[t] = red64(a, lane_r) * (1.f / D); }
#pragma unroll
            for (int t = 0; t < RT; ++t) { float a = 0.f;
#pragma unroll
                for (int j = 0; j < 4; ++j) { v[t][j] = v[t][j] - s1[t]; a += (v[t][j].x * v[t][j].x + v[t][j].y * v[t][j].y) + (v[t][j].z * v[t][j].z + v[t][j].w * v[t][j].w); }
                s2[t] = rsqrtf(red64(a, lane_r) * (1.f / D) + LN_EPS); }
#pragma unroll
            for (int j = 0; j < 4; ++j) {
                const f32x4 gg = *(const f32x4*)(p.g + 4 * lane_r + 256 * j), bb = *(const f32x4*)(p.b + 4 * lane_r + 256 * j);
#pragma unroll
                for (int t = 0; t < RT; ++t) v[t][j] = v[t][j] * s2[t] * gg + bb;
            }
            store_rowsN(v, nullptr, p.hb, tok0, lane_r);
            if (lane_r == 0) {
#pragma unroll
                for (int t = 0; t < RT; ++t) { st[2 * (tl0 + t)] = s1[t]; st[2 * (tl0 + t) + 1] = s2[t]; } }
        }
        if (wv < 4) {
            int lane_r = lane; asm volatile("" : "+v"(lane_r));
            const int fr = lane_r & 15, fq = lane_r >> 4;
            const bf16* arow = p.pin + (size_t)(tb + 16 * wv + fr) * D + 8 * fq;
            f32x4 acc = (f32x4){0.f, 0.f, 0.f, 0.f};
#pragma unroll 8
            for (int kk = 0; kk < 32; ++kk) {
                const bf16x8 a = *(const bf16x8*)(arow + 32 * kk);
                acc = __builtin_amdgcn_mfma_f32_16x16x32_bf16(a, WF[(kk * 2 + 0) * 64 + lane_r], acc, 0, 0, 0);
                acc = __builtin_amdgcn_mfma_f32_16x16x32_bf16(a, WF[(kk * 2 + 1) * 64 + lane_r], acc, 0, 0, 0);
            }
#pragma unroll
            for (int i = 0; i < 4; ++i) lg[(16 * wv + 4 * fq + i) * 16 + fr] = acc[i];
        }
        __syncthreads();
        {
            const int tid2 = opaque_tid(wv_s);
            if (tid2 < 64) {
                const float mu = st[2 * tid2], rstd = st[2 * tid2 + 1];
                float s[16], ss[16];
#pragma unroll
                for (int e4 = 0; e4 < 4; ++e4) { const f32x4 raw = *(const f32x4*)&lg[tid2 * 16 + 4 * e4];
#pragma unroll
                    for (int q = 0; q < 4; ++q) { const int e = 4 * e4 + q; const float r = q == 0 ? raw.x : (q == 1 ? raw.y : (q == 2 ? raw.z : raw.w));
                        const float lgt = rstd * (r - mu * cs[e]) + c0[e]; s[e] = sigmoidf_(lgt); ss[e] = s[e] + p.rbias[e]; } }
                int gbest = 0; float gscore = -INFINITY; int l1b = 0, l2b = 1;
#pragma unroll
                for (int g = 0; g < 4; ++g) {
                    float v1 = ss[4 * g], v2 = -INFINITY; int i1 = 0, i2 = -1;
#pragma unroll
                    for (int i = 1; i < 4; ++i) {
                        const float x = ss[4 * g + i];
                        if (x > v1) { v2 = v1; i2 = i1; v1 = x; i1 = i; }
                        else if (x > v2) { v2 = x; i2 = i; }
                    }
                    const float sc = v1 + v2;
                    if (sc > gscore) { gscore = sc; gbest = g; l1b = i1; l2b = i2; }
                }
                const int e0 = 4 * gbest + l1b, e1 = 4 * gbest + l2b;
                float s0 = 0.f, s1v = 0.f;
#pragma unroll
                for (int e = 0; e < 16; ++e) { s0 = (e == e0) ? s[e] : s0; s1v = (e == e1) ? s[e] : s1v; }
                const float inv = 1.0f / (s0 + s1v);
                sel_e[2 * tid2] = e0; sel_e[2 * tid2 + 1] = e1; sel_g[2 * tid2] = s0 * inv; sel_g[2 * tid2 + 1] = s1v * inv;
                lrank[2 * tid2] = atomicAdd(&lcnt[e0], 1); lrank[2 * tid2 + 1] = atomicAdd(&lcnt[e1], 1);
            }
            __syncthreads();
            if (tid2 < 16) lbase[tid2] = atomicAdd(p.counts + tid2 * CNT_STRIDE, lcnt[tid2]);
            __syncthreads();
            if (tid2 < 128) {
                const int tl = tid2 >> 1, k = tid2 & 1, e = sel_e[2 * tl + k], r = lbase[e] + lrank[2 * tl + k];
                p.rtok[e * CAP + r] = tb + tl; p.rgate[e * CAP + r] = sel_g[2 * tl + k]; p.slot[2 * (tb + tl) + k] = e * CAP + r;
            }
            __syncthreads();
        }
    }
}

struct LnCombP { bf16* hb; const bf16* y; const int* slot; const int* counts; const float* g; const float* b; const float* wf; const float* bf; float* logf; float* outp; int do_f; int pad; };
__device__ __forceinline__ void ph_ln_comb(const LnCombP& p, unsigned char* lds, const int wv_s) {
    const int tid = opaque_tid(wv_s); const int lane = tid & 63, wv = tid >> 6;
    int* pstart = (int*)lds;
    f32x4* wl = (f32x4*)(lds + 2048);
    if (p.do_f) stage_w16(p.wf, NW_IN, wl, tid);
    if (tid == 0) { int acc = 0; for (int e = 0; e < NE; ++e) { pstart[e] = acc; acc += ((p.counts[e * CNT_STRIDE] + 255) >> 8) * 256; } }
    __syncthreads();
    u32x2 hr[RT][4], ya[RT][4], yb[RT][4];
#define LC_ISSUE(tk_, ln_) do { _Pragma("unroll") for (int t = 0; t < RT; ++t) { \
        const int sl0 = p.slot[2 * ((tk_) + t)], sl1 = p.slot[2 * ((tk_) + t) + 1]; \
        const int c0 = pstart[sl0 / CAP] + (sl0 % CAP), c1 = pstart[sl1 / CAP] + (sl1 % CAP); \
        _Pragma("unroll") for (int j = 0; j < 4; ++j) { hr[t][j] = *(const u32x2*)(p.hb + (size_t)((tk_) + t) * D + 4 * (ln_) + 256 * j); \
            ya[t][j] = *(const u32x2*)(p.y + (size_t)c0 * D + 4 * (ln_) + 256 * j); yb[t][j] = *(const u32x2*)(p.y + (size_t)c1 * D + 4 * (ln_) + 256 * j); } } } while (0)
    const int tok_first = (blockIdx.x * 8 + wv) * RT, tok_step = gridDim.x * 8 * RT;
    if (tok_first < M) LC_ISSUE(tok_first, lane);
#pragma unroll 1
    for (int tok0 = tok_first; tok0 < M; tok0 += tok_step) {
        int lane_r = lane; asm volatile("" : "+v"(lane_r));
        f32x4 v[RT][4];
#pragma unroll
        for (int t = 0; t < RT; ++t)
#pragma unroll
            for (int j = 0; j < 4; ++j) { const u32x2 h2 = hr[t][j], a = ya[t][j], bq = yb[t][j];
                v[t][j].x = ALPHA * bf2f(h2.x & 0xffff) + (bf2f(a.x & 0xffff) + bf2f(bq.x & 0xffff));
                v[t][j].y = ALPHA * bf2f(h2.x >> 16) + (bf2f(a.x >> 16) + bf2f(bq.x >> 16));
                v[t][j].z = ALPHA * bf2f(h2.y & 0xffff) + (bf2f(a.y & 0xffff) + bf2f(bq.y & 0xffff));
                v[t][j].w = ALPHA * bf2f(h2.y >> 16) + (bf2f(a.y >> 16) + bf2f(bq.y >> 16)); }
        if (tok0 + tok_step < M) LC_ISSUE(tok0 + tok_step, lane_r);
        ln_rowsN(v, p.g, p.b, lane_r);
        store_rowsN(v, p.outp, p.outp ? nullptr : p.hb, tok0, lane_r);
        if (p.do_f) {
            const float f = rowsN_dot16(v, wl, lane_r);
            if (lane_r < 16 * RT) p.logf[(size_t)(tok0 + (lane_r >> 4)) * 16 + (lane_r & 15)] = -softplusf_(-(f + p.bf[lane_r & 15]));
        }
    }
#undef LC_ISSUE
}

struct ScanP { const bf16* r; const bf16* k; const bf16* v; const _Float16* lw; const bf16* a; const bf16* g; bf16* yg;
               const float* kk; const float* ka; const float* rk; const float* gng; const float* gnb; };
__device__ __forceinline__ void ph_scan(const ScanP& p, unsigned char* lds, int nscan, const int wv_s) {
    typedef float (*arr64)[64];
    arr64 s_r = (arr64)lds, s_kk = (arr64)(lds + 8192), s_b = (arr64)(lds + 16384), s_w = (arr64)(lds + 24576), s_k = (arr64)(lds + 32768), s_v = (arr64)(lds + 40960), s_y = (arr64)(lds + 49152);
    float* s_bonus = (float*)(lds + 57344);
    const int tid = opaque_tid(wv_s);
    const int i = tid >> 3, jq = tid & 7;
    const int lt = tid >> 4, c4 = (tid & 15) * 4;
    for (int unit = blockIdx.x; unit < NB * H; unit += nscan) {
        const int b = unit / H, h = unit % H;
        f32x2 S[4];
#pragma unroll
        for (int j = 0; j < 4; ++j) S[j] = (f32x2){0.f, 0.f};
        const f32x4 kkp = *(const f32x4*)(p.kk + h * HD + c4), kap = *(const f32x4*)(p.ka + h * HD + c4), rkp = *(const f32x4*)(p.rk + h * HD + c4);
        const f32x4 gng = *(const f32x4*)(p.gng + h * HD + c4), gnb = *(const f32x4*)(p.gnb + h * HD + c4);
        typedef _Float16 h4 __attribute__((ext_vector_type(4)));
        size_t base = (size_t)(b * T + lt) * D + h * HD + c4;
        u32x2 r2 = *(const u32x2*)(p.r + base), k2 = *(const u32x2*)(p.k + base), v2 = *(const u32x2*)(p.v + base), a2 = *(const u32x2*)(p.a + base), g2 = *(const u32x2*)(p.g + base);
        h4 lwh = *(const h4*)(p.lw + base);
        for (int blk = 0; blk < T / 32; ++blk) {
            const size_t obase = base;
            const u32x2 g2c = g2;
            {
                const f32x4 lw4 = {(float)lwh[0], (float)lwh[1], (float)lwh[2], (float)lwh[3]};
                const f32x4 rr = {bf2f(r2.x & 0xffff), bf2f(r2.x >> 16), bf2f(r2.y & 0xffff), bf2f(r2.y >> 16)};
                const f32x4 kr = {bf2f(k2.x & 0xffff), bf2f(k2.x >> 16), bf2f(k2.y & 0xffff), bf2f(k2.y >> 16)};
                const f32x4 vv = {bf2f(v2.x & 0xffff), bf2f(v2.x >> 16), bf2f(v2.y & 0xffff), bf2f(v2.y >> 16)};
                const f32x4 aa = {bf2f(a2.x & 0xffff), bf2f(a2.x >> 16), bf2f(a2.y & 0xffff), bf2f(a2.y >> 16)};
                const f32x4 kkn = kr * kkp;
                const float ss = red16((kkn.x * kkn.x + kkn.y * kkn.y) + (kkn.z * kkn.z + kkn.w * kkn.w));
                const float inv = fminf(__builtin_amdgcn_rsqf(ss), 1e12f);
                const f32x4 kkv = kkn * inv;
                const f32x4 km = kr * (1.0f + (aa - 1.0f) * kap);
                const f32x4 bb = kkv * aa;
                f32x4 wd; wd.x = __expf(lw4.x); wd.y = __expf(lw4.y); wd.z = __expf(lw4.z); wd.w = __expf(lw4.w);
                const f32x4 bt = rr * km * rkp;
                const float bo = red16((bt.x + bt.y) + (bt.z + bt.w));
                *(f32x4*)&s_r[lt][c4] = rr; *(f32x4*)&s_kk[lt][c4] = kkv; *(f32x4*)&s_b[lt][c4] = bb; *(f32x4*)&s_w[lt][c4] = wd;
                *(f32x4*)&s_k[lt][c4] = km; *(f32x4*)&s_v[lt][c4] = vv;
                if ((tid & 15) == 0) s_bonus[lt] = bo;
            }
            __syncthreads();
            if (blk + 1 < T / 32) {
                base += (size_t)32 * D;
                r2 = *(const u32x2*)(p.r + base); k2 = *(const u32x2*)(p.k + base); v2 = *(const u32x2*)(p.v + base); a2 = *(const u32x2*)(p.a + base); g2 = *(const u32x2*)(p.g + base);
                lwh = *(const h4*)(p.lw + base);
            }
#define SC_LOAD(X, tt_) do { X##k0 = *(const f32x4*)&s_kk[tt_][8 * jq]; X##k1 = *(const f32x4*)&s_kk[tt_][8 * jq + 4]; X##w0 = *(const f32x4*)&s_w[tt_][8 * jq]; X##w1 = *(const f32x4*)&s_w[tt_][8 * jq + 4]; \
                X##b0 = *(const f32x4*)&s_b[tt_][8 * jq]; X##b1 = *(const f32x4*)&s_b[tt_][8 * jq + 4]; X##q0 = *(const f32x4*)&s_k[tt_][8 * jq]; X##q1 = *(const f32x4*)&s_k[tt_][8 * jq + 4]; \
                X##r0 = *(const f32x4*)&s_r[tt_][8 * jq]; X##r1 = *(const f32x4*)&s_r[tt_][8 * jq + 4]; X##vi = s_v[tt_][i]; } while (0)
#define SC_STEP(X, tt_) do { \
                const f32x2 d_ = S[0] * (f32x2){X##k0.x, X##k0.y} + S[1] * (f32x2){X##k0.z, X##k0.w} + S[2] * (f32x2){X##k1.x, X##k1.y} + S[3] * (f32x2){X##k1.z, X##k1.w}; \
                const float sa_ = red8(d_.x + d_.y); \
                S[0] = S[0] * (f32x2){X##w0.x, X##w0.y} - sa_ * (f32x2){X##b0.x, X##b0.y} + X##vi * (f32x2){X##q0.x, X##q0.y}; \
                S[1] = S[1] * (f32x2){X##w0.z, X##w0.w} - sa_ * (f32x2){X##b0.z, X##b0.w} + X##vi * (f32x2){X##q0.z, X##q0.w}; \
                S[2] = S[2] * (f32x2){X##w1.x, X##w1.y} - sa_ * (f32x2){X##b1.x, X##b1.y} + X##vi * (f32x2){X##q1.x, X##q1.y}; \
                S[3] = S[3] * (f32x2){X##w1.z, X##w1.w} - sa_ * (f32x2){X##b1.z, X##b1.w} + X##vi * (f32x2){X##q1.z, X##q1.w}; \
                const f32x2 e_ = S[0] * (f32x2){X##r0.x, X##r0.y} + S[1] * (f32x2){X##r0.z, X##r0.w} + S[2] * (f32x2){X##r1.x, X##r1.y} + S[3] * (f32x2){X##r1.z, X##r1.w}; \
                const float y_ = red8(e_.x + e_.y); \
                if (jq == 0) s_y[tt_][i] = y_; } while (0)
            f32x4 Ak0, Ak1, Aw0, Aw1, Ab0, Ab1, Aq0, Aq1, Ar0, Ar1, Bk0, Bk1, Bw0, Bw1, Bb0, Bb1, Bq0, Bq1, Br0, Br1; float Avi, Bvi;
            SC_LOAD(A, 0);
            for (int tt = 0; tt < 32; tt += 2) {
                SC_LOAD(B, tt + 1);
                SC_STEP(A, tt);
                { const int tn = (tt + 2) & 31; SC_LOAD(A, tn); }
                SC_STEP(B, tt + 1);
            }
#undef SC_LOAD
#undef SC_STEP
            __syncthreads();
            {
                const f32x4 y4 = *(const f32x4*)&s_y[lt][c4];
                const float mu = red16((y4.x + y4.y) + (y4.z + y4.w)) * (1.f / 64.f);
                const f32x4 dd = y4 - mu;
                const float rstd = rsqrtf(red16((dd.x * dd.x + dd.y * dd.y) + (dd.z * dd.z + dd.w * dd.w)) * (1.f / 64.f) + GN_EPS);
                const f32x4 vv = *(const f32x4*)&s_v[lt][c4];
                const float bo = s_bonus[lt];
                const f32x4 gg = {bf2f(g2c.x & 0xffff), bf2f(g2c.x >> 16), bf2f(g2c.y & 0xffff), bf2f(g2c.y >> 16)};
                const f32x4 o = (dd * rstd * gng + gnb + bo * vv) * gg;
                u32x2 ob; ob.x = pk2(o.x, o.y); ob.y = pk2(o.z, o.w);
                *(u32x2*)(p.yg + obase) = ob;
            }
            __syncthreads();
        }
    }
}

namespace sc {
constexpr int GLD = 64;
__device__ __forceinline__ int swz(int row, int col) { return row * GLD + ((((col >> 3) ^ row) & 7) << 3) + (col & 7); }
constexpr int BUFB = 64 * GLD * 2;
constexpr int B_KKD = 0, B_RD = 1, B_BINV = 2, B_KINV = 3, B_VT = 4, B_KDT = 5, B_NBDT = 6, B_SB = 7, B_M = 8, B_NQ = 9;
constexpr int B_XT = B_KKD, B_N = B_BINV, B_P = B_KINV;
constexpr int MS = 68;
constexpr int F_M = 10 * BUFB, F_R = F_M + 64 * MS * 4, PART = F_R + 64 * 65 * 4, GT = PART + 2 * 8 * 64 * 4, BON = GT + 256, SCR = BON + 256, END = SCR + 4 * 4096;
constexpr int LD16 = 24, O_XR = 0, O_XT = 768, O_TR = 1536, O_RT = 2304, O_TD = 3072;
static_assert(END <= 147392, "scan LDS");
__device__ __forceinline__ bf16* buf(unsigned char* lds, int i) { return (bf16*)(lds + i * BUFB); }
__device__ __forceinline__ bf16* xtb(unsigned char* lds) { return (bf16*)(lds + SCR); }
__device__ __forceinline__ void tile_mma(f32x4& acc, const bf16* A, int arow0, const bf16* Bt, int brow0, int fr, int fq) {
#pragma unroll
    for (int kk = 0; kk < 2; ++kk) {
        const bf16x8 a = *(const bf16x8*)&A[swz(arow0 + fr, kk * 32 + 8 * fq)];
        const bf16x8 b = *(const bf16x8*)&Bt[swz(brow0 + fr, kk * 32 + 8 * fq)];
        acc = __builtin_amdgcn_mfma_f32_16x16x32_bf16(a, b, acc, 0, 0, 0);
    }
}
__device__ __forceinline__ unsigned cvtpk(float lo, float hi);
__device__ __forceinline__ bf16 cvt1(float x);
__device__ __forceinline__ void mm16(f32x4& acc, const bf16* A, const bf16* Bt, int fr, int fq) {
    bf16x8 a = (bf16x8){0, 0, 0, 0, 0, 0, 0, 0}, b = a;
    if (fq < 2) { a = *(const bf16x8*)&A[fr * LD16 + 8 * fq]; b = *(const bf16x8*)&Bt[fr * LD16 + 8 * fq]; }
    acc = __builtin_amdgcn_mfma_f32_16x16x32_bf16(a, b, acc, 0, 0, 0);
}
__device__ __forceinline__ void wr_rm(bf16* R, const f32x4 v, int fr, int fq) {
#pragma unroll
    for (int i = 0; i < 4; ++i) R[(4 * fq + i) * LD16 + fr] = cvt1(v[i]);
}
__device__ __forceinline__ void wr_tr(bf16* Tt, const f32x4 v, int fr, int fq) { u32x2 o; o.x = cvtpk(v[0], v[1]); o.y = cvtpk(v[2], v[3]); *(u32x2*)&Tt[fr * LD16 + 4 * fq] = o; }
#define SC_LWAIT() asm volatile("s_waitcnt lgkmcnt(0)" ::: "memory")
typedef short s16x4 __attribute__((ext_vector_type(4)));
__device__ __forceinline__ s16x4 pk4(const f32x4 v) { u32x2 o; o.x = cvtpk(v[0], v[1]); o.y = cvtpk(v[2], v[3]); return __builtin_bit_cast(s16x4, o); }
__device__ __forceinline__ f32x4 mm16k(const s16x4 a, const s16x4 b, const f32x4 c) { return __builtin_amdgcn_mfma_f32_16x16x16bf16_1k(a, b, c, 0, 0, 0); }
constexpr int MP = 20, MDS = 16 * MP;
constexpr int PRM = F_M + 8192;
__device__ __forceinline__ void cvt8(const u32x4 v, float (&o)[8]) {
    o[0] = bf2f(v.x & 0xffff); o[1] = bf2f(v.x >> 16); o[2] = bf2f(v.y & 0xffff); o[3] = bf2f(v.y >> 16);
    o[4] = bf2f(v.z & 0xffff); o[5] = bf2f(v.z >> 16); o[6] = bf2f(v.w & 0xffff); o[7] = bf2f(v.w >> 16);
}
typedef __bf16 bf16x2_hw __attribute__((ext_vector_type(2)));
__device__ __forceinline__ unsigned cvtpk(float lo, float hi) { const f32x2 v = {lo, hi}; const bf16x2_hw b = __builtin_convertvector(v, bf16x2_hw); return __builtin_bit_cast(unsigned, b); }
__device__ __forceinline__ bf16 cvt1(float x) { return (bf16)(cvtpk(x, x) & 0xffffu); }
__device__ __forceinline__ u32x4 pack8(const float (&x)[8]) { u32x4 o; o.x = cvtpk(x[0], x[1]); o.y = cvtpk(x[2], x[3]); o.z = cvtpk(x[4], x[5]); o.w = cvtpk(x[6], x[7]); return o; }
}

__device__ __forceinline__ void ph_scan_chunk(const ScanP& p, unsigned char* lds, int nscan, const int wv_s) {
    using namespace sc;
    const int w = wv_s;
#define SC_LANES const int tid = opaque_tid(wv_s), lane = tid & 63, fr = lane & 15, fq = lane >> 4; (void)fr; (void)fq; (void)tid
    float* Mf = (float*)(lds + F_M); float* Rf = (float*)(lds + F_R); float* part = (float*)(lds + PART); float* gt = (float*)(lds + GT); float* bon = (float*)(lds + BON);
    typedef _Float16 h8 __attribute__((ext_vector_type(8)));
    for (int unit = blockIdx.x; unit < NB * H; unit += nscan) {
        const int b = unit / H, h = unit % H;
        __syncthreads();
        f32x4 Sreg[2];
        Sreg[0] = Sreg[1] = (f32x4){0.f, 0.f, 0.f, 0.f};
        size_t base;
        { SC_LANES; base = (size_t)(b * T + lane) * D + h * HD + 8 * w;
        for (int z = tid; z < BUFB / 4; z += 512) ((unsigned*)buf(lds, B_SB))[z] = 0u;
        }
        float* prm = (float*)(lds + PRM);
        size_t ob;
        { SC_LANES; const int n8 = (tid & 7) * 8;
          if (tid < 64) { prm[tid] = p.kk[h * HD + tid]; prm[64 + tid] = p.ka[h * HD + tid]; prm[128 + tid] = p.rk[h * HD + tid]; prm[192 + tid] = p.gng[h * HD + tid]; prm[256 + tid] = p.gnb[h * HD + tid]; }
          ob = (size_t)(b * T + (tid >> 3)) * D + h * HD + n8; }
        u32x4 vg, gg8;
        u32x4 r8 = *(const u32x4*)(p.r + base), k8 = *(const u32x4*)(p.k + base), v8 = *(const u32x4*)(p.v + base), a8 = *(const u32x4*)(p.a + base);
        h8 lw8 = *(const h8*)(p.lw + base);
        __syncthreads();
        for (int ch = 0; ch < T / 64; ++ch) {
            {   SC_LANES;
            float rr[8], kr[8], aa[8], lwf[8];
            cvt8(r8, rr); cvt8(k8, kr); cvt8(a8, aa);
#pragma unroll
            for (int q = 0; q < 8; ++q) lwf[q] = (float)lw8[q];
            float kkn[8], km[8]; float ssp = 0.f, bop = 0.f;
#pragma unroll
            for (int q = 0; q < 8; ++q) { const float kkp = prm[8 * w + q], kap = prm[64 + 8 * w + q], rkp = prm[128 + 8 * w + q];
                kkn[q] = kr[q] * kkp; ssp += kkn[q] * kkn[q]; km[q] = kr[q] * (1.0f + (aa[q] - 1.0f) * kap); bop += rr[q] * km[q] * rkp; }
            part[w * 64 + lane] = ssp; part[512 + w * 64 + lane] = bop;
            float cum[8];
#pragma unroll
            for (int q = 0; q < 8; ++q) cum[q] = lwf[q];
#define SC_DPP8(ctl) "v_add_f32_dpp %0, %0, %0 " ctl "\n\tv_add_f32_dpp %1, %1, %1 " ctl "\n\tv_add_f32_dpp %2, %2, %2 " ctl "\n\tv_add_f32_dpp %3, %3, %3 " ctl "\n\t" \
                     "v_add_f32_dpp %4, %4, %4 " ctl "\n\tv_add_f32_dpp %5, %5, %5 " ctl "\n\tv_add_f32_dpp %6, %6, %6 " ctl "\n\tv_add_f32_dpp %7, %7, %7 " ctl "\n\t"
            asm volatile("s_nop 1\n\t"
                         SC_DPP8("row_shr:1 row_mask:0xf bank_mask:0xf bound_ctrl:1") SC_DPP8("row_shr:2 row_mask:0xf bank_mask:0xf bound_ctrl:1")
                         SC_DPP8("row_shr:4 row_mask:0xf bank_mask:0xf bound_ctrl:1") SC_DPP8("row_shr:8 row_mask:0xf bank_mask:0xf bound_ctrl:1")
                         SC_DPP8("row_bcast:15 row_mask:0xa bank_mask:0xf") SC_DPP8("row_bcast:31 row_mask:0xc bank_mask:0xf")
                         : "+v"(cum[0]), "+v"(cum[1]), "+v"(cum[2]), "+v"(cum[3]), "+v"(cum[4]), "+v"(cum[5]), "+v"(cum[6]), "+v"(cum[7]));
#undef SC_DPP8
            __syncthreads();
            float ss = 0.f, bo = 0.f;
#pragma unroll
            for (int q = 0; q < 8; ++q) { ss += part[q * 64 + lane]; bo += part[512 + q * 64 + lane]; }
            const float inv = fminf(__builtin_amdgcn_rsqf(ss), 1e12f);
            {
                float o_kkd[8], o_rd[8], o_binv[8], o_kinv[8];
                bf16* bVT = buf(lds, B_VT); bf16* bKDT = buf(lds, B_KDT); bf16* bNBDT = buf(lds, B_NBDT);
#pragma unroll
                for (int q = 0; q < 8; ++q) {
                    const float kkv = kkn[q] * inv, bb = kkv * aa[q];
                    const float e_c = __builtin_amdgcn_exp2f(cum[q]), e_n = __builtin_amdgcn_exp2f(-cum[q]);
                    const float e_tot = __int_as_float(__builtin_amdgcn_readlane(__float_as_int(e_c), 63));
                    const float e_x = __int_as_float(__builtin_amdgcn_update_dpp(0x3f800000, __float_as_int(e_c), 0x138, 0xF, 0xF, false));
                    const float e_t = e_tot * e_n;
                    o_kkd[q] = kkv * e_x; o_rd[q] = rr[q] * e_c; o_binv[q] = bb * e_n; o_kinv[q] = km[q] * e_n;
                    bVT[swz(8 * w + q, lane)] = (bf16)((q & 1) ? (v8[q >> 1] >> 16) : (v8[q >> 1] & 0xffffu));
                    const unsigned kb = cvtpk(km[q] * e_t, -bb * e_t);
                    bKDT[swz(8 * w + q, lane)] = (bf16)(kb & 0xffffu);
                    bNBDT[swz(8 * w + q, lane)] = (bf16)(kb >> 16);
                    if (lane == 0) gt[8 * w + q] = e_tot;
                }
                *(u32x4*)&buf(lds, B_KKD)[swz(lane, 8 * w)] = pack8(o_kkd); *(u32x4*)&buf(lds, B_RD)[swz(lane, 8 * w)] = pack8(o_rd);
                *(u32x4*)&buf(lds, B_BINV)[swz(lane, 8 * w)] = pack8(o_binv); *(u32x4*)&buf(lds, B_KINV)[swz(lane, 8 * w)] = pack8(o_kinv);
                if (w == 0) bon[lane] = bo;
            }
            }
            __syncthreads();
            {   SC_LANES;
                const int m = w >> 1;
                const bf16* A = buf(lds, (m & 1) ? B_KINV : B_BINV); const bf16* Bt = buf(lds, m < 2 ? B_KKD : B_RD);
                f32x4 acc[8];
#pragma unroll
                for (int q = 0; q < 8; ++q) { const int tt = (w & 1) * 2 + (q >> 2), st = q & 3; acc[q] = (f32x4){0.f, 0.f, 0.f, 0.f}; tile_mma(acc[q], A, 16 * st, Bt, 16 * tt, fr, fq); }
                __syncthreads();
                {
                    const float sgn = (m == 2) ? -1.f : 1.f;
                    bf16* dst = buf(lds, m == 0 ? B_M : (m == 1 ? B_N : (m == 2 ? B_NQ : B_P)));
#pragma unroll
                    for (int q = 0; q < 8; ++q) { const int tt = (w & 1) * 2 + (q >> 2), st = q & 3; const int t = 16 * tt + fr, s0 = 16 * st + 4 * fq;
                        f32x4 val;
#pragma unroll
                        for (int i = 0; i < 4; ++i) { const int s = s0 + i; const float keep = (m < 2) ? ((s < t) ? 1.f : 0.f) : ((s <= t) ? sgn : 0.f); val[i] = acc[q][i] * keep; }
                        if (m == 0) { if (st == tt) *(f32x4*)&Mf[tt * MDS + fr * MP + 4 * fq] = val; val = -val; }
                        u32x2 o; o.x = cvtpk(val[0], val[1]); o.y = cvtpk(val[2], val[3]);
                        *(u32x2*)&dst[swz(t, s0)] = o; }
                }
            }
            __syncthreads();
            vg = *(const u32x4*)(p.v + ob); gg8 = *(const u32x4*)(p.g + ob);
            if (ch + 1 < T / 64) { base += (size_t)64 * D; r8 = *(const u32x4*)(p.r + base); k8 = *(const u32x4*)(p.k + base); v8 = *(const u32x4*)(p.v + base); a8 = *(const u32x4*)(p.a + base); lw8 = *(const h8*)(p.lw + base); }
#define SC_LD2(dst, img, row0) { dst[0] = *(const bf16x8*)&(img)[swz((row0) + fr, 8 * fq)]; dst[1] = *(const bf16x8*)&(img)[swz((row0) + fr, 32 + 8 * fq)]; }
#define SC_MM(acc, a, b) acc = __builtin_amdgcn_mfma_f32_16x16x32_bf16(a, b, acc, 0, 0, 0)
            f32x4 yacc[4];
            {   SC_LANES;
                const f32x4 z4 = (f32x4){0.f, 0.f, 0.f, 0.f};
                if (w < 4) {
                    bf16x8 bS[2], bV[2], aK[4][2], aN[4][2];
                    SC_LD2(bS, buf(lds, B_SB), 16 * w); SC_LD2(bV, buf(lds, B_VT), 16 * w);
#pragma unroll
                    for (int mt = 0; mt < 4; ++mt) { SC_LD2(aK[mt], buf(lds, B_KKD), 16 * mt); SC_LD2(aN[mt], buf(lds, B_N), 16 * mt); }
                    f32x4 cX[4], cXt[4], cTt[4];
#pragma unroll
                    for (int d = 0; d < 4; ++d) { const float* Md = Mf + d * MDS; cXt[d] = *(const f32x4*)&Md[fr * MP + 4 * fq];
#pragma unroll
                        for (int i = 0; i < 4; ++i) cX[d][i] = Md[(4 * fq + i) * MP + fr]; }
                    s16x4 nM[6];
#pragma unroll
                    for (int e = 0; e < 6; ++e) { const int bc = e < 3 ? 0 : (e < 5 ? 1 : 2), br = e < 3 ? e + 1 : (e < 5 ? e - 1 : 3);
                        nM[e] = *(const s16x4*)&buf(lds, B_M)[swz(16 * br + fr, 16 * bc + 4 * fq)]; }
                    SC_LWAIT();
                    f32x4 racc[4];
#pragma unroll
                    for (int mt = 0; mt < 4; ++mt) { racc[mt] = z4; SC_MM(racc[mt], aK[mt][0], bS[0]); }
#pragma unroll
                    for (int mt = 0; mt < 4; ++mt) SC_MM(racc[mt], aK[mt][1], bS[1]);
#pragma unroll
                    for (int mt = 0; mt < 4; ++mt) SC_MM(racc[mt], aN[mt][0], bV[0]);
#pragma unroll
                    for (int mt = 0; mt < 4; ++mt) SC_MM(racc[mt], aN[mt][1], bV[1]);
                    s16x4 pA[4], pAt[4], TT[4];
                    f32x4 XA[4], XB[4];
#pragma unroll
                    for (int d = 0; d < 4; ++d) { pA[d] = pk4(cX[d]); pAt[d] = pk4(cXt[d]);
#pragma unroll
                        for (int i = 0; i < 4; ++i) cTt[d][i] = ((4 * fq + i) == fr ? 1.f : 0.f) - cXt[d][i]; }
#pragma unroll
                    for (int st = 0; st < 3; ++st) {
#pragma unroll
                        for (int d = 0; d < 4; ++d) XA[d] = mm16k(pAt[d], pA[d], z4);
                        if (st < 2) {
#pragma unroll
                            for (int d = 0; d < 4; ++d) XB[d] = mm16k(pA[d], pAt[d], z4);
                        }
#pragma unroll
                        for (int d = 0; d < 4; ++d) TT[d] = pk4(cTt[d]);
#pragma unroll
                        for (int d = 0; d < 4; ++d) pA[d] = pk4(XA[d]);
#pragma unroll
                        for (int d = 0; d < 4; ++d) cTt[d] = mm16k(pA[d], TT[d], cTt[d]);
                        if (st < 2) {
#pragma unroll
                            for (int d = 0; d < 4; ++d) pAt[d] = pk4(XB[d]);
                        }
                    }
#pragma unroll
                    for (int d = 0; d < 4; ++d) TT[d] = pk4(cTt[d]);
#pragma unroll
                    for (int blk = 0; blk < 4; ++blk) {
                        const f32x4 xx = mm16k(TT[blk], pk4(racc[blk]), z4);
                        const s16x4 pxx = pk4(xx);
                        *(s16x4*)&xtb(lds)[swz(16 * w + fr, 16 * blk + 4 * fq)] = pxx;
#pragma unroll
                        for (int br = blk + 1; br < 4; ++br) { const int e = blk == 0 ? br - 1 : (blk == 1 ? br + 1 : 5); racc[br] = mm16k(nM[e], pxx, racc[br]); }
                    }
                } else {
                    const int mt = w - 4;
                    bf16x8 aR[2], aP[2], bS[4][2], bV[4][2];
                    SC_LD2(aR, buf(lds, B_RD), 16 * mt); SC_LD2(aP, buf(lds, B_P), 16 * mt);
#pragma unroll
                    for (int nt = 0; nt < 4; ++nt) { SC_LD2(bS[nt], buf(lds, B_SB), 16 * nt); SC_LD2(bV[nt], buf(lds, B_VT), 16 * nt); }
                    asm volatile("s_waitcnt lgkmcnt(0)" : "+v"(aR[0]), "+v"(aR[1]), "+v"(aP[0]), "+v"(aP[1]), "+v"(bS[0][0]), "+v"(bS[0][1]), "+v"(bS[1][0]), "+v"(bS[1][1]), "+v"(bS[2][0]), "+v"(bS[2][1]),
                                 "+v"(bS[3][0]), "+v"(bS[3][1]), "+v"(bV[0][0]), "+v"(bV[0][1]), "+v"(bV[1][0]), "+v"(bV[1][1]), "+v"(bV[2][0]), "+v"(bV[2][1]), "+v"(bV[3][0]), "+v"(bV[3][1]) :: "memory");
#pragma unroll
                    for (int nt = 0; nt < 4; ++nt) { yacc[nt] = z4; SC_MM(yacc[nt], aR[0], bS[nt][0]); }
#pragma unroll
                    for (int nt = 0; nt < 4; ++nt) SC_MM(yacc[nt], aR[1], bS[nt][1]);
#pragma unroll
                    for (int nt = 0; nt < 4; ++nt) SC_MM(yacc[nt], aP[0], bV[nt][0]);
#pragma unroll
                    for (int nt = 0; nt < 4; ++nt) SC_MM(yacc[nt], aP[1], bV[nt][1]);
                }
            }
            __syncthreads();
            {   SC_LANES;
                const int mt6 = w >> 1, nt6 = 2 * (w & 1);
                bf16x8 aV[2], aX[2], bK[2][2], bB[2][2], aQ[2], bX[4][2];
                SC_LD2(aV, buf(lds, B_VT), 16 * mt6); SC_LD2(aX, xtb(lds), 16 * mt6);
#pragma unroll
                for (int q = 0; q < 2; ++q) { SC_LD2(bK[q], buf(lds, B_KDT), 16 * (nt6 + q)); SC_LD2(bB[q], buf(lds, B_NBDT), 16 * (nt6 + q)); }
                const float g0 = gt[16 * nt6 + fr], g1 = gt[16 * nt6 + 16 + fr];
                if (w >= 4) {
                    SC_LD2(aQ, buf(lds, B_NQ), 16 * (w - 4));
#pragma unroll
                    for (int nt = 0; nt < 4; ++nt) SC_LD2(bX[nt], xtb(lds), 16 * nt);
                }
                SC_LWAIT();
                if (w >= 4) {
#pragma unroll
                    for (int nt = 0; nt < 4; ++nt) SC_MM(yacc[nt], aQ[0], bX[nt][0]);
#pragma unroll
                    for (int nt = 0; nt < 4; ++nt) SC_MM(yacc[nt], aQ[1], bX[nt][1]);
                }
                f32x4 s0 = Sreg[0] * g0, s1 = Sreg[1] * g1;
                SC_MM(s0, aV[0], bK[0][0]); SC_MM(s1, aV[0], bK[1][0]); SC_MM(s0, aV[1], bK[0][1]); SC_MM(s1, aV[1], bK[1][1]);
                SC_MM(s0, aX[0], bB[0][0]); SC_MM(s1, aX[0], bB[1][0]); SC_MM(s0, aX[1], bB[0][1]); SC_MM(s1, aX[1], bB[1][1]);
                Sreg[0] = s0; Sreg[1] = s1;
                if (w >= 4) {
#pragma unroll
                    for (int nt = 0; nt < 4; ++nt) {
#pragma unroll
                        for (int i = 0; i < 4; ++i) Rf[(16 * (w - 4) + 4 * fq + i) * 65 + 16 * nt + fr] = yacc[nt][i]; }
                }
#pragma unroll
                for (int i = 0; i < 4; ++i) { buf(lds, B_SB)[swz(16 * mt6 + 4 * fq + i, 16 * nt6 + fr)] = cvt1(s0[i]); buf(lds, B_SB)[swz(16 * mt6 + 4 * fq + i, 16 * nt6 + 16 + fr)] = cvt1(s1[i]); }
            }
            __syncthreads();
#undef SC_LD2
#undef SC_MM
            {   SC_LANES;
                const int t = tid >> 3, n8 = (tid & 7) * 8;
                float y[8], vf[8], gf[8]; cvt8(vg, vf); cvt8(gg8, gf);
                float sm = 0.f;
#pragma unroll
                for (int q = 0; q < 8; ++q) { y[q] = Rf[t * 65 + n8 + q]; sm += y[q]; }
                const float mu = red8(sm) * (1.f / 64.f);
                float vs = 0.f;
#pragma unroll
                for (int q = 0; q < 8; ++q) { y[q] -= mu; vs += y[q] * y[q]; }
                const float rstd = rsqrtf(red8(vs) * (1.f / 64.f) + GN_EPS);
                const float bo2 = bon[t];
                float o[8];
#pragma unroll
                for (int q = 0; q < 8; ++q) o[q] = (y[q] * rstd * prm[192 + n8 + q] + prm[256 + n8 + q] + bo2 * vf[q]) * gf[q];
                *(u32x4*)(p.yg + ob) = pack8(o);
                ob += (size_t)64 * D;
            }
        }
    }
#undef SC_LANES
}
namespace sc2 {
using namespace sc;
constexpr int IMG = 8192;
constexpr int O_KKD = 0, O_RD = 1, O_N = 2, O_P = 3, O_VT = 4, O_KDT = 5, O_NBDT = 6, O_NQ = 7;
constexpr int O_MC = 8 * IMG, O_TT = O_MC + 3072, O_GT = O_TT + 2048, O_BON = O_GT + 256, SETB = O_BON + 256;
constexpr int RFP = 68;
constexpr int RF = 2 * SETB, PARTO = RF + 64 * RFP * 4, PRMO = PARTO + 2048, END2 = PRMO + 1280;
constexpr int SYNCO = END2;
static_assert(SYNCO + 64 <= 163776, "scan LDS");
__device__ __forceinline__ bf16* img(unsigned char* lds, int setb, int i) { return (bf16*)(lds + setb + i * IMG); }
__device__ __forceinline__ bf16x8 ld128(const bf16* im, int row, int col) { return *(const bf16x8*)&im[swz(row, col)]; }
__device__ __forceinline__ s16x4 ld64(const bf16* im, int row, int col) { return *(const s16x4*)&im[swz(row, col)]; }
__device__ __forceinline__ f32x4 mm32(const bf16x8 a, const bf16x8 b, const f32x4 c) { return __builtin_amdgcn_mfma_f32_16x16x32_bf16(a, b, c, 0, 0, 0); }
__device__ __forceinline__ void grp_sync(LAS unsigned* cnt, unsigned target, int lane) {
    asm volatile("s_waitcnt lgkmcnt(0)" ::: "memory");
    if (lane == 0) (void)__hip_atomic_fetch_add(cnt, 1u, __ATOMIC_RELAXED, __HIP_MEMORY_SCOPE_WORKGROUP);
    while ((unsigned)__builtin_amdgcn_readfirstlane((int)__hip_atomic_load(cnt, __ATOMIC_RELAXED, __HIP_MEMORY_SCOPE_WORKGROUP)) < target) __builtin_amdgcn_s_sleep(1);
    asm volatile("" ::: "memory");
}
}

__device__ __forceinline__ void pc_out(const ScanP& p, const float* Rf, const float* prm, const float bo2, const u32x4 (&vg)[2], const u32x4 (&gg)[2], size_t ob, int w, int lane) {
    using namespace sc2;
    const int tc = w * 64 + lane, t = tc >> 2, qd = tc & 3;
    float y[2][8], vf[2][8], gf[2][8]; cvt8(vg[0], vf[0]); cvt8(vg[1], vf[1]); cvt8(gg[0], gf[0]); cvt8(gg[1], gf[1]);
    float sm = 0.f;
#pragma unroll
    for (int j = 0; j < 4; ++j) { const f32x4 yy = *(const f32x4*)&Rf[t * RFP + 16 * qd + 4 * j]; y[j >> 1][4 * (j & 1)] = yy[0]; y[j >> 1][4 * (j & 1) + 1] = yy[1]; y[j >> 1][4 * (j & 1) + 2] = yy[2]; y[j >> 1][4 * (j & 1) + 3] = yy[3];
        sm += (yy[0] + yy[1]) + (yy[2] + yy[3]); }
    sm += dppx<0xB1>(sm); sm += dppx<0x4E>(sm);
    const float mu = sm * (1.f / 64.f);
    float vs = 0.f;
#pragma unroll
    for (int q = 0; q < 16; ++q) { y[q >> 3][q & 7] -= mu; vs += y[q >> 3][q & 7] * y[q >> 3][q & 7]; }
    vs += dppx<0xB1>(vs); vs += dppx<0x4E>(vs);
    const float rstd = rsqrtf(vs * (1.f / 64.f) + GN_EPS);
    float o[2][8];
#pragma unroll
    for (int q = 0; q < 16; ++q) o[q >> 3][q & 7] = (y[q >> 3][q & 7] * rstd * prm[192 + 16 * qd + q] + prm[256 + 16 * qd + q] + bo2 * vf[q >> 3][q & 7]) * gf[q >> 3][q & 7];
    *(u32x4*)(p.yg + ob) = pack8(o[0]); *(u32x4*)(p.yg + ob + 512) = pack8(o[1]);
}

__device__ __forceinline__ void ph_scan_pc(const ScanP& p, unsigned char* lds, int nscan, const int wv_s) {
    using namespace sc2;
    const int w = wv_s;
#define SC_LANES const int tid = opaque_tid(wv_s), lane = tid & 63, fr = lane & 15, fq = lane >> 4; (void)fr; (void)fq; (void)tid
    typedef _Float16 h8 __attribute__((ext_vector_type(8)));
    float* Rf = (float*)(lds + RF); float* part = (float*)(lds + PARTO); float* prm = (float*)(lds + PRMO);
    const f32x4 z4 = (f32x4){0.f, 0.f, 0.f, 0.f};
    for (int unit = blockIdx.x; unit < NB * H; unit += nscan) {
        const int b = unit / H, h = unit % H;
        __syncthreads();
        { SC_LANES; if (tid == 0) { ((LAS unsigned*)(lds + SYNCO))[0] = 0u; ((LAS unsigned*)(lds + SYNCO))[1] = 0u; }
          if (tid < 64) { prm[tid] = p.kk[h * HD + tid]; prm[64 + tid] = p.ka[h * HD + tid]; prm[128 + tid] = p.rk[h * HD + tid]; prm[192 + tid] = p.gng[h * HD + tid]; prm[256 + tid] = p.gnb[h * HD + tid]; } }
        f32x4 ST[4]; ST[0] = ST[1] = ST[2] = ST[3] = z4;
        s16x4 pxx[4];
        u32x4 vg[2], gg[2];
        float bo_out = 0.f;
        u32x4 r8[2], k8[2], v8[2], a8[2]; h8 lw8[2];
        size_t pbase = 0, sbase = 0, ob = 0, vb = 0, yb = 0;
        { SC_LANES;
          if (w >= 4) { pbase = (size_t)(b * T + lane) * D + h * HD + 16 * (w - 4);
              sbase = pg8::scan_idx(b * T + lane, h * HD + 16 * (w - 4));
#pragma unroll
              for (int o = 0; o < 2; ++o) { r8[o] = *(const u32x4*)(p.r + sbase + 512 * o); k8[o] = *(const u32x4*)(p.k + sbase + 512 * o); v8[o] = *(const u32x4*)(p.v + sbase + 512 * o);
                  a8[o] = *(const u32x4*)(p.a + sbase + 512 * o); lw8[o] = *(const h8*)(p.lw + sbase + 512 * o); } }
          else { ob = (size_t)(b * T + ((w * 64 + lane) >> 2)) * D + h * HD + 16 * (lane & 3); vb = pg8::scan_idx(b * T + ((w * 64 + lane) >> 2), h * HD + 16 * (lane & 3)); yb = vb; } }
        __syncthreads();
        for (int ch = -1; ch < T / 64; ++ch) {
            if (w >= 4) {
                if (ch + 1 < T / 64) {
                    const int pw = w - 4, setb = ((ch + 1) & 1) * SETB;
                    float rr[2][8], aa[2][8], kkn[2][8], km[2][8], cum[2][8];
                    {   SC_LANES;
                        float ssp = 0.f, bop = 0.f;
#pragma unroll
                        for (int o = 0; o < 2; ++o) {
                            float kr[8]; cvt8(r8[o], rr[o]); cvt8(k8[o], kr); cvt8(a8[o], aa[o]);
#pragma unroll
                            for (int q = 0; q < 8; ++q) { const int c = 16 * pw + 8 * o + q; const float kkp = prm[c], kap = prm[64 + c], rkp = prm[128 + c];
                                kkn[o][q] = kr[q] * kkp; ssp += kkn[o][q] * kkn[o][q]; km[o][q] = kr[q] * (1.0f + (aa[o][q] - 1.0f) * kap); bop += rr[o][q] * km[o][q] * rkp; cum[o][q] = (float)lw8[o][q]; }
                        }
                        part[pw * 64 + lane] = ssp; part[256 + pw * 64 + lane] = bop;
                        if (ch + 2 < T / 64) { pbase += (size_t)64 * D; sbase += 4096;
#pragma unroll
                            for (int o = 0; o < 2; ++o) { r8[o] = *(const u32x4*)(p.r + sbase + 512 * o); k8[o] = *(const u32x4*)(p.k + sbase + 512 * o);
                                a8[o] = *(const u32x4*)(p.a + sbase + 512 * o); lw8[o] = *(const h8*)(p.lw + sbase + 512 * o); } }
#define SC_DPP8(ctl) "v_add_f32_dpp %0, %0, %0 " ctl "\n\tv_add_f32_dpp %1, %1, %1 " ctl "\n\tv_add_f32_dpp %2, %2, %2 " ctl "\n\tv_add_f32_dpp %3, %3, %3 " ctl "\n\t" \
                     "v_add_f32_dpp %4, %4, %4 " ctl "\n\tv_add_f32_dpp %5, %5, %5 " ctl "\n\tv_add_f32_dpp %6, %6, %6 " ctl "\n\tv_add_f32_dpp %7, %7, %7 " ctl "\n\t"
#pragma unroll
                        for (int o = 0; o < 2; ++o)
                            asm volatile("s_nop 1\n\t"
                                         SC_DPP8("row_shr:1 row_mask:0xf bank_mask:0xf bound_ctrl:1") SC_DPP8("row_shr:2 row_mask:0xf bank_mask:0xf bound_ctrl:1")
                                         SC_DPP8("row_shr:4 row_mask:0xf bank_mask:0xf bound_ctrl:1") SC_DPP8("row_shr:8 row_mask:0xf bank_mask:0xf bound_ctrl:1")
                                         SC_DPP8("row_bcast:15 row_mask:0xa bank_mask:0xf") SC_DPP8("row_bcast:31 row_mask:0xc bank_mask:0xf")
                                         : "+v"(cum[o][0]), "+v"(cum[o][1]), "+v"(cum[o][2]), "+v"(cum[o][3]), "+v"(cum[o][4]), "+v"(cum[o][5]), "+v"(cum[o][6]), "+v"(cum[o][7]));
#undef SC_DPP8
                    }
                    { SC_LANES; grp_sync((LAS unsigned*)(lds + SYNCO), 4u * (3u * (unsigned)(ch + 1) + 1u), lane); }
                    {   SC_LANES;
                        float ss = 0.f, bo = 0.f;
#pragma unroll
                        for (int q = 0; q < 4; ++q) { ss += part[q * 64 + lane]; bo += part[256 + q * 64 + lane]; }
                        const float inv = fminf(__builtin_amdgcn_rsqf(ss), 1e12f);
                        bf16* bVT = img(lds, setb, O_VT); bf16* bKDT = img(lds, setb, O_KDT); bf16* bNBDT = img(lds, setb, O_NBDT);
                        float* gt = (float*)(lds + setb + O_GT); float* bon = (float*)(lds + setb + O_BON);
#pragma unroll
                        for (int o = 0; o < 2; ++o) {
                            const int cb = 16 * pw + 8 * o;
                            float o_kkd[8], o_rd[8], o_binv[8], o_kinv[8];
#pragma unroll
                            for (int q = 0; q < 8; ++q) {
                                const float kkv = kkn[o][q] * inv, bb = kkv * aa[o][q];
                                const float e_c = __builtin_amdgcn_exp2f(cum[o][q]), e_n = __builtin_amdgcn_exp2f(-cum[o][q]);
                                const float e_tot = __int_as_float(__builtin_amdgcn_readlane(__float_as_int(e_c), 63));
                                const float e_x = __int_as_float(__builtin_amdgcn_update_dpp(0x3f800000, __float_as_int(e_c), 0x138, 0xF, 0xF, false));
                                const float e_t = e_tot * e_n;
                                o_kkd[q] = kkv * e_x; o_rd[q] = rr[o][q] * e_c; o_binv[q] = bb * e_n; o_kinv[q] = km[o][q] * e_n;
                                bVT[swz(cb + q, lane)] = (bf16)((q & 1) ? (v8[o][q >> 1] >> 16) : (v8[o][q >> 1] & 0xffffu));
                                const unsigned kb2 = cvtpk(km[o][q] * e_t, -bb * e_t);
                                bKDT[swz(cb + q, lane)] = (bf16)(kb2 & 0xffffu);
                                bNBDT[swz(cb + q, lane)] = (bf16)(kb2 >> 16);
                                if (lane == 0) gt[cb + q] = e_tot;
                            }
                            *(u32x4*)&img(lds, setb, O_KKD)[swz(lane, cb)] = pack8(o_kkd); *(u32x4*)&img(lds, setb, O_RD)[swz(lane, cb)] = pack8(o_rd);
                            *(u32x4*)&img(lds, setb, O_N)[swz(lane, cb)] = pack8(o_binv); *(u32x4*)&img(lds, setb, O_P)[swz(lane, cb)] = pack8(o_kinv);
                        }
                        if (pw == 0) bon[lane] = bo;
                        if (ch + 2 < T / 64) { v8[0] = *(const u32x4*)(p.v + sbase); v8[1] = *(const u32x4*)(p.v + sbase + 512); }
                    }
                    { SC_LANES; grp_sync((LAS unsigned*)(lds + SYNCO), 4u * (3u * (unsigned)(ch + 1) + 2u), lane); }
                    f32x4 acc[10], cX, cXt;
                    {   SC_LANES;
                        const bf16* A = img(lds, setb, (pw & 1) ? O_P : O_N); const bf16* Bt = img(lds, setb, pw < 2 ? O_KKD : O_RD);
                        bf16x8 fa[4][2], fb[4][2], dB[2], dK[2];
#pragma unroll
                        for (int x = 0; x < 4; ++x) {
#pragma unroll
                            for (int kk = 0; kk < 2; ++kk) { fa[x][kk] = ld128(A, 16 * x + fr, 32 * kk + 8 * fq); fb[x][kk] = ld128(Bt, 16 * x + fr, 32 * kk + 8 * fq); } }
#pragma unroll
                        for (int kk = 0; kk < 2; ++kk) { dB[kk] = ld128(img(lds, setb, O_N), 16 * pw + fr, 32 * kk + 8 * fq); dK[kk] = ld128(img(lds, setb, O_KKD), 16 * pw + fr, 32 * kk + 8 * fq); }
                        int idx = 0;
#pragma unroll
                        for (int tt = 0; tt < 4; ++tt) {
#pragma unroll
                            for (int st = 0; st <= tt; ++st) { acc[idx] = mm32(fa[st][0], fb[tt][0], z4); acc[idx] = mm32(fa[st][1], fb[tt][1], acc[idx]); ++idx; } }
                        cXt = mm32(dB[0], dK[0], z4); cXt = mm32(dB[1], dK[1], cXt);
                        cX = mm32(dK[0], dB[0], z4); cX = mm32(dK[1], dB[1], cX);
                    }
                    { SC_LANES; grp_sync((LAS unsigned*)(lds + SYNCO), 4u * (3u * (unsigned)(ch + 1) + 3u), lane); }
                    {   SC_LANES;
                        f32x4 mk; const bool strict = pw < 2;
#pragma unroll
                        for (int i = 0; i < 4; ++i) { const int d = 4 * fq + i - fr; mk[i] = (strict ? (d < 0) : (d <= 0)) ? 1.f : 0.f; }
                        const unsigned sx = (pw == 0 || pw == 2) ? 0x80008000u : 0u;
                        if (pw == 0) {
#pragma unroll
                            for (int e = 0; e < 6; ++e) { const int ix = e == 0 ? 1 : (e == 1 ? 3 : (e == 2 ? 6 : (e == 3 ? 4 : (e == 4 ? 7 : 8))));
                                u32x2 o; o.x = cvtpk(acc[ix][0], acc[ix][1]) ^ sx; o.y = cvtpk(acc[ix][2], acc[ix][3]) ^ sx;
                                *(u32x2*)(lds + setb + O_MC + (e * 64 + lane) * 8) = o; }
                        } else {
                            bf16* dst = img(lds, setb, pw == 1 ? O_N : (pw == 2 ? O_NQ : O_P));
                            int idx = 0;
#pragma unroll
                            for (int tt = 0; tt < 4; ++tt) {
#pragma unroll
                                for (int st = 0; st < 4; ++st) {
                                    u32x2 o = (u32x2){0u, 0u};
                                    if (st <= tt) {
                                        f32x4 val = acc[idx]; ++idx;
                                        if (st == tt) val = val * mk;
                                        o.x = cvtpk(val[0], val[1]) ^ sx; o.y = cvtpk(val[2], val[3]) ^ sx;
                                    }
                                    *(u32x2*)&dst[swz(16 * tt + fr, 16 * st + 4 * fq)] = o;
                                } }
                        }
                        f32x4 cTt;
#pragma unroll
                        for (int i = 0; i < 4; ++i) { const int d = 4 * fq + i - fr; cXt[i] = d < 0 ? cXt[i] : 0.f; cX[i] = d > 0 ? cX[i] : 0.f; cTt[i] = (d == 0 ? 1.f : 0.f) - cXt[i]; }
                        s16x4 pA = pk4(cX), pAt = pk4(cXt);
#pragma unroll
                        for (int st = 0; st < 3; ++st) {
                            const f32x4 XA = mm16k(pAt, pA, z4);
                            f32x4 XB = z4; if (st < 2) XB = mm16k(pA, pAt, z4);
                            const s16x4 pT = pk4(cTt);
                            pA = pk4(XA);
                            cTt = mm16k(pA, pT, cTt);
                            if (st < 2) pAt = pk4(XB);
                        }
                        *(s16x4*)(lds + setb + O_TT + (pw * 64 + lane) * 8) = pk4(cTt);
                    }
                    __syncthreads();
                } else { __syncthreads(); }
            } else {
                if (ch >= 0) {
                    const int setb = (ch & 1) * SETB;
                    {   SC_LANES;
                        if (ch > 0) {
                            pc_out(p, Rf, prm, bo_out, vg, gg, yb, w, lane);
                            ob += (size_t)64 * D; yb += 4096;
                            grp_sync((LAS unsigned*)(lds + SYNCO) + 1, 4u * (unsigned)ch, lane);
                        }
                        vg[0] = *(const u32x4*)(p.v + vb); vg[1] = *(const u32x4*)(p.v + vb + 512); gg[0] = *(const u32x4*)(p.g + ob); gg[1] = *(const u32x4*)(p.g + ob + 8);
                        vb += 4096;
                        bo_out = ((const float*)(lds + setb + O_BON))[(w * 64 + lane) >> 2];
                    }
                    s16x4 pST[4]; bf16x8 bV[2];
                    {   SC_LANES;
#pragma unroll
                        for (int kb = 0; kb < 4; ++kb) pST[kb] = pk4(ST[kb]);
                        const bf16* iK = img(lds, setb, O_KKD); const bf16* iN = img(lds, setb, O_N);
                        bV[0] = ld128(img(lds, setb, O_VT), 16 * w + fr, 8 * fq); bV[1] = ld128(img(lds, setb, O_VT), 16 * w + fr, 32 + 8 * fq);
                        s16x4 aK[4][4]; bf16x8 aN[6]; s16x4 TT[4], nM[6];
#pragma unroll
                        for (int mt = 0; mt < 4; ++mt) {
#pragma unroll
                            for (int kb = 0; kb < 4; ++kb) aK[mt][kb] = ld64(iK, 16 * mt + fr, 16 * kb + 4 * fq); }
                        aN[0] = ld128(iN, fr, 8 * fq); aN[1] = ld128(iN, 16 + fr, 8 * fq); aN[2] = ld128(iN, 32 + fr, 8 * fq); aN[3] = ld128(iN, 32 + fr, 32 + 8 * fq); aN[4] = ld128(iN, 48 + fr, 8 * fq); aN[5] = ld128(iN, 48 + fr, 32 + 8 * fq);
#pragma unroll
                        for (int d = 0; d < 4; ++d) TT[d] = *(const s16x4*)(lds + setb + O_TT + (d * 64 + lane) * 8);
#pragma unroll
                        for (int e = 0; e < 6; ++e) nM[e] = *(const s16x4*)(lds + setb + O_MC + (e * 64 + lane) * 8);
                        f32x4 racc[4];
#pragma unroll
                        for (int mt = 0; mt < 4; ++mt) { racc[mt] = z4;
#pragma unroll
                            for (int kb = 0; kb < 4; ++kb) racc[mt] = mm16k(aK[mt][kb], pST[kb], racc[mt]); }
                        {
                            f32x4 r2[4];
                            r2[0] = mm32(aN[0], bV[0], z4); r2[1] = mm32(aN[1], bV[0], z4);
                            r2[2] = mm32(aN[2], bV[0], z4); r2[2] = mm32(aN[3], bV[1], r2[2]); r2[3] = mm32(aN[4], bV[0], z4); r2[3] = mm32(aN[5], bV[1], r2[3]);
#pragma unroll
                            for (int mt = 0; mt < 4; ++mt) racc[mt] = racc[mt] + r2[mt];
                        }
#pragma unroll
                        for (int blk = 0; blk < 4; ++blk) {
                            const f32x4 xx = mm16k(TT[blk], pk4(racc[blk]), z4);
                            pxx[blk] = pk4(xx);
#pragma unroll
                            for (int br = blk + 1; br < 4; ++br) { const int e = blk == 0 ? br - 1 : (blk == 1 ? br + 1 : 5); racc[br] = mm16k(nM[e], pxx[blk], racc[br]); }
                        }
                    }
                    {   SC_LANES;
                        const bf16* iR = img(lds, setb, O_RD); const bf16* iP = img(lds, setb, O_P); const bf16* iQ = img(lds, setb, O_NQ);
                        s16x4 aR[4][4], aQ[10]; bf16x8 aP[6];
#pragma unroll
                        for (int mt = 0; mt < 4; ++mt) {
#pragma unroll
                            for (int kb = 0; kb < 4; ++kb) aR[mt][kb] = ld64(iR, 16 * mt + fr, 16 * kb + 4 * fq); }
                        aP[0] = ld128(iP, fr, 8 * fq); aP[1] = ld128(iP, 16 + fr, 8 * fq); aP[2] = ld128(iP, 32 + fr, 8 * fq); aP[3] = ld128(iP, 32 + fr, 32 + 8 * fq); aP[4] = ld128(iP, 48 + fr, 8 * fq); aP[5] = ld128(iP, 48 + fr, 32 + 8 * fq);
                        { int ix = 0;
#pragma unroll
                          for (int mt = 0; mt < 4; ++mt) {
#pragma unroll
                              for (int blk = 0; blk <= mt; ++blk) { aQ[ix] = ld64(iQ, 16 * mt + fr, 16 * blk + 4 * fq); ++ix; } } }
                        f32x4 yacc[4];
#pragma unroll
                        for (int mt = 0; mt < 4; ++mt) { yacc[mt] = z4;
#pragma unroll
                            for (int kb = 0; kb < 4; ++kb) yacc[mt] = mm16k(aR[mt][kb], pST[kb], yacc[mt]); }
                        { int ix = 0;
#pragma unroll
                          for (int mt = 0; mt < 4; ++mt) {
#pragma unroll
                              for (int blk = 0; blk <= mt; ++blk) { yacc[mt] = mm16k(aQ[ix], pxx[blk], yacc[mt]); ++ix; } } }
                        {   f32x4 y2[4];
                            y2[0] = mm32(aP[0], bV[0], z4); y2[1] = mm32(aP[1], bV[0], z4);
                            y2[2] = mm32(aP[2], bV[0], z4); y2[2] = mm32(aP[3], bV[1], y2[2]); y2[3] = mm32(aP[4], bV[0], z4); y2[3] = mm32(aP[5], bV[1], y2[3]);
#pragma unroll
                            for (int mt = 0; mt < 4; ++mt) yacc[mt] = yacc[mt] + y2[mt];
                        }
#pragma unroll
                        for (int mt = 0; mt < 4; ++mt) {
#pragma unroll
                            for (int i = 0; i < 4; ++i) Rf[(16 * mt + 4 * fq + i) * RFP + 16 * w + fr] = yacc[mt][i]; }
                    }
                    {   SC_LANES;
                        const bf16* iKd = img(lds, setb, O_KDT); const bf16* iBd = img(lds, setb, O_NBDT); const float* gt = (const float*)(lds + setb + O_GT);
                        bf16x8 aKd[4][2]; s16x4 aB[4][4]; f32x4 g4[4];
#pragma unroll
                        for (int kb = 0; kb < 4; ++kb) { aKd[kb][0] = ld128(iKd, 16 * kb + fr, 8 * fq); aKd[kb][1] = ld128(iKd, 16 * kb + fr, 32 + 8 * fq); g4[kb] = *(const f32x4*)&gt[16 * kb + 4 * fq];
#pragma unroll
                            for (int blk = 0; blk < 4; ++blk) aB[kb][blk] = ld64(iBd, 16 * kb + fr, 16 * blk + 4 * fq); }
#pragma unroll
                        for (int kb = 0; kb < 4; ++kb) {
                            f32x4 s2 = mm32(aKd[kb][0], bV[0], z4); s2 = mm32(aKd[kb][1], bV[1], s2);
                            f32x4 s = z4;
#pragma unroll
                            for (int blk = 0; blk < 4; ++blk) s = mm16k(aB[kb][blk], pxx[blk], s);
                            ST[kb] = ST[kb] * g4[kb] + s2 + s; }
                    }
                    __syncthreads();
                } else { __syncthreads(); }
            }
        }
        if (w < 4) {
            SC_LANES;
            pc_out(p, Rf, prm, bo_out, vg, gg, yb, w, lane);
        }
    }
#undef SC_LANES
}
__device__ __forceinline__ void ph_cumsum(const float* logf, float* cum, const int wv_s) {
    const int tid_ = opaque_tid(wv_s); const int lane = tid_ & 63, wv = tid_ >> 6;
    for (int seq = blockIdx.x * 8 + wv; seq < NB * H; seq += gridDim.x * 8) {
        const int b = seq / H, h = seq % H;
        float loc[32]; float run = 0.f;
#pragma unroll
        for (int q = 0; q < 32; ++q) { run += logf[(size_t)(b * T + lane * 32 + q) * 16 + h]; loc[q] = run; }
        float incl = run;
#pragma unroll
        for (int o = 1; o < 64; o <<= 1) { const float t = __int_as_float(__builtin_amdgcn_ds_bpermute((lane >= o ? lane - o : lane) << 2, __float_as_int(incl))); if (lane >= o) incl += t; }
        const float excl = incl - run;
#pragma unroll
        for (int q = 0; q < 32; ++q) cum[(size_t)seq * T + lane * 32 + q] = -(excl + loc[q]) * LOG2E;
    }
}
#include <hip/hip_bf16.h>
#include <cmath>
namespace attn_body {
using bf16=__hip_bfloat16;
using bf16x8=__attribute__((ext_vector_type(8)))short;
using s16x4=__attribute__((ext_vector_type(4)))short;
using f32x16=__attribute__((ext_vector_type(16)))float;
using u32x4=__attribute__((ext_vector_type(4)))unsigned;
constexpr int BATCH=8,NHEAD=16,SEQ=2048,D=64,DM=NHEAD*D;
constexpr int NW=8,QBLK=32,QB=QBLK*NW,KVBLK=64,NQB=SEQ/QB;
constexpr int ATTN_PITCH=DM, ATTN_UNIT_ROWS=QB;
__device__ __forceinline__ int crow(int r,int hi){return (r&3)+8*(r>>2)+4*hi;}
#define SBAR() __builtin_amdgcn_sched_barrier(0)
__device__ __forceinline__ void cmask(f32x16&p0,f32x16&p1,int jb,int qrel,int hi){
  const float NEG=-INFINITY; int kb=64*jb+4*hi;
  #pragma unroll
  for(int r=0;r<16;++r){int kv=kb+(r&3)+8*(r>>2); if(kv>qrel)p0[r]=NEG; if(kv+32>qrel)p1[r]=NEG;}
}

constexpr int NSLOT=3, SLOTB=8192;
constexpr int LDS_K=0, LDS_V=NSLOT*SLOTB, LDS_WS=2*NSLOT*SLOTB, LDS_OST=LDS_WS+NW*64*4, LDS_BYTES=LDS_OST+NW*4096;
constexpr float C2=0.125f*1.4426950408889634f;
__device__ __forceinline__ void glds16(const void*gsrc,unsigned lds_dst){unsigned keep;
  asm volatile("s_mov_b32 %0, m0\n\ts_mov_b32 m0, %2\n\ts_nop 0\n\tglobal_load_lds_dwordx4 %1, off\n\ts_mov_b32 m0, %0":"=&s"(keep):"v"(gsrc),"s"(lds_dst):"memory");}
__device__ __forceinline__ float max3f(float a,float b,float c){float r;asm("v_max3_f32 %0, %1, %2, %3":"=v"(r):"v"(a),"v"(b),"v"(c));return r;}
__device__ __forceinline__ float max2f(float a,float b){float r;asm("v_max_f32_e32 %0, %1, %2":"=v"(r):"v"(a),"v"(b));return r;}
__device__ __forceinline__ float fadd_s(float a,float b){float r;asm("v_add_f32_e32 %0, %1, %2":"=v"(r):"v"(a),"v"(b));return r;}
__device__ __forceinline__ float fsub_s(float a,float b){float r;asm("v_sub_f32_e32 %0, %1, %2":"=v"(r):"v"(a),"v"(b));return r;}
typedef float f32x2_t __attribute__((ext_vector_type(2))); typedef __bf16 bf16x2_t __attribute__((ext_vector_type(2)));
__device__ __forceinline__ unsigned cvtpk_s(float lo,float hi){f32x2_t v={lo,hi};bf16x2_t b=__builtin_convertvector(v,bf16x2_t);return __builtin_bit_cast(unsigned,b);}
#define WAIT_BAR(N) asm volatile("s_waitcnt vmcnt(" #N ") lgkmcnt(0)\n\ts_barrier":::"memory")

__device__ __forceinline__ void qkt(f32x16&p0,f32x16&p1,const char*Kslot,const bf16x8*qr,const f32x16&negm,int r32,int hi){
  const char*kb=Kslot+hi*1024+r32*16;
  #pragma unroll
  for(int d0=0;d0<4;++d0){
    const bf16x8 b0=*reinterpret_cast<const bf16x8*>(kb+d0*2048);
    const bf16x8 b1=*reinterpret_cast<const bf16x8*>(kb+d0*2048+512);
    if(d0==0){p0=__builtin_amdgcn_mfma_f32_32x32x16_bf16(b0,qr[0],negm,0,0,0);p1=__builtin_amdgcn_mfma_f32_32x32x16_bf16(b1,qr[0],negm,0,0,0);}
    else{p0=__builtin_amdgcn_mfma_f32_32x32x16_bf16(b0,qr[d0],p0,0,0,0);p1=__builtin_amdgcn_mfma_f32_32x32x16_bf16(b1,qr[d0],p1,0,0,0);}}
}
typedef __attribute__((address_space(3))) const char* lds_cptr;
typedef short v4i16_t __attribute__((ext_vector_type(4)));
__device__ __forceinline__ void kload8(bf16x8*kf,lds_cptr kp){
  kf[0]=*(const __attribute__((address_space(3))) bf16x8*)(kp);      kf[1]=*(const __attribute__((address_space(3))) bf16x8*)(kp+512);
  kf[2]=*(const __attribute__((address_space(3))) bf16x8*)(kp+2048); kf[3]=*(const __attribute__((address_space(3))) bf16x8*)(kp+2560);
  kf[4]=*(const __attribute__((address_space(3))) bf16x8*)(kp+4096); kf[5]=*(const __attribute__((address_space(3))) bf16x8*)(kp+4608);
  kf[6]=*(const __attribute__((address_space(3))) bf16x8*)(kp+6144); kf[7]=*(const __attribute__((address_space(3))) bf16x8*)(kp+6656);
}
__device__ __forceinline__ void kload2(bf16x8*kf,lds_cptr kp,int j){ kf[2*j]=*(const __attribute__((address_space(3))) bf16x8*)(kp+j*2048); kf[2*j+1]=*(const __attribute__((address_space(3))) bf16x8*)(kp+j*2048+512); }
__device__ __forceinline__ s16x4 vtr(lds_cptr p){ return __builtin_bit_cast(s16x4,__builtin_amdgcn_ds_read_tr16_b64_v4i16((__attribute__((address_space(3))) v4i16_t*)p)); }
__device__ __forceinline__ float rowmax(const f32x16&p0,const f32x16&p1){
  float a=max3f(p0[0],p0[1],p1[0]),b=max3f(p0[2],p0[3],p1[1]);a=max3f(a,p1[2],p1[3]);
  #pragma unroll
  for(int r=4;r<16;r+=4){a=max3f(a,p0[r],p0[r+1]);b=max3f(b,p0[r+2],p0[r+3]);a=max3f(a,p1[r],p1[r+1]);b=max3f(b,p1[r+2],p1[r+3]);}
  const float m=max2f(a,b);
  auto rr=__builtin_amdgcn_permlane32_swap(__float_as_uint(m),__float_as_uint(m),false,false);
  return max2f(__uint_as_float(rr[0]),__uint_as_float(rr[1]));
}
__device__ __forceinline__ void pv(f32x16*o,int vb,bf16x8 pa0,bf16x8 pa1,bf16x8 pa2,bf16x8 pa3){
  #pragma unroll
  for(int d0=0;d0<2;++d0){s16x4 lo[4],hi[4];
    #pragma unroll
    for(int ks=0;ks<4;++ks){
      asm volatile("ds_read_b64_tr_b16 %0,%1 offset:%c2":"=&v"(lo[ks]):"v"(vb),"i"(d0*4096+ks*1024):"memory");
      asm volatile("ds_read_b64_tr_b16 %0,%1 offset:%c2":"=&v"(hi[ks]):"v"(vb),"i"(d0*4096+ks*1024+512):"memory");}
    asm volatile("s_waitcnt lgkmcnt(0)":::"memory");SBAR();
    #define PK(k) (bf16x8){lo[k][0],lo[k][1],lo[k][2],lo[k][3],hi[k][0],hi[k][1],hi[k][2],hi[k][3]}
    o[d0]=__builtin_amdgcn_mfma_f32_32x32x16_bf16(pa0,PK(0),o[d0],0,0,0);
    o[d0]=__builtin_amdgcn_mfma_f32_32x32x16_bf16(pa1,PK(1),o[d0],0,0,0);
    o[d0]=__builtin_amdgcn_mfma_f32_32x32x16_bf16(pa2,PK(2),o[d0],0,0,0);
    o[d0]=__builtin_amdgcn_mfma_f32_32x32x16_bf16(pa3,PK(3),o[d0],0,0,0);
    #undef PK
  }
}

#ifndef ATTN_STORE16
#define ATTN_STORE16(p,v) (*(u32x4*)(p)=(v))
#endif
typedef __attribute__((address_space(3))) const float* lds_cfptr;
typedef float f32x4b __attribute__((ext_vector_type(4)));
#define BIAS(C0,C1,t) do{ const lds_cfptr nb_=nbt+(t)*64+4*hi; \
    _Pragma("unroll") for(int g_=0;g_<4;++g_){ const f32x4b b0_=*(const __attribute__((address_space(3))) f32x4b*)(nb_+8*g_); const f32x4b b1_=*(const __attribute__((address_space(3))) f32x4b*)(nb_+32+8*g_); \
      C0[4*g_]+=b0_.x; C0[4*g_+1]+=b0_.y; C0[4*g_+2]+=b0_.z; C0[4*g_+3]+=b0_.w; C1[4*g_]+=b1_.x; C1[4*g_+1]+=b1_.y; C1[4*g_+2]+=b1_.z; C1[4*g_+3]+=b1_.w; } }while(0)
template<int THRL> __device__ __forceinline__ void attn_unit(int b,int h,int qb,const bf16*Q,const bf16*__restrict__ K,const bf16*__restrict__ V,bf16*O,char*shm,lds_cfptr nbt,const int wv_s){
  const int tid=::opaque_tid(wv_s),lane=tid&63,r32=lane&31,hi=lane>>5; const int wid=wv_s;
  const long rowbase=(long)b*SEQ; const int q0=qb*QB;
  const bf16*Qw=Q+(rowbase+q0+wid*QBLK)*DM+h*D;
  const bf16*Kh=K+rowbase*DM+h*D,*Vh=V+rowbase*DM+h*D;
  const unsigned lds0=(unsigned)(uintptr_t)shm;
  float*wsf=(float*)(shm+LDS_WS)+wid*64;
  const bf16*ksrc=Kh+(long)lane*DM+wid*8;
  const bf16*vsrc=Vh+(long)(16*(wid&3)+(lane>>2))*DM+(wid>>2)*32+(lane&3)*8;
  const unsigned kdst=lds0+LDS_K+wid*1024, vdst=lds0+LDS_V+wid*1024;
  #define DMA_K(t,slot) glds16(ksrc+(long)(t)*KVBLK*DM,(unsigned)__builtin_amdgcn_readfirstlane(kdst+(slot)))
  #define DMA_V(t,slot) glds16(vsrc+(long)(t)*KVBLK*DM,(unsigned)__builtin_amdgcn_readfirstlane(vdst+(slot)))
  const int vb0=(int)(lds0+LDS_V)+((lane>>4)&1)*32+(lane&3)*8+(4*hi+((lane&15)>>2))*64;
  const char*Kbase=shm+LDS_K; bf16x8 kf[8];
  const lds_cptr shm3=(lds_cptr)shm; const lds_cptr kp0=shm3+LDS_K+hi*1024+r32*16; const lds_cptr vp0=shm3+LDS_V+((lane>>4)&1)*32+(lane&3)*8+(4*hi+((lane&15)>>2))*64;
  const int NT=(q0+QB)/KVBLK;
  DMA_K(0,0);DMA_V(0,0);DMA_K(1,SLOTB);
  bf16x8 qr[4];
  #pragma unroll
  for(int d0=0;d0<4;++d0)qr[d0]=*reinterpret_cast<const bf16x8*>(&Qw[(long)r32*DM+d0*16+hi*8]);
  float mhat=0.f,l_reg=0.f;f32x16 o[2];o[0]=f32x16{};o[1]=f32x16{};f32x16 negm=f32x16{};asm volatile("":"+v"(negm));
  const int qrel=wid*QBLK+r32;
  #define CMASK(P0,P1,t) do{int jb_=(t)-(NT-4); if(jb_>=0)cmask(P0,P1,jb_,qrel,hi);}while(0)
  bool resc=false;
  #define START(P0,P1) do{ const float rm=rowmax(P0,P1); resc=false; \
    { const float dl=rm; mhat=fadd_s(mhat,dl); \
      _Pragma("unroll") for(int r=0;r<16;++r){P0[r]=fsub_s(P0[r],dl);P1[r]=fsub_s(P1[r],dl);} \
      _Pragma("unroll") for(int r=0;r<16;++r)negm[r]=-mhat; asm volatile("":"+v"(negm)); } \
    _Pragma("unroll") for(int r=0;r<16;++r)P0[r]=__builtin_amdgcn_exp2f(P0[r]); }while(0)
  #define RESC() do{ if(resc){ asm volatile("s_waitcnt lgkmcnt(0)":::"memory"); \
      _Pragma("unroll") for(int d_=0;d_<2;++d_) _Pragma("unroll") for(int r=0;r<16;++r)o[d_][r]*=wsf[crow(r,hi)]; } }while(0)
  f32x16 pA0,pA1,pB0,pB1;
  int sl_prev=0,sl_cur=0,sl_next=SLOTB;
  #define ROT() do{sl_prev=sl_cur;sl_cur=sl_next;sl_next=(sl_next==(NSLOT-1)*SLOTB)?0:sl_next+SLOTB;}while(0)
  DMA_K(2,2*SLOTB);
  WAIT_BAR(3);
  qkt(pA0,pA1,Kbase,qr,negm,r32,hi);asm volatile("s_nop 15\n\ts_nop 7":"+v"(pA0),"+v"(pA1));BIAS(pA0,pA1,0);CMASK(pA0,pA1,0);
  START(pA0,pA1);
  _Pragma("unroll") for(int r=0;r<16;++r)pA1[r]=__builtin_amdgcn_exp2f(pA1[r]);
  WAIT_BAR(0);
  DMA_K(3,0);DMA_V(1,SLOTB);
  ROT();
  kload8(kf,kp0+sl_cur);
  WAIT_BAR(2);
  s16x4 vlo[8],vhi[8]; u32x4 pw0,pw1,pw2,pw3;
  #define PKW(P,B) cvtpk_s(P[B],P[B+1])
  #define PAF(k) __builtin_bit_cast(bf16x8,pw##k)
  #define VFR(i) (bf16x8){vlo[i][0],vlo[i][1],vlo[i][2],vlo[i][3],vhi[i][0],vhi[i][1],vhi[i][2],vhi[i][3]}
  #define PIN(x) asm volatile("":"+v"(x))
  #define MX3(a,b,c) __builtin_fmaxf(__builtin_fmaxf((a),(b)),(c))
  #define GAPA(MF,A0,A1,A2,A3,W0,W1,PW) do{ MF; sacc+=A0; sacc+=A1; sacc+=A2; sacc+=A3; PIN(sacc); W0; W1; PIN(PW); SBAR(); }while(0)
  #define EX(v) __builtin_amdgcn_exp2f(v)
  #define GAPB(MF,X,B) do{ MF; X[B]=EX(X[B]); X[B+1]=EX(X[B+1]); X[B+2]=EX(X[B+2]); X[B+3]=EX(X[B+3]); PIN(X); SBAR(); }while(0)
  #define VRD(i) do{ vlo[i]=vtr(vp_+(((i)>>2)*4096+((i)&3)*1024)); vhi[i]=vtr(vp_+(((i)>>2)*4096+((i)&3)*1024+512)); }while(0)
  #define KRD(G,j) do{ if(G){ kload2(kf,kp0+sl_next,j); SBAR(); } }while(0)
  #define STEP(C0,C1,P0,P1,t,GK,GV,GL) do{ SBAR(); \
    const lds_cptr vp_=vp0+sl_prev; \
    VRD(0); SBAR(); float sacc=(P0[0]+P0[1]); \
    GAPA(C0=__builtin_amdgcn_mfma_f32_32x32x16_bf16(kf[0],qr[0],negm,0,0,0), P0[2],P0[3],P0[4],P0[5],     pw0[0]=PKW(P0,0), pw0[1]=PKW(P0,2), pw0); \
    VRD(4); SBAR(); GAPA(C1=__builtin_amdgcn_mfma_f32_32x32x16_bf16(kf[1],qr[0],negm,0,0,0), P0[6],P0[7],P0[8],P0[9],     pw0[2]=PKW(P0,4), pw0[3]=PKW(P0,6), pw0); \
    VRD(1); SBAR(); GAPA(C0=__builtin_amdgcn_mfma_f32_32x32x16_bf16(kf[2],qr[1],C0,0,0,0),   P0[10],P0[11],P0[12],P0[13], pw1[0]=PKW(P0,8), pw1[1]=PKW(P0,10), pw1); \
    VRD(5); SBAR(); GAPA(C1=__builtin_amdgcn_mfma_f32_32x32x16_bf16(kf[3],qr[1],C1,0,0,0),   P0[14],P0[15],P1[0],P1[1],   pw1[2]=PKW(P0,12),pw1[3]=PKW(P0,14), pw1); \
    VRD(2); SBAR(); GAPA(C0=__builtin_amdgcn_mfma_f32_32x32x16_bf16(kf[4],qr[2],C0,0,0,0),   P1[2],P1[3],P1[4],P1[5],     pw2[0]=PKW(P1,0), pw2[1]=PKW(P1,2), pw2); \
    VRD(6); SBAR(); GAPA(C1=__builtin_amdgcn_mfma_f32_32x32x16_bf16(kf[5],qr[2],C1,0,0,0),   P1[6],P1[7],P1[8],P1[9],     pw2[2]=PKW(P1,4), pw2[3]=PKW(P1,6), pw2); \
    VRD(3); SBAR(); GAPA(C0=__builtin_amdgcn_mfma_f32_32x32x16_bf16(kf[6],qr[3],C0,0,0,0),   P1[10],P1[11],P1[12],P1[13], pw3[0]=PKW(P1,8), pw3[1]=PKW(P1,10), pw3); \
    VRD(7); SBAR(); GAPA(C1=__builtin_amdgcn_mfma_f32_32x32x16_bf16(kf[7],qr[3],C1,0,0,0),   P1[14],P1[15],0.f,0.f,       pw3[2]=PKW(P1,12),pw3[3]=PKW(P1,14), pw3); \
    l_reg+=sacc; \
    if(GK){DMA_K((t)+3,sl_cur);} if(GV){DMA_V((t)+1,sl_next);} \
    BIAS(C0,C1,t); CMASK(C0,C1,t); \
    { float a=MX3(C0[0],C0[1],C1[0]),b=MX3(C0[2],C0[3],C1[1]); a=MX3(a,C1[2],C1[3]); \
      _Pragma("unroll") for(int r=4;r<16;r+=4){a=MX3(a,C0[r],C0[r+1]);b=MX3(b,C0[r+2],C0[r+3]);a=MX3(a,C1[r],C1[r+1]);b=MX3(b,C1[r+2],C1[r+3]);} \
      float rm=__builtin_fmaxf(a,b); { auto rr=__builtin_amdgcn_permlane32_swap(__float_as_uint(rm),__float_as_uint(rm),false,false); rm=__builtin_fmaxf(__uint_as_float(rr[0]),__uint_as_float(rr[1])); } \
      resc=false; \
      if(__builtin_expect(__any(rm>(float)THRL),0)){ const float dl=__builtin_fmaxf(rm,0.f); mhat+=dl; \
        _Pragma("unroll") for(int r=0;r<16;++r){C0[r]-=dl;C1[r]-=dl;} \
        _Pragma("unroll") for(int r=0;r<16;++r)negm[r]=-mhat; asm volatile("":"+v"(negm)); \
        const float f=__builtin_amdgcn_exp2f(-dl); l_reg*=f; if(hi==0)wsf[r32]=f; resc=true; } } \
    SBAR(); \
    GAPB(o[0]=__builtin_amdgcn_mfma_f32_32x32x16_bf16(PAF(0),VFR(0),o[0],0,0,0), C0,0); \
    GAPB(o[1]=__builtin_amdgcn_mfma_f32_32x32x16_bf16(PAF(0),VFR(4),o[1],0,0,0), C0,4); \
    KRD(GL,0); GAPB(o[0]=__builtin_amdgcn_mfma_f32_32x32x16_bf16(PAF(1),VFR(1),o[0],0,0,0), C0,8); \
    KRD(GL,1); GAPB(o[1]=__builtin_amdgcn_mfma_f32_32x32x16_bf16(PAF(1),VFR(5),o[1],0,0,0), C0,12); \
    KRD(GL,2); GAPB(o[0]=__builtin_amdgcn_mfma_f32_32x32x16_bf16(PAF(2),VFR(2),o[0],0,0,0), C1,0); \
    KRD(GL,3); GAPB(o[1]=__builtin_amdgcn_mfma_f32_32x32x16_bf16(PAF(2),VFR(6),o[1],0,0,0), C1,4); \
    GAPB(o[0]=__builtin_amdgcn_mfma_f32_32x32x16_bf16(PAF(3),VFR(3),o[0],0,0,0), C1,8); \
    GAPB(o[1]=__builtin_amdgcn_mfma_f32_32x32x16_bf16(PAF(3),VFR(7),o[1],0,0,0), C1,12); \
    }while(0)
  int t=1;
  #undef CMASK
  #define CMASK(P0,P1,t) do{}while(0)
  for(;t+5<NT;t+=2){
    STEP(pB0,pB1,pA0,pA1,t,true,true,true);     WAIT_BAR(2); RESC(); ROT();
    STEP(pA0,pA1,pB0,pB1,t+1,true,true,true);   WAIT_BAR(2); RESC(); ROT();
  }
  #undef CMASK
  #define CMASK(P0,P1,t) do{int jb_=(t)-(NT-4); if(jb_>=0)cmask(P0,P1,jb_,qrel,hi);}while(0)
  #define ENDW(tt) do{ if((tt)+3<NT){WAIT_BAR(2);} else if((tt)+2<NT){WAIT_BAR(1);} else {WAIT_BAR(0);} }while(0)
  for(;t+1<NT;t+=2){
    STEP(pB0,pB1,pA0,pA1,t,(t+3<NT),(t+1<NT),(t+1<NT));       ENDW(t);   RESC(); ROT();
    STEP(pA0,pA1,pB0,pB1,t+1,(t+4<NT),(t+2<NT),(t+2<NT));     ENDW(t+1); RESC(); ROT();
  }
  STEP(pB0,pB1,pA0,pA1,NT-1,false,false,false); RESC();
  { float sacc=pB0[0]+pB0[1]; _Pragma("unroll") for(int r=2;r<16;++r)sacc+=pB0[r]; _Pragma("unroll") for(int r=0;r<16;++r)sacc+=pB1[r]; l_reg+=sacc;
    pw0=(u32x4){PKW(pB0,0),PKW(pB0,2),PKW(pB0,4),PKW(pB0,6)};pw1=(u32x4){PKW(pB0,8),PKW(pB0,10),PKW(pB0,12),PKW(pB0,14)};pw2=(u32x4){PKW(pB1,0),PKW(pB1,2),PKW(pB1,4),PKW(pB1,6)};pw3=(u32x4){PKW(pB1,8),PKW(pB1,10),PKW(pB1,12),PKW(pB1,14)};
    SBAR(); pv(o,vb0+sl_cur,PAF(0),PAF(1),PAF(2),PAF(3)); }
  #undef PKW
  #undef PAF
  #undef VFR
  #undef PIN
  #undef MX3
  #undef GAPA
  #undef GAPB
  #undef EX
  #undef VRD
  #undef KRD
  #undef STEP
  #undef ENDW
  {auto rr=__builtin_amdgcn_permlane32_swap(__float_as_uint(l_reg),__float_as_uint(l_reg),false,false);l_reg=__uint_as_float(rr[0])+__uint_as_float(rr[1]);}
  if(hi==0)wsf[32+r32]=l_reg;asm volatile("s_waitcnt lgkmcnt(0)":::"memory");
  float rli[16];
  #pragma unroll
  for(int r=0;r<16;++r)rli[r]=__builtin_amdgcn_rcpf(wsf[32+crow(r,hi)]);
  bf16*Ow=O+(rowbase+q0+wid*QBLK)*DM+h*D;
  { bf16*stg=(bf16*)(shm+LDS_OST)+wid*2048;
    #pragma unroll
    for(int r=0;r<16;++r){const int orow=crow(r,hi);
      #pragma unroll
      for(int d0=0;d0<2;++d0)stg[orow*64+d0*32+r32]=__float2bfloat16(o[d0][r]*rli[r]);}
    asm volatile("s_waitcnt lgkmcnt(0)":::"memory");
    #pragma unroll
    for(int i=0;i<4;++i){const int row=i*8+(lane>>3),ch=lane&7; const u32x4 v=*(const u32x4*)(stg+row*64+ch*8); ATTN_STORE16(Ow+(long)row*DM+ch*8,v);} }
  asm volatile("s_waitcnt lgkmcnt(0)\n\ts_barrier":::"memory");
  #undef DMA_K
  #undef DMA_V
  #undef CMASK
  #undef START
  #undef RESC
  #undef ROT
}
constexpr int ATTN_LDS_BYTES=LDS_BYTES;
struct AttnTensors { const bf16* Q; const bf16* K; const bf16* V; bf16* O; };
struct AttnUnit { int bh; int qb; };
struct StaticOrder {
  int vcu, G;
  __device__ __forceinline__ explicit StaticOrder(int grid,int block):vcu((grid%8==0)?(block%8)*(grid/8)+block/8:block),G(grid){}
  __device__ __forceinline__ bool next(int i,AttnUnit&u)const{ if(G!=256||i>=4)return false; const int s=vcu&1; u.bh=vcu>>1; u.qb=(i==0)?s:(i==1)?7-s:(i==2)?3-s:4+s; return true; }
  __device__ __forceinline__ void a_ready(const AttnUnit&)const{}
  __device__ __forceinline__ void done(const AttnUnit&)const{}
};
template<class Sched,int THRL=8> __device__ __forceinline__ void attn_phase(char*lds,const AttnTensors&T,const float*nbias,const Sched&S,const int wv_s){
  AttnUnit u;
  if(!S.next(0,u))return;
  { float*tab=(float*)(lds+LDS_BYTES); const float*src=nbias+(long)u.bh*SEQ;
    for(int k=::opaque_tid(wv_s);k<SEQ;k+=NW*64)tab[k]=src[k];
    asm volatile("s_waitcnt vmcnt(0) lgkmcnt(0)\n\ts_barrier":::"memory"); }
  const lds_cfptr nbt=(lds_cfptr)(lds+LDS_BYTES);
  for(int i=0;S.next(i,u);++i){ S.a_ready(u); attn_unit<THRL>(u.bh/NHEAD,u.bh%NHEAD,u.qb,T.Q,T.K,T.V,T.O,lds,nbt,wv_s); S.done(u); }
}
#undef BIAS
#undef SBAR
#undef WAIT_BAR
}
#define XB_TMO      128
#define XB_XCNT(j)  (256  + 64 * (j))
#define XB_XSUB(j)  (1280 + 64 * (j))
#define XB_XGEN(j)  (2304 + 64 * (j))
#define XB_TOP      3328
#define XB_TOPGEN   3392
#define XCD_BAR_WORDS 3456
#define XB_SPIN_CAP (1u << 18)


__device__ __forceinline__ unsigned xb_ld(unsigned* p)              { return __hip_atomic_load(p, __ATOMIC_RELAXED, __HIP_MEMORY_SCOPE_AGENT); }
__device__ __forceinline__ unsigned xb_add(unsigned* p, unsigned v) { return __hip_atomic_fetch_add(p, v, __ATOMIC_RELAXED, __HIP_MEMORY_SCOPE_AGENT); }
__device__ __forceinline__ unsigned xb_xcc_id() { return (unsigned)__builtin_amdgcn_s_getreg((3 << 11) | 20) & 0xFu; }
#define XB_SPIN(cond, bar) do { unsigned _sp = 0; while (cond) { __builtin_amdgcn_s_sleep(1); \
    if ((++_sp & 255u) == 0u) { if (xb_ld(&(bar)[XB_TMO])) break; if (_sp > XB_SPIN_CAP) { atomicAdd(&(bar)[XB_TMO], 1u); break; } } } } while (0)

struct XcdBarrier { unsigned* bar; unsigned x; volatile LAS unsigned* st; };

__device__ __forceinline__ XcdBarrier xcd_barrier_post(unsigned* bar, volatile LAS unsigned* st) {
    XcdBarrier b; b.bar = bar; b.x = xb_xcc_id(); b.st = st;
    if (threadIdx.x == 0) (void)xb_add(&bar[XB_XCNT(b.x)], 1u);
    return b;
}
__device__ __forceinline__ void xcd_barrier_complete(unsigned* bar, unsigned x, unsigned& nloc, unsigned& nx) {
    const unsigned G = gridDim.x * gridDim.y * gridDim.z;
    unsigned sum, cnt, mine, sp = 0u;
    for (;;) {
        sum = 0u; cnt = 0u; mine = 0u;
#pragma unroll
        for (unsigned j = 0; j < 16; ++j) { const unsigned c = xb_ld(&bar[XB_XCNT(j)]); sum += c; cnt += (c > 0u) ? 1u : 0u; mine = (j == x) ? c : mine; }
        if (sum == G) break;
        __builtin_amdgcn_s_sleep(1);
        if ((++sp & 255u) == 0u) { if (xb_ld(&bar[XB_TMO])) break; if (sp > XB_SPIN_CAP) { atomicAdd(&bar[XB_TMO], 1u); break; } }
    }
    nloc = mine > 0u ? mine : 1u; nx = cnt > 0u ? cnt : 1u;
}
__device__ __forceinline__ void xcd_barrier(const XcdBarrier& b) {
    asm volatile("s_waitcnt vmcnt(0)" ::: "memory");
    __syncthreads();
    if (threadIdx.x == 0) {
        unsigned* bar = b.bar; unsigned bx = b.x; asm volatile("" : "+s"(bx));
        __builtin_amdgcn_s_waitcnt(0);
        unsigned nloc = b.st[0], nx = b.st[1];
        if (nloc == 0u) { xcd_barrier_complete(bar, bx, nloc, nx); b.st[0] = nloc; b.st[1] = nx; }
        const unsigned old = xb_add(&bar[XB_XSUB(bx)], 1u);
        const unsigned gen = old / nloc;
        if (old + 1u == (gen + 1u) * nloc) {
            __builtin_amdgcn_fence(__ATOMIC_RELEASE, "agent");
            asm volatile("s_waitcnt vmcnt(0)" ::: "memory");
            const unsigned og = xb_add(&bar[XB_TOP], 1u);
            const unsigned tg = og / nx;
            if (og + 1u == (tg + 1u) * nx) xb_add(&bar[XB_TOPGEN], 1u);
            else XB_SPIN(xb_ld(&bar[XB_TOPGEN]) == tg, bar);
            __builtin_amdgcn_fence(__ATOMIC_ACQUIRE, "agent");
            xb_add(&bar[XB_XGEN(bx)], 1u);
            asm volatile("s_waitcnt vmcnt(0)" ::: "memory");
        } else {
            XB_SPIN(xb_ld(&bar[XB_XGEN(bx)]) == gen, bar);
            __builtin_amdgcn_fence(__ATOMIC_ACQUIRE, "agent");
            asm volatile("s_waitcnt vmcnt(0)" ::: "memory");
        }
    }
    __syncthreads();
}

enum { I_X = 0, I_MIX, I_WR, I_WK, I_WV, I_WO, I_W0, I_W1, I_W2, I_A0, I_A1, I_A2, I_G1, I_G2, I_KK, I_KA, I_RK, I_GNG, I_GNB,
       I_FWIN, I_FBF, I_FWO, I_RW, I_RB, I_MG, I_MU, I_MD, I_LNG, I_LNB, N_IN };
constexpr int LDS_BYTES = 163840;
constexpr int LDS_MISC = LDS_BYTES - 64;
static_assert(CTL_BAR_OFF + XCD_BAR_WORDS * 4 <= CTL_BYTES, "ctl block");

struct Params { const float* in[N_IN]; float* out; unsigned char* ws; };

__device__ __forceinline__ void ph_xmix(const float* x, const float* mix, bf16* xcat, bf16* xr3, int gw, int NGW, int lane) {
    f32x4 mr[4], mk[4], mv[4];
#pragma unroll
    for (int j = 0; j < 4; ++j) { mr[j] = *(const f32x4*)(mix + 0 * D + 4 * lane + 256 * j); mk[j] = *(const f32x4*)(mix + 2 * D + 4 * lane + 256 * j); mv[j] = *(const f32x4*)(mix + 3 * D + 4 * lane + 256 * j); }
    for (int row = gw; row < M; row += NGW) {
        const bool hp = (row & (T - 1)) != 0;
#pragma unroll
        for (int j = 0; j < 4; ++j) {
            const int col = 4 * lane + 256 * j;
            const f32x4 c4 = *(const f32x4*)(x + (size_t)row * D + col);
            f32x4 p4 = (f32x4){0.f, 0.f, 0.f, 0.f};
            if (hp) p4 = *(const f32x4*)(x + (size_t)(row - 1) * D + col);
            const f32x4 xx = p4 - c4;
            u32x2 o;
            o.x = pk2(c4.x, c4.y); o.y = pk2(c4.z, c4.w); *(u32x2*)(xcat + (size_t)row * 2048 + col) = o;
            o.x = pk2(xx.x, xx.y); o.y = pk2(xx.z, xx.w); *(u32x2*)(xcat + (size_t)row * 2048 + 1024 + col) = o;
            f32x4 v = c4 + xx * mr[j]; o.x = pk2(v.x, v.y); o.y = pk2(v.z, v.w); *(u32x2*)(xr3 + (size_t)row * D + col) = o;
            v = c4 + xx * mk[j]; o.x = pk2(v.x, v.y); o.y = pk2(v.z, v.w); *(u32x2*)(xr3 + (size_t)M * D + (size_t)row * D + col) = o;
            v = c4 + xx * mv[j]; o.x = pk2(v.x, v.y); o.y = pk2(v.z, v.w); *(u32x2*)(xr3 + 2 * (size_t)M * D + (size_t)row * D + col) = o;
        }
    }
}

__global__ void __launch_bounds__(512, 2) fwd(Params P) {
    extern __shared__ __attribute__((aligned(16))) unsigned char lds[];
    LAS unsigned char* lds3 = (LAS unsigned char*)lds;
    volatile LAS unsigned* misc = (volatile LAS unsigned*)(lds3 + LDS_MISC);
    if (threadIdx.x < 16) misc[threadIdx.x] = 0u;
    const int wv_s = __builtin_amdgcn_readfirstlane(threadIdx.x >> 6);
    __syncthreads();
    unsigned char* ws = P.ws;
    XcdBarrier bar = xcd_barrier_post((unsigned*)(ws + WS_CTL + CTL_BAR_OFF), misc);
    const int G = gridDim.x, bid = blockIdx.x;
    float* hbuf = P.out;
    bf16* PRE = (bf16*)P.out;
    int* counts0 = (int*)(ws + WS_CTL);
    bf16* HB = (bf16*)(ws + WS_HB); bf16* R = (bf16*)(ws + WS_R); bf16* KB = (bf16*)(ws + WS_K); bf16* VB = (bf16*)(ws + WS_V);
    _Float16* LW = (_Float16*)(ws + WS_LW); bf16* AA = (bf16*)(ws + WS_AA); bf16* GG = (bf16*)(ws + WS_G); bf16* L1 = (bf16*)(ws + WS_L1);
    float* LOGF = (float*)(ws + WS_LOGF); float* CUM = (float*)(ws + WS_CUM); bf16* Y = (bf16*)(ws + WS_Y); bf16* HID = (bf16*)(ws + WS_HID);
    bf16* GUT = (bf16*)(ws + WS_MOEW); bf16* DNT = (bf16*)(ws + WS_DNT);
    bf16* GUT1 = (bf16*)((unsigned char*)P.out + 32 * MiB); bf16* DNT1 = (bf16*)(ws + WS_DNT1);
    const size_t BIG = (size_t)1 << 20;

    {
        const int tid = opaque_tid(wv_s), lane = tid & 63, wave = tid >> 6;
        const int gw = bid * 8 + wave, NGW = G * 8;
        LAS float* scr = (LAS float*)(lds3 + wave * 16384);
        bf16* WRKV = (bf16*)(ws + WS_WRKV); bf16* WO = (bf16*)(ws + WS_WO); bf16* B1T = (bf16*)(ws + WS_B1T); bf16* B2T = (bf16*)(ws + WS_B2T);
        bf16* WIN = (bf16*)(ws + WS_WIN); bf16* FWO = (bf16*)(ws + WS_FWO);
        const float* mix = P.in[I_MIX];
        int ib = 0;
        ib = tr_matrix(ib, gw, NGW, P.in[I_WR], D, D, D, nullptr, WRKV, D, 0, 0, 0, scr, lane);
        ib = tr_matrix(ib, gw, NGW, P.in[I_WK], D, D, D, nullptr, WRKV, D, 0, D, 0, scr, lane);
        ib = tr_matrix(ib, gw, NGW, P.in[I_WV], D, D, D, nullptr, WRKV, D, 0, 2 * D, 0, scr, lane);
        ib = tr_matrix(ib, gw, NGW, P.in[I_W1], 64, D, 64, nullptr, B1T, 2048, 0, 0, 0, scr, lane);
        ib = tr_matrix(ib, gw, NGW, P.in[I_W1], 64, D, 64, mix + 1 * D, B1T, 2048, 1024, 0, 0, scr, lane);
        ib = tr_matrix(ib, gw, NGW, P.in[I_A1], 64, D, 64, nullptr, B1T, 2048, 0, 64, 0, scr, lane);
        ib = tr_matrix(ib, gw, NGW, P.in[I_A1], 64, D, 64, mix + 4 * D, B1T, 2048, 1024, 64, 0, scr, lane);
        ib = tr_matrix(ib, gw, NGW, P.in[I_G1], 128, D, 128, nullptr, B1T, 2048, 0, 128, 0, scr, lane);
        ib = tr_matrix(ib, gw, NGW, P.in[I_G1], 128, D, 128, mix + 5 * D, B1T, 2048, 1024, 128, 0, scr, lane);
        ib = tr_matrix(ib, gw, NGW, P.in[I_W2], D, 64, D, nullptr, B2T, 256, 0, 0, 0, scr, lane);
        ib = tr_matrix(ib, gw, NGW, P.in[I_A2], D, 64, D, nullptr, B2T, 256, 64, 1024, 0, scr, lane);
        ib = tr_matrix(ib, gw, NGW, P.in[I_G2], D, 128, D, nullptr, B2T, 256, 128, 2048, 0, scr, lane);
        for (int ch = bid * 512 + tid; ch < 3072 * 32; ch += G * 512) {
            const int row = ch >> 5, c8 = ch & 31;
            const bool covered = row < 1024 ? (c8 < 8) : (row < 2048 ? (c8 >= 8 && c8 < 16) : (c8 >= 16));
            if (!covered) *(u32x4*)(B2T + (size_t)row * 256 + c8 * 8) = (u32x4){0u, 0u, 0u, 0u};
        }
        ph_xmix(P.in[I_X], mix, (bf16*)(ws + WS_XCAT), (bf16*)(ws + WS_XR), gw, NGW, lane);
    }
    xcd_barrier(bar);
    {
        const int G1 = G / 4, G2 = G - G1;
        pg8::DenseOrder S1; S1.init(M, 256, 2048, G1, bid < G1 ? bid : -1, ws + WS_XCAT, ws + WS_B1T, 1 << 20, 0);
        pg8::EpiBf16 E1; E1.O = L1; E1.ldc = 256; E1.split_div = 1; E1.split_stride = 0; E1.scale0 = 1.f; E1.act = 1; E1.scanlay = 0;
        pg8::gemm_phase<pg8::EpiBf16, pg8::DenseOrder, true, false>(lds3, 2048, S1, E1, wv_s);
        pg8::DenseOrder S2; S2.init(M, 3 * D, D, G2, bid >= G1 ? bid - G1 : -1, ws + WS_XR, ws + WS_WRKV, 4, (size_t)M * D * 2);
        pg8::EpiBf16 E2; E2.O = R; E2.ldc = D; E2.split_div = 4; E2.split_stride = (size_t)M * D; E2.scale0 = 1.f; E2.act = 0; E2.scanlay = 1;
        pg8::gemm_phase<pg8::EpiBf16, pg8::DenseOrder, true, false>(lds3, D, S2, E2, wv_s);
    }
    xcd_barrier(bar);
    {
        pg8::DenseOrder S; S.init(M, 3 * D, 256, G, bid, L1, ws + WS_B2T, 8, 256); S.kl = 128; S.bsel = 1;
        pg8::EpiLora2 E; E.LW = LW; E.AG = AA; E.w0 = P.in[I_W0]; E.a0 = P.in[I_A0];
        pg8::gemm_phase<pg8::EpiLora2, pg8::DenseOrder, true, false>(lds3, 256, S, E, wv_s);
    }
    xcd_barrier(bar);
    {
        const bool split = G >= 256;
        if (!split || bid < NB * H) {
            ScanP p; p.r = R; p.k = KB; p.v = VB; p.lw = LW; p.a = AA; p.g = GG; p.yg = R; p.kk = P.in[I_KK]; p.ka = P.in[I_KA]; p.rk = P.in[I_RK]; p.gng = P.in[I_GNG]; p.gnb = P.in[I_GNB];
            ph_scan_pc(p, lds, split ? NB * H : G, wv_s);
        }
        if (!split || bid >= NB * H) {
            const int tid = opaque_tid(wv_s), lane = tid & 63, wave = tid >> 6;
            __syncthreads();
            if (bid == G - 1) {
                build_router_frags(P.in[I_LNG] + 0 * D, P.in[I_LNB] + 0 * D, P.in[I_RW], ws + WS_WF, lds, tid);
                build_router_frags(P.in[I_LNG] + 2 * D, P.in[I_LNB] + 2 * D, P.in[I_RW], ws + WS_WF + WF_STRIDE, lds, tid);
            }
            {
                const int gw = split ? (bid - NB * H) * 8 + wave : bid * 8 + wave, NGW = split ? (G - NB * H) * 8 : G * 8; LAS float* scr = (LAS float*)(lds3 + wave * 16384); int ib = 0;
                ib = tr_matrix(ib, gw, NGW, P.in[I_WO], D, D, D, nullptr, (bf16*)(ws + WS_WO), D, 0, 0, 0, scr, lane);
                ib = tr_matrix(ib, gw, NGW, P.in[I_FWIN], NW_IN, D, 3 * D, nullptr, (bf16*)(ws + WS_WIN), D, 0, 0, 0, scr, lane);
                ib = tr_matrix(ib, gw, NGW, P.in[I_FWO], D, D, D, nullptr, (bf16*)(ws + WS_FWO), D, 0, 0, 0, scr, lane);
            }
            convert_moe(P.in[I_MG], P.in[I_MU], P.in[I_MD], GUT, DNT, split ? (bid - NB * H) * 8 + wave : bid * 8 + wave, split ? (G - NB * H) * 8 : G * 8, (LAS float*)(lds3 + wave * 16384), lane);
            convert_moe(P.in[I_MG] + (size_t)NE * D * DE, P.in[I_MU] + (size_t)NE * D * DE, P.in[I_MD] + (size_t)NE * DE * D, GUT1, DNT1, split ? (bid - NB * H) * 8 + wave : bid * 8 + wave, split ? (G - NB * H) * 8 : G * 8, (LAS float*)(lds3 + wave * 16384), lane);
        }
    }
    xcd_barrier(bar);
    {
        pg8::DenseOrder S; S.init(M, D, D, G, bid, R, ws + WS_WO, 1 << 20, 0); S.ascan = 1;
        pg8::EpiPre E; E.hin32 = P.in[I_X]; E.hin16 = nullptr; E.out = PRE;
        pg8::gemm_phase<pg8::EpiPre, pg8::DenseOrder, true, false>(lds3, D, S, E, wv_s);
    }
    xcd_barrier(bar);
    for (int layer = 0; layer < 2; ++layer) {
        if (layer == 1) {
            ph_cumsum(LOGF, CUM, wv_s);
            {
                pg8::DenseOrder S; S.init(M, 3 * D, D, G, bid, HB, ws + WS_WIN, 1 << 20, 0);
                pg8::EpiBf16 E; E.O = R; E.ldc = D; E.split_div = 4; E.split_stride = (size_t)M * D; E.scale0 = attn_body::C2; E.act = 0; E.scanlay = 0;
                pg8::gemm_phase<pg8::EpiBf16, pg8::DenseOrder, true, false>(lds3, D, S, E, wv_s);
            }
            xcd_barrier(bar);
            {   const attn_body::AttnTensors AT{(const attn_body::bf16*)R, (const attn_body::bf16*)KB, (const attn_body::bf16*)VB, (attn_body::bf16*)R};
                const attn_body::StaticOrder S(G, bid);
                attn_body::attn_phase<attn_body::StaticOrder, 30>((char*)lds, AT, CUM, S, wv_s); }
            xcd_barrier(bar);
            {
                pg8::DenseOrder S; S.init(M, D, D, G, bid, R, ws + WS_FWO, 1 << 20, 0);
                pg8::EpiPre E; E.hin32 = nullptr; E.hin16 = HB; E.out = PRE;
                pg8::gemm_phase<pg8::EpiPre, pg8::DenseOrder, true, false>(lds3, D, S, E, wv_s);
            }
            xcd_barrier(bar);
        }
        int* counts = counts0 + 16 * CNT_STRIDE * layer;
        int* rtok = (int*)(ws + WS_RTOK) + (size_t)layer * NE * CAP; float* rgate = (float*)(ws + WS_RGATE) + (size_t)layer * NE * CAP; int* slot = (int*)(ws + WS_SLOT) + (size_t)layer * M * 2;
        {   LnRouteP p; p.pin = PRE; p.hb = HB; p.g = P.in[I_LNG] + (layer * 2 + 0) * D; p.b = P.in[I_LNB] + (layer * 2 + 0) * D; p.wfg = ws + WS_WF + (size_t)layer * WF_STRIDE; p.rbias = P.in[I_RB];
            p.counts = counts; p.rtok = rtok; p.rgate = rgate; p.slot = slot;
            ph_ln_route(p, lds, wv_s); }
        xcd_barrier(bar);
        {
            int total = 0; for (int e = 0; e < NE; ++e) total += (counts[e * CNT_STRIDE] + 255) >> 8;
            total *= 4;
            const int n3 = total > 512 ? total - 512 : 0, early = total < 512 ? total : 512;
            unsigned* gu3 = (unsigned*)(ws + WS_CTL + 36864) + 64 * layer;
            pg8::EpiGU EG; EG.hid = HID;
            pg8::EpiDN ED; ED.y = Y; ED.rgate = rgate;
            pg8::MoeOrder SG; SG.counts = counts; SG.rtok = rtok; SG.A = (const char*)HB; SG.B = (const char*)(layer == 0 ? GUT : GUT1); SG.bexp_stride = (size_t)D * D * 2; SG.nN = 4; SG.K = D; SG.gather = 1;
            pg8::MoeOrder SD; SD.counts = counts; SD.rtok = rtok; SD.A = (const char*)HID; SD.B = (const char*)(layer == 0 ? DNT : DNT1); SD.bexp_stride = (size_t)D * DE * 2; SD.nN = 4; SD.K = DE; SD.gather = 0;
            SG.base = bid; SG.stride = G; SG.hi = early;
            pg8::gemm_phase<pg8::EpiGU, pg8::MoeOrder, true, true>(lds3, D, SG, EG, wv_s);
            xcd_barrier(bar);
            int late_idx = -1;
            if (bid < n3) {
                SG.base = 512 + bid; SG.stride = 1 << 20; SG.hi = total;
                pg8::gemm_phase<pg8::EpiGU, pg8::MoeOrder, true, true>(lds3, D, SG, EG, wv_s);
                __syncthreads();
                if (opaque_tid(wv_s) == 0) { __builtin_amdgcn_fence(__ATOMIC_RELEASE, "agent"); asm volatile("s_waitcnt vmcnt(0)" ::: "memory"); __hip_atomic_fetch_add(gu3, 1u, __ATOMIC_RELAXED, __HIP_MEMORY_SCOPE_AGENT); }
                SD.base = bid; SD.stride = 1 << 20; SD.hi = early;
            } else {
                const int d = bid - n3, W = G - n3;
                SD.base = n3 + d; SD.stride = W; SD.hi = early;
                int idx = n3 + d; while (idx < 512) idx += W;
                if (idx < total) late_idx = idx;
            }
            pg8::gemm_phase<pg8::EpiDN, pg8::MoeOrder, true, false>(lds3, DE, SD, ED, wv_s);
            if (late_idx >= 0) {
                if (opaque_tid(wv_s) == 0) {
                    unsigned sp = 0; while (__hip_atomic_load(gu3, __ATOMIC_RELAXED, __HIP_MEMORY_SCOPE_AGENT) < (unsigned)n3) { __builtin_amdgcn_s_sleep(2); if (++sp > (1u << 22)) break; }
                    __builtin_amdgcn_fence(__ATOMIC_ACQUIRE, "agent"); asm volatile("s_waitcnt vmcnt(0)" ::: "memory");
                }
                __syncthreads();
                SD.base = late_idx; SD.stride = 1 << 20; SD.hi = total;
                pg8::gemm_phase<pg8::EpiDN, pg8::MoeOrder, true, false>(lds3, DE, SD, ED, wv_s);
            }
        }
        xcd_barrier(bar);
        {   LnCombP p; p.hb = HB; p.y = Y; p.slot = slot; p.counts = counts; p.g = P.in[I_LNG] + (layer * 2 + 1) * D; p.b = P.in[I_LNB] + (layer * 2 + 1) * D;
            p.wf = P.in[I_FWIN] + 3 * D; p.bf = P.in[I_FBF]; p.logf = LOGF; p.outp = (layer == 1) ? hbuf : nullptr; p.do_f = (layer == 0) ? 1 : 0; p.pad = 0;
            ph_ln_comb(p, lds, wv_s); }
        if (layer == 0) {
            xcd_barrier(bar);
        }
    }
}

extern "C" void kernel_launch(void* const* d_in, const int* in_sizes, int n_in, void* d_out, int out_size, void* d_ws, size_t ws_size, hipStream_t stream) {
    static int grid = 0;
    if (grid == 0) {
        if (n_in != N_IN || out_size != M * D || ws_size < WS_END) { fprintf(stderr, "kernel_launch: unexpected problem (n_in %d out %d ws %zu, need %zu)\n", n_in, out_size, ws_size, (size_t)WS_END); grid = -1; return; }
        int dev = 0, cus = 0;
        if (hipGetDevice(&dev) != hipSuccess || hipDeviceGetAttribute(&cus, hipDeviceAttributeMultiprocessorCount, dev) != hipSuccess) { grid = -1; return; }
        if (hipFuncSetAttribute((const void*)fwd, hipFuncAttributeMaxDynamicSharedMemorySize, LDS_BYTES) != hipSuccess) { fprintf(stderr, "kernel_launch: hipFuncSetAttribute failed\n"); grid = -1; return; }
        int per_cu = 0;
        if (hipOccupancyMaxActiveBlocksPerMultiprocessor(&per_cu, (const void*)fwd, 512, LDS_BYTES) != hipSuccess || per_cu < 1) { fprintf(stderr, "kernel_launch: occupancy query says %d\n", per_cu); (void)hipGetLastError(); }
        grid = cus;
    }
    if (grid < 0) return;
    (void)hipMemsetAsync((char*)d_ws + WS_CTL, 0, CTL_BYTES, stream);
    Params P{};
    for (int i = 0; i < N_IN; ++i) P.in[i] = (const float*)d_in[i];
    P.out = (float*)d_out; P.ws = (unsigned char*)d_ws;
    hipLaunchKernelGGL(fwd, dim3(grid), dim3(512), LDS_BYTES, stream, P);
}
```

```cpp
#include <hip/hip_runtime.h>
#include <stdint.h>
#include <stdio.h>

typedef unsigned short bf16;
typedef short bf16x8 __attribute__((ext_vector_type(8)));
typedef float f32x4 __attribute__((ext_vector_type(4)));
typedef float f32x2 __attribute__((ext_vector_type(2)));
typedef unsigned u32x4 __attribute__((ext_vector_type(4)));
typedef unsigned u32x2 __attribute__((ext_vector_type(2)));
#define LAS __attribute__((address_space(3)))

constexpr int NB = 8, T = 2048, D = 1024, H = 16, HD = 64, M = NB * T;
constexpr int NE = 16, DE = 512, CAP = 16384, MAXROWS = 36864;
constexpr int NW_IN = 3 * D + H;
constexpr float ALPHA = 1.4142135623730951f;
constexpr float LN_EPS = 1e-5f, GN_EPS = 64e-5f;
constexpr float LOG2E = 1.4426950408889634f;

constexpr size_t MiB = 1u << 20;
constexpr size_t WS_CTL = 0;
constexpr size_t CTL_BYTES = 65536;
constexpr size_t CTL_BAR_OFF = 16384;
constexpr size_t WS_RTOK = 1 * MiB;
constexpr size_t WS_RGATE = 3 * MiB;
constexpr size_t WS_SLOT = 5 * MiB;
constexpr size_t WS_WRKV = 6 * MiB;
constexpr size_t WS_WO = 12 * MiB;
constexpr size_t WS_B1T = 14 * MiB;
constexpr size_t WS_B2T = 15 * MiB;
constexpr size_t WS_WIN = 17 * MiB;
constexpr size_t WS_FWO = 23 * MiB;
constexpr size_t WS_X0 = 25 * MiB;
constexpr size_t WS_XCAT = WS_X0;
constexpr size_t WS_XR = WS_X0 + 64 * MiB;
constexpr size_t WS_MOEW = WS_X0;
constexpr size_t WS_DNT = WS_MOEW + 32 * MiB;
constexpr size_t WS_LW = WS_X0 + 48 * MiB;
constexpr size_t WS_HB = WS_X0 + 48 * MiB;
constexpr size_t WS_AA = WS_X0 + 80 * MiB;
constexpr size_t WS_G = WS_X0 + 112 * MiB;
constexpr size_t WS_DNT1 = WS_X0 + 144 * MiB;
constexpr size_t WS_HID = WS_X0 + 80 * MiB;
constexpr size_t WS_R = WS_X0 + 160 * MiB;
constexpr size_t WS_K = WS_R + 32 * MiB;
constexpr size_t WS_V = WS_R + 64 * MiB;
constexpr size_t WS_Y = WS_R;
constexpr size_t WS_L1 = WS_R + 96 * MiB;
constexpr size_t WS_LOGF = WS_L1;
constexpr size_t WS_CUM = WS_L1 + 1 * MiB;
constexpr size_t WS_WF = WS_L1 + 4 * MiB;
constexpr size_t WF_STRIDE = 65536 + 256;
constexpr size_t WS_END = WS_L1 + 8 * MiB;
static_assert(WS_END == 289 * MiB, "map");

__device__ __forceinline__ unsigned f2bf(float f) { unsigned u = __float_as_uint(f); return (u + 0x7fffu + ((u >> 16) & 1u)) >> 16; }
__device__ __forceinline__ float bf2f(unsigned b) { return __uint_as_float(b << 16); }
typedef __bf16 bf16x2_t_ __attribute__((ext_vector_type(2)));
__device__ __forceinline__ unsigned pk2(float lo, float hi) { const f32x2 v = {lo, hi}; const bf16x2_t_ b = __builtin_convertvector(v, bf16x2_t_); return __builtin_bit_cast(unsigned, b); }
__device__ __forceinline__ float sigmoidf_(float x) { return 1.0f / (1.0f + __expf(-x)); }
__device__ __forceinline__ float sigmoid_fast(float x) { return __builtin_amdgcn_rcpf(1.0f + __expf(-x)); }
__device__ __forceinline__ float tanh_fast(float x) { return 2.0f * sigmoid_fast(2.0f * x) - 1.0f; }
__device__ __forceinline__ float softplusf_(float x) { return fmaxf(x, 0.f) + __logf(1.0f + __expf(-fabsf(x))); }
__device__ __forceinline__ float shx(float v, int o, int lane) { return __int_as_float(__builtin_amdgcn_ds_bpermute((lane ^ o) << 2, __float_as_int(v))); }
__device__ __forceinline__ float wave_sum(float v, int lane) {
#pragma unroll
    for (int o = 1; o < 64; o <<= 1) v += shx(v, o, lane);
    return v;
}
__device__ __forceinline__ int opaque_tid(int wv_s) { int l; asm volatile("v_mbcnt_lo_u32_b32 %0, -1, 0\n\tv_mbcnt_hi_u32_b32 %0, -1, %0" : "=v"(l)); return wv_s * 64 + l; }

namespace pg8 {
constexpr int BM = 256, BK = 64, HALF = 128, HTB = HALF * BK * 2, STAGE_BYTES = 8 * HTB, NXCD = 8, WGM = 8;
__host__ __device__ __forceinline__ int lds_byte(int r, int c) { const int st = (r >> 4) * 2 + (c >> 5), rr = r & 15, cc = c & 31, ob = rr * 64 + cc * 2; return st * 1024 + (ob ^ (((ob >> 9) & 1) << 5)); }
__host__ __device__ __forceinline__ void stage_rc(int b, int& R, int& C) { const int st = b / 1024, sb = b % 1024, swz = sb ^ (((sb >> 9) & 1) << 5); R = (st >> 1) * 16 + swz / 64; C = (st & 1) * 32 + (swz % 64) / 2; }
__host__ __device__ __forceinline__ int perm32(int rho) { const int n = rho >> 4, i = rho & 15; return 8 * (i >> 2) + 4 * n + (i & 3); }

struct Unit { int pm, pn; const char* A; const char* B; int e, r0, nvalid, pad; };

typedef __bf16 bf16x2_cv __attribute__((ext_vector_type(2)));
__device__ __forceinline__ unsigned cvt_pk_bf16(float lo, float hi) { const f32x2 v = {lo, hi}; const bf16x2_cv b = __builtin_convertvector(v, bf16x2_cv); return __builtin_bit_cast(unsigned, b); }

template <class Epi, class Sched, bool ALIGN_EPI, bool GATHER>
__device__ __forceinline__ void gemm_phase(LAS unsigned char* lds, const int K_in, const Sched& S, const Epi& E, const int wv_s) {
    int K = K_in; asm volatile("" : "+s"(K));
    const int tid = opaque_tid(wv_s), wid = wv_s, lane = tid & 63, wr = wid >> 2, wc = wid & 3, fr = lane & 15, fq = lane >> 4;
    const int nt = S.kloop(K) / BK;
    int Rr[2], Cc[2]; unsigned voffB[2];
#pragma unroll
    for (int i = 0; i < 2; ++i) { int R, C; stage_rc(tid * 16 + i * 8192, R, C); Rr[i] = R; Cc[i] = C; const int Rb = Epi::PERM ? ((R & ~31) + perm32(R & 31)) : R; voffB[i] = (unsigned)(Rb * K + C) * 2u; }
    const size_t kstep = (size_t)(BK * 2);
    const size_t kstepA = S.kstepA();
    const size_t hstep = (size_t)HALF * K * 2;
    const unsigned ldsw = (unsigned)wid * 1024u;
    const int aoff = lds_byte(wr * 64 + fr, fq * 8), boff = lds_byte(wc * 32 + fr, fq * 8);
#define PG8_SA(b, h) (((b) * 2 + (h)) * HTB)
#define PG8_SB(b, h) ((4 + (b) * 2 + (h)) * HTB)
#define PG8_STAGE(bufoff, gbase, voff) do { _Pragma("unroll") for (int _i = 0; _i < 2; ++_i) \
        __builtin_amdgcn_global_load_lds((const unsigned*)((const char*)(gbase) + (voff)[_i]), (LAS unsigned*)(lds + (bufoff) + ldsw + _i * 8192), 16, 0, 0); } while (0)
#define PG8_LDA(dst, b, h) do { _Pragma("unroll") for (int m = 0; m < 4; ++m) _Pragma("unroll") for (int k = 0; k < 2; ++k) dst[m][k] = *(const LAS bf16x8*)(lds + PG8_SA(b, h) + aoff + m * 2048 + k * 1024); } while (0)
#define PG8_LDB(dst, b, h) do { _Pragma("unroll") for (int n = 0; n < 2; ++n) _Pragma("unroll") for (int k = 0; k < 2; ++k) dst[n][k] = *(const LAS bf16x8*)(lds + PG8_SB(b, h) + boff + n * 2048 + k * 1024); } while (0)
#define PG8_MMA(ai, bj, At, Bt) do { __builtin_amdgcn_s_setprio(1); _Pragma("unroll") for (int m = 0; m < 4; ++m) _Pragma("unroll") for (int n = 0; n < 2; ++n) _Pragma("unroll") for (int k = 0; k < 2; ++k) \
        acc[ai][bj][m][n] = __builtin_amdgcn_mfma_f32_16x16x32_bf16(Bt[n][k], At[m][k], acc[ai][bj][m][n], 0, 0, 0); __builtin_amdgcn_s_setprio(0); } while (0)
#define PG8_WAIT_V(n) asm volatile("s_waitcnt vmcnt(" #n ")" ::: "memory")
#define PG8_WAIT_L(n) asm volatile("s_waitcnt lgkmcnt(" #n ")" ::: "memory")
#define PG8_BAR __builtin_amdgcn_s_barrier()
#define PG8_SCHED __builtin_amdgcn_sched_barrier(0)
    Unit cur, nxt; int ui = 0;
    if (!S.next(0, cur)) return;
    f32x4 acc[2][2][4][2];
#pragma unroll
    for (int a = 0; a < 2; ++a)
#pragma unroll
        for (int b = 0; b < 2; ++b)
#pragma unroll
            for (int m = 0; m < 4; ++m)
#pragma unroll
                for (int n = 0; n < 2; ++n) acc[a][b][m][n] = (f32x4){0.f, 0.f, 0.f, 0.f};
    bf16x8 At[4][2], B0[2][2], B1[2][2];
    unsigned cv[2][2], nv[2][2];
    S.fill(cur, Rr, Cc, K, cv);
    const char* cA = cur.A; const char* cB = cur.B;
    PG8_STAGE(PG8_SB(0, 0), cB, voffB); PG8_STAGE(PG8_SB(0, 1), cB + hstep, voffB); PG8_STAGE(PG8_SA(0, 0), cA, cv[0]); PG8_STAGE(PG8_SA(0, 1), cA, cv[1]);
    if (wr == 1) PG8_BAR;
    PG8_WAIT_V(2); PG8_BAR;
    PG8_STAGE(PG8_SB(1, 0), cB + kstep, voffB); PG8_STAGE(PG8_SA(1, 0), cA + kstepA, cv[0]); PG8_STAGE(PG8_SB(1, 1), cB + hstep + kstep, voffB);
    PG8_WAIT_V(6); PG8_BAR;
    for (;;) {
        const bool has_next = S.next(ui + 1, nxt);
        const char* nA = has_next ? nxt.A : cA; const char* nB = has_next ? nxt.B : cB;
        if (GATHER) { if (has_next) S.fill(nxt, Rr, Cc, K, nv); else { nv[0][0] = cv[0][0]; nv[0][1] = cv[0][1]; nv[1][0] = cv[1][0]; nv[1][1] = cv[1][1]; } }
        for (int t = 0; t < nt; t += 2) {
            const bool last = (t == nt - 2);
            const char* a1 = cA + (size_t)(t + 1) * kstepA;
            const char* a2 = last ? nA : cA + (size_t)(t + 2) * kstepA; const char* b2 = last ? nB : cB + (size_t)(t + 2) * kstep;
            const char* a3 = a2 + kstepA; const char* b3 = b2 + kstep;
            unsigned v2[2][2];
            if (GATHER) { v2[0][0] = last ? nv[0][0] : cv[0][0]; v2[0][1] = last ? nv[0][1] : cv[0][1]; v2[1][0] = last ? nv[1][0] : cv[1][0]; v2[1][1] = last ? nv[1][1] : cv[1][1]; }
            else { v2[0][0] = cv[0][0]; v2[0][1] = cv[0][1]; v2[1][0] = cv[1][0]; v2[1][1] = cv[1][1]; }
            PG8_LDB(B0, 0, 0); PG8_LDB(B1, 0, 1); PG8_SCHED; PG8_LDA(At, 0, 0); PG8_STAGE(PG8_SA(1, 1), a1, cv[1]);
            PG8_WAIT_V(8); PG8_WAIT_L(0); PG8_BAR; PG8_MMA(0, 0, At, B0); PG8_MMA(0, 1, At, B1); PG8_BAR; PG8_SCHED;
            PG8_LDA(At, 0, 1); PG8_STAGE(PG8_SB(0, 0), b2, voffB); PG8_STAGE(PG8_SB(0, 1), b2 + hstep, voffB); PG8_STAGE(PG8_SA(0, 0), a2, v2[0]);
            PG8_WAIT_V(8); PG8_WAIT_L(0); PG8_BAR; PG8_MMA(1, 0, At, B0); PG8_MMA(1, 1, At, B1); PG8_BAR; PG8_SCHED;
            PG8_LDB(B0, 1, 0); PG8_LDB(B1, 1, 1); PG8_SCHED; PG8_LDA(At, 1, 0); PG8_STAGE(PG8_SA(0, 1), a2, v2[1]);
            PG8_WAIT_V(8); PG8_WAIT_L(0); PG8_BAR; PG8_MMA(0, 0, At, B0); PG8_MMA(0, 1, At, B1); PG8_BAR; PG8_SCHED;
            PG8_LDA(At, 1, 1); PG8_STAGE(PG8_SB(1, 0), b3, voffB); PG8_STAGE(PG8_SB(1, 1), b3 + hstep, voffB); PG8_STAGE(PG8_SA(1, 0), a3, v2[0]);
            PG8_WAIT_V(8); PG8_WAIT_L(0); PG8_BAR; PG8_MMA(1, 0, At, B0); PG8_MMA(1, 1, At, B1); PG8_BAR; PG8_SCHED;
        }
        if constexpr (ALIGN_EPI) { if (wr == 0) PG8_BAR; }
        { int fr_ = fr, fq_ = fq; asm volatile("" : "+v"(fr_), "+v"(fq_));
          E(acc, cur, wr, wc, fr_, fq_); }
        if (!has_next) break;
#pragma unroll
        for (int a = 0; a < 2; ++a)
#pragma unroll
            for (int b = 0; b < 2; ++b)
#pragma unroll
                for (int m = 0; m < 4; ++m)
#pragma unroll
                    for (int n = 0; n < 2; ++n) acc[a][b][m][n] = (f32x4){0.f, 0.f, 0.f, 0.f};
        cur = nxt; cA = nA; cB = nB; ++ui;
        if (GATHER) { cv[0][0] = nv[0][0]; cv[0][1] = nv[0][1]; cv[1][0] = nv[1][0]; cv[1][1] = nv[1][1]; }
        if constexpr (ALIGN_EPI) { if (wr == 1) PG8_BAR; }
    }
    PG8_WAIT_V(0);
    if constexpr (!ALIGN_EPI) { if (wr == 0) PG8_BAR; }
    PG8_BAR;
#undef PG8_SA
#undef PG8_SB
#undef PG8_STAGE
#undef PG8_LDA
#undef PG8_LDB
#undef PG8_MMA
#undef PG8_WAIT_V
#undef PG8_WAIT_L
#undef PG8_BAR
#undef PG8_SCHED
}

struct DenseOrder {
    int nM, nN, nwg, G, c, K;
    int kl, bsel;
    const char* A; const char* B; size_t asel_stride; int asel_div, ascan;
    __device__ void init(int M_, int N_, int K_, int G_, int c_, const void* A_, const void* B_, int asel_div_, size_t asel_stride_) {
        nM = M_ / BM; nN = N_ / BM; nwg = nM * nN; G = G_; c = c_; K = K_; A = (const char*)A_; B = (const char*)B_; asel_div = asel_div_; asel_stride = asel_stride_; ascan = 0; kl = 0; bsel = 0; }
    __device__ __forceinline__ bool next(int i, Unit& u) const {
        if (c < 0 || c >= G) return false;
        const long L = (long)i * G + c; if (L >= nwg) return false;
        int wgid = (int)L; { const int q = nwg / NXCD, r = nwg % NXCD, xcd = wgid % NXCD, off = wgid / NXCD; wgid = (xcd < r ? xcd * (q + 1) : r * (q + 1) + (xcd - r) * q) + off; }
        const int nig = WGM * nN, gid = wgid / nig, fm = gid * WGM, gsz = (nM - fm) < WGM ? (nM - fm) : WGM;
        u.pm = fm + ((wgid % nig) % gsz); u.pn = (wgid % nig) / gsz;
        u.A = ascan ? A + 2 * ((size_t)(u.pm >> 3) * 2097152 + (size_t)((u.pm * 4) & 31) * 4096) : A + (size_t)(u.pn / asel_div) * asel_stride + (size_t)u.pm * BM * K * 2;
        u.B = B + (size_t)u.pn * BM * K * 2 + (bsel ? (size_t)(u.pn / asel_div) * asel_stride : (size_t)0);
        u.e = 0; u.r0 = 0; u.nvalid = BM; u.pad = 0; return true;
    }
    __device__ __forceinline__ void fill(const Unit&, const int (&R)[2], const int (&C)[2], int K_, unsigned (&v)[2][2]) const {
#pragma unroll
        for (int h = 0; h < 2; ++h)
#pragma unroll
            for (int i = 0; i < 2; ++i) { const int lr = h * HALF + R[i]; v[h][i] = ascan ? (unsigned)((lr >> 6) * 4096 + (lr & 63) * 8 + (C[i] >> 3) * 512) * 2u : (unsigned)(lr * K_ + C[i]) * 2u; }
    }
    __device__ __forceinline__ size_t kstepA() const { return ascan ? (size_t)262144 : (size_t)(BK * 2); }
    __device__ __forceinline__ int kloop(int K_) const { return kl ? kl : K_; }
};
struct MoeOrder {
    const int* counts; const int* rtok; const char* A; const char* B; size_t bexp_stride;
    int nN, K, gather, base, stride, hi;
    __device__ __forceinline__ bool next(int i, Unit& u) const {
        const int L = base + i * stride; if (L >= hi) return false;
        const int rt = L / nN; int acc = 0;
        for (int e = 0; e < NE; ++e) {
            const int cnt = counts[e * 64], ntile = (cnt + 255) >> 8;
            if (rt < acc + ntile) {
                u.pm = rt; u.pn = L % nN; u.e = e; u.r0 = (rt - acc) * 256; u.nvalid = min(256, cnt - u.r0); u.pad = 0;
                u.A = gather ? A : A + (size_t)rt * BM * K * 2; u.B = B + (size_t)e * bexp_stride + (size_t)u.pn * BM * K * 2; return true;
            }
            acc += ntile;
        }
        return false;
    }
    __device__ __forceinline__ void fill(const Unit& u, const int (&R)[2], const int (&C)[2], int K_, unsigned (&v)[2][2]) const {
#pragma unroll
        for (int h = 0; h < 2; ++h)
#pragma unroll
            for (int i = 0; i < 2; ++i) {
                const int rl = h * HALF + R[i];
                if (gather) { const int tok = (rl < u.nvalid) ? rtok[u.e * CAP + u.r0 + rl] : 0; v[h][i] = (unsigned)(tok * K_ + C[i]) * 2u; }
                else v[h][i] = (unsigned)(rl * K_ + C[i]) * 2u;
            }
    }
    __device__ __forceinline__ size_t kstepA() const { return (size_t)(BK * 2); }
    __device__ __forceinline__ int kloop(int K_) const { return K_; }
};

__device__ __forceinline__ size_t scan_idx(int row, int col) { return ((size_t)((((row >> 11) * H + (col >> 6)) * 32 + ((row >> 6) & 31)) * 8 + ((col >> 3) & 7)) * 64 + (row & 63)) * 8 + (col & 7); }
struct EpiBf16 {
    static constexpr bool PERM = true;
    bf16* O; int ldc, split_div; size_t split_stride; float scale0; int act, scanlay;
    __device__ __forceinline__ void operator()(const f32x4 (&acc)[2][2][4][2], const Unit& u, int wr, int wc, int fr, int fq) const {
        const int t = u.pn / split_div; bf16* base = O + (size_t)t * split_stride;
        const int colt = (u.pn - t * split_div) * BM;
        const float sc = (t == 0) ? scale0 : 1.f;
        const int row0 = u.pm * BM + wr * 64 + fr, col0 = colt + wc * 32 + 8 * fq;
#pragma unroll
        for (int ai = 0; ai < 2; ++ai)
#pragma unroll
            for (int m = 0; m < 4; ++m) { const int row = row0 + ai * HALF + m * 16; bf16* rowp = base + (size_t)row * ldc + col0;
#pragma unroll
                for (int bj = 0; bj < 2; ++bj) { f32x4 v0 = acc[ai][bj][m][0] * sc, v1 = acc[ai][bj][m][1] * sc;
                    if (act == 1) {
                        if (bj == 0 && wc < 2) { v0.x = tanh_fast(v0.x); v0.y = tanh_fast(v0.y); v0.z = tanh_fast(v0.z); v0.w = tanh_fast(v0.w); v1.x = tanh_fast(v1.x); v1.y = tanh_fast(v1.y); v1.z = tanh_fast(v1.z); v1.w = tanh_fast(v1.w); }
                        else if (bj == 1) { v0.x = sigmoid_fast(v0.x); v0.y = sigmoid_fast(v0.y); v0.z = sigmoid_fast(v0.z); v0.w = sigmoid_fast(v0.w); v1.x = sigmoid_fast(v1.x); v1.y = sigmoid_fast(v1.y); v1.z = sigmoid_fast(v1.z); v1.w = sigmoid_fast(v1.w); }
                    }
                    u32x4 w; w.x = cvt_pk_bf16(v0[0], v0[1]); w.y = cvt_pk_bf16(v0[2], v0[3]); w.z = cvt_pk_bf16(v1[0], v1[1]); w.w = cvt_pk_bf16(v1[2], v1[3]);
                    bf16* dst = (scanlay != 0) ? base + scan_idx(row, col0 + bj * HALF) : rowp + bj * HALF;
                    *(u32x4*)dst = w; } }
    }
};
struct EpiLora2 {
    static constexpr bool PERM = true;
    _Float16* LW; bf16* AG; const float* w0; const float* a0;
    __device__ __forceinline__ void operator()(const f32x4 (&acc)[2][2][4][2], const Unit& u, int wr, int wc, int fr, int fq) const {
        const int t = u.pn >> 2, colt = (u.pn & 3) * BM;
        const int row0 = u.pm * BM + wr * 64 + fr, col0 = colt + wc * 32 + 8 * fq;
        if (t == 0) {
#pragma unroll
            for (int bj = 0; bj < 2; ++bj) {
                const f32x4 b0 = *(const f32x4*)(w0 + col0 + bj * HALF), b1 = *(const f32x4*)(w0 + col0 + bj * HALF + 4);
#pragma unroll
                for (int ai = 0; ai < 2; ++ai)
#pragma unroll
                    for (int m = 0; m < 4; ++m) {
                        const size_t o = scan_idx(row0 + ai * HALF + m * 16, col0 + bj * HALF);
                        const f32x4 v0 = acc[ai][bj][m][0] + b0, v1 = acc[ai][bj][m][1] + b1;
                        typedef _Float16 h8 __attribute__((ext_vector_type(8)));
                        h8 hv;
                        hv[0] = (_Float16)(-0.87503877f * sigmoid_fast(v0.x)); hv[1] = (_Float16)(-0.87503877f * sigmoid_fast(v0.y));
                        hv[2] = (_Float16)(-0.87503877f * sigmoid_fast(v0.z)); hv[3] = (_Float16)(-0.87503877f * sigmoid_fast(v0.w));
                        hv[4] = (_Float16)(-0.87503877f * sigmoid_fast(v1.x)); hv[5] = (_Float16)(-0.87503877f * sigmoid_fast(v1.y));
                        hv[6] = (_Float16)(-0.87503877f * sigmoid_fast(v1.z)); hv[7] = (_Float16)(-0.87503877f * sigmoid_fast(v1.w));
                        *(h8*)(LW + o) = hv;
                    }
            }
        } else if (t == 1) {
#pragma unroll
            for (int bj = 0; bj < 2; ++bj) {
                const f32x4 b0 = *(const f32x4*)(a0 + col0 + bj * HALF), b1 = *(const f32x4*)(a0 + col0 + bj * HALF + 4);
#pragma unroll
                for (int ai = 0; ai < 2; ++ai)
#pragma unroll
                    for (int m = 0; m < 4; ++m) {
                        const size_t o = scan_idx(row0 + ai * HALF + m * 16, col0 + bj * HALF);
                        const f32x4 v0 = acc[ai][bj][m][0] + b0, v1 = acc[ai][bj][m][1] + b1;
                        u32x4 w; w.x = cvt_pk_bf16(sigmoid_fast(v0.x), sigmoid_fast(v0.y)); w.y = cvt_pk_bf16(sigmoid_fast(v0.z), sigmoid_fast(v0.w));
                        w.z = cvt_pk_bf16(sigmoid_fast(v1.x), sigmoid_fast(v1.y)); w.w = cvt_pk_bf16(sigmoid_fast(v1.z), sigmoid_fast(v1.w));
                        *(u32x4*)(AG + o) = w;
                    }
            }
        } else {
#pragma unroll
            for (int bj = 0; bj < 2; ++bj)
#pragma unroll
                for (int ai = 0; ai < 2; ++ai)
#pragma unroll
                    for (int m = 0; m < 4; ++m) {
                        const size_t o = (size_t)M * D + (size_t)(row0 + ai * HALF + m * 16) * D + col0 + bj * HALF;
                        const f32x4 v0 = acc[ai][bj][m][0], v1 = acc[ai][bj][m][1];
                        u32x4 w; w.x = cvt_pk_bf16(v0.x, v0.y); w.y = cvt_pk_bf16(v0.z, v0.w); w.z = cvt_pk_bf16(v1.x, v1.y); w.w = cvt_pk_bf16(v1.z, v1.w);
                        *(u32x4*)(AG + o) = w;
                    }
        }
    }
};
struct EpiPre {
    static constexpr bool PERM = true;
    const float* hin32; const bf16* hin16; bf16* out;
    __device__ __forceinline__ void operator()(const f32x4 (&acc)[2][2][4][2], const Unit& u, int wr, int wc, int fr, int fq) const {
        const int row0 = u.pm * BM + wr * 64 + fr, col0 = u.pn * BM + wc * 32 + 8 * fq;
#pragma unroll
        for (int ai = 0; ai < 2; ++ai)
#pragma unroll
            for (int m = 0; m < 4; ++m) { const size_t ro = (size_t)(row0 + ai * HALF + m * 16) * D + col0;
#pragma unroll
                for (int bj = 0; bj < 2; ++bj) { const size_t o = ro + bj * HALF;
                    f32x4 h0, h1;
                    if (hin32) { h0 = *(const f32x4*)(hin32 + o); h1 = *(const f32x4*)(hin32 + o + 4); }
                    else { const u32x4 hv = *(const u32x4*)(hin16 + o); h0 = (f32x4){bf2f(hv.x & 0xffff), bf2f(hv.x >> 16), bf2f(hv.y & 0xffff), bf2f(hv.y >> 16)}; h1 = (f32x4){bf2f(hv.z & 0xffff), bf2f(hv.z >> 16), bf2f(hv.w & 0xffff), bf2f(hv.w >> 16)}; }
                    const f32x4 v0 = h0 * ALPHA + acc[ai][bj][m][0], v1 = h1 * ALPHA + acc[ai][bj][m][1];
                    u32x4 w; w.x = cvt_pk_bf16(v0[0], v0[1]); w.y = cvt_pk_bf16(v0[2], v0[3]); w.z = cvt_pk_bf16(v1[0], v1[1]); w.w = cvt_pk_bf16(v1[2], v1[3]);
                    *(u32x4*)(out + o) = w; } }
    }
};
struct EpiGU {
    static constexpr bool PERM = true;
    bf16* hid;
    __device__ __forceinline__ void operator()(const f32x4 (&acc)[2][2][4][2], const Unit& u, int wr, int wc, int fr, int fq) const {
        const int row0 = u.pm * BM + wr * 64 + fr, col0 = u.pn * 128 + wc * 16 + 4 * fq;
#pragma unroll
        for (int ai = 0; ai < 2; ++ai)
#pragma unroll
            for (int m = 0; m < 4; ++m) { bf16* rowp = hid + (size_t)(row0 + ai * HALF + m * 16) * DE + col0;
#pragma unroll
                for (int bj = 0; bj < 2; ++bj) { const f32x4 g = acc[ai][bj][m][0], uu = acc[ai][bj][m][1];
                    u32x2 w; w.x = cvt_pk_bf16(g.x * sigmoid_fast(g.x) * uu.x, g.y * sigmoid_fast(g.y) * uu.y); w.y = cvt_pk_bf16(g.z * sigmoid_fast(g.z) * uu.z, g.w * sigmoid_fast(g.w) * uu.w);
                    *(u32x2*)(rowp + bj * 64) = w; } }
    }
};
struct EpiDN {
    static constexpr bool PERM = true;
    bf16* y; const float* rgate;
    __device__ __forceinline__ void operator()(const f32x4 (&acc)[2][2][4][2], const Unit& u, int wr, int wc, int fr, int fq) const {
        const int col0 = u.pn * BM + wc * 32 + 8 * fq;
#pragma unroll
        for (int ai = 0; ai < 2; ++ai)
#pragma unroll
            for (int m = 0; m < 4; ++m) { const int rl = ai * HALF + wr * 64 + m * 16 + fr;
                if (rl < u.nvalid) { const float gt = rgate[u.e * CAP + u.r0 + rl]; bf16* rowp = y + (size_t)(u.pm * BM + rl) * D + col0;
#pragma unroll
                    for (int bj = 0; bj < 2; ++bj) { const f32x4 v0 = acc[ai][bj][m][0] * gt, v1 = acc[ai][bj][m][1] * gt;
                        u32x4 w; w.x = cvt_pk_bf16(v0[0], v0[1]); w.y = cvt_pk_bf16(v0[2], v0[3]); w.z = cvt_pk_bf16(v1[0], v1[1]); w.w = cvt_pk_bf16(v1[2], v1[3]);
                        *(u32x4*)(rowp + bj * HALF) = w; } } }
    }
};
}

__device__ __forceinline__ void tr_load(const float* W, int ld, int k0, int n0, float (&v)[32], int lane) {
#pragma unroll
    for (int i = 0; i < 32; ++i) v[i] = W[(size_t)(k0 + 2 * i + (lane >> 5)) * ld + n0 + (lane & 31)];
}
__device__ __forceinline__ void tr_put(const float (&v)[32], int k0, int n0, const float* kscale, bf16* WT, int Kd, int koff, int drow0, int mode, LAS float* scr, int lane) {
#pragma unroll
    for (int i = 0; i < 32; ++i) { const int kk = 2 * i + (lane >> 5); float x = v[i]; if (kscale) x *= kscale[k0 + kk]; scr[kk * 33 + (lane & 31)] = x; }
    asm volatile("s_waitcnt lgkmcnt(0)" ::: "memory");
    const int c = lane & 7;
#pragma unroll
    for (int j = 0; j < 4; ++j) { const int n = (lane >> 3) + 8 * j; const LAS float* s = scr + (8 * c) * 33 + n;
        u32x4 o; o.x = pk2(s[0 * 33], s[1 * 33]); o.y = pk2(s[2 * 33], s[3 * 33]); o.z = pk2(s[4 * 33], s[5 * 33]); o.w = pk2(s[6 * 33], s[7 * 33]);
        const int nn = n0 + n; const int drow = (mode == 0) ? (drow0 + nn) : (drow0 + 8 * (nn >> 2) + (nn & 3) + (mode == 2 ? 4 : 0));
        *(u32x4*)(WT + (size_t)drow * Kd + koff + k0 + 8 * c) = o; }
    asm volatile("s_waitcnt lgkmcnt(0)" ::: "memory");
}
__device__ __forceinline__ void tr_item(const float* W, int ld, int k0, int n0, const float* kscale, bf16* WT, int Kd, int koff, int drow0, int mode, LAS float* scr, int lane) {
    float v[32]; tr_load(W, ld, k0, n0, v, lane); tr_put(v, k0, n0, kscale, WT, Kd, koff, drow0, mode, scr, lane);
}
__device__ __forceinline__ int tr_matrix(int item_base, int gw, int NGW, const float* W, int ld, int Ks, int Ns, const float* kscale, bf16* WT, int Kd, int koff, int drow0, int mode, LAS float* scr, int lane) {
    const int nblk = Ns / 32, nit = (Ks / 64) * nblk;
    int first = gw - (item_base % NGW); if (first < 0) first += NGW;
    for (int it = first; it < nit; it += NGW) tr_item(W, ld, 64 * (it / nblk), 32 * (it % nblk), kscale, WT, Kd, koff, drow0, mode, scr, lane);
    return item_base + nit;
}
struct MoeItem { const float* W; bf16* WT; int ld, k0, n0, Kd, mode; };
__device__ __forceinline__ MoeItem moe_item(int it, const float* wg, const float* wu, const float* wd, bf16* gut, bf16* dnt) {
    const int e = it / 768, r = it % 768; MoeItem m;
    if (r < 512) { const int q = r & 255; m.W = (r < 256 ? wg : wu) + (size_t)e * D * DE; m.ld = DE; m.k0 = 64 * (q / 16); m.n0 = 32 * (q % 16); m.WT = gut + (size_t)e * D * D; m.Kd = D; m.mode = r < 256 ? 1 : 2; }
    else { const int q = r - 512; m.W = wd + (size_t)e * DE * D; m.ld = D; m.k0 = 64 * (q / 32); m.n0 = 32 * (q % 32); m.WT = dnt + (size_t)e * D * DE; m.Kd = DE; m.mode = 0; }
    return m;
}
__device__ __forceinline__ void convert_moe(const float* wg, const float* wu, const float* wd, bf16* gut, bf16* dnt, int gw, int NGW, LAS float* scr, int lane) {
    float va[32], vb[32];
    int it = gw;
    if (it < NE * 768) { const MoeItem m = moe_item(it, wg, wu, wd, gut, dnt); tr_load(m.W, m.ld, m.k0, m.n0, va, lane); }
    while (it < NE * 768) {
        const MoeItem ma = moe_item(it, wg, wu, wd, gut, dnt);
        const int itb = it + NGW;
        if (itb < NE * 768) { const MoeItem m = moe_item(itb, wg, wu, wd, gut, dnt); tr_load(m.W, m.ld, m.k0, m.n0, vb, lane); }
        tr_put(va, ma.k0, ma.n0, nullptr, ma.WT, ma.Kd, 0, 0, ma.mode, scr, lane);
        if (itb >= NE * 768) break;
        const MoeItem mb = moe_item(itb, wg, wu, wd, gut, dnt);
        const int itc = itb + NGW;
        if (itc < NE * 768) { const MoeItem m = moe_item(itc, wg, wu, wd, gut, dnt); tr_load(m.W, m.ld, m.k0, m.n0, va, lane); }
        tr_put(vb, mb.k0, mb.n0, nullptr, mb.WT, mb.Kd, 0, 0, mb.mode, scr, lane);
        it = itc;
    }
}
constexpr int CNT_STRIDE = 64;
constexpr int RT = 2;
template <int CTRL> __device__ __forceinline__ float dppx(float v) { return __int_as_float(__builtin_amdgcn_update_dpp(0, __float_as_int(v), CTRL, 0xF, 0xF, false)); }
__device__ __forceinline__ float red8(float v) { v += dppx<0xB1>(v); v += dppx<0x4E>(v); v += dppx<0x141>(v); return v; }
__device__ __forceinline__ float red16(float v) { v = red8(v); v += dppx<0x140>(v); return v; }
__device__ __forceinline__ float red64(float v, int lane) { v = red16(v); v += shx(v, 16, lane); v += shx(v, 32, lane); return v; }
__device__ __forceinline__ void ln_rowsN(f32x4 (&v)[RT][4], const float* g, const float* b, int lane) {
    float s[RT];
#pragma unroll
    for (int t = 0; t < RT; ++t) { s[t] = 0.f;
#pragma unroll
        for (int j = 0; j < 4; ++j) s[t] += (v[t][j].x + v[t][j].y) + (v[t][j].z + v[t][j].w); }
#pragma unroll
    for (int t = 0; t < RT; ++t) s[t] = red64(s[t], lane);
    float s2[RT];
#pragma unroll
    for (int t = 0; t < RT; ++t) { const float mean = s[t] * (1.f / D); s2[t] = 0.f;
#pragma unroll
        for (int j = 0; j < 4; ++j) { v[t][j] = v[t][j] - mean; s2[t] += (v[t][j].x * v[t][j].x + v[t][j].y * v[t][j].y) + (v[t][j].z * v[t][j].z + v[t][j].w * v[t][j].w); } }
#pragma unroll
    for (int t = 0; t < RT; ++t) s2[t] = red64(s2[t], lane);
#pragma unroll
    for (int j = 0; j < 4; ++j) {
        const f32x4 gg = *(const f32x4*)(g + 4 * lane + 256 * j), bb = *(const f32x4*)(b + 4 * lane + 256 * j);
#pragma unroll
        for (int t = 0; t < RT; ++t) { const float rstd = rsqrtf(s2[t] * (1.f / D) + LN_EPS); v[t][j] = v[t][j] * rstd * gg + bb; }
    }
}
__device__ __forceinline__ void stage_w16(const float* Wm, int ldw, f32x4* wl, int tid) {
    for (int i = tid; i < 4096; i += 512) { const int c = i >> 2, e4 = i & 3, jq = (c >> 8) * 4 + (c & 3), ln = (c & 255) >> 2;
        wl[(jq * 4 + e4) * 64 + ln] = *(const f32x4*)(Wm + (size_t)c * ldw + 4 * e4); }
}
__device__ __forceinline__ float rowsN_dot16(const f32x4 (&v)[RT][4], const f32x4* wl, int lane) {
    float a[RT * 16];
#pragma unroll
    for (int i = 0; i < RT * 16; ++i) a[i] = 0.f;
    int lw = lane;
#pragma unroll
    for (int idx = 0; idx < 16; ++idx) {
        const int j = idx >> 2, q = idx & 3;
        if ((idx & 3) == 0) {
#pragma unroll
            for (int t = 0; t < RT; ++t)
                asm volatile("" : "+v"(lw), "+v"(a[t * 16 + 0]), "+v"(a[t * 16 + 1]), "+v"(a[t * 16 + 2]), "+v"(a[t * 16 + 3]), "+v"(a[t * 16 + 4]), "+v"(a[t * 16 + 5]), "+v"(a[t * 16 + 6]), "+v"(a[t * 16 + 7]),
                             "+v"(a[t * 16 + 8]), "+v"(a[t * 16 + 9]), "+v"(a[t * 16 + 10]), "+v"(a[t * 16 + 11]), "+v"(a[t * 16 + 12]), "+v"(a[t * 16 + 13]), "+v"(a[t * 16 + 14]), "+v"(a[t * 16 + 15]));
        }
        const f32x4 w0 = wl[(idx * 4 + 0) * 64 + lw], w1 = wl[(idx * 4 + 1) * 64 + lw], w2 = wl[(idx * 4 + 2) * 64 + lw], w3 = wl[(idx * 4 + 3) * 64 + lw];
#pragma unroll
        for (int t = 0; t < RT; ++t) {
            const float hv = q == 0 ? v[t][j].x : (q == 1 ? v[t][j].y : (q == 2 ? v[t][j].z : v[t][j].w));
            a[t * 16 + 0] += hv * w0.x; a[t * 16 + 1] += hv * w0.y; a[t * 16 + 2] += hv * w0.z; a[t * 16 + 3] += hv * w0.w;
            a[t * 16 + 4] += hv * w1.x; a[t * 16 + 5] += hv * w1.y; a[t * 16 + 6] += hv * w1.z; a[t * 16 + 7] += hv * w1.w;
            a[t * 16 + 8] += hv * w2.x; a[t * 16 + 9] += hv * w2.y; a[t * 16 + 10] += hv * w2.z; a[t * 16 + 11] += hv * w2.w;
            a[t * 16 + 12] += hv * w3.x; a[t * 16 + 13] += hv * w3.y; a[t * 16 + 14] += hv * w3.z; a[t * 16 + 15] += hv * w3.w;
        }
    }
#define TRED(o, n) do { const bool up_ = (lane & (o)) != 0; _Pragma("unroll") for (int i = 0; i < (n); ++i) { const float keep_ = up_ ? a[i + (n)] : a[i]; const float send_ = up_ ? a[i] : a[i + (n)]; a[i] = keep_ + shx(send_, (o), lane); } } while (0)
#pragma unroll
    for (int i = 0; i < RT * 16; ++i) a[i] += shx(a[i], 32, lane);
    if constexpr (RT == 1) {
#pragma unroll
        for (int i = 0; i < 16; ++i) a[i] += shx(a[i], 16, lane);
    } else { TRED(16, 16); }
    TRED(8, 8); TRED(4, 4); TRED(2, 2); TRED(1, 1);
#undef TRED
    return a[0];
}
__device__ __forceinline__ void store_rowsN(const f32x4 (&v)[RT][4], float* h, bf16* hb, int tok0, int lane) {
#pragma unroll
    for (int t = 0; t < RT; ++t)
#pragma unroll
        for (int j = 0; j < 4; ++j) {
            if (h) *(f32x4*)(h + (size_t)(tok0 + t) * D + 4 * lane + 256 * j) = v[t][j];
            if (hb) { u32x2 o; o.x = pk2(v[t][j].x, v[t][j].y); o.y = pk2(v[t][j].z, v[t][j].w);
                *(u32x2*)(hb + (size_t)(tok0 + t) * D + 4 * lane + 256 * j) = o; }
        }
}
__device__ __forceinline__ f32x4 ld_bf4(const bf16* p) { const u32x2 a = *(const u32x2*)p; return (f32x4){bf2f(a.x & 0xffff), bf2f(a.x >> 16), bf2f(a.y & 0xffff), bf2f(a.y >> 16)}; }

struct LnRouteP { const bf16* pin; bf16* hb; const float* g; const float* b; const unsigned char* wfg; const float* rbias; int* counts; int* rtok; float* rgate; int* slot; };
__device__ __forceinline__ void build_router_frags(const float* g, const float* b, const float* rw, unsigned char* out, unsigned char* lds, int tid) {
    float* prt = (float*)(lds + 6400);
    u32x4* WFo = (u32x4*)out; float* csc0 = (float*)(out + 65536);
    __syncthreads();
    for (int f = tid; f < 2048; f += 512) { const int kk = f >> 6, l = f & 63, e = l & 15, k0 = 32 * kk + 8 * (l >> 4);
        float wv8[8]; unsigned hi[4], lo[4];
#pragma unroll
        for (int q = 0; q < 8; ++q) wv8[q] = g[k0 + q] * rw[(size_t)(k0 + q) * NE + e];
#pragma unroll
        for (int q = 0; q < 4; ++q) { hi[q] = pk2(wv8[2 * q], wv8[2 * q + 1]); lo[q] = pk2(wv8[2 * q] - bf2f(hi[q] & 0xffff), wv8[2 * q + 1] - bf2f(hi[q] >> 16)); }
        u32x4 h4 = {hi[0], hi[1], hi[2], hi[3]}, l4 = {lo[0], lo[1], lo[2], lo[3]};
        WFo[(kk * 2 + 0) * 64 + l] = h4; WFo[(kk * 2 + 1) * 64 + l] = l4; }
    {   const int e = tid & 15, part = tid >> 4; float a0 = 0.f, a1 = 0.f;
#pragma unroll 8
        for (int q = 0; q < 32; ++q) { const int k = 32 * part + q; const float r = rw[(size_t)k * NE + e]; a0 += g[k] * r; a1 += b[k] * r; }
        prt[part * 16 + e] = a0; prt[512 + part * 16 + e] = a1; }
    __syncthreads();
    if (tid < 32) { const int e = tid & 15, which = tid >> 4; float a = 0.f;
#pragma unroll 8
        for (int q = 0; q < 32; ++q) a += prt[which * 512 + q * 16 + e];
        csc0[which * 16 + e] = a; }
    __syncthreads();
}
__device__ __forceinline__ void ph_ln_route(const LnRouteP& p, unsigned char* lds, const int wv_s) {
    const int tid = opaque_tid(wv_s); const int lane = tid & 63, wv = tid >> 6;
    int* sel_e = (int*)lds;
    float* sel_g = (float*)(lds + 512);
    int* lrank = (int*)(lds + 1024);
    int* lcnt = (int*)(lds + 1536);
    int* lbase = (int*)(lds + 1600);
    float* cs = (float*)(lds + 1664);
    float* c0 = (float*)(lds + 1728);
    float* st = (float*)(lds + 1792);
    float* lg = (float*)(lds + 2304);
    float* prt = (float*)(lds + 6400);
    bf16x8* WF = (bf16x8*)(lds + 16384);
    {
        const u32x4* wsrc = (const u32x4*)p.wfg; u32x4 tmp[8];
#pragma unroll
        for (int i = 0; i < 8; ++i) tmp[i] = wsrc[tid + 512 * i];
#pragma unroll
        for (int i = 0; i < 8; ++i) *(u32x4*)&WF[tid + 512 * i] = tmp[i];
        if (tid < 32) { const float x = ((const float*)(p.wfg + 65536))[tid]; if (tid < 16) cs[tid] = x; else c0[tid - 16] = x; }
        __syncthreads();
    }
    for (int tb = blockIdx.x * 64; tb < M; tb += gridDim.x * 64) {
        { const int tid0 = opaque_tid(wv_s); if (tid0 < 16) lcnt[tid0] = 0; }
        u32x2 raw[64 / (8 * RT)][RT][4];
#pragma unroll
        for (int rd = 0; rd < 64 / (8 * RT); ++rd)
#pragma unroll
            for (int t = 0; t < RT; ++t)
#pragma unroll
                for (int j = 0; j < 4; ++j) raw[rd][t][j] = *(const u32x2*)(p.pin + (size_t)(tb + rd * 8 * RT + wv * RT + t) * D + 4 * lane + 256 * j);
#pragma unroll
        for (int rd = 0; rd < 64 / (8 * RT); ++rd) {
            const int tl0 = rd * 8 * RT + wv * RT, tok0 = tb + tl0;
            int lane_r = lane; asm volatile("" : "+v"(lane_r));
            f32x4 v[RT][4];
#pragma unroll
            for (int t = 0; t < RT; ++t)
#pragma unroll
                for (int j = 0; j < 4; ++j) { const u32x2 a = raw[rd][t][j]; v[t][j] = (f32x4){bf2f(a.x & 0xffff), bf2f(a.x >> 16), bf2f(a.y & 0xffff), bf2f(a.y >> 16)}; }
            float s1[RT], s2[RT];
#pragma unroll
            for (int t = 0; t < RT; ++t) { float a = 0.f;
#pragma unroll
                for (int j = 0; j < 4; ++j) a += (v[t][j].x + v[t][j].y) + (v[t][j].z + v[t][j].w);
                s1[t] = red64(a, lane_r) * (1.f / D); }
#pragma unroll
            for (int t = 0; t < RT; ++t) { float a = 0.f;
#pragma unroll
                for (int j = 0; j < 4; ++j) { v[t][j] = v[t][j] - s1[t]; a += (v[t][j].x * v[t][j].x + v[t][j].y * v[t][j].y) + (v[t][j].z * v[t][j].z + v[t][j].w * v[t][j].w); }
                s2[t] = rsqrtf(red64(a, lane_r) * (1.f / D) + LN_EPS); }
#pragma unroll
            for (int j = 0; j < 4; ++j) {
                const f32x4 gg = *(const f32x4*)(p.g + 4 * lane_r + 256 * j), bb = *(const f32x4*)(p.b + 4 * lane_r + 256 * j);
#pragma unroll
                for (int t = 0; t < RT; ++t) v[t][j] = v[t][j] * s2[t] * gg + bb;
            }
            store_rowsN(v, nullptr, p.hb, tok0, lane_r);
            if (lane_r == 0) {
#pragma unroll
                for (int t = 0; t < RT; ++t) { st[2 * (tl0 + t)] = s1[t]; st[2 * (tl0 + t) + 1] = s2[t]; } }
        }
        if (wv < 4) {
            int lane_r = lane; asm volatile("" : "+v"(lane_r));
            const int fr = lane_r & 15, fq = lane_r >> 4;
            const bf16* arow = p.pin + (size_t)(tb + 16 * wv + fr) * D + 8 * fq;
            f32x4 acc = (f32x4){0.f, 0.f, 0.f, 0.f};
#pragma unroll 8
            for (int kk = 0; kk < 32; ++kk) {
                const bf16x8 a = *(const bf16x8*)(arow + 32 * kk);
                acc = __builtin_amdgcn_mfma_f32_16x16x32_bf16(a, WF[(kk * 2 + 0) * 64 + lane_r], acc, 0, 0, 0);
                acc = __builtin_amdgcn_mfma_f32_16x16x32_bf16(a, WF[(kk * 2 + 1) * 64 + lane_r], acc, 0, 0, 0);
            }
#pragma unroll
            for (int i = 0; i < 4; ++i) lg[(16 * wv + 4 * fq + i) * 16 + fr] = acc[i];
        }
        __syncthreads();
        {
            const int tid2 = opaque_tid(wv_s);
            if (tid2 < 64) {
                const float mu = st[2 * tid2], rstd = st[2 * tid2 + 1];
                float s[16], ss[16];
#pragma unroll
                for (int e4 = 0; e4 < 4; ++e4) { const f32x4 raw = *(const f32x4*)&lg[tid2 * 16 + 4 * e4];
#pragma unroll
                    for (int q = 0; q < 4; ++q) { const int e = 4 * e4 + q; const float r = q == 0 ? raw.x : (q == 1 ? raw.y : (q == 2 ? raw.z : raw.w));
                        const float lgt = rstd * (r - mu * cs[e]) + c0[e]; s[e] = sigmoidf_(lgt); ss[e] = s[e] + p.rbias[e]; } }
                int gbest = 0; float gscore = -INFINITY; int l1b = 0, l2b = 1;
#pragma unroll
                for (int g = 0; g < 4; ++g) {
                    float v1 = ss[4 * g], v2 = -INFINITY; int i1 = 0, i2 = -1;
#pragma unroll
                    for (int i = 1; i < 4; ++i) {
                        const float x = ss[4 * g + i];
                        if (x > v1) { v2 = v1; i2 = i1; v1 = x; i1 = i; }
                        else if (x > v2) { v2 = x; i2 = i; }
                    }
                    const float sc = v1 + v2;
                    if (sc > gscore) { gscore = sc; gbest = g; l1b = i1; l2b = i2; }
                }
                const int e0 = 4 * gbest + l1b, e1 = 4 * gbest + l2b;
                float s0 = 0.f, s1v = 0.f;
#pragma unroll
                for (int e = 0; e < 16; ++e) { s0 = (e == e0) ? s[e] : s0; s1v = (e == e1) ? s[e] : s1v; }
                const float inv = 1.0f / (s0 + s1v);
                sel_e[2 * tid2] = e0; sel_e[2 * tid2 + 1] = e1; sel_g[2 * tid2] = s0 * inv; sel_g[2 * tid2 + 1] = s1v * inv;
                lrank[2 * tid2] = atomicAdd(&lcnt[e0], 1); lrank[2 * tid2 + 1] = atomicAdd(&lcnt[e1], 1);
            }
            __syncthreads();
            if (tid2 < 16) lbase[tid2] = atomicAdd(p.counts + tid2 * CNT_STRIDE, lcnt[tid2]);
            __syncthreads();
            if (tid2 < 128) {
                const int tl = tid2 >> 1, k = tid2 & 1, e = sel_e[2 * tl + k], r = lbase[e] + lrank[2 * tl + k];
                p.rtok[e * CAP + r] = tb + tl; p.rgate[e * CAP + r] = sel_g[2 * tl + k]; p.slot[2 * (tb + tl) + k] = e * CAP + r;
            }
            __syncthreads();
        }
    }
}

struct LnCombP { bf16* hb; const bf16* y; const int* slot; const int* counts; const float* g; const float* b; const float* wf; const float* bf; float* logf; float* outp; int do_f; int pad; };
__device__ __forceinline__ void ph_ln_comb(const LnCombP& p, unsigned char* lds, const int wv_s) {
    const int tid = opaque_tid(wv_s); const int lane = tid & 63, wv = tid >> 6;
    int* pstart = (int*)lds;
    f32x4* wl = (f32x4*)(lds + 2048);
    if (p.do_f) stage_w16(p.wf, NW_IN, wl, tid);
    if (tid == 0) { int acc = 0; for (int e = 0; e < NE; ++e) { pstart[e] = acc; acc += ((p.counts[e * CNT_STRIDE] + 255) >> 8) * 256; } }
    __syncthreads();
    u32x2 hr[RT][4], ya[RT][4], yb[RT][4];
#define LC_ISSUE(tk_, ln_) do { _Pragma("unroll") for (int t = 0; t < RT; ++t) { \
        const int sl0 = p.slot[2 * ((tk_) + t)], sl1 = p.slot[2 * ((tk_) + t) + 1]; \
        const int c0 = pstart[sl0 / CAP] + (sl0 % CAP), c1 = pstart[sl1 / CAP] + (sl1 % CAP); \
        _Pragma("unroll") for (int j = 0; j < 4; ++j) { hr[t][j] = *(const u32x2*)(p.hb + (size_t)((tk_) + t) * D + 4 * (ln_) + 256 * j); \
            ya[t][j] = *(const u32x2*)(p.y + (size_t)c0 * D + 4 * (ln_) + 256 * j); yb[t][j] = *(const u32x2*)(p.y + (size_t)c1 * D + 4 * (ln_) + 256 * j); } } } while (0)
    const int tok_first = (blockIdx.x * 8 + wv) * RT, tok_step = gridDim.x * 8 * RT;
    if (tok_first < M) LC_ISSUE(tok_first, lane);
#pragma unroll 1
    for (int tok0 = tok_first; tok0 < M; tok0 += tok_step) {
        int lane_r = lane; asm volatile("" : "+v"(lane_r));
        f32x4 v[RT][4];
#pragma unroll
        for (int t = 0; t < RT; ++t)
#pragma unroll
            for (int j = 0; j < 4; ++j) { const u32x2 h2 = hr[t][j], a = ya[t][j], bq = yb[t][j];
                v[t][j].x = ALPHA * bf2f(h2.x & 0xffff) + (bf2f(a.x & 0xffff) + bf2f(bq.x & 0xffff));
                v[t][j].y = ALPHA * bf2f(h2.x >> 16) + (bf2f(a.x >> 16) + bf2f(bq.x >> 16));
                v[t][j].z = ALPHA * bf2f(h2.y & 0xffff) + (bf2f(a.y & 0xffff) + bf2f(bq.y & 0xffff));
                v[t][j].w = ALPHA * bf2f(h2.y >> 16) + (bf2f(a.y >> 16) + bf2f(bq.y >> 16)); }
        if (tok0 + tok_step < M) LC_ISSUE(tok0 + tok_step, lane_r);
        ln_rowsN(v, p.g, p.b, lane_r);
        store_rowsN(v, p.outp, p.outp ? nullptr : p.hb, tok0, lane_r);
        if (p.do_f) {
            const float f = rowsN_dot16(v, wl, lane_r);
            if (lane_r < 16 * RT) p.logf[(size_t)(tok0 + (lane_r >> 4)) * 16 + (lane_r & 15)] = -softplusf_(-(f + p.bf[lane_r & 15]));
        }
    }
#undef LC_ISSUE
}

struct ScanP { const bf16* r; const bf16* k; const bf16* v; const _Float16* lw; const bf16* a; const bf16* g; bf16* yg;
               const float* kk; const float* ka; const float* rk; const float* gng; const float* gnb; };
__device__ __forceinline__ void ph_scan(const ScanP& p, unsigned char* lds, int nscan, const int wv_s) {
    typedef float (*arr64)[64];
    arr64 s_r = (arr64)lds, s_kk = (arr64)(lds + 8192), s_b = (arr64)(lds + 16384), s_w = (arr64)(lds + 24576), s_k = (arr64)(lds + 32768), s_v = (arr64)(lds + 40960), s_y = (arr64)(lds + 49152);
    float* s_bonus = (float*)(lds + 57344);
    const int tid = opaque_tid(wv_s);
    const int i = tid >> 3, jq = tid & 7;
    const int lt = tid >> 4, c4 = (tid & 15) * 4;
    for (int unit = blockIdx.x; unit < NB * H; unit += nscan) {
        const int b = unit / H, h = unit % H;
        f32x2 S[4];
#pragma unroll
        for (int j = 0; j < 4; ++j) S[j] = (f32x2){0.f, 0.f};
        const f32x4 kkp = *(const f32x4*)(p.kk + h * HD + c4), kap = *(const f32x4*)(p.ka + h * HD + c4), rkp = *(const f32x4*)(p.rk + h * HD + c4);
        const f32x4 gng = *(const f32x4*)(p.gng + h * HD + c4), gnb = *(const f32x4*)(p.gnb + h * HD + c4);
        typedef _Float16 h4 __attribute__((ext_vector_type(4)));
        size_t base = (size_t)(b * T + lt) * D + h * HD + c4;
        u32x2 r2 = *(const u32x2*)(p.r + base), k2 = *(const u32x2*)(p.k + base), v2 = *(const u32x2*)(p.v + base), a2 = *(const u32x2*)(p.a + base), g2 = *(const u32x2*)(p.g + base);
        h4 lwh = *(const h4*)(p.lw + base);
        for (int blk = 0; blk < T / 32; ++blk) {
            const size_t obase = base;
            const u32x2 g2c = g2;
            {
                const f32x4 lw4 = {(float)lwh[0], (float)lwh[1], (float)lwh[2], (float)lwh[3]};
                const f32x4 rr = {bf2f(r2.x & 0xffff), bf2f(r2.x >> 16), bf2f(r2.y & 0xffff), bf2f(r2.y >> 16)};
                const f32x4 kr = {bf2f(k2.x & 0xffff), bf2f(k2.x >> 16), bf2f(k2.y & 0xffff), bf2f(k2.y >> 16)};
                const f32x4 vv = {bf2f(v2.x & 0xffff), bf2f(v2.x >> 16), bf2f(v2.y & 0xffff), bf2f(v2.y >> 16)};
                const f32x4 aa = {bf2f(a2.x & 0xffff), bf2f(a2.x >> 16), bf2f(a2.y & 0xffff), bf2f(a2.y >> 16)};
                const f32x4 kkn = kr * kkp;
                const float ss = red16((kkn.x * kkn.x + kkn.y * kkn.y) + (kkn.z * kkn.z + kkn.w * kkn.w));
                const float inv = fminf(__builtin_amdgcn_rsqf(ss), 1e12f);
                const f32x4 kkv = kkn * inv;
                const f32x4 km = kr * (1.0f + (aa - 1.0f) * kap);
                const f32x4 bb = kkv * aa;
                f32x4 wd; wd.x = __expf(lw4.x); wd.y = __expf(lw4.y); wd.z = __expf(lw4.z); wd.w = __expf(lw4.w);
                const f32x4 bt = rr * km * rkp;
                const float bo = red16((bt.x + bt.y) + (bt.z + bt.w));
                *(f32x4*)&s_r[lt][c4] = rr; *(f32x4*)&s_kk[lt][c4] = kkv; *(f32x4*)&s_b[lt][c4] = bb; *(f32x4*)&s_w[lt][c4] = wd;
                *(f32x4*)&s_k[lt][c4] = km; *(f32x4*)&s_v[lt][c4] = vv;
                if ((tid & 15) == 0) s_bonus[lt] = bo;
            }
            __syncthreads();
            if (blk + 1 < T / 32) {
                base += (size_t)32 * D;
                r2 = *(const u32x2*)(p.r + base); k2 = *(const u32x2*)(p.k + base); v2 = *(const u32x2*)(p.v + base); a2 = *(const u32x2*)(p.a + base); g2 = *(const u32x2*)(p.g + base);
                lwh = *(const h4*)(p.lw + base);
            }
#define SC_LOAD(X, tt_) do { X##k0 = *(const f32x4*)&s_kk[tt_][8 * jq]; X##k1 = *(const f32x4*)&s_kk[tt_][8 * jq + 4]; X##w0 = *(const f32x4*)&s_w[tt_][8 * jq]; X##w1 = *(const f32x4*)&s_w[tt_][8 * jq + 4]; \
                X##b0 = *(const f32x4*)&s_b[tt_][8 * jq]; X##b1 = *(const f32x4*)&s_b[tt_][8 * jq + 4]; X##q0 = *(const f32x4*)&s_k[tt_][8 * jq]; X##q1 = *(const f32x4*)&s_k[tt_][8 * jq + 4]; \
                X##r0 = *(const f32x4*)&s_r[tt_][8 * jq]; X##r1 = *(const f32x4*)&s_r[tt_][8 * jq + 4]; X##vi = s_v[tt_][i]; } while (0)
#define SC_STEP(X, tt_) do { \
                const f32x2 d_ = S[0] * (f32x2){X##k0.x, X##k0.y} + S[1] * (f32x2){X##k0.z, X##k0.w} + S[2] * (f32x2){X##k1.x, X##k1.y} + S[3] * (f32x2){X##k1.z, X##k1.w}; \
                const float sa_ = red8(d_.x + d_.y); \
                S[0] = S[0] * (f32x2){X##w0.x, X##w0.y} - sa_ * (f32x2){X##b0.x, X##b0.y} + X##vi * (f32x2){X##q0.x, X##q0.y}; \
                S[1] = S[1] * (f32x2){X##w0.z, X##w0.w} - sa_ * (f32x2){X##b0.z, X##b0.w} + X##vi * (f32x2){X##q0.z, X##q0.w}; \
                S[2] = S[2] * (f32x2){X##w1.x, X##w1.y} - sa_ * (f32x2){X##b1.x, X##b1.y} + X##vi * (f32x2){X##q1.x, X##q1.y}; \
                S[3] = S[3] * (f32x2){X##w1.z, X##w1.w} - sa_ * (f32x2){X##b1.z, X##b1.w} + X##vi * (f32x2){X##q1.z, X##q1.w}; \
                const f32x2 e_ = S[0] * (f32x2){X##r0.x, X##r0.y} + S[1] * (f32x2){X##r0.z, X##r0.w} + S[2] * (f32x2){X##r1.x, X##r1.y} + S[3] * (f32x2){X##r1.z, X##r1.w}; \
                const float y_ = red8(e_.x + e_.y); \
                if (jq == 0) s_y[tt_][i] = y_; } while (0)
            f32x4 Ak0, Ak1, Aw0, Aw1, Ab0, Ab1, Aq0, Aq1, Ar0, Ar1, Bk0, Bk1, Bw0, Bw1, Bb0, Bb1, Bq0, Bq1, Br0, Br1; float Avi, Bvi;
            SC_LOAD(A, 0);
            for (int tt = 0; tt < 32; tt += 2) {
                SC_LOAD(B, tt + 1);
                SC_STEP(A, tt);
                { const int tn = (tt + 2) & 31; SC_LOAD(A, tn); }
                SC_STEP(B, tt + 1);
            }
#undef SC_LOAD
#undef SC_STEP
            __syncthreads();
            {
                const f32x4 y4 = *(const f32x4*)&s_y[lt][c4];
                const float mu = red16((y4.x + y4.y) + (y4.z + y4.w)) * (1.f / 64.f);
                const f32x4 dd = y4 - mu;
                const float rstd = rsqrtf(red16((dd.x * dd.x + dd.y * dd.y) + (dd.z * dd.z + dd.w * dd.w)) * (1.f / 64.f) + GN_EPS);
                const f32x4 vv = *(const f32x4*)&s_v[lt][c4];
                const float bo = s_bonus[lt];
                const f32x4 gg = {bf2f(g2c.x & 0xffff), bf2f(g2c.x >> 16), bf2f(g2c.y & 0xffff), bf2f(g2c.y >> 16)};
                const f32x4 o = (dd * rstd * gng + gnb + bo * vv) * gg;
                u32x2 ob; ob.x = pk2(o.x, o.y); ob.y = pk2(o.z, o.w);
                *(u32x2*)(p.yg + obase) = ob;
            }
            __syncthreads();
        }
    }
}

namespace sc {
constexpr int GLD = 64;
__device__ __forceinline__ int swz(int row, int col) { return row * GLD + ((((col >> 3) ^ row) & 7) << 3) + (col & 7); }
constexpr int BUFB = 64 * GLD * 2;
constexpr int B_KKD = 0, B_RD = 1, B_BINV = 2, B_KINV = 3, B_VT = 4, B_KDT = 5, B_NBDT = 6, B_SB = 7, B_M = 8, B_NQ = 9;
constexpr int B_XT = B_KKD, B_N = B_BINV, B_P = B_KINV;
constexpr int MS = 68;
constexpr int F_M = 10 * BUFB, F_R = F_M + 64 * MS * 4, PART = F_R + 64 * 65 * 4, GT = PART + 2 * 8 * 64 * 4, BON = GT + 256, SCR = BON + 256, END = SCR + 4 * 4096;
constexpr int LD16 = 24, O_XR = 0, O_XT = 768, O_TR = 1536, O_RT = 2304, O_TD = 3072;
static_assert(END <= 147392, "scan LDS");
__device__ __forceinline__ bf16* buf(unsigned char* lds, int i) { return (bf16*)(lds + i * BUFB); }
__device__ __forceinline__ bf16* xtb(unsigned char* lds) { return (bf16*)(lds + SCR); }
__device__ __forceinline__ void tile_mma(f32x4& acc, const bf16* A, int arow0, const bf16* Bt, int brow0, int fr, int fq) {
#pragma unroll
    for (int kk = 0; kk < 2; ++kk) {
        const bf16x8 a = *(const bf16x8*)&A[swz(arow0 + fr, kk * 32 + 8 * fq)];
        const bf16x8 b = *(const bf16x8*)&Bt[swz(brow0 + fr, kk * 32 + 8 * fq)];
        acc = __builtin_amdgcn_mfma_f32_16x16x32_bf16(a, b, acc, 0, 0, 0);
    }
}
__device__ __forceinline__ unsigned cvtpk(float lo, float hi);
__device__ __forceinline__ bf16 cvt1(float x);
__device__ __forceinline__ void mm16(f32x4& acc, const bf16* A, const bf16* Bt, int fr, int fq) {
    bf16x8 a = (bf16x8){0, 0, 0, 0, 0, 0, 0, 0}, b = a;
    if (fq < 2) { a = *(const bf16x8*)&A[fr * LD16 + 8 * fq]; b = *(const bf16x8*)&Bt[fr * LD16 + 8 * fq]; }
    acc = __builtin_amdgcn_mfma_f32_16x16x32_bf16(a, b, acc, 0, 0, 0);
}
__device__ __forceinline__ void wr_rm(bf16* R, const f32x4 v, int fr, int fq) {
#pragma unroll
    for (int i = 0; i < 4; ++i) R[(4 * fq + i) * LD16 + fr] = cvt1(v[i]);
}
__device__ __forceinline__ void wr_tr(bf16* Tt, const f32x4 v, int fr, int fq) { u32x2 o; o.x = cvtpk(v[0], v[1]); o.y = cvtpk(v[2], v[3]); *(u32x2*)&Tt[fr * LD16 + 4 * fq] = o; }
#define SC_LWAIT() asm volatile("s_waitcnt lgkmcnt(0)" ::: "memory")
typedef short s16x4 __attribute__((ext_vector_type(4)));
__device__ __forceinline__ s16x4 pk4(const f32x4 v) { u32x2 o; o.x = cvtpk(v[0], v[1]); o.y = cvtpk(v[2], v[3]); return __builtin_bit_cast(s16x4, o); }
__device__ __forceinline__ f32x4 mm16k(const s16x4 a, const s16x4 b, const f32x4 c) { return __builtin_amdgcn_mfma_f32_16x16x16bf16_1k(a, b, c, 0, 0, 0); }
constexpr int MP = 20, MDS = 16 * MP;
constexpr int PRM = F_M + 8192;
__device__ __forceinline__ void cvt8(const u32x4 v, float (&o)[8]) {
    o[0] = bf2f(v.x & 0xffff); o[1] = bf2f(v.x >> 16); o[2] = bf2f(v.y & 0xffff); o[3] = bf2f(v.y >> 16);
    o[4] = bf2f(v.z & 0xffff); o[5] = bf2f(v.z >> 16); o[6] = bf2f(v.w & 0xffff); o[7] = bf2f(v.w >> 16);
}
typedef __bf16 bf16x2_hw __attribute__((ext_vector_type(2)));
__device__ __forceinline__ unsigned cvtpk(float lo, float hi) { const f32x2 v = {lo, hi}; const bf16x2_hw b = __builtin_convertvector(v, bf16x2_hw); return __builtin_bit_cast(unsigned, b); }
__device__ __forceinline__ bf16 cvt1(float x) { return (bf16)(cvtpk(x, x) & 0xffffu); }
__device__ __forceinline__ u32x4 pack8(const float (&x)[8]) { u32x4 o; o.x = cvtpk(x[0], x[1]); o.y = cvtpk(x[2], x[3]); o.z = cvtpk(x[4], x[5]); o.w = cvtpk(x[6], x[7]); return o; }
}

__device__ __forceinline__ void ph_scan_chunk(const ScanP& p, unsigned char* lds, int nscan, const int wv_s) {
    using namespace sc;
    const int w = wv_s;
#define SC_LANES const int tid = opaque_tid(wv_s), lane = tid & 63, fr = lane & 15, fq = lane >> 4; (void)fr; (void)fq; (void)tid
    float* Mf = (float*)(lds + F_M); float* Rf = (float*)(lds + F_R); float* part = (float*)(lds + PART); float* gt = (float*)(lds + GT); float* bon = (float*)(lds + BON);
    typedef _Float16 h8 __attribute__((ext_vector_type(8)));
    for (int unit = blockIdx.x; unit < NB * H; unit += nscan) {
        const int b = unit / H, h = unit % H;
        __syncthreads();
        f32x4 Sreg[2];
        Sreg[0] = Sreg[1] = (f32x4){0.f, 0.f, 0.f, 0.f};
        size_t base;
        { SC_LANES; base = (size_t)(b * T + lane) * D + h * HD + 8 * w;
        for (int z = tid; z < BUFB / 4; z += 512) ((unsigned*)buf(lds, B_SB))[z] = 0u;
        }
        float* prm = (float*)(lds + PRM);
        size_t ob;
        { SC_LANES; const int n8 = (tid & 7) * 8;
          if (tid < 64) { prm[tid] = p.kk[h * HD + tid]; prm[64 + tid] = p.ka[h * HD + tid]; prm[128 + tid] = p.rk[h * HD + tid]; prm[192 + tid] = p.gng[h * HD + tid]; prm[256 + tid] = p.gnb[h * HD + tid]; }
          ob = (size_t)(b * T + (tid >> 3)) * D + h * HD + n8; }
        u32x4 vg, gg8;
        u32x4 r8 = *(const u32x4*)(p.r + base), k8 = *(const u32x4*)(p.k + base), v8 = *(const u32x4*)(p.v + base), a8 = *(const u32x4*)(p.a + base);
        h8 lw8 = *(const h8*)(p.lw + base);
        __syncthreads();
        for (int ch = 0; ch < T / 64; ++ch) {
            {   SC_LANES;
            float rr[8], kr[8], aa[8], lwf[8];
            cvt8(r8, rr); cvt8(k8, kr); cvt8(a8, aa);
#pragma unroll
            for (int q = 0; q < 8; ++q) lwf[q] = (float)lw8[q];
            float kkn[8], km[8]; float ssp = 0.f, bop = 0.f;
#pragma unroll
            for (int q = 0; q < 8; ++q) { const float kkp = prm[8 * w + q], kap = prm[64 + 8 * w + q], rkp = prm[128 + 8 * w + q];
                kkn[q] = kr[q] * kkp; ssp += kkn[q] * kkn[q]; km[q] = kr[q] * (1.0f + (aa[q] - 1.0f) * kap); bop += rr[q] * km[q] * rkp; }
            part[w * 64 + lane] = ssp; part[512 + w * 64 + lane] = bop;
            float cum[8];
#pragma unroll
            for (int q = 0; q < 8; ++q) cum[q] = lwf[q];
#define SC_DPP8(ctl) "v_add_f32_dpp %0, %0, %0 " ctl "\n\tv_add_f32_dpp %1, %1, %1 " ctl "\n\tv_add_f32_dpp %2, %2, %2 " ctl "\n\tv_add_f32_dpp %3, %3, %3 " ctl "\n\t" \
                     "v_add_f32_dpp %4, %4, %4 " ctl "\n\tv_add_f32_dpp %5, %5, %5 " ctl "\n\tv_add_f32_dpp %6, %6, %6 " ctl "\n\tv_add_f32_dpp %7, %7, %7 " ctl "\n\t"
            asm volatile("s_nop 1\n\t"
                         SC_DPP8("row_shr:1 row_mask:0xf bank_mask:0xf bound_ctrl:1") SC_DPP8("row_shr:2 row_mask:0xf bank_mask:0xf bound_ctrl:1")
                         SC_DPP8("row_shr:4 row_mask:0xf bank_mask:0xf bound_ctrl:1") SC_DPP8("row_shr:8 row_mask:0xf bank_mask:0xf bound_ctrl:1")
                         SC_DPP8("row_bcast:15 row_mask:0xa bank_mask:0xf") SC_DPP8("row_bcast:31 row_mask:0xc bank_mask:0xf")
                         : "+v"(cum[0]), "+v"(cum[1]), "+v"(cum[2]), "+v"(cum[3]), "+v"(cum[4]), "+v"(cum[5]), "+v"(cum[6]), "+v"(cum[7]));
#undef SC_DPP8
            __syncthreads();
            float ss = 0.f, bo = 0.f;
#pragma unroll
            for (int q = 0; q < 8; ++q) { ss += part[q * 64 + lane]; bo += part[512 + q * 64 + lane]; }
            const float inv = fminf(__builtin_amdgcn_rsqf(ss), 1e12f);
            {
                float o_kkd[8], o_rd[8], o_binv[8], o_kinv[8];
                bf16* bVT = buf(lds, B_VT); bf16* bKDT = buf(lds, B_KDT); bf16* bNBDT = buf(lds, B_NBDT);
#pragma unroll
                for (int q = 0; q < 8; ++q) {
                    const float kkv = kkn[q] * inv, bb = kkv * aa[q];
                    const float e_c = __builtin_amdgcn_exp2f(cum[q]), e_n = __builtin_amdgcn_exp2f(-cum[q]);
                    const float e_tot = __int_as_float(__builtin_amdgcn_readlane(__float_as_int(e_c), 63));
                    const float e_x = __int_as_float(__builtin_amdgcn_update_dpp(0x3f800000, __float_as_int(e_c), 0x138, 0xF, 0xF, false));
                    const float e_t = e_tot * e_n;
                    o_kkd[q] = kkv * e_x; o_rd[q] = rr[q] * e_c; o_binv[q] = bb * e_n; o_kinv[q] = km[q] * e_n;
                    bVT[swz(8 * w + q, lane)] = (bf16)((q & 1) ? (v8[q >> 1] >> 16) : (v8[q >> 1] & 0xffffu));
                    const unsigned kb = cvtpk(km[q] * e_t, -bb * e_t);
                    bKDT[swz(8 * w + q, lane)] = (bf16)(kb & 0xffffu);
                    bNBDT[swz(8 * w + q, lane)] = (bf16)(kb >> 16);
                    if (lane == 0) gt[8 * w + q] = e_tot;
                }
                *(u32x4*)&buf(lds, B_KKD)[swz(lane, 8 * w)] = pack8(o_kkd); *(u32x4*)&buf(lds, B_RD)[swz(lane, 8 * w)] = pack8(o_rd);
                *(u32x4*)&buf(lds, B_BINV)[swz(lane, 8 * w)] = pack8(o_binv); *(u32x4*)&buf(lds, B_KINV)[swz(lane, 8 * w)] = pack8(o_kinv);
                if (w == 0) bon[lane] = bo;
            }
            }
            __syncthreads();
            {   SC_LANES;
                const int m = w >> 1;
                const bf16* A = buf(lds, (m & 1) ? B_KINV : B_BINV); const bf16* Bt = buf(lds, m < 2 ? B_KKD : B_RD);
                f32x4 acc[8];
#pragma unroll
                for (int q = 0; q < 8; ++q) { const int tt = (w & 1) * 2 + (q >> 2), st = q & 3; acc[q] = (f32x4){0.f, 0.f, 0.f, 0.f}; tile_mma(acc[q], A, 16 * st, Bt, 16 * tt, fr, fq); }
                __syncthreads();
                {
                    const float sgn = (m == 2) ? -1.f : 1.f;
                    bf16* dst = buf(lds, m == 0 ? B_M : (m == 1 ? B_N : (m == 2 ? B_NQ : B_P)));
#pragma unroll
                    for (int q = 0; q < 8; ++q) { const int tt = (w & 1) * 2 + (q >> 2), st = q & 3; const int t = 16 * tt + fr, s0 = 16 * st + 4 * fq;
                        f32x4 val;
#pragma unroll
                        for (int i = 0; i < 4; ++i) { const int s = s0 + i; const float keep = (m < 2) ? ((s < t) ? 1.f : 0.f) : ((s <= t) ? sgn : 0.f); val[i] = acc[q][i] * keep; }
                        if (m == 0) { if (st == tt) *(f32x4*)&Mf[tt * MDS + fr * MP + 4 * fq] = val; val = -val; }
                        u32x2 o; o.x = cvtpk(val[0], val[1]); o.y = cvtpk(val[2], val[3]);
                        *(u32x2*)&dst[swz(t, s0)] = o; }
                }
            }
            __syncthreads();
            vg = *(const u32x4*)(p.v + ob); gg8 = *(const u32x4*)(p.g + ob);
            if (ch + 1 < T / 64) { base += (size_t)64 * D; r8 = *(const u32x4*)(p.r + base); k8 = *(const u32x4*)(p.k + base); v8 = *(const u32x4*)(p.v + base); a8 = *(const u32x4*)(p.a + base); lw8 = *(const h8*)(p.lw + base); }
#define SC_LD2(dst, img, row0) { dst[0] = *(const bf16x8*)&(img)[swz((row0) + fr, 8 * fq)]; dst[1] = *(const bf16x8*)&(img)[swz((row0) + fr, 32 + 8 * fq)]; }
#define SC_MM(acc, a, b) acc = __builtin_amdgcn_mfma_f32_16x16x32_bf16(a, b, acc, 0, 0, 0)
            f32x4 yacc[4];
            {   SC_LANES;
                const f32x4 z4 = (f32x4){0.f, 0.f, 0.f, 0.f};
                if (w < 4) {
                    bf16x8 bS[2], bV[2], aK[4][2], aN[4][2];
                    SC_LD2(bS, buf(lds, B_SB), 16 * w); SC_LD2(bV, buf(lds, B_VT), 16 * w);
#pragma unroll
                    for (int mt = 0; mt < 4; ++mt) { SC_LD2(aK[mt], buf(lds, B_KKD), 16 * mt); SC_LD2(aN[mt], buf(lds, B_N), 16 * mt); }
                    f32x4 cX[4], cXt[4], cTt[4];
#pragma unroll
                    for (int d = 0; d < 4; ++d) { const float* Md = Mf + d * MDS; cXt[d] = *(const f32x4*)&Md[fr * MP + 4 * fq];
#pragma unroll
                        for (int i = 0; i < 4; ++i) cX[d][i] = Md[(4 * fq + i) * MP + fr]; }
                    s16x4 nM[6];
#pragma unroll
                    for (int e = 0; e < 6; ++e) { const int bc = e < 3 ? 0 : (e < 5 ? 1 : 2), br = e < 3 ? e + 1 : (e < 5 ? e - 1 : 3);
                        nM[e] = *(const s16x4*)&buf(lds, B_M)[swz(16 * br + fr, 16 * bc + 4 * fq)]; }
                    SC_LWAIT();
                    f32x4 racc[4];
#pragma unroll
                    for (int mt = 0; mt < 4; ++mt) { racc[mt] = z4; SC_MM(racc[mt], aK[mt][0], bS[0]); }
#pragma unroll
                    for (int mt = 0; mt < 4; ++mt) SC_MM(racc[mt], aK[mt][1], bS[1]);
#pragma unroll
                    for (int mt = 0; mt < 4; ++mt) SC_MM(racc[mt], aN[mt][0], bV[0]);
#pragma unroll
                    for (int mt = 0; mt < 4; ++mt) SC_MM(racc[mt], aN[mt][1], bV[1]);
                    s16x4 pA[4], pAt[4], TT[4];
                    f32x4 XA[4], XB[4];
#pragma unroll
                    for (int d = 0; d < 4; ++d) { pA[d] = pk4(cX[d]); pAt[d] = pk4(cXt[d]);
#pragma unroll
                        for (int i = 0; i < 4; ++i) cTt[d][i] = ((4 * fq + i) == fr ? 1.f : 0.f) - cXt[d][i]; }
#pragma unroll
                    for (int st = 0; st < 3; ++st) {
#pragma unroll
                        for (int d = 0; d < 4; ++d) XA[d] = mm16k(pAt[d], pA[d], z4);
                        if (st < 2) {
#pragma unroll
                            for (int d = 0; d < 4; ++d) XB[d] = mm16k(pA[d], pAt[d], z4);
                        }
#pragma unroll
                        for (int d = 0; d < 4; ++d) TT[d] = pk4(cTt[d]);
#pragma unroll
                        for (int d = 0; d < 4; ++d) pA[d] = pk4(XA[d]);
#pragma unroll
                        for (int d = 0; d < 4; ++d) cTt[d] = mm16k(pA[d], TT[d], cTt[d]);
                        if (st < 2) {
#pragma unroll
                            for (int d = 0; d < 4; ++d) pAt[d] = pk4(XB[d]);
                        }
                    }
#pragma unroll
                    for (int d = 0; d < 4; ++d) TT[d] = pk4(cTt[d]);
#pragma unroll
                    for (int blk = 0; blk < 4; ++blk) {
                        const f32x4 xx = mm16k(TT[blk], pk4(racc[blk]), z4);
                        const s16x4 pxx = pk4(xx);
                        *(s16x4*)&xtb(lds)[swz(16 * w + fr, 16 * blk + 4 * fq)] = pxx;
#pragma unroll
                        for (int br = blk + 1; br < 4; ++br) { const int e = blk == 0 ? br - 1 : (blk == 1 ? br + 1 : 5); racc[br] = mm16k(nM[e], pxx, racc[br]); }
                    }
                } else {
                    const int mt = w - 4;
                    bf16x8 aR[2], aP[2], bS[4][2], bV[4][2];
                    SC_LD2(aR, buf(lds, B_RD), 16 * mt); SC_LD2(aP, buf(lds, B_P), 16 * mt);
#pragma unroll
                    for (int nt = 0; nt < 4; ++nt) { SC_LD2(bS[nt], buf(lds, B_SB), 16 * nt); SC_LD2(bV[nt], buf(lds, B_VT), 16 * nt); }
                    asm volatile("s_waitcnt lgkmcnt(0)" : "+v"(aR[0]), "+v"(aR[1]), "+v"(aP[0]), "+v"(aP[1]), "+v"(bS[0][0]), "+v"(bS[0][1]), "+v"(bS[1][0]), "+v"(bS[1][1]), "+v"(bS[2][0]), "+v"(bS[2][1]),
                                 "+v"(bS[3][0]), "+v"(bS[3][1]), "+v"(bV[0][0]), "+v"(bV[0][1]), "+v"(bV[1][0]), "+v"(bV[1][1]), "+v"(bV[2][0]), "+v"(bV[2][1]), "+v"(bV[3][0]), "+v"(bV[3][1]) :: "memory");
#pragma unroll
                    for (int nt = 0; nt < 4; ++nt) { yacc[nt] = z4; SC_MM(yacc[nt], aR[0], bS[nt][0]); }
#pragma unroll
                    for (int nt = 0; nt < 4; ++nt) SC_MM(yacc[nt], aR[1], bS[nt][1]);
#pragma unroll
                    for (int nt = 0; nt < 4; ++nt) SC_MM(yacc[nt], aP[0], bV[nt][0]);
#pragma unroll
                    for (int nt = 0; nt < 4; ++nt) SC_MM(yacc[nt], aP[1], bV[nt][1]);
                }
            }
            __syncthreads();
            {   SC_LANES;
                const int mt6 = w >> 1, nt6 = 2 * (w & 1);
                bf16x8 aV[2], aX[2], bK[2][2], bB[2][2], aQ[2], bX[4][2];
                SC_LD2(aV, buf(lds, B_VT), 16 * mt6); SC_LD2(aX, xtb(lds), 16 * mt6);
#pragma unroll
                for (int q = 0; q < 2; ++q) { SC_LD2(bK[q], buf(lds, B_KDT), 16 * (nt6 + q)); SC_LD2(bB[q], buf(lds, B_NBDT), 16 * (nt6 + q)); }
                const float g0 = gt[16 * nt6 + fr], g1 = gt[16 * nt6 + 16 + fr];
                if (w >= 4) {
                    SC_LD2(aQ, buf(lds, B_NQ), 16 * (w - 4));
#pragma unroll
                    for (int nt = 0; nt < 4; ++nt) SC_LD2(bX[nt], xtb(lds), 16 * nt);
                }
                SC_LWAIT();
                if (w >= 4) {
#pragma unroll
                    for (int nt = 0; nt < 4; ++nt) SC_MM(yacc[nt], aQ[0], bX[nt][0]);
#pragma unroll
                    for (int nt = 0; nt < 4; ++nt) SC_MM(yacc[nt], aQ[1], bX[nt][1]);
                }
                f32x4 s0 = Sreg[0] * g0, s1 = Sreg[1] * g1;
                SC_MM(s0, aV[0], bK[0][0]); SC_MM(s1, aV[0], bK[1][0]); SC_MM(s0, aV[1], bK[0][1]); SC_MM(s1, aV[1], bK[1][1]);
                SC_MM(s0, aX[0], bB[0][0]); SC_MM(s1, aX[0], bB[1][0]); SC_MM(s0, aX[1], bB[0][1]); SC_MM(s1, aX[1], bB[1][1]);
                Sreg[0] = s0; Sreg[1] = s1;
                if (w >= 4) {
#pragma unroll
                    for (int nt = 0; nt < 4; ++nt) {
#pragma unroll
                        for (int i = 0; i < 4; ++i) Rf[(16 * (w - 4) + 4 * fq + i) * 65 + 16 * nt + fr] = yacc[nt][i]; }
                }
#pragma unroll
                for (int i = 0; i < 4; ++i) { buf(lds, B_SB)[swz(16 * mt6 + 4 * fq + i, 16 * nt6 + fr)] = cvt1(s0[i]); buf(lds, B_SB)[swz(16 * mt6 + 4 * fq + i, 16 * nt6 + 16 + fr)] = cvt1(s1[i]); }
            }
            __syncthreads();
#undef SC_LD2
#undef SC_MM
            {   SC_LANES;
                const int t = tid >> 3, n8 = (tid & 7) * 8;
                float y[8], vf[8], gf[8]; cvt8(vg, vf); cvt8(gg8, gf);
                float sm = 0.f;
#pragma unroll
                for (int q = 0; q < 8; ++q) { y[q] = Rf[t * 65 + n8 + q]; sm += y[q]; }
                const float mu = red8(sm) * (1.f / 64.f);
                float vs = 0.f;
#pragma unroll
                for (int q = 0; q < 8; ++q) { y[q] -= mu; vs += y[q] * y[q]; }
                const float rstd = rsqrtf(red8(vs) * (1.f / 64.f) + GN_EPS);
                const float bo2 = bon[t];
                float o[8];
#pragma unroll
                for (int q = 0; q < 8; ++q) o[q] = (y[q] * rstd * prm[192 + n8 + q] + prm[256 + n8 + q] + bo2 * vf[q]) * gf[q];
                *(u32x4*)(p.yg + ob) = pack8(o);
                ob += (size_t)64 * D;
            }
        }
    }
#undef SC_LANES
}
namespace sc2 {
using namespace sc;
constexpr int IMG = 8192;
constexpr int O_KKD = 0, O_RD = 1, O_N = 2, O_P = 3, O_VT = 4, O_KDT = 5, O_NBDT = 6, O_NQ = 7;
constexpr int O_MC = 8 * IMG, O_TT = O_MC + 3072, O_GT = O_TT + 2048, O_BON = O_GT + 256, SETB = O_BON + 256;
constexpr int RFP = 68;
constexpr int RF = 2 * SETB, PARTO = RF + 64 * RFP * 4, PRMO = PARTO + 2048, END2 = PRMO + 1280;
constexpr int SYNCO = END2;
static_assert(SYNCO + 64 <= 163776, "scan LDS");
__device__ __forceinline__ bf16* img(unsigned char* lds, int setb, int i) { return (bf16*)(lds + setb + i * IMG); }
__device__ __forceinline__ bf16x8 ld128(const bf16* im, int row, int col) { return *(const bf16x8*)&im[swz(row, col)]; }
__device__ __forceinline__ s16x4 ld64(const bf16* im, int row, int col) { return *(const s16x4*)&im[swz(row, col)]; }
__device__ __forceinline__ f32x4 mm32(const bf16x8 a, const bf16x8 b, const f32x4 c) { return __builtin_amdgcn_mfma_f32_16x16x32_bf16(a, b, c, 0, 0, 0); }
__device__ __forceinline__ void grp_sync(LAS unsigned* cnt, unsigned target, int lane) {
    asm volatile("s_waitcnt lgkmcnt(0)" ::: "memory");
    if (lane == 0) (void)__hip_atomic_fetch_add(cnt, 1u, __ATOMIC_RELAXED, __HIP_MEMORY_SCOPE_WORKGROUP);
    while ((unsigned)__builtin_amdgcn_readfirstlane((int)__hip_atomic_load(cnt, __ATOMIC_RELAXED, __HIP_MEMORY_SCOPE_WORKGROUP)) < target) __builtin_amdgcn_s_sleep(1);
    asm volatile("" ::: "memory");
}
}

__device__ __forceinline__ void pc_out(const ScanP& p, const float* Rf, const float* prm, const float bo2, const u32x4 (&vg)[2], const u32x4 (&gg)[2], size_t ob, int w, int lane) {
    using namespace sc2;
    const int tc = w * 64 + lane, t = tc >> 2, qd = tc & 3;
    float y[2][8], vf[2][8], gf[2][8]; cvt8(vg[0], vf[0]); cvt8(vg[1], vf[1]); cvt8(gg[0], gf[0]); cvt8(gg[1], gf[1]);
    float sm = 0.f;
#pragma unroll
    for (int j = 0; j < 4; ++j) { const f32x4 yy = *(const f32x4*)&Rf[t * RFP + 16 * qd + 4 * j]; y[j >> 1][4 * (j & 1)] = yy[0]; y[j >> 1][4 * (j & 1) + 1] = yy[1]; y[j >> 1][4 * (j & 1) + 2] = yy[2]; y[j >> 1][4 * (j & 1) + 3] = yy[3];
        sm += (yy[0] + yy[1]) + (yy[2] + yy[3]); }
    sm += dppx<0xB1>(sm); sm += dppx<0x4E>(sm);
    const float mu = sm * (1.f / 64.f);
    float vs = 0.f;
#pragma unroll
    for (int q = 0; q < 16; ++q) { y[q >> 3][q & 7] -= mu; vs += y[q >> 3][q & 7] * y[q >> 3][q & 7]; }
    vs += dppx<0xB1>(vs); vs += dppx<0x4E>(vs);
    const float rstd = rsqrtf(vs * (1.f / 64.f) + GN_EPS);
    float o[2][8];
#pragma unroll
    for (int q = 0; q < 16; ++q) o[q >> 3][q & 7] = (y[q >> 3][q & 7] * rstd * prm[192 + 16 * qd + q] + prm[256 + 16 * qd + q] + bo2 * vf[q >> 3][q & 7]) * gf[q >> 3][q & 7];
    *(u32x4*)(p.yg + ob) = pack8(o[0]); *(u32x4*)(p.yg + ob + 512) = pack8(o[1]);
}

__device__ __forceinline__ void ph_scan_pc(const ScanP& p, unsigned char* lds, int nscan, const int wv_s) {
    using namespace sc2;
    const int w = wv_s;
#define SC_LANES const int tid = opaque_tid(wv_s), lane = tid & 63, fr = lane & 15, fq = lane >> 4; (void)fr; (void)fq; (void)tid
    typedef _Float16 h8 __attribute__((ext_vector_type(8)));
    float* Rf = (float*)(lds + RF); float* part = (float*)(lds + PARTO); float* prm = (float*)(lds + PRMO);
    const f32x4 z4 = (f32x4){0.f, 0.f, 0.f, 0.f};
    for (int unit = blockIdx.x; unit < NB * H; unit += nscan) {
        const int b = unit / H, h = unit % H;
        __syncthreads();
        { SC_LANES; if (tid == 0) { ((LAS unsigned*)(lds + SYNCO))[0] = 0u; ((LAS unsigned*)(lds + SYNCO))[1] = 0u; }
          if (tid < 64) { prm[tid] = p.kk[h * HD + tid]; prm[64 + tid] = p.ka[h * HD + tid]; prm[128 + tid] = p.rk[h * HD + tid]; prm[192 + tid] = p.gng[h * HD + tid]; prm[256 + tid] = p.gnb[h * HD + tid]; } }
        f32x4 ST[4]; ST[0] = ST[1] = ST[2] = ST[3] = z4;
        s16x4 pxx[4];
        u32x4 vg[2], gg[2];
        float bo_out = 0.f;
        u32x4 r8[2], k8[2], v8[2], a8[2]; h8 lw8[2];
        size_t pbase = 0, sbase = 0, ob = 0, vb = 0, yb = 0;
        { SC_LANES;
          if (w >= 4) { pbase = (size_t)(b * T + lane) * D + h * HD + 16 * (w - 4);
              sbase = pg8::scan_idx(b * T + lane, h * HD + 16 * (w - 4));
#pragma unroll
              for (int o = 0; o < 2; ++o) { r8[o] = *(const u32x4*)(p.r + sbase + 512 * o); k8[o] = *(const u32x4*)(p.k + sbase + 512 * o); v8[o] = *(const u32x4*)(p.v + sbase + 512 * o);
                  a8[o] = *(const u32x4*)(p.a + sbase + 512 * o); lw8[o] = *(const h8*)(p.lw + sbase + 512 * o); } }
          else { ob = (size_t)(b * T + ((w * 64 + lane) >> 2)) * D + h * HD + 16 * (lane & 3); vb = pg8::scan_idx(b * T + ((w * 64 + lane) >> 2), h * HD + 16 * (lane & 3)); yb = vb; } }
        __syncthreads();
        for (int ch = -1; ch < T / 64; ++ch) {
            if (w >= 4) {
                if (ch + 1 < T / 64) {
                    const int pw = w - 4, setb = ((ch + 1) & 1) * SETB;
                    float rr[2][8], aa[2][8], kkn[2][8], km[2][8], cum[2][8];
                    {   SC_LANES;
                        float ssp = 0.f, bop = 0.f;
#pragma unroll
                        for (int o = 0; o < 2; ++o) {
                            float kr[8]; cvt8(r8[o], rr[o]); cvt8(k8[o], kr); cvt8(a8[o], aa[o]);
#pragma unroll
                            for (int q = 0; q < 8; ++q) { const int c = 16 * pw + 8 * o + q; const float kkp = prm[c], kap = prm[64 + c], rkp = prm[128 + c];
                                kkn[o][q] = kr[q] * kkp; ssp += kkn[o][q] * kkn[o][q]; km[o][q] = kr[q] * (1.0f + (aa[o][q] - 1.0f) * kap); bop += rr[o][q] * km[o][q] * rkp; cum[o][q] = (float)lw8[o][q]; }
                        }
                        part[pw * 64 + lane] = ssp; part[256 + pw * 64 + lane] = bop;
                        if (ch + 2 < T / 64) { pbase += (size_t)64 * D; sbase += 4096;
#pragma unroll
                            for (int o = 0; o < 2; ++o) { r8[o] = *(const u32x4*)(p.r + sbase + 512 * o); k8[o] = *(const u32x4*)(p.k + sbase + 512 * o);
                                a8[o] = *(const u32x4*)(p.a + sbase + 512 * o); lw8[o] = *(const h8*)(p.lw + sbase + 512 * o); } }
#define SC_DPP8(ctl) "v_add_f32_dpp %0, %0, %0 " ctl "\n\tv_add_f32_dpp %1, %1, %1 " ctl "\n\tv_add_f32_dpp %2, %2, %2 " ctl "\n\tv_add_f32_dpp %3, %3, %3 " ctl "\n\t" \
                     "v_add_f32_dpp %4, %4, %4 " ctl "\n\tv_add_f32_dpp %5, %5, %5 " ctl "\n\tv_add_f32_dpp %6, %6, %6 " ctl "\n\tv_add_f32_dpp %7, %7, %7 " ctl "\n\t"
#pragma unroll
                        for (int o = 0; o < 2; ++o)
                            asm volatile("s_nop 1\n\t"
                                         SC_DPP8("row_shr:1 row_mask:0xf bank_mask:0xf bound_ctrl:1") SC_DPP8("row_shr:2 row_mask:0xf bank_mask:0xf bound_ctrl:1")
                                         SC_DPP8("row_shr:4 row_mask:0xf bank_mask:0xf bound_ctrl:1") SC_DPP8("row_shr:8 row_mask:0xf bank_mask:0xf bound_ctrl:1")
                                         SC_DPP8("row_bcast:15 row_mask:0xa bank_mask:0xf") SC_DPP8("row_bcast:31 row_mask:0xc bank_mask:0xf")
                                         : "+v"(cum[o][0]), "+v"(cum[o][1]), "+v"(cum[o][2]), "+v"(cum[o][3]), "+v"(cum[o][4]), "+v"(cum[o][5]), "+v"(cum[o][6]), "+v"(cum[o][7]));
#undef SC_DPP8
                    }
                    { SC_LANES; grp_sync((LAS unsigned*)(lds + SYNCO), 4u * (3u * (unsigned)(ch + 1) + 1u), lane); }
                    {   SC_LANES;
                        float ss = 0.f, bo = 0.f;
#pragma unroll
                        for (int q = 0; q < 4; ++q) { ss += part[q * 64 + lane]; bo += part[256 + q * 64 + lane]; }
                        const float inv = fminf(__builtin_amdgcn_rsqf(ss), 1e12f);
                        bf16* bVT = img(lds, setb, O_VT); bf16* bKDT = img(lds, setb, O_KDT); bf16* bNBDT = img(lds, setb, O_NBDT);
                        float* gt = (float*)(lds + setb + O_GT); float* bon = (float*)(lds + setb + O_BON);
#pragma unroll
                        for (int o = 0; o < 2; ++o) {
                            const int cb = 16 * pw + 8 * o;
                            float o_kkd[8], o_rd[8], o_binv[8], o_kinv[8];
#pragma unroll
                            for (int q = 0; q < 8; ++q) {
                                const float kkv = kkn[o][q] * inv, bb = kkv * aa[o][q];
                                const float e_c = __builtin_amdgcn_exp2f(cum[o][q]), e_n = __builtin_amdgcn_exp2f(-cum[o][q]);
                                const float e_tot = __int_as_float(__builtin_amdgcn_readlane(__float_as_int(e_c), 63));
                                const float e_x = __int_as_float(__builtin_amdgcn_update_dpp(0x3f800000, __float_as_int(e_c), 0x138, 0xF, 0xF, false));
                                const float e_t = e_tot * e_n;
                                o_kkd[q] = kkv * e_x; o_rd[q] = rr[o][q] * e_c; o_binv[q] = bb * e_n; o_kinv[q] = km[o][q] * e_n;
                                bVT[swz(cb + q, lane)] = (bf16)((q & 1) ? (v8[o][q >> 1] >> 16) : (v8[o][q >> 1] & 0xffffu));
                                const unsigned kb2 = cvtpk(km[o][q] * e_t, -bb * e_t);
                                bKDT[swz(cb + q, lane)] = (bf16)(kb2 & 0xffffu);
                                bNBDT[swz(cb + q, lane)] = (bf16)(kb2 >> 16);
                                if (lane == 0) gt[cb + q] = e_tot;
                            }
                            *(u32x4*)&img(lds, setb, O_KKD)[swz(lane, cb)] = pack8(o_kkd); *(u32x4*)&img(lds, setb, O_RD)[swz(lane, cb)] = pack8(o_rd);
                            *(u32x4*)&img(lds, setb, O_N)[swz(lane, cb)] = pack8(o_binv); *(u32x4*)&img(lds, setb, O_P)[swz(lane, cb)] = pack8(o_kinv);
                        }
                        if (pw == 0) bon[lane] = bo;
                        if (ch + 2 < T / 64) { v8[0] = *(const u32x4*)(p.v + sbase); v8[1] = *(const u32x4*)(p.v + sbase + 512); }
                    }
                    { SC_LANES; grp_sync((LAS unsigned*)(lds + SYNCO), 4u * (3u * (unsigned)(ch + 1) + 2u), lane); }
                    f32x4 acc[10], cX, cXt;
                    {   SC_LANES;
                        const bf16* A = img(lds, setb, (pw & 1) ? O_P : O_N); const bf16* Bt = img(lds, setb, pw < 2 ? O_KKD : O_RD);
                        bf16x8 fa[4][2], fb[4][2], dB[2], dK[2];
#pragma unroll
                        for (int x = 0; x < 4; ++x) {
#pragma unroll
                            for (int kk = 0; kk < 2; ++kk) { fa[x][kk] = ld128(A, 16 * x + fr, 32 * kk + 8 * fq); fb[x][kk] = ld128(Bt, 16 * x + fr, 32 * kk + 8 * fq); } }
#pragma unroll
                        for (int kk = 0; kk < 2; ++kk) { dB[kk] = ld128(img(lds, setb, O_N), 16 * pw + fr, 32 * kk + 8 * fq); dK[kk] = ld128(img(lds, setb, O_KKD), 16 * pw + fr, 32 * kk + 8 * fq); }
                        int idx = 0;
#pragma unroll
                        for (int tt = 0; tt < 4; ++tt) {
#pragma unroll
                            for (int st = 0; st <= tt; ++st) { acc[idx] = mm32(fa[st][0], fb[tt][0], z4); acc[idx] = mm32(fa[st][1], fb[tt][1], acc[idx]); ++idx; } }
                        cXt = mm32(dB[0], dK[0], z4); cXt = mm32(dB[1], dK[1], cXt);
                        cX = mm32(dK[0], dB[0], z4); cX = mm32(dK[1], dB[1], cX);
                    }
                    { SC_LANES; grp_sync((LAS unsigned*)(lds + SYNCO), 4u * (3u * (unsigned)(ch + 1) + 3u), lane); }
                    {   SC_LANES;
                        f32x4 mk; const bool strict = pw < 2;
#pragma unroll
                        for (int i = 0; i < 4; ++i) { const int d = 4 * fq + i - fr; mk[i] = (strict ? (d < 0) : (d <= 0)) ? 1.f : 0.f; }
                        const unsigned sx = (pw == 0 || pw == 2) ? 0x80008000u : 0u;
                        if (pw == 0) {
#pragma unroll
                            for (int e = 0; e < 6; ++e) { const int ix = e == 0 ? 1 : (e == 1 ? 3 : (e == 2 ? 6 : (e == 3 ? 4 : (e == 4 ? 7 : 8))));
                                u32x2 o; o.x = cvtpk(acc[ix][0], acc[ix][1]) ^ sx; o.y = cvtpk(acc[ix][2], acc[ix][3]) ^ sx;
                                *(u32x2*)(lds + setb + O_MC + (e * 64 + lane) * 8) = o; }
                        } else {
                            bf16* dst = img(lds, setb, pw == 1 ? O_N : (pw == 2 ? O_NQ : O_P));
                            int idx = 0;
#pragma unroll
                            for (int tt = 0; tt < 4; ++tt) {
#pragma unroll
                                for (int st = 0; st < 4; ++st) {
                                    u32x2 o = (u32x2){0u, 0u};
                                    if (st <= tt) {
                                        f32x4 val = acc[idx]; ++idx;
                                        if (st == tt) val = val * mk;
                                        o.x = cvtpk(val[0], val[1]) ^ sx; o.y = cvtpk(val[2], val[3]) ^ sx;
                                    }
                                    *(u32x2*)&dst[swz(16 * tt + fr, 16 * st + 4 * fq)] = o;
                                } }
                        }
                        f32x4 cTt;
#pragma unroll
                        for (int i = 0; i < 4; ++i) { const int d = 4 * fq + i - fr; cXt[i] = d < 0 ? cXt[i] : 0.f; cX[i] = d > 0 ? cX[i] : 0.f; cTt[i] = (d == 0 ? 1.f : 0.f) - cXt[i]; }
                        s16x4 pA = pk4(cX), pAt = pk4(cXt);
#pragma unroll
                        for (int st = 0; st < 3; ++st) {
                            const f32x4 XA = mm16k(pAt, pA, z4);
                            f32x4 XB = z4; if (st < 2) XB = mm16k(pA, pAt, z4);
                            const s16x4 pT = pk4(cTt);
                            pA = pk4(XA);
                            cTt = mm16k(pA, pT, cTt);
                            if (st < 2) pAt = pk4(XB);
                        }
                        *(s16x4*)(lds + setb + O_TT + (pw * 64 + lane) * 8) = pk4(cTt);
                    }
                    __syncthreads();
                } else { __syncthreads(); }
            } else {
                if (ch >= 0) {
                    const int setb = (ch & 1) * SETB;
                    {   SC_LANES;
                        if (ch > 0) {
                            pc_out(p, Rf, prm, bo_out, vg, gg, yb, w, lane);
                            ob += (size_t)64 * D; yb += 4096;
                            grp_sync((LAS unsigned*)(lds + SYNCO) + 1, 4u * (unsigned)ch, lane);
                        }
                        vg[0] = *(const u32x4*)(p.v + vb); vg[1] = *(const u32x4*)(p.v + vb + 512); gg[0] = *(const u32x4*)(p.g + ob); gg[1] = *(const u32x4*)(p.g + ob + 8);
                        vb += 4096;
                        bo_out = ((const float*)(lds + setb + O_BON))[(w * 64 + lane) >> 2];
                    }
                    s16x4 pST[4]; bf16x8 bV[2];
                    {   SC_LANES;
#pragma unroll
                        for (int kb = 0; kb < 4; ++kb) pST[kb] = pk4(ST[kb]);
                        const bf16* iK = img(lds, setb, O_KKD); const bf16* iN = img(lds, setb, O_N);
                        bV[0] = ld128(img(lds, setb, O_VT), 16 * w + fr, 8 * fq); bV[1] = ld128(img(lds, setb, O_VT), 16 * w + fr, 32 + 8 * fq);
                        s16x4 aK[4][4]; bf16x8 aN[6]; s16x4 TT[4], nM[6];
#pragma unroll
                        for (int mt = 0; mt < 4; ++mt) {
#pragma unroll
                            for (int kb = 0; kb < 4; ++kb) aK[mt][kb] = ld64(iK, 16 * mt + fr, 16 * kb + 4 * fq); }
                        aN[0] = ld128(iN, fr, 8 * fq); aN[1] = ld128(iN, 16 + fr, 8 * fq); aN[2] = ld128(iN, 32 + fr, 8 * fq); aN[3] = ld128(iN, 32 + fr, 32 + 8 * fq); aN[4] = ld128(iN, 48 + fr, 8 * fq); aN[5] = ld128(iN, 48 + fr, 32 + 8 * fq);
#pragma unroll
                        for (int d = 0; d < 4; ++d) TT[d] = *(const s16x4*)(lds + setb + O_TT + (d * 64 + lane) * 8);
#pragma unroll
                        for (int e = 0; e < 6; ++e) nM[e] = *(const s16x4*)(lds + setb + O_MC + (e * 64 + lane) * 8);
                        f32x4 racc[4];
#pragma unroll
                        for (int mt = 0; mt < 4; ++mt) { racc[mt] = z4;
#pragma unroll
                            for (int kb = 0; kb < 4; ++kb) racc[mt] = mm16k(aK[mt][kb], pST[kb], racc[mt]); }
                        {
                            f32x4 r2[4];
                            r2[0] = mm32(aN[0], bV[0], z4); r2[1] = mm32(aN[1], bV[0], z4);
                            r2[2] = mm32(aN[2], bV[0], z4); r2[2] = mm32(aN[3], bV[1], r2[2]); r2[3] = mm32(aN[4], bV[0], z4); r2[3] = mm32(aN[5], bV[1], r2[3]);
#pragma unroll
                            for (int mt = 0; mt < 4; ++mt) racc[mt] = racc[mt] + r2[mt];
                        }
#pragma unroll
                        for (int blk = 0; blk < 4; ++blk) {
                            const f32x4 xx = mm16k(TT[blk], pk4(racc[blk]), z4);
                            pxx[blk] = pk4(xx);
#pragma unroll
                            for (int br = blk + 1; br < 4; ++br) { const int e = blk == 0 ? br - 1 : (blk == 1 ? br + 1 : 5); racc[br] = mm16k(nM[e], pxx[blk], racc[br]); }
                        }
                    }
                    {   SC_LANES;
                        const bf16* iR = img(lds, setb, O_RD); const bf16* iP = img(lds, setb, O_P); const bf16* iQ = img(lds, setb, O_NQ);
                        s16x4 aR[4][4], aQ[10]; bf16x8 aP[6];
#pragma unroll
                        for (int mt = 0; mt < 4; ++mt) {
#pragma unroll
                            for (int kb = 0; kb < 4; ++kb) aR[mt][kb] = ld64(iR, 16 * mt + fr, 16 * kb + 4 * fq); }
                        aP[0] = ld128(iP, fr, 8 * fq); aP[1] = ld128(iP, 16 + fr, 8 * fq); aP[2] = ld128(iP, 32 + fr, 8 * fq); aP[3] = ld128(iP, 32 + fr, 32 + 8 * fq); aP[4] = ld128(iP, 48 + fr, 8 * fq); aP[5] = ld128(iP, 48 + fr, 32 + 8 * fq);
                        { int ix = 0;
#pragma unroll
                          for (int mt = 0; mt < 4; ++mt) {
#pragma unroll
                              for (int blk = 0; blk <= mt; ++blk) { aQ[ix] = ld64(iQ, 16 * mt + fr, 16 * blk + 4 * fq); ++ix; } } }
                        f32x4 yacc[4];
#pragma unroll
                        for (int mt = 0; mt < 4; ++mt) { yacc[mt] = z4;
#pragma unroll
                            for (int kb = 0; kb < 4; ++kb) yacc[mt] = mm16k(aR[mt][kb], pST[kb], yacc[mt]); }
                        { int ix = 0;
#pragma unroll
                          for (int mt = 0; mt < 4; ++mt) {
#pragma unroll
                              for (int blk = 0; blk <= mt; ++blk) { yacc[mt] = mm16k(aQ[ix], pxx[blk], yacc[mt]); ++ix; } } }
                        {   f32x4 y2[4];
                            y2[0] = mm32(aP[0], bV[0], z4); y2[1] = mm32(aP[1], bV[0], z4);
                            y2[2] = mm32(aP[2], bV[0], z4); y2[2] = mm32(aP[3], bV[1], y2[2]); y2[3] = mm32(aP[4], bV[0], z4); y2[3] = mm32(aP[5], bV[1], y2[3]);
#pragma unroll
                            for (int mt = 0; mt < 4; ++mt) yacc[mt] = yacc[mt] + y2[mt];
                        }
#pragma unroll
                        for (int mt = 0; mt < 4; ++mt) {
#pragma unroll
                            for (int i = 0; i < 4; ++i) Rf[(16 * mt + 4 * fq + i) * RFP + 16 * w + fr] = yacc[mt][i]; }
                    }
                    {   SC_LANES;
                        const bf16* iKd = img(lds, setb, O_KDT); const bf16* iBd = img(lds, setb, O_NBDT); const float* gt = (const float*)(lds + setb + O_GT);
                        bf16x8 aKd[4][2]; s16x4 aB[4][4]; f32x4 g4[4];
#pragma unroll
                        for (int kb = 0; kb < 4; ++kb) { aKd[kb][0] = ld128(iKd, 16 * kb + fr, 8 * fq); aKd[kb][1] = ld128(iKd, 16 * kb + fr, 32 + 8 * fq); g4[kb] = *(const f32x4*)&gt[16 * kb + 4 * fq];
#pragma unroll
                            for (int blk = 0; blk < 4; ++blk) aB[kb][blk] = ld64(iBd, 16 * kb + fr, 16 * blk + 4 * fq); }
#pragma unroll
                        for (int kb = 0; kb < 4; ++kb) {
                            f32x4 s2 = mm32(aKd[kb][0], bV[0], z4); s2 = mm32(aKd[kb][1], bV[1], s2);
                            f32x4 s = z4;
#pragma unroll
                            for (int blk = 0; blk < 4; ++blk) s = mm16k(aB[kb][blk], pxx[blk], s);
                            ST[kb] = ST[kb] * g4[kb] + s2 + s; }
                    }
                    __syncthreads();
                } else { __syncthreads(); }
            }
        }
        if (w < 4) {
            SC_LANES;
            pc_out(p, Rf, prm, bo_out, vg, gg, yb, w, lane);
        }
    }
#undef SC_LANES
}
__device__ __forceinline__ void ph_cumsum(const float* logf, float* cum, const int wv_s) {
    const int tid_ = opaque_tid(wv_s); const int lane = tid_ & 63, wv = tid_ >> 6;
    for (int seq = blockIdx.x * 8 + wv; seq < NB * H; seq += gridDim.x * 8) {
        const int b = seq / H, h = seq % H;
        float loc[32]; float run = 0.f;
#pragma unroll
        for (int q = 0; q < 32; ++q) { run += logf[(size_t)(b * T + lane * 32 + q) * 16 + h]; loc[q] = run; }
        float incl = run;
#pragma unroll
        for (int o = 1; o < 64; o <<= 1) { const float t = __int_as_float(__builtin_amdgcn_ds_bpermute((lane >= o ? lane - o : lane) << 2, __float_as_int(incl))); if (lane >= o) incl += t; }
        const float excl = incl - run;
#pragma unroll
        for (int q = 0; q < 32; ++q) cum[(size_t)seq * T + lane * 32 + q] = -(excl + loc[q]) * LOG2E;
    }
}
#include <hip/hip_bf16.h>
#include <cmath>
namespace attn_body {
using bf16=__hip_bfloat16;
using bf16x8=__attribute__((ext_vector_type(8)))short;
using s16x4=__attribute__((ext_vector_type(4)))short;
using f32x16=__attribute__((ext_vector_type(16)))float;
using u32x4=__attribute__((ext_vector_type(4)))unsigned;
constexpr int BATCH=8,NHEAD=16,SEQ=2048,D=64,DM=NHEAD*D;
constexpr int NW=8,QBLK=32,QB=QBLK*NW,KVBLK=64,NQB=SEQ/QB;
constexpr int ATTN_PITCH=DM, ATTN_UNIT_ROWS=QB;
__device__ __forceinline__ int crow(int r,int hi){return (r&3)+8*(r>>2)+4*hi;}
#define SBAR() __builtin_amdgcn_sched_barrier(0)
__device__ __forceinline__ void cmask(f32x16&p0,f32x16&p1,int jb,int qrel,int hi){
  const float NEG=-INFINITY; int kb=64*jb+4*hi;
  #pragma unroll
  for(int r=0;r<16;++r){int kv=kb+(r&3)+8*(r>>2); if(kv>qrel)p0[r]=NEG; if(kv+32>qrel)p1[r]=NEG;}
}

constexpr int NSLOT=3, SLOTB=8192;
constexpr int LDS_K=0, LDS_V=NSLOT*SLOTB, LDS_WS=2*NSLOT*SLOTB, LDS_OST=LDS_WS+NW*64*4, LDS_BYTES=LDS_OST+NW*4096;
constexpr float C2=0.125f*1.4426950408889634f;
__device__ __forceinline__ void glds16(const void*gsrc,unsigned lds_dst){unsigned keep;
  asm volatile("s_mov_b32 %0, m0\n\ts_mov_b32 m0, %2\n\ts_nop 0\n\tglobal_load_lds_dwordx4 %1, off\n\ts_mov_b32 m0, %0":"=&s"(keep):"v"(gsrc),"s"(lds_dst):"memory");}
__device__ __forceinline__ float max3f(float a,float b,float c){float r;asm("v_max3_f32 %0, %1, %2, %3":"=v"(r):"v"(a),"v"(b),"v"(c));return r;}
__device__ __forceinline__ float max2f(float a,float b){float r;asm("v_max_f32_e32 %0, %1, %2":"=v"(r):"v"(a),"v"(b));return r;}
__device__ __forceinline__ float fadd_s(float a,float b){float r;asm("v_add_f32_e32 %0, %1, %2":"=v"(r):"v"(a),"v"(b));return r;}
__device__ __forceinline__ float fsub_s(float a,float b){float r;asm("v_sub_f32_e32 %0, %1, %2":"=v"(r):"v"(a),"v"(b));return r;}
typedef float f32x2_t __attribute__((ext_vector_type(2))); typedef __bf16 bf16x2_t __attribute__((ext_vector_type(2)));
__device__ __forceinline__ unsigned cvtpk_s(float lo,float hi){f32x2_t v={lo,hi};bf16x2_t b=__builtin_convertvector(v,bf16x2_t);return __builtin_bit_cast(unsigned,b);}
#define WAIT_BAR(N) asm volatile("s_waitcnt vmcnt(" #N ") lgkmcnt(0)\n\ts_barrier":::"memory")

__device__ __forceinline__ void qkt(f32x16&p0,f32x16&p1,const char*Kslot,const bf16x8*qr,const f32x16&negm,int r32,int hi){
  const char*kb=Kslot+hi*1024+r32*16;
  #pragma unroll
  for(int d0=0;d0<4;++d0){
    const bf16x8 b0=*reinterpret_cast<const bf16x8*>(kb+d0*2048);
    const bf16x8 b1=*reinterpret_cast<const bf16x8*>(kb+d0*2048+512);
    if(d0==0){p0=__builtin_amdgcn_mfma_f32_32x32x16_bf16(b0,qr[0],negm,0,0,0);p1=__builtin_amdgcn_mfma_f32_32x32x16_bf16(b1,qr[0],negm,0,0,0);}
    else{p0=__builtin_amdgcn_mfma_f32_32x32x16_bf16(b0,qr[d0],p0,0,0,0);p1=__builtin_amdgcn_mfma_f32_32x32x16_bf16(b1,qr[d0],p1,0,0,0);}}
}
typedef __attribute__((address_space(3))) const char* lds_cptr;
typedef short v4i16_t __attribute__((ext_vector_type(4)));
__device__ __forceinline__ void kload8(bf16x8*kf,lds_cptr kp){
  kf[0]=*(const __attribute__((address_space(3))) bf16x8*)(kp);      kf[1]=*(const __attribute__((address_space(3))) bf16x8*)(kp+512);
  kf[2]=*(const __attribute__((address_space(3))) bf16x8*)(kp+2048); kf[3]=*(const __attribute__((address_space(3))) bf16x8*)(kp+2560);
  kf[4]=*(const __attribute__((address_space(3))) bf16x8*)(kp+4096); kf[5]=*(const __attribute__((address_space(3))) bf16x8*)(kp+4608);
  kf[6]=*(const __attribute__((address_space(3))) bf16x8*)(kp+6144); kf[7]=*(const __attribute__((address_space(3))) bf16x8*)(kp+6656);
}
__device__ __forceinline__ void kload2(bf16x8*kf,lds_cptr kp,int j){ kf[2*j]=*(const __attribute__((address_space(3))) bf16x8*)(kp+j*2048); kf[2*j+1]=*(const __attribute__((address_space(3))) bf16x8*)(kp+j*2048+512); }
__device__ __forceinline__ s16x4 vtr(lds_cptr p){ return __builtin_bit_cast(s16x4,__builtin_amdgcn_ds_read_tr16_b64_v4i16((__attribute__((address_space(3))) v4i16_t*)p)); }
__device__ __forceinline__ float rowmax(const f32x16&p0,const f32x16&p1){
  float a=max3f(p0[0],p0[1],p1[0]),b=max3f(p0[2],p0[3],p1[1]);a=max3f(a,p1[2],p1[3]);
  #pragma unroll
  for(int r=4;r<16;r+=4){a=max3f(a,p0[r],p0[r+1]);b=max3f(b,p0[r+2],p0[r+3]);a=max3f(a,p1[r],p1[r+1]);b=max3f(b,p1[r+2],p1[r+3]);}
  const float m=max2f(a,b);
  auto rr=__builtin_amdgcn_permlane32_swap(__float_as_uint(m),__float_as_uint(m),false,false);
  return max2f(__uint_as_float(rr[0]),__uint_as_float(rr[1]));
}
__device__ __forceinline__ void pv(f32x16*o,int vb,bf16x8 pa0,bf16x8 pa1,bf16x8 pa2,bf16x8 pa3){
  #pragma unroll
  for(int d0=0;d0<2;++d0){s16x4 lo[4],hi[4];
    #pragma unroll
    for(int ks=0;ks<4;++ks){
      asm volatile("ds_read_b64_tr_b16 %0,%1 offset:%c2":"=&v"(lo[ks]):"v"(vb),"i"(d0*4096+ks*1024):"memory");
      asm volatile("ds_read_b64_tr_b16 %0,%1 offset:%c2":"=&v"(hi[ks]):"v"(vb),"i"(d0*4096+ks*1024+512):"memory");}
    asm volatile("s_waitcnt lgkmcnt(0)":::"memory");SBAR();
    #define PK(k) (bf16x8){lo[k][0],lo[k][1],lo[k][2],lo[k][3],hi[k][0],hi[k][1],hi[k][2],hi[k][3]}
    o[d0]=__builtin_amdgcn_mfma_f32_32x32x16_bf16(pa0,PK(0),o[d0],0,0,0);
    o[d0]=__builtin_amdgcn_mfma_f32_32x32x16_bf16(pa1,PK(1),o[d0],0,0,0);
    o[d0]=__builtin_amdgcn_mfma_f32_32x32x16_bf16(pa2,PK(2),o[d0],0,0,0);
    o[d0]=__builtin_amdgcn_mfma_f32_32x32x16_bf16(pa3,PK(3),o[d0],0,0,0);
    #undef PK
  }
}

#ifndef ATTN_STORE16
#define ATTN_STORE16(p,v) (*(u32x4*)(p)=(v))
#endif
typedef __attribute__((address_space(3))) const float* lds_cfptr;
typedef float f32x4b __attribute__((ext_vector_type(4)));
#define BIAS(C0,C1,t) do{ const lds_cfptr nb_=nbt+(t)*64+4*hi; \
    _Pragma("unroll") for(int g_=0;g_<4;++g_){ const f32x4b b0_=*(const __attribute__((address_space(3))) f32x4b*)(nb_+8*g_); const f32x4b b1_=*(const __attribute__((address_space(3))) f32x4b*)(nb_+32+8*g_); \
      C0[4*g_]+=b0_.x; C0[4*g_+1]+=b0_.y; C0[4*g_+2]+=b0_.z; C0[4*g_+3]+=b0_.w; C1[4*g_]+=b1_.x; C1[4*g_+1]+=b1_.y; C1[4*g_+2]+=b1_.z; C1[4*g_+3]+=b1_.w; } }while(0)
template<int THRL> __device__ __forceinline__ void attn_unit(int b,int h,int qb,const bf16*Q,const bf16*__restrict__ K,const bf16*__restrict__ V,bf16*O,char*shm,lds_cfptr nbt,const int wv_s){
  const int tid=::opaque_tid(wv_s),lane=tid&63,r32=lane&31,hi=lane>>5; const int wid=wv_s;
  const long rowbase=(long)b*SEQ; const int q0=qb*QB;
  const bf16*Qw=Q+(rowbase+q0+wid*QBLK)*DM+h*D;
  const bf16*Kh=K+rowbase*DM+h*D,*Vh=V+rowbase*DM+h*D;
  const unsigned lds0=(unsigned)(uintptr_t)shm;
  float*wsf=(float*)(shm+LDS_WS)+wid*64;
  const bf16*ksrc=Kh+(long)lane*DM+wid*8;
  const bf16*vsrc=Vh+(long)(16*(wid&3)+(lane>>2))*DM+(wid>>2)*32+(lane&3)*8;
  const unsigned kdst=lds0+LDS_K+wid*1024, vdst=lds0+LDS_V+wid*1024;
  #define DMA_K(t,slot) glds16(ksrc+(long)(t)*KVBLK*DM,(unsigned)__builtin_amdgcn_readfirstlane(kdst+(slot)))
  #define DMA_V(t,slot) glds16(vsrc+(long)(t)*KVBLK*DM,(unsigned)__builtin_amdgcn_readfirstlane(vdst+(slot)))
  const int vb0=(int)(lds0+LDS_V)+((lane>>4)&1)*32+(lane&3)*8+(4*hi+((lane&15)>>2))*64;
  const char*Kbase=shm+LDS_K; bf16x8 kf[8];
  const lds_cptr shm3=(lds_cptr)shm; const lds_cptr kp0=shm3+LDS_K+hi*1024+r32*16; const lds_cptr vp0=shm3+LDS_V+((lane>>4)&1)*32+(lane&3)*8+(4*hi+((lane&15)>>2))*64;
  const int NT=(q0+QB)/KVBLK;
  DMA_K(0,0);DMA_V(0,0);DMA_K(1,SLOTB);
  bf16x8 qr[4];
  #pragma unroll
  for(int d0=0;d0<4;++d0)qr[d0]=*reinterpret_cast<const bf16x8*>(&Qw[(long)r32*DM+d0*16+hi*8]);
  float mhat=0.f,l_reg=0.f;f32x16 o[2];o[0]=f32x16{};o[1]=f32x16{};f32x16 negm=f32x16{};asm volatile("":"+v"(negm));
  const int qrel=wid*QBLK+r32;
  #define CMASK(P0,P1,t) do{int jb_=(t)-(NT-4); if(jb_>=0)cmask(P0,P1,jb_,qrel,hi);}while(0)
  bool resc=false;
  #define START(P0,P1) do{ const float rm=rowmax(P0,P1); resc=false; \
    { const float dl=rm; mhat=fadd_s(mhat,dl); \
      _Pragma("unroll") for(int r=0;r<16;++r){P0[r]=fsub_s(P0[r],dl);P1[r]=fsub_s(P1[r],dl);} \
      _Pragma("unroll") for(int r=0;r<16;++r)negm[r]=-mhat; asm volatile("":"+v"(negm)); } \
    _Pragma("unroll") for(int r=0;r<16;++r)P0[r]=__builtin_amdgcn_exp2f(P0[r]); }while(0)
  #define RESC() do{ if(resc){ asm volatile("s_waitcnt lgkmcnt(0)":::"memory"); \
      _Pragma("unroll") for(int d_=0;d_<2;++d_) _Pragma("unroll") for(int r=0;r<16;++r)o[d_][r]*=wsf[crow(r,hi)]; } }while(0)
  f32x16 pA0,pA1,pB0,pB1;
  int sl_prev=0,sl_cur=0,sl_next=SLOTB;
  #define ROT() do{sl_prev=sl_cur;sl_cur=sl_next;sl_next=(sl_next==(NSLOT-1)*SLOTB)?0:sl_next+SLOTB;}while(0)
  DMA_K(2,2*SLOTB);
  WAIT_BAR(3);
  qkt(pA0,pA1,Kbase,qr,negm,r32,hi);asm volatile("s_nop 15\n\ts_nop 7":"+v"(pA0),"+v"(pA1));BIAS(pA0,pA1,0);CMASK(pA0,pA1,0);
  START(pA0,pA1);
  _Pragma("unroll") for(int r=0;r<16;++r)pA1[r]=__builtin_amdgcn_exp2f(pA1[r]);
  WAIT_BAR(0);
  DMA_K(3,0);DMA_V(1,SLOTB);
  ROT();
  kload8(kf,kp0+sl_cur);
  WAIT_BAR(2);
  s16x4 vlo[8],vhi[8]; u32x4 pw0,pw1,pw2,pw3;
  #define PKW(P,B) cvtpk_s(P[B],P[B+1])
  #define PAF(k) __builtin_bit_cast(bf16x8,pw##k)
  #define VFR(i) (bf16x8){vlo[i][0],vlo[i][1],vlo[i][2],vlo[i][3],vhi[i][0],vhi[i][1],vhi[i][2],vhi[i][3]}
  #define PIN(x) asm volatile("":"+v"(x))
  #define MX3(a,b,c) __builtin_fmaxf(__builtin_fmaxf((a),(b)),(c))
  #define GAPA(MF,A0,A1,A2,A3,W0,W1,PW) do{ MF; sacc+=A0; sacc+=A1; sacc+=A2; sacc+=A3; PIN(sacc); W0; W1; PIN(PW); SBAR(); }while(0)
  #define EX(v) __builtin_amdgcn_exp2f(v)
  #define GAPB(MF,X,B) do{ MF; X[B]=EX(X[B]); X[B+1]=EX(X[B+1]); X[B+2]=EX(X[B+2]); X[B+3]=EX(X[B+3]); PIN(X); SBAR(); }while(0)
  #define VRD(i) do{ vlo[i]=vtr(vp_+(((i)>>2)*4096+((i)&3)*1024)); vhi[i]=vtr(vp_+(((i)>>2)*4096+((i)&3)*1024+512)); }while(0)
  #define KRD(G,j) do{ if(G){ kload2(kf,kp0+sl_next,j); SBAR(); } }while(0)
  #define STEP(C0,C1,P0,P1,t,GK,GV,GL) do{ SBAR(); \
    const lds_cptr vp_=vp0+sl_prev; \
    VRD(0); SBAR(); float sacc=(P0[0]+P0[1]); \
    GAPA(C0=__builtin_amdgcn_mfma_f32_32x32x16_bf16(kf[0],qr[0],negm,0,0,0), P0[2],P0[3],P0[4],P0[5],     pw0[0]=PKW(P0,0), pw0[1]=PKW(P0,2), pw0); \
    VRD(4); SBAR(); GAPA(C1=__builtin_amdgcn_mfma_f32_32x32x16_bf16(kf[1],qr[0],negm,0,0,0), P0[6],P0[7],P0[8],P0[9],     pw0[2]=PKW(P0,4), pw0[3]=PKW(P0,6), pw0); \
    VRD(1); SBAR(); GAPA(C0=__builtin_amdgcn_mfma_f32_32x32x16_bf16(kf[2],qr[1],C0,0,0,0),   P0[10],P0[11],P0[12],P0[13], pw1[0]=PKW(P0,8), pw1[1]=PKW(P0,10), pw1); \
    VRD(5); SBAR(); GAPA(C1=__builtin_amdgcn_mfma_f32_32x32x16_bf16(kf[3],qr[1],C1,0,0,0),   P0[14],P0[15],P1[0],P1[1],   pw1[2]=PKW(P0,12),pw1[3]=PKW(P0,14), pw1); \
    VRD(2); SBAR(); GAPA(C0=__builtin_amdgcn_mfma_f32_32x32x16_bf16(kf[4],qr[2],C0,0,0,0),   P1[2],P1[3],P1[4],P1[5],     pw2[0]=PKW(P1,0), pw2[1]=PKW(P1,2), pw2); \
    VRD(6); SBAR(); GAPA(C1=__builtin_amdgcn_mfma_f32_32x32x16_bf16(kf[5],qr[2],C1,0,0,0),   P1[6],P1[7],P1[8],P1[9],     pw2[2]=PKW(P1,4), pw2[3]=PKW(P1,6), pw2); \
    VRD(3); SBAR(); GAPA(C0=__builtin_amdgcn_mfma_f32_32x32x16_bf16(kf[6],qr[3],C0,0,0,0),   P1[10],P1[11],P1[12],P1[13], pw3[0]=PKW(P1,8), pw3[1]=PKW(P1,10), pw3); \
    VRD(7); SBAR(); GAPA(C1=__builtin_amdgcn_mfma_f32_32x32x16_bf16(kf[7],qr[3],C1,0,0,0),   P1[14],P1[15],0.f,0.f,       pw3[2]=PKW(P1,12),pw3[3]=PKW(P1,14), pw3); \
    l_reg+=sacc; \
    if(GK){DMA_K((t)+3,sl_cur);} if(GV){DMA_V((t)+1,sl_next);} \
    BIAS(C0,C1,t); CMASK(C0,C1,t); \
    { float a=MX3(C0[0],C0[1],C1[0]),b=MX3(C0[2],C0[3],C1[1]); a=MX3(a,C1[2],C1[3]); \
      _Pragma("unroll") for(int r=4;r<16;r+=4){a=MX3(a,C0[r],C0[r+1]);b=MX3(b,C0[r+2],C0[r+3]);a=MX3(a,C1[r],C1[r+1]);b=MX3(b,C1[r+2],C1[r+3]);} \
      float rm=__builtin_fmaxf(a,b); { auto rr=__builtin_amdgcn_permlane32_swap(__float_as_uint(rm),__float_as_uint(rm),false,false); rm=__builtin_fmaxf(__uint_as_float(rr[0]),__uint_as_float(rr[1])); } \
      resc=false; \
      if(__builtin_expect(__any(rm>(float)THRL),0)){ const float dl=__builtin_fmaxf(rm,0.f); mhat+=dl; \
        _Pragma("unroll") for(int r=0;r<16;++r){C0[r]-=dl;C1[r]-=dl;} \
        _Pragma("unroll") for(int r=0;r<16;++r)negm[r]=-mhat; asm volatile("":"+v"(negm)); \
        const float f=__builtin_amdgcn_exp2f(-dl); l_reg*=f; if(hi==0)wsf[r32]=f; resc=true; } } \
    SBAR(); \
    GAPB(o[0]=__builtin_amdgcn_mfma_f32_32x32x16_bf16(PAF(0),VFR(0),o[0],0,0,0), C0,0); \
    GAPB(o[1]=__builtin_amdgcn_mfma_f32_32x32x16_bf16(PAF(0),VFR(4),o[1],0,0,0), C0,4); \
    KRD(GL,0); GAPB(o[0]=__builtin_amdgcn_mfma_f32_32x32x16_bf16(PAF(1),VFR(1),o[0],0,0,0), C0,8); \
    KRD(GL,1); GAPB(o[1]=__builtin_amdgcn_mfma_f32_32x32x16_bf16(PAF(1),VFR(5),o[1],0,0,0), C0,12); \
    KRD(GL,2); GAPB(o[0]=__builtin_amdgcn_mfma_f32_32x32x16_bf16(PAF(2),VFR(2),o[0],0,0,0), C1,0); \
    KRD(GL,3); GAPB(o[1]=__builtin_amdgcn_mfma_f32_32x32x16_bf16(PAF(2),VFR(6),o[1],0,0,0), C1,4); \
    GAPB(o[0]=__builtin_amdgcn_mfma_f32_32x32x16_bf16(PAF(3),VFR(3),o[0],0,0,0), C1,8); \
    GAPB(o[1]=__builtin_amdgcn_mfma_f32_32x32x16_bf16(PAF(3),VFR(7),o[1],0,0,0), C1,12); \
    }while(0)
  int t=1;
  #undef CMASK
  #define CMASK(P0,P1,t) do{}while(0)
  for(;t+5<NT;t+=2){
    STEP(pB0,pB1,pA0,pA1,t,true,true,true);     WAIT_BAR(2); RESC(); ROT();
    STEP(pA0,pA1,pB0,pB1,t+1,true,true,true);   WAIT_BAR(2); RESC(); ROT();
  }
  #undef CMASK
  #define CMASK(P0,P1,t) do{int jb_=(t)-(NT-4); if(jb_>=0)cmask(P0,P1,jb_,qrel,hi);}while(0)
  #define ENDW(tt) do{ if((tt)+3<NT){WAIT_BAR(2);} else if((tt)+2<NT){WAIT_BAR(1);} else {WAIT_BAR(0);} }while(0)
  for(;t+1<NT;t+=2){
    STEP(pB0,pB1,pA0,pA1,t,(t+3<NT),(t+1<NT),(t+1<NT));       ENDW(t);   RESC(); ROT();
    STEP(pA0,pA1,pB0,pB1,t+1,(t+4<NT),(t+2<NT),(t+2<NT));     ENDW(t+1); RESC(); ROT();
  }
  STEP(pB0,pB1,pA0,pA1,NT-1,false,false,false); RESC();
  { float sacc=pB0[0]+pB0[1]; _Pragma("unroll") for(int r=2;r<16;++r)sacc+=pB0[r]; _Pragma("unroll") for(int r=0;r<16;++r)sacc+=pB1[r]; l_reg+=sacc;
    pw0=(u32x4){PKW(pB0,0),PKW(pB0,2),PKW(pB0,4),PKW(pB0,6)};pw1=(u32x4){PKW(pB0,8),PKW(pB0,10),PKW(pB0,12),PKW(pB0,14)};pw2=(u32x4){PKW(pB1,0),PKW(pB1,2),PKW(pB1,4),PKW(pB1,6)};pw3=(u32x4){PKW(pB1,8),PKW(pB1,10),PKW(pB1,12),PKW(pB1,14)};
    SBAR(); pv(o,vb0+sl_cur,PAF(0),PAF(1),PAF(2),PAF(3)); }
  #undef PKW
  #undef PAF
  #undef VFR
  #undef PIN
  #undef MX3
  #undef GAPA
  #undef GAPB
  #undef EX
  #undef VRD
  #undef KRD
  #undef STEP
  #undef ENDW
  {auto rr=__builtin_amdgcn_permlane32_swap(__float_as_uint(l_reg),__float_as_uint(l_reg),false,false);l_reg=__uint_as_float(rr[0])+__uint_as_float(rr[1]);}
  if(hi==0)wsf[32+r32]=l_reg;asm volatile("s_waitcnt lgkmcnt(0)":::"memory");
  float rli[16];
  #pragma unroll
  for(int r=0;r<16;++r)rli[r]=__builtin_amdgcn_rcpf(wsf[32+crow(r,hi)]);
  bf16*Ow=O+(rowbase+q0+wid*QBLK)*DM+h*D;
  { bf16*stg=(bf16*)(shm+LDS_OST)+wid*2048;
    #pragma unroll
    for(int r=0;r<16;++r){const int orow=crow(r,hi);
      #pragma unroll
      for(int d0=0;d0<2;++d0)stg[orow*64+d0*32+r32]=__float2bfloat16(o[d0][r]*rli[r]);}
    asm volatile("s_waitcnt lgkmcnt(0)":::"memory");
    #pragma unroll
    for(int i=0;i<4;++i){const int row=i*8+(lane>>3),ch=lane&7; const u32x4 v=*(const u32x4*)(stg+row*64+ch*8); ATTN_STORE16(Ow+(long)row*DM+ch*8,v);} }
  asm volatile("s_waitcnt lgkmcnt(0)\n\ts_barrier":::"memory");
  #undef DMA_K
  #undef DMA_V
  #undef CMASK
  #undef START
  #undef RESC
  #undef ROT
}
constexpr int ATTN_LDS_BYTES=LDS_BYTES;
struct AttnTensors { const bf16* Q; const bf16* K; const bf16* V; bf16* O; };
struct AttnUnit { int bh; int qb; };
struct StaticOrder {
  int vcu, G;
  __device__ __forceinline__ explicit StaticOrder(int grid,int block):vcu((grid%8==0)?(block%8)*(grid/8)+block/8:block),G(grid){}
  __device__ __forceinline__ bool next(int i,AttnUnit&u)const{ if(G!=256||i>=4)return false; const int s=vcu&1; u.bh=vcu>>1; u.qb=(i==0)?s:(i==1)?7-s:(i==2)?3-s:4+s; return true; }
  __device__ __forceinline__ void a_ready(const AttnUnit&)const{}
  __device__ __forceinline__ void done(const AttnUnit&)const{}
};
template<class Sched,int THRL=8> __device__ __forceinline__ void attn_phase(char*lds,const AttnTensors&T,const float*nbias,const Sched&S,const int wv_s){
  AttnUnit u;
  if(!S.next(0,u))return;
  { float*tab=(float*)(lds+LDS_BYTES); const float*src=nbias+(long)u.bh*SEQ;
    for(int k=::opaque_tid(wv_s);k<SEQ;k+=NW*64)tab[k]=src[k];
    asm volatile("s_waitcnt vmcnt(0) lgkmcnt(0)\n\ts_barrier":::"memory"); }
  const lds_cfptr nbt=(lds_cfptr)(lds+LDS_BYTES);
  for(int i=0;S.next(i,u);++i){ S.a_ready(u); attn_unit<THRL>(u.bh/NHEAD,u.bh%NHEAD,u.qb,T.Q,T.K,T.V,T.O,lds,nbt,wv_s); S.done(u); }
}
#undef BIAS
#undef SBAR
#undef WAIT_BAR
}
#define XB_TMO      128
#define XB_XCNT(j)  (256  + 64 * (j))
#define XB_XSUB(j)  (1280 + 64 * (j))
#define XB_XGEN(j)  (2304 + 64 * (j))
#define XB_TOP      3328
#define XB_TOPGEN   3392
#define XCD_BAR_WORDS 3456
#define XB_SPIN_CAP (1u << 18)


__device__ __forceinline__ unsigned xb_ld(unsigned* p)              { return __hip_atomic_load(p, __ATOMIC_RELAXED, __HIP_MEMORY_SCOPE_AGENT); }
__device__ __forceinline__ unsigned xb_add(unsigned* p, unsigned v) { return __hip_atomic_fetch_add(p, v, __ATOMIC_RELAXED, __HIP_MEMORY_SCOPE_AGENT); }
__device__ __forceinline__ unsigned xb_xcc_id() { return (unsigned)__builtin_amdgcn_s_getreg((3 << 11) | 20) & 0xFu; }
#define XB_SPIN(cond, bar) do { unsigned _sp = 0; while (cond) { __builtin_amdgcn_s_sleep(1); \
    if ((++_sp & 255u) == 0u) { if (xb_ld(&(bar)[XB_TMO])) break; if (_sp > XB_SPIN_CAP) { atomicAdd(&(bar)[XB_TMO], 1u); break; } } } } while (0)

struct XcdBarrier { unsigned* bar; unsigned x; volatile LAS unsigned* st; };

__device__ __forceinline__ XcdBarrier xcd_barrier_post(unsigned* bar, volatile LAS unsigned* st) {
    XcdBarrier b; b.bar = bar; b.x = xb_xcc_id(); b.st = st;
    if (threadIdx.x == 0) (void)xb_add(&bar[XB_XCNT(b.x)], 1u);
    return b;
}
__device__ __forceinline__ void xcd_barrier_complete(unsigned* bar, unsigned x, unsigned& nloc, unsigned& nx) {
    const unsigned G = gridDim.x * gridDim.y * gridDim.z;
    unsigned sum, cnt, mine, sp = 0u;
    for (;;) {
        sum = 0u; cnt = 0u; mine = 0u;
#pragma unroll
        for (unsigned j = 0; j < 16; ++j) { const unsigned c = xb_ld(&bar[XB_XCNT(j)]); sum += c; cnt += (c > 0u) ? 1u : 0u; mine = (j == x) ? c : mine; }
        if (sum == G) break;
        __builtin_amdgcn_s_sleep(1);
        if ((++sp & 255u) == 0u) { if (xb_ld(&bar[XB_TMO])) break; if (sp > XB_SPIN_CAP) { atomicAdd(&bar[XB_TMO], 1u); break; } }
    }
    nloc = mine > 0u ? mine : 1u; nx = cnt > 0u ? cnt : 1u;
}
__device__ __forceinline__ void xcd_barrier(const XcdBarrier& b) {
    asm volatile("s_waitcnt vmcnt(0)" ::: "memory");
    __syncthreads();
    if (threadIdx.x == 0) {
        unsigned* bar = b.bar; unsigned bx = b.x; asm volatile("" : "+s"(bx));
        __builtin_amdgcn_s_waitcnt(0);
        unsigned nloc = b.st[0], nx = b.st[1];
        if (nloc == 0u) { xcd_barrier_complete(bar, bx, nloc, nx); b.st[0] = nloc; b.st[1] = nx; }
        const unsigned old = xb_add(&bar[XB_XSUB(bx)], 1u);
        const unsigned gen = old / nloc;
        if (old + 1u == (gen + 1u) * nloc) {
            __builtin_amdgcn_fence(__ATOMIC_RELEASE, "agent");
            asm volatile("s_waitcnt vmcnt(0)" ::: "memory");
            const unsigned og = xb_add(&bar[XB_TOP], 1u);
            const unsigned tg = og / nx;
            if (og + 1u == (tg + 1u) * nx) xb_add(&bar[XB_TOPGEN], 1u);
            else XB_SPIN(xb_ld(&bar[XB_TOPGEN]) == tg, bar);
            __builtin_amdgcn_fence(__ATOMIC_ACQUIRE, "agent");
            xb_add(&bar[XB_XGEN(bx)], 1u);
            asm volatile("s_waitcnt vmcnt(0)" ::: "memory");
        } else {
            XB_SPIN(xb_ld(&bar[XB_XGEN(bx)]) == gen, bar);
            __builtin_amdgcn_fence(__ATOMIC_ACQUIRE, "agent");
            asm volatile("s_waitcnt vmcnt(0)" ::: "memory");
        }
    }
    __syncthreads();
}

enum { I_X = 0, I_MIX, I_WR, I_WK, I_WV, I_WO, I_W0, I_W1, I_W2, I_A0, I_A1, I_A2, I_G1, I_G2, I_KK, I_KA, I_RK, I_GNG, I_GNB,
       I_FWIN, I_FBF, I_FWO, I_RW, I_RB, I_MG, I_MU, I_MD, I_LNG, I_LNB, N_IN };
constexpr int LDS_BYTES = 163840;
constexpr int LDS_MISC = LDS_BYTES - 64;
static_assert(CTL_BAR_OFF + XCD_BAR_WORDS * 4 <= CTL_BYTES, "ctl block");

struct Params { const float* in[N_IN]; float* out; unsigned char* ws; };

__device__ __forceinline__ void ph_xmix(const float* x, const float* mix, bf16* xcat, bf16* xr3, int gw, int NGW, int lane) {
    f32x4 mr[4], mk[4], mv[4];
#pragma unroll
    for (int j = 0; j < 4; ++j) { mr[j] = *(const f32x4*)(mix + 0 * D + 4 * lane + 256 * j); mk[j] = *(const f32x4*)(mix + 2 * D + 4 * lane + 256 * j); mv[j] = *(const f32x4*)(mix + 3 * D + 4 * lane + 256 * j); }
    for (int row = gw; row < M; row += NGW) {
        const bool hp = (row & (T - 1)) != 0;
#pragma unroll
        for (int j = 0; j < 4; ++j) {
            const int col = 4 * lane + 256 * j;
            const f32x4 c4 = *(const f32x4*)(x + (size_t)row * D + col);
            f32x4 p4 = (f32x4){0.f, 0.f, 0.f, 0.f};
            if (hp) p4 = *(const f32x4*)(x + (size_t)(row - 1) * D + col);
            const f32x4 xx = p4 - c4;
            u32x2 o;
            o.x = pk2(c4.x, c4.y); o.y = pk2(c4.z, c4.w); *(u32x2*)(xcat + (size_t)row * 2048 + col) = o;
            o.x = pk2(xx.x, xx.y); o.y = pk2(xx.z, xx.w); *(u32x2*)(xcat + (size_t)row * 2048 + 1024 + col) = o;
            f32x4 v = c4 + xx * mr[j]; o.x = pk2(v.x, v.y); o.y = pk2(v.z, v.w); *(u32x2*)(xr3 + (size_t)row * D + col) = o;
            v = c4 + xx * mk[j]; o.x = pk2(v.x, v.y); o.y = pk2(v.z, v.w); *(u32x2*)(xr3 + (size_t)M * D + (size_t)row * D + col) = o;
            v = c4 + xx * mv[j]; o.x = pk2(v.x, v.y); o.y = pk2(v.z, v.w); *(u32x2*)(xr3 + 2 * (size_t)M * D + (size_t)row * D + col) = o;
        }
    }
}

__global__ void __launch_bounds__(512, 2) fwd(Params P) {
    extern __shared__ __attribute__((aligned(16))) unsigned char lds[];
    LAS unsigned char* lds3 = (LAS unsigned char*)lds;
    volatile LAS unsigned* misc = (volatile LAS unsigned*)(lds3 + LDS_MISC);
    if (threadIdx.x < 16) misc[threadIdx.x] = 0u;
    const int wv_s = __builtin_amdgcn_readfirstlane(threadIdx.x >> 6);
    __syncthreads();
    unsigned char* ws = P.ws;
    XcdBarrier bar = xcd_barrier_post((unsigned*)(ws + WS_CTL + CTL_BAR_OFF), misc);
    const int G = gridDim.x, bid = blockIdx.x;
    float* hbuf = P.out;
    bf16* PRE = (bf16*)P.out;
    int* counts0 = (int*)(ws + WS_CTL);
    bf16* HB = (bf16*)(ws + WS_HB); bf16* R = (bf16*)(ws + WS_R); bf16* KB = (bf16*)(ws + WS_K); bf16* VB = (bf16*)(ws + WS_V);
    _Float16* LW = (_Float16*)(ws + WS_LW); bf16* AA = (bf16*)(ws + WS_AA); bf16* GG = (bf16*)(ws + WS_G); bf16* L1 = (bf16*)(ws + WS_L1);
    float* LOGF = (float*)(ws + WS_LOGF); float* CUM = (float*)(ws + WS_CUM); bf16* Y = (bf16*)(ws + WS_Y); bf16* HID = (bf16*)(ws + WS_HID);
    bf16* GUT = (bf16*)(ws + WS_MOEW); bf16* DNT = (bf16*)(ws + WS_DNT);
    bf16* GUT1 = (bf16*)((unsigned char*)P.out + 32 * MiB); bf16* DNT1 = (bf16*)(ws + WS_DNT1);
    const size_t BIG = (size_t)1 << 20;

    {
        const int tid = opaque_tid(wv_s), lane = tid & 63, wave = tid >> 6;
        const int gw = bid * 8 + wave, NGW = G * 8;
        LAS float* scr = (LAS float*)(lds3 + wave * 16384);
        bf16* WRKV = (bf16*)(ws + WS_WRKV); bf16* WO = (bf16*)(ws + WS_WO); bf16* B1T = (bf16*)(ws + WS_B1T); bf16* B2T = (bf16*)(ws + WS_B2T);
        bf16* WIN = (bf16*)(ws + WS_WIN); bf16* FWO = (bf16*)(ws + WS_FWO);
        const float* mix = P.in[I_MIX];
        int ib = 0;
        ib = tr_matrix(ib, gw, NGW, P.in[I_WR], D, D, D, nullptr, WRKV, D, 0, 0, 0, scr, lane);
        ib = tr_matrix(ib, gw, NGW, P.in[I_WK], D, D, D, nullptr, WRKV, D, 0, D, 0, scr, lane);
        ib = tr_matrix(ib, gw, NGW, P.in[I_WV], D, D, D, nullptr, WRKV, D, 0, 2 * D, 0, scr, lane);
        ib = tr_matrix(ib, gw, NGW, P.in[I_W1], 64, D, 64, nullptr, B1T, 2048, 0, 0, 0, scr, lane);
        ib = tr_matrix(ib, gw, NGW, P.in[I_W1], 64, D, 64, mix + 1 * D, B1T, 2048, 1024, 0, 0, scr, lane);
        ib = tr_matrix(ib, gw, NGW, P.in[I_A1], 64, D, 64, nullptr, B1T, 2048, 0, 64, 0, scr, lane);
        ib = tr_matrix(ib, gw, NGW, P.in[I_A1], 64, D, 64, mix + 4 * D, B1T, 2048, 1024, 64, 0, scr, lane);
        ib = tr_matrix(ib, gw, NGW, P.in[I_G1], 128, D, 128, nullptr, B1T, 2048, 0, 128, 0, scr, lane);
        ib = tr_matrix(ib, gw, NGW, P.in[I_G1], 128, D, 128, mix + 5 * D, B1T, 2048, 1024, 128, 0, scr, lane);
        ib = tr_matrix(ib, gw, NGW, P.in[I_W2], D, 64, D, nullptr, B2T, 256, 0, 0, 0, scr, lane);
        ib = tr_matrix(ib, gw, NGW, P.in[I_A2], D, 64, D, nullptr, B2T, 256, 64, 1024, 0, scr, lane);
        ib = tr_matrix(ib, gw, NGW, P.in[I_G2], D, 128, D, nullptr, B2T, 256, 128, 2048, 0, scr, lane);
        for (int ch = bid * 512 + tid; ch < 3072 * 32; ch += G * 512) {
            const int row = ch >> 5, c8 = ch & 31;
            const bool covered = row < 1024 ? (c8 < 8) : (row < 2048 ? (c8 >= 8 && c8 < 16) : (c8 >= 16));
            if (!covered) *(u32x4*)(B2T + (size_t)row * 256 + c8 * 8) = (u32x4){0u, 0u, 0u, 0u};
        }
        ph_xmix(P.in[I_X], mix, (bf16*)(ws + WS_XCAT), (bf16*)(ws + WS_XR), gw, NGW, lane);
    }
    xcd_barrier(bar);
    {
        const int G1 = G / 4, G2 = G - G1;
        pg8::DenseOrder S1; S1.init(M, 256, 2048, G1, bid < G1 ? bid : -1, ws + WS_XCAT, ws + WS_B1T, 1 << 20, 0);
        pg8::EpiBf16 E1; E1.O = L1; E1.ldc = 256; E1.split_div = 1; E1.split_stride = 0; E1.scale0 = 1.f; E1.act = 1; E1.scanlay = 0;
        pg8::gemm_phase<pg8::EpiBf16, pg8::DenseOrder, true, false>(lds3, 2048, S1, E1, wv_s);
        pg8::DenseOrder S2; S2.init(M, 3 * D, D, G2, bid >= G1 ? bid - G1 : -1, ws + WS_XR, ws + WS_WRKV, 4, (size_t)M * D * 2);
        pg8::EpiBf16 E2; E2.O = R; E2.ldc = D; E2.split_div = 4; E2.split_stride = (size_t)M * D; E2.scale0 = 1.f; E2.act = 0; E2.scanlay = 1;
        pg8::gemm_phase<pg8::EpiBf16, pg8::DenseOrder, true, false>(lds3, D, S2, E2, wv_s);
    }
    xcd_barrier(bar);
    {
        pg8::DenseOrder S; S.init(M, 3 * D, 256, G, bid, L1, ws + WS_B2T, 8, 256); S.kl = 128; S.bsel = 1;
        pg8::EpiLora2 E; E.LW = LW; E.AG = AA; E.w0 = P.in[I_W0]; E.a0 = P.in[I_A0];
        pg8::gemm_phase<pg8::EpiLora2, pg8::DenseOrder, true, false>(lds3, 256, S, E, wv_s);
    }
    xcd_barrier(bar);
    {
        const bool split = G >= 256;
        if (!split || bid < NB * H) {
            ScanP p; p.r = R; p.k = KB; p.v = VB; p.lw = LW; p.a = AA; p.g = GG; p.yg = R; p.kk = P.in[I_KK]; p.ka = P.in[I_KA]; p.rk = P.in[I_RK]; p.gng = P.in[I_GNG]; p.gnb = P.in[I_GNB];
            ph_scan_pc(p, lds, split ? NB * H : G, wv_s);
        }
        if (!split || bid >= NB * H) {
            const int tid = opaque_tid(wv_s), lane = tid & 63, wave = tid >> 6;
            __syncthreads();
            if (bid == G - 1) {
                build_router_frags(P.in[I_LNG] + 0 * D, P.in[I_LNB] + 0 * D, P.in[I_RW], ws + WS_WF, lds, tid);
                build_router_frags(P.in[I_LNG] + 2 * D, P.in[I_LNB] + 2 * D, P.in[I_RW], ws + WS_WF + WF_STRIDE, lds, tid);
            }
            {
                const int gw = split ? (bid - NB * H) * 8 + wave : bid * 8 + wave, NGW = split ? (G - NB * H) * 8 : G * 8; LAS float* scr = (LAS float*)(lds3 + wave * 16384); int ib = 0;
                ib = tr_matrix(ib, gw, NGW, P.in[I_WO], D, D, D, nullptr, (bf16*)(ws + WS_WO), D, 0, 0, 0, scr, lane);
                ib = tr_matrix(ib, gw, NGW, P.in[I_FWIN], NW_IN, D, 3 * D, nullptr, (bf16*)(ws + WS_WIN), D, 0, 0, 0, scr, lane);
                ib = tr_matrix(ib, gw, NGW, P.in[I_FWO], D, D, D, nullptr, (bf16*)(ws + WS_FWO), D, 0, 0, 0, scr, lane);
            }
            convert_moe(P.in[I_MG], P.in[I_MU], P.in[I_MD], GUT, DNT, split ? (bid - NB * H) * 8 + wave : bid * 8 + wave, split ? (G - NB * H) * 8 : G * 8, (LAS float*)(lds3 + wave * 16384), lane);
            convert_moe(P.in[I_MG] + (size_t)NE * D * DE, P.in[I_MU] + (size_t)NE * D * DE, P.in[I_MD] + (size_t)NE * DE * D, GUT1, DNT1, split ? (bid - NB * H) * 8 + wave : bid * 8 + wave, split ? (G - NB * H) * 8 : G * 8, (LAS float*)(lds3 + wave * 16384), lane);
            if (split) {
                const float* xs = P.in[I_X]; float accd = 0.f;
                const size_t nline = (size_t)M * D / 32, stride = (size_t)(G - NB * H) * 512;
#pragma unroll 8
                for (size_t i = (size_t)(bid - NB * H) * 512 + tid; i < nline; i += stride) accd += xs[i * 32];
                if (accd == 1.2345e38f) ((float*)(ws + WS_CTL))[8191] = accd;
            }
        }
    }
    xcd_barrier(bar);
    {
        pg8::DenseOrder S; S.init(M, D, D, G, bid, R, ws + WS_WO, 1 << 20, 0); S.ascan = 1;
        pg8::EpiPre E; E.hin32 = P.in[I_X]; E.hin16 = nullptr; E.out = PRE;
        pg8::gemm_phase<pg8::EpiPre, pg8::DenseOrder, true, false>(lds3, D, S, E, wv_s);
    }
    xcd_barrier(bar);
    for (int layer = 0; layer < 2; ++layer) {
        if (layer == 1) {
            ph_cumsum(LOGF, CUM, wv_s);
            {
                pg8::DenseOrder S; S.init(M, 3 * D, D, G, bid, HB, ws + WS_WIN, 1 << 20, 0);
                pg8::EpiBf16 E; E.O = R; E.ldc = D; E.split_div = 4; E.split_stride = (size_t)M * D; E.scale0 = attn_body::C2; E.act = 0; E.scanlay = 0;
                pg8::gemm_phase<pg8::EpiBf16, pg8::DenseOrder, true, false>(lds3, D, S, E, wv_s);
            }
            xcd_barrier(bar);
            {   const attn_body::AttnTensors AT{(const attn_body::bf16*)R, (const attn_body::bf16*)KB, (const attn_body::bf16*)VB, (attn_body::bf16*)R};
                const attn_body::StaticOrder S(G, bid);
                attn_body::attn_phase<attn_body::StaticOrder, 30>((char*)lds, AT, CUM, S, wv_s); }
            xcd_barrier(bar);
            {
                pg8::DenseOrder S; S.init(M, D, D, G, bid, R, ws + WS_FWO, 1 << 20, 0);
                pg8::EpiPre E; E.hin32 = nullptr; E.hin16 = HB; E.out = PRE;
                pg8::gemm_phase<pg8::EpiPre, pg8::DenseOrder, true, false>(lds3, D, S, E, wv_s);
            }
            xcd_barrier(bar);
        }
        int* counts = counts0 + 16 * CNT_STRIDE * layer;
        int* rtok = (int*)(ws + WS_RTOK) + (size_t)layer * NE * CAP; float* rgate = (float*)(ws + WS_RGATE) + (size_t)layer * NE * CAP; int* slot = (int*)(ws + WS_SLOT) + (size_t)layer * M * 2;
        {   LnRouteP p; p.pin = PRE; p.hb = HB; p.g = P.in[I_LNG] + (layer * 2 + 0) * D; p.b = P.in[I_LNB] + (layer * 2 + 0) * D; p.wfg = ws + WS_WF + (size_t)layer * WF_STRIDE; p.rbias = P.in[I_RB];
            p.counts = counts; p.rtok = rtok; p.rgate = rgate; p.slot = slot;
            ph_ln_route(p, lds, wv_s); }
        xcd_barrier(bar);
        {
            int total = 0; for (int e = 0; e < NE; ++e) total += (counts[e * CNT_STRIDE] + 255) >> 8;
            total *= 4;
            const int n3 = total > 512 ? total - 512 : 0, early = total < 512 ? total : 512;
            unsigned* gu3 = (unsigned*)(ws + WS_CTL + 36864) + 64 * layer;
            pg8::EpiGU EG; EG.hid = HID;
            pg8::EpiDN ED; ED.y = Y; ED.rgate = rgate;
            pg8::MoeOrder SG; SG.counts = counts; SG.rtok = rtok; SG.A = (const char*)HB; SG.B = (const char*)(layer == 0 ? GUT : GUT1); SG.bexp_stride = (size_t)D * D * 2; SG.nN = 4; SG.K = D; SG.gather = 1;
            pg8::MoeOrder SD; SD.counts = counts; SD.rtok = rtok; SD.A = (const char*)HID; SD.B = (const char*)(layer == 0 ? DNT : DNT1); SD.bexp_stride = (size_t)D * DE * 2; SD.nN = 4; SD.K = DE; SD.gather = 0;
            SG.base = bid; SG.stride = G; SG.hi = early;
            pg8::gemm_phase<pg8::EpiGU, pg8::MoeOrder, true, true>(lds3, D, SG, EG, wv_s);
            xcd_barrier(bar);
            int late_idx = -1;
            if (bid < n3) {
                SG.base = 512 + bid; SG.stride = 1 << 20; SG.hi = total;
                pg8::gemm_phase<pg8::EpiGU, pg8::MoeOrder, true, true>(lds3, D, SG, EG, wv_s);
                __syncthreads();
                if (opaque_tid(wv_s) == 0) { __builtin_amdgcn_fence(__ATOMIC_RELEASE, "agent"); asm volatile("s_waitcnt vmcnt(0)" ::: "memory"); __hip_atomic_fetch_add(gu3, 1u, __ATOMIC_RELAXED, __HIP_MEMORY_SCOPE_AGENT); }
                SD.base = bid; SD.stride = 1 << 20; SD.hi = early;
            } else {
                const int d = bid - n3, W = G - n3;
                SD.base = n3 + d; SD.stride = W; SD.hi = early;
                int idx = n3 + d; while (idx < 512) idx += W;
                if (idx < total) late_idx = idx;
            }
            pg8::gemm_phase<pg8::EpiDN, pg8::MoeOrder, true, false>(lds3, DE, SD, ED, wv_s);
            if (late_idx >= 0) {
                if (opaque_tid(wv_s) == 0) {
                    unsigned sp = 0; while (__hip_atomic_load(gu3, __ATOMIC_RELAXED, __HIP_MEMORY_SCOPE_AGENT) < (unsigned)n3) { __builtin_amdgcn_s_sleep(2); if (++sp > (1u << 22)) break; }
                    __builtin_amdgcn_fence(__ATOMIC_ACQUIRE, "agent"); asm volatile("s_waitcnt vmcnt(0)" ::: "memory");
                }
                __syncthreads();
                SD.base = late_idx; SD.stride = 1 << 20; SD.hi = total;
                pg8::gemm_phase<pg8::EpiDN, pg8::MoeOrder, true, false>(lds3, DE, SD, ED, wv_s);
            }
        }
        xcd_barrier(bar);
        {   LnCombP p; p.hb = HB; p.y = Y; p.slot = slot; p.counts = counts; p.g = P.in[I_LNG] + (layer * 2 + 1) * D; p.b = P.in[I_LNB] + (layer * 2 + 1) * D;
            p.wf = P.in[I_FWIN] + 3 * D; p.bf = P.in[I_FBF]; p.logf = LOGF; p.outp = (layer == 1) ? hbuf : nullptr; p.do_f = (layer == 0) ? 1 : 0; p.pad = 0;
            ph_ln_comb(p, lds, wv_s); }
        if (layer == 0) {
            xcd_barrier(bar);
        }
    }
}

extern "C" void kernel_launch(void* const* d_in, const int* in_sizes, int n_in, void* d_out, int out_size, void* d_ws, size_t ws_size, hipStream_t stream) {
    static int grid = 0;
    if (grid == 0) {
        if (n_in != N_IN || out_size != M * D || ws_size < WS_END) { fprintf(stderr, "kernel_launch: unexpected problem (n_in %d out %d ws %zu, need %zu)\n", n_in, out_size, ws_size, (size_t)WS_END); grid = -1; return; }
        int dev = 0, cus = 0;
        if (hipGetDevice(&dev) != hipSuccess || hipDeviceGetAttribute(&cus, hipDeviceAttributeMultiprocessorCount, dev) != hipSuccess) { grid = -1; return; }
        if (hipFuncSetAttribute((const void*)fwd, hipFuncAttributeMaxDynamicSharedMemorySize, LDS_BYTES) != hipSuccess) { fprintf(stderr, "kernel_launch: hipFuncSetAttribute failed\n"); grid = -1; return; }
        int per_cu = 0;
        if (hipOccupancyMaxActiveBlocksPerMultiprocessor(&per_cu, (const void*)fwd, 512, LDS_BYTES) != hipSuccess || per_cu < 1) { fprintf(stderr, "kernel_launch: occupancy query says %d\n", per_cu); (void)hipGetLastError(); }
        grid = cus;
    }
    if (grid < 0) return;
    (void)hipMemsetAsync((char*)d_ws + WS_CTL, 0, CTL_BYTES, stream);
    Params P{};
    for (int i = 0; i < N_IN; ++i) P.in[i] = (const float*)d_in[i];
    P.out = (float*)d_out; P.ws = (unsigned char*)d_ws;
    hipLaunchKernelGGL(fwd, dim3(grid), dim3(512), LDS_BYTES, stream, P);
}
```

```cpp
#include <hip/hip_runtime.h>
#include <stdint.h>
#include <stdio.h>

typedef unsigned short bf16;
typedef short bf16x8 __attribute__((ext_vector_type(8)));
typedef float f32x4 __attribute__((ext_vector_type(4)));
typedef float f32x2 __attribute__((ext_vector_type(2)));
typedef unsigned u32x4 __attribute__((ext_vector_type(4)));
typedef unsigned u32x2 __attribute__((ext_vector_type(2)));
#define LAS __attribute__((address_space(3)))

constexpr int NB = 8, T = 2048, D = 1024, H = 16, HD = 64, M = NB * T;
constexpr int NE = 16, DE = 512, CAP = 16384, MAXROWS = 36864;
constexpr int NW_IN = 3 * D + H;
constexpr float ALPHA = 1.4142135623730951f;
constexpr float LN_EPS = 1e-5f, GN_EPS = 64e-5f;
constexpr float LOG2E = 1.4426950408889634f;

constexpr size_t MiB = 1u << 20;
constexpr size_t WS_CTL = 0;
constexpr size_t CTL_BYTES = 65536;
constexpr size_t CTL_BAR_OFF = 16384;
constexpr size_t WS_RTOK = 1 * MiB;
constexpr size_t WS_RGATE = 3 * MiB;
constexpr size_t WS_SLOT = 5 * MiB;
constexpr size_t WS_WRKV = 6 * MiB;
constexpr size_t WS_WO = 12 * MiB;
constexpr size_t WS_B1T = 14 * MiB;
constexpr size_t WS_B2T = 15 * MiB;
constexpr size_t WS_WIN = 17 * MiB;
constexpr size_t WS_FWO = 23 * MiB;
constexpr size_t WS_X0 = 25 * MiB;
constexpr size_t WS_XCAT = WS_X0;
constexpr size_t WS_XR = WS_X0 + 64 * MiB;
constexpr size_t WS_MOEW = WS_X0;
constexpr size_t WS_DNT = WS_MOEW + 32 * MiB;
constexpr size_t WS_LW = WS_X0 + 48 * MiB;
constexpr size_t WS_HB = WS_X0 + 48 * MiB;
constexpr size_t WS_AA = WS_X0 + 80 * MiB;
constexpr size_t WS_G = WS_X0 + 112 * MiB;
constexpr size_t WS_DNT1 = WS_X0 + 144 * MiB;
constexpr size_t WS_HID = WS_X0 + 80 * MiB;
constexpr size_t WS_R = WS_X0 + 160 * MiB;
constexpr size_t WS_K = WS_R + 32 * MiB;
constexpr size_t WS_V = WS_R + 64 * MiB;
constexpr size_t WS_Y = WS_R;
constexpr size_t WS_L1 = WS_R + 96 * MiB;
constexpr size_t WS_LOGF = WS_L1;
constexpr size_t WS_CUM = WS_L1 + 1 * MiB;
constexpr size_t WS_WF = WS_L1 + 4 * MiB;
constexpr size_t WF_STRIDE = 65536 + 256;
constexpr size_t WS_END = WS_L1 + 8 * MiB;
static_assert(WS_END == 289 * MiB, "map");

__device__ __forceinline__ unsigned f2bf(float f) { unsigned u = __float_as_uint(f); return (u + 0x7fffu + ((u >> 16) & 1u)) >> 16; }
__device__ __forceinline__ float bf2f(unsigned b) { return __uint_as_float(b << 16); }
typedef __bf16 bf16x2_t_ __attribute__((ext_vector_type(2)));
__device__ __forceinline__ unsigned pk2(float lo, float hi) { const f32x2 v = {lo, hi}; const bf16x2_t_ b = __builtin_convertvector(v, bf16x2_t_); return __builtin_bit_cast(unsigned, b); }
__device__ __forceinline__ float sigmoidf_(float x) { return 1.0f / (1.0f + __expf(-x)); }
__device__ __forceinline__ float sigmoid_fast(float x) { return __builtin_amdgcn_rcpf(1.0f + __expf(-x)); }
__device__ __forceinline__ float tanh_fast(float x) { return 2.0f * sigmoid_fast(2.0f * x) - 1.0f; }
__device__ __forceinline__ float softplusf_(float x) { return fmaxf(x, 0.f) + __logf(1.0f + __expf(-fabsf(x))); }
__device__ __forceinline__ float shx(float v, int o, int lane) { return __int_as_float(__builtin_amdgcn_ds_bpermute((lane ^ o) << 2, __float_as_int(v))); }
__device__ __forceinline__ float wave_sum(float v, int lane) {
#pragma unroll
    for (int o = 1; o < 64; o <<= 1) v += shx(v, o, lane);
    return v;
}
__device__ __forceinline__ int opaque_tid(int wv_s) { int l; asm volatile("v_mbcnt_lo_u32_b32 %0, -1, 0\n\tv_mbcnt_hi_u32_b32 %0, -1, %0" : "=v"(l)); return wv_s * 64 + l; }

namespace pg8 {
constexpr int BM = 256, BK = 64, HALF = 128, HTB = HALF * BK * 2, STAGE_BYTES = 8 * HTB, NXCD = 8, WGM = 8;
__host__ __device__ __forceinline__ int lds_byte(int r, int c) { const int st = (r >> 4) * 2 + (c >> 5), rr = r & 15, cc = c & 31, ob = rr * 64 + cc * 2; return st * 1024 + (ob ^ (((ob >> 9) & 1) << 5)); }
__host__ __device__ __forceinline__ void stage_rc(int b, int& R, int& C) { const int st = b / 1024, sb = b % 1024, swz = sb ^ (((sb >> 9) & 1) << 5); R = (st >> 1) * 16 + swz / 64; C = (st & 1) * 32 + (swz % 64) / 2; }
__host__ __device__ __forceinline__ int perm32(int rho) { const int n = rho >> 4, i = rho & 15; return 8 * (i >> 2) + 4 * n + (i & 3); }

struct Unit { int pm, pn; const char* A; const char* B; int e, r0, nvalid, pad; };

typedef __bf16 bf16x2_cv __attribute__((ext_vector_type(2)));
__device__ __forceinline__ unsigned cvt_pk_bf16(float lo, float hi) { const f32x2 v = {lo, hi}; const bf16x2_cv b = __builtin_convertvector(v, bf16x2_cv); return __builtin_bit_cast(unsigned, b); }

template <class Epi, class Sched, bool ALIGN_EPI, bool GATHER>
__device__ __forceinline__ void gemm_phase(LAS unsigned char* lds, const int K_in, const Sched& S, const Epi& E, const int wv_s) {
    int K = K_in; asm volatile("" : "+s"(K));
    const int tid = opaque_tid(wv_s), wid = wv_s, lane = tid & 63, wr = wid >> 2, wc = wid & 3, fr = lane & 15, fq = lane >> 4;
    const int nt = S.kloop(K) / BK;
    int Rr[2], Cc[2]; unsigned voffB[2];
#pragma unroll
    for (int i = 0; i < 2; ++i) { int R, C; stage_rc(tid * 16 + i * 8192, R, C); Rr[i] = R; Cc[i] = C; const int Rb = Epi::PERM ? ((R & ~31) + perm32(R & 31)) : R; voffB[i] = (unsigned)(Rb * K + C) * 2u; }
    const size_t kstep = (size_t)(BK * 2);
    const size_t kstepA = S.kstepA();
    const size_t hstep = (size_t)HALF * K * 2;
    const unsigned ldsw = (unsigned)wid * 1024u;
    const int aoff = lds_byte(wr * 64 + fr, fq * 8), boff = lds_byte(wc * 32 + fr, fq * 8);
#define PG8_SA(b, h) (((b) * 2 + (h)) * HTB)
#define PG8_SB(b, h) ((4 + (b) * 2 + (h)) * HTB)
#define PG8_STAGE(bufoff, gbase, voff) do { _Pragma("unroll") for (int _i = 0; _i < 2; ++_i) \
        __builtin_amdgcn_global_load_lds((const unsigned*)((const char*)(gbase) + (voff)[_i]), (LAS unsigned*)(lds + (bufoff) + ldsw + _i * 8192), 16, 0, 0); } while (0)
#define PG8_LDA(dst, b, h) do { _Pragma("unroll") for (int m = 0; m < 4; ++m) _Pragma("unroll") for (int k = 0; k < 2; ++k) dst[m][k] = *(const LAS bf16x8*)(lds + PG8_SA(b, h) + aoff + m * 2048 + k * 1024); } while (0)
#define PG8_LDB(dst, b, h) do { _Pragma("unroll") for (int n = 0; n < 2; ++n) _Pragma("unroll") for (int k = 0; k < 2; ++k) dst[n][k] = *(const LAS bf16x8*)(lds + PG8_SB(b, h) + boff + n * 2048 + k * 1024); } while (0)
#define PG8_MMA(ai, bj, At, Bt) do { __builtin_amdgcn_s_setprio(1); _Pragma("unroll") for (int m = 0; m < 4; ++m) _Pragma("unroll") for (int n = 0; n < 2; ++n) _Pragma("unroll") for (int k = 0; k < 2; ++k) \
        acc[ai][bj][m][n] = __builtin_amdgcn_mfma_f32_16x16x32_bf16(Bt[n][k], At[m][k], acc[ai][bj][m][n], 0, 0, 0); __builtin_amdgcn_s_setprio(0); } while (0)
#define PG8_WAIT_V(n) asm volatile("s_waitcnt vmcnt(" #n ")" ::: "memory")
#define PG8_WAIT_L(n) asm volatile("s_waitcnt lgkmcnt(" #n ")" ::: "memory")
#define PG8_BAR __builtin_amdgcn_s_barrier()
#define PG8_SCHED __builtin_amdgcn_sched_barrier(0)
    Unit cur, nxt; int ui = 0;
    if (!S.next(0, cur)) return;
    f32x4 acc[2][2][4][2];
#pragma unroll
    for (int a = 0; a < 2; ++a)
#pragma unroll
        for (int b = 0; b < 2; ++b)
#pragma unroll
            for (int m = 0; m < 4; ++m)
#pragma unroll
                for (int n = 0; n < 2; ++n) acc[a][b][m][n] = (f32x4){0.f, 0.f, 0.f, 0.f};
    bf16x8 At[4][2], B0[2][2], B1[2][2];
    unsigned cv[2][2], nv[2][2];
    S.fill(cur, Rr, Cc, K, cv);
    const char* cA = cur.A; const char* cB = cur.B;
    PG8_STAGE(PG8_SB(0, 0), cB, voffB); PG8_STAGE(PG8_SB(0, 1), cB + hstep, voffB); PG8_STAGE(PG8_SA(0, 0), cA, cv[0]); PG8_STAGE(PG8_SA(0, 1), cA, cv[1]);
    if (wr == 1) PG8_BAR;
    PG8_WAIT_V(2); PG8_BAR;
    PG8_STAGE(PG8_SB(1, 0), cB + kstep, voffB); PG8_STAGE(PG8_SA(1, 0), cA + kstepA, cv[0]); PG8_STAGE(PG8_SB(1, 1), cB + hstep + kstep, voffB);
    PG8_WAIT_V(6); PG8_BAR;
    for (;;) {
        const bool has_next = S.next(ui + 1, nxt);
        const char* nA = has_next ? nxt.A : cA; const char* nB = has_next ? nxt.B : cB;
        if (GATHER) { if (has_next) S.fill(nxt, Rr, Cc, K, nv); else { nv[0][0] = cv[0][0]; nv[0][1] = cv[0][1]; nv[1][0] = cv[1][0]; nv[1][1] = cv[1][1]; } }
        for (int t = 0; t < nt; t += 2) {
            const bool last = (t == nt - 2);
            const char* a1 = cA + (size_t)(t + 1) * kstepA;
            const char* a2 = last ? nA : cA + (size_t)(t + 2) * kstepA; const char* b2 = last ? nB : cB + (size_t)(t + 2) * kstep;
            const char* a3 = a2 + kstepA; const char* b3 = b2 + kstep;
            unsigned v2[2][2];
            if (GATHER) { v2[0][0] = last ? nv[0][0] : cv[0][0]; v2[0][1] = last ? nv[0][1] : cv[0][1]; v2[1][0] = last ? nv[1][0] : cv[1][0]; v2[1][1] = last ? nv[1][1] : cv[1][1]; }
            else { v2[0][0] = cv[0][0]; v2[0][1] = cv[0][1]; v2[1][0] = cv[1][0]; v2[1][1] = cv[1][1]; }
            PG8_LDB(B0, 0, 0); PG8_LDB(B1, 0, 1); PG8_SCHED; PG8_LDA(At, 0, 0); PG8_STAGE(PG8_SA(1, 1), a1, cv[1]);
            PG8_WAIT_V(8); PG8_WAIT_L(0); PG8_BAR; PG8_MMA(0, 0, At, B0); PG8_MMA(0, 1, At, B1); PG8_BAR; PG8_SCHED;
            PG8_LDA(At, 0, 1); PG8_STAGE(PG8_SB(0, 0), b2, voffB); PG8_STAGE(PG8_SB(0, 1), b2 + hstep, voffB); PG8_STAGE(PG8_SA(0, 0), a2, v2[0]);
            PG8_WAIT_V(8); PG8_WAIT_L(0); PG8_BAR; PG8_MMA(1, 0, At, B0); PG8_MMA(1, 1, At, B1); PG8_BAR; PG8_SCHED;
            PG8_LDB(B0, 1, 0); PG8_LDB(B1, 1, 1); PG8_SCHED; PG8_LDA(At, 1, 0); PG8_STAGE(PG8_SA(0, 1), a2, v2[1]);
            PG8_WAIT_V(8); PG8_WAIT_L(0); PG8_BAR; PG8_MMA(0, 0, At, B0); PG8_MMA(0, 1, At, B1); PG8_BAR; PG8_SCHED;
            PG8_LDA(At, 1, 1); PG8_STAGE(PG8_SB(1, 0), b3, voffB); PG8_STAGE(PG8_SB(1, 1), b3 + hstep, voffB); PG8_STAGE(PG8_SA(1, 0), a3, v2[0]);
            PG8_WAIT_V(8); PG8_WAIT_L(0); PG8_BAR; PG8_MMA(1, 0, At, B0); PG8_MMA(1, 1, At, B1); PG8_BAR; PG8_SCHED;
        }
        if constexpr (ALIGN_EPI) { if (wr == 0) PG8_BAR; }
        { int fr_ = fr, fq_ = fq; asm volatile("" : "+v"(fr_), "+v"(fq_));
          E(acc, cur, wr, wc, fr_, fq_); }
        if (!has_next) break;
#pragma unroll
        for (int a = 0; a < 2; ++a)
#pragma unroll
            for (int b = 0; b < 2; ++b)
#pragma unroll
                for (int m = 0; m < 4; ++m)
#pragma unroll
                    for (int n = 0; n < 2; ++n) acc[a][b][m][n] = (f32x4){0.f, 0.f, 0.f, 0.f};
        cur = nxt; cA = nA; cB = nB; ++ui;
        if (GATHER) { cv[0][0] = nv[0][0]; cv[0][1] = nv[0][1]; cv[1][0] = nv[1][0]; cv[1][1] = nv[1][1]; }
        if constexpr (ALIGN_EPI) { if (wr == 1) PG8_BAR; }
    }
    PG8_WAIT_V(0);
    if constexpr (!ALIGN_EPI) { if (wr == 0) PG8_BAR; }
    PG8_BAR;
#undef PG8_SA
#undef PG8_SB
#undef PG8_STAGE
#undef PG8_LDA
#undef PG8_LDB
#undef PG8_MMA
#undef PG8_WAIT_V
#undef PG8_WAIT_L
#undef PG8_BAR
#undef PG8_SCHED
}

struct DenseOrder {
    int nM, nN, nwg, G, c, K;
    int kl, bsel;
    const char* A; const char* B; size_t asel_stride; int asel_div, ascan;
    __device__ void init(int M_, int N_, int K_, int G_, int c_, const void* A_, const void* B_, int asel_div_, size_t asel_stride_) {
        nM = M_ / BM; nN = N_ / BM; nwg = nM * nN; G = G_; c = c_; K = K_; A = (const char*)A_; B = (const char*)B_; asel_div = asel_div_; asel_stride = asel_stride_; ascan = 0; kl = 0; bsel = 0; }
    __device__ __forceinline__ bool next(int i, Unit& u) const {
        if (c < 0 || c >= G) return false;
        const long L = (long)i * G + c; if (L >= nwg) return false;
        int wgid = (int)L; { const int q = nwg / NXCD, r = nwg % NXCD, xcd = wgid % NXCD, off = wgid / NXCD; wgid = (xcd < r ? xcd * (q + 1) : r * (q + 1) + (xcd - r) * q) + off; }
        const int nig = WGM * nN, gid = wgid / nig, fm = gid * WGM, gsz = (nM - fm) < WGM ? (nM - fm) : WGM;
        u.pm = fm + ((wgid % nig) % gsz); u.pn = (wgid % nig) / gsz;
        u.A = ascan ? A + 2 * ((size_t)(u.pm >> 3) * 2097152 + (size_t)((u.pm * 4) & 31) * 4096) : A + (size_t)(u.pn / asel_div) * asel_stride + (size_t)u.pm * BM * K * 2;
        u.B = B + (size_t)u.pn * BM * K * 2 + (bsel ? (size_t)(u.pn / asel_div) * asel_stride : (size_t)0);
        u.e = 0; u.r0 = 0; u.nvalid = BM; u.pad = 0; return true;
    }
    __device__ __forceinline__ void fill(const Unit&, const int (&R)[2], const int (&C)[2], int K_, unsigned (&v)[2][2]) const {
#pragma unroll
        for (int h = 0; h < 2; ++h)
#pragma unroll
            for (int i = 0; i < 2; ++i) { const int lr = h * HALF + R[i]; v[h][i] = ascan ? (unsigned)((lr >> 6) * 4096 + (lr & 63) * 8 + (C[i] >> 3) * 512) * 2u : (unsigned)(lr * K_ + C[i]) * 2u; }
    }
    __device__ __forceinline__ size_t kstepA() const { return ascan ? (size_t)262144 : (size_t)(BK * 2); }
    __device__ __forceinline__ int kloop(int K_) const { return kl ? kl : K_; }
};
struct MoeOrder {
    const int* counts; const int* rtok; const char* A; const char* B; size_t bexp_stride;
    int nN, K, gather, base, stride, hi;
    int cnt[NE];
    __device__ __forceinline__ void load_counts() {
#pragma unroll
        for (int e = 0; e < NE; ++e) cnt[e] = counts[e * 64];
    }
    __device__ __forceinline__ bool next(int i, Unit& u) const {
        const int L = base + i * stride; if (L >= hi) return false;
        const int rt = L / nN; int acc = 0, es = -1, accs = 0, cnts = 0;
#pragma unroll
        for (int e = 0; e < NE; ++e) {
            const int ntile = (cnt[e] + 255) >> 8;
            const bool hit = (es < 0) && (rt < acc + ntile);
            es = hit ? e : es; accs = hit ? acc : accs; cnts = hit ? cnt[e] : cnts;
            acc += ntile;
        }
        if (es < 0) return false;
        u.pm = rt; u.pn = L % nN; u.e = es; u.r0 = (rt - accs) * 256; u.nvalid = min(256, cnts - u.r0); u.pad = 0;
        u.A = gather ? A : A + (size_t)rt * BM * K * 2; u.B = B + (size_t)es * bexp_stride + (size_t)u.pn * BM * K * 2; return true;
    }
    __device__ __forceinline__ void fill(const Unit& u, const int (&R)[2], const int (&C)[2], int K_, unsigned (&v)[2][2]) const {
#pragma unroll
        for (int h = 0; h < 2; ++h)
#pragma unroll
            for (int i = 0; i < 2; ++i) {
                const int rl = h * HALF + R[i];
                if (gather) { const int tok = (rl < u.nvalid) ? rtok[u.e * CAP + u.r0 + rl] : 0; v[h][i] = (unsigned)(tok * K_ + C[i]) * 2u; }
                else v[h][i] = (unsigned)(rl * K_ + C[i]) * 2u;
            }
    }
    __device__ __forceinline__ size_t kstepA() const { return (size_t)(BK * 2); }
    __device__ __forceinline__ int kloop(int K_) const { return K_; }
};

__device__ __forceinline__ size_t scan_idx(int row, int col) { return ((size_t)((((row >> 11) * H + (col >> 6)) * 32 + ((row >> 6) & 31)) * 8 + ((col >> 3) & 7)) * 64 + (row & 63)) * 8 + (col & 7); }
struct EpiBf16 {
    static constexpr bool PERM = true;
    bf16* O; int ldc, split_div; size_t split_stride; float scale0; int act, scanlay;
    __device__ __forceinline__ void operator()(const f32x4 (&acc)[2][2][4][2], const Unit& u, int wr, int wc, int fr, int fq) const {
        const int t = u.pn / split_div; bf16* base = O + (size_t)t * split_stride;
        const int colt = (u.pn - t * split_div) * BM;
        const float sc = (t == 0) ? scale0 : 1.f;
        const int row0 = u.pm * BM + wr * 64 + fr, col0 = colt + wc * 32 + 8 * fq;
#pragma unroll
        for (int ai = 0; ai < 2; ++ai)
#pragma unroll
            for (int m = 0; m < 4; ++m) { const int row = row0 + ai * HALF + m * 16; bf16* rowp = base + (size_t)row * ldc + col0;
#pragma unroll
                for (int bj = 0; bj < 2; ++bj) { f32x4 v0 = acc[ai][bj][m][0] * sc, v1 = acc[ai][bj][m][1] * sc;
                    if (act == 1) {
                        if (bj == 0 && wc < 2) { v0.x = tanh_fast(v0.x); v0.y = tanh_fast(v0.y); v0.z = tanh_fast(v0.z); v0.w = tanh_fast(v0.w); v1.x = tanh_fast(v1.x); v1.y = tanh_fast(v1.y); v1.z = tanh_fast(v1.z); v1.w = tanh_fast(v1.w); }
                        else if (bj == 1) { v0.x = sigmoid_fast(v0.x); v0.y = sigmoid_fast(v0.y); v0.z = sigmoid_fast(v0.z); v0.w = sigmoid_fast(v0.w); v1.x = sigmoid_fast(v1.x); v1.y = sigmoid_fast(v1.y); v1.z = sigmoid_fast(v1.z); v1.w = sigmoid_fast(v1.w); }
                    }
                    u32x4 w; w.x = cvt_pk_bf16(v0[0], v0[1]); w.y = cvt_pk_bf16(v0[2], v0[3]); w.z = cvt_pk_bf16(v1[0], v1[1]); w.w = cvt_pk_bf16(v1[2], v1[3]);
                    bf16* dst = (scanlay != 0) ? base + scan_idx(row, col0 + bj * HALF) : rowp + bj * HALF;
                    *(u32x4*)dst = w; } }
    }
};
struct EpiLora2 {
    static constexpr bool PERM = true;
    _Float16* LW; bf16* AG; const float* w0; const float* a0;
    __device__ __forceinline__ void operator()(const f32x4 (&acc)[2][2][4][2], const Unit& u, int wr, int wc, int fr, int fq) const {
        const int t = u.pn >> 2, colt = (u.pn & 3) * BM;
        const int row0 = u.pm * BM + wr * 64 + fr, col0 = colt + wc * 32 + 8 * fq;
        if (t == 0) {
#pragma unroll
            for (int bj = 0; bj < 2; ++bj) {
                const f32x4 b0 = *(const f32x4*)(w0 + col0 + bj * HALF), b1 = *(const f32x4*)(w0 + col0 + bj * HALF + 4);
#pragma unroll
                for (int ai = 0; ai < 2; ++ai)
#pragma unroll
                    for (int m = 0; m < 4; ++m) {
                        const size_t o = scan_idx(row0 + ai * HALF + m * 16, col0 + bj * HALF);
                        const f32x4 v0 = acc[ai][bj][m][0] + b0, v1 = acc[ai][bj][m][1] + b1;
                        typedef _Float16 h8 __attribute__((ext_vector_type(8)));
                        h8 hv;
                        hv[0] = (_Float16)(-0.87503877f * sigmoid_fast(v0.x)); hv[1] = (_Float16)(-0.87503877f * sigmoid_fast(v0.y));
                        hv[2] = (_Float16)(-0.87503877f * sigmoid_fast(v0.z)); hv[3] = (_Float16)(-0.87503877f * sigmoid_fast(v0.w));
                        hv[4] = (_Float16)(-0.87503877f * sigmoid_fast(v1.x)); hv[5] = (_Float16)(-0.87503877f * sigmoid_fast(v1.y));
                        hv[6] = (_Float16)(-0.87503877f * sigmoid_fast(v1.z)); hv[7] = (_Float16)(-0.87503877f * sigmoid_fast(v1.w));
                        *(h8*)(LW + o) = hv;
                    }
            }
        } else if (t == 1) {
#pragma unroll
            for (int bj = 0; bj < 2; ++bj) {
                const f32x4 b0 = *(const f32x4*)(a0 + col0 + bj * HALF), b1 = *(const f32x4*)(a0 + col0 + bj * HALF + 4);
#pragma unroll
                for (int ai = 0; ai < 2; ++ai)
#pragma unroll
                    for (int m = 0; m < 4; ++m) {
                        const size_t o = scan_idx(row0 + ai * HALF + m * 16, col0 + bj * HALF);
                        const f32x4 v0 = acc[ai][bj][m][0] + b0, v1 = acc[ai][bj][m][1] + b1;
                        u32x4 w; w.x = cvt_pk_bf16(sigmoid_fast(v0.x), sigmoid_fast(v0.y)); w.y = cvt_pk_bf16(sigmoid_fast(v0.z), sigmoid_fast(v0.w));
                        w.z = cvt_pk_bf16(sigmoid_fast(v1.x), sigmoid_fast(v1.y)); w.w = cvt_pk_bf16(sigmoid_fast(v1.z), sigmoid_fast(v1.w));
                        *(u32x4*)(AG + o) = w;
                    }
            }
        } else {
#pragma unroll
            for (int bj = 0; bj < 2; ++bj)
#pragma unroll
                for (int ai = 0; ai < 2; ++ai)
#pragma unroll
                    for (int m = 0; m < 4; ++m) {
                        const size_t o = (size_t)M * D + (size_t)(row0 + ai * HALF + m * 16) * D + col0 + bj * HALF;
                        const f32x4 v0 = acc[ai][bj][m][0], v1 = acc[ai][bj][m][1];
                        u32x4 w; w.x = cvt_pk_bf16(v0.x, v0.y); w.y = cvt_pk_bf16(v0.z, v0.w); w.z = cvt_pk_bf16(v1.x, v1.y); w.w = cvt_pk_bf16(v1.z, v1.w);
                        *(u32x4*)(AG + o) = w;
                    }
        }
    }
};
struct EpiPre {
    static constexpr bool PERM = true;
    const float* hin32; const bf16* hin16; bf16* out;
    __device__ __forceinline__ void operator()(const f32x4 (&acc)[2][2][4][2], const Unit& u, int wr, int wc, int fr, int fq) const {
        const int row0 = u.pm * BM + wr * 64 + fr, col0 = u.pn * BM + wc * 32 + 8 * fq;
#pragma unroll
        for (int ai = 0; ai < 2; ++ai)
#pragma unroll
            for (int m = 0; m < 4; ++m) { const size_t ro = (size_t)(row0 + ai * HALF + m * 16) * D + col0;
#pragma unroll
                for (int bj = 0; bj < 2; ++bj) { const size_t o = ro + bj * HALF;
                    f32x4 h0, h1;
                    if (hin32) { h0 = *(const f32x4*)(hin32 + o); h1 = *(const f32x4*)(hin32 + o + 4); }
                    else { const u32x4 hv = *(const u32x4*)(hin16 + o); h0 = (f32x4){bf2f(hv.x & 0xffff), bf2f(hv.x >> 16), bf2f(hv.y & 0xffff), bf2f(hv.y >> 16)}; h1 = (f32x4){bf2f(hv.z & 0xffff), bf2f(hv.z >> 16), bf2f(hv.w & 0xffff), bf2f(hv.w >> 16)}; }
                    const f32x4 v0 = h0 * ALPHA + acc[ai][bj][m][0], v1 = h1 * ALPHA + acc[ai][bj][m][1];
                    u32x4 w; w.x = cvt_pk_bf16(v0[0], v0[1]); w.y = cvt_pk_bf16(v0[2], v0[3]); w.z = cvt_pk_bf16(v1[0], v1[1]); w.w = cvt_pk_bf16(v1[2], v1[3]);
                    *(u32x4*)(out + o) = w; } }
    }
};
struct EpiGU {
    static constexpr bool PERM = true;
    bf16* hid;
    __device__ __forceinline__ void operator()(const f32x4 (&acc)[2][2][4][2], const Unit& u, int wr, int wc, int fr, int fq) const {
        const int row0 = u.pm * BM + wr * 64 + fr, col0 = u.pn * 128 + wc * 16 + 4 * fq;
#pragma unroll
        for (int ai = 0; ai < 2; ++ai)
#pragma unroll
            for (int m = 0; m < 4; ++m) { bf16* rowp = hid + (size_t)(row0 + ai * HALF + m * 16) * DE + col0;
#pragma unroll
                for (int bj = 0; bj < 2; ++bj) { const f32x4 g = acc[ai][bj][m][0], uu = acc[ai][bj][m][1];
                    u32x2 w; w.x = cvt_pk_bf16(g.x * sigmoid_fast(g.x) * uu.x, g.y * sigmoid_fast(g.y) * uu.y); w.y = cvt_pk_bf16(g.z * sigmoid_fast(g.z) * uu.z, g.w * sigmoid_fast(g.w) * uu.w);
                    *(u32x2*)(rowp + bj * 64) = w; } }
    }
};
struct EpiDN {
    static constexpr bool PERM = true;
    bf16* y; const float* rgate;
    __device__ __forceinline__ void operator()(const f32x4 (&acc)[2][2][4][2], const Unit& u, int wr, int wc, int fr, int fq) const {
        const int col0 = u.pn * BM + wc * 32 + 8 * fq;
#pragma unroll
        for (int ai = 0; ai < 2; ++ai)
#pragma unroll
            for (int m = 0; m < 4; ++m) { const int rl = ai * HALF + wr * 64 + m * 16 + fr;
                if (rl < u.nvalid) { const float gt = rgate[u.e * CAP + u.r0 + rl]; bf16* rowp = y + (size_t)(u.pm * BM + rl) * D + col0;
#pragma unroll
                    for (int bj = 0; bj < 2; ++bj) { const f32x4 v0 = acc[ai][bj][m][0] * gt, v1 = acc[ai][bj][m][1] * gt;
                        u32x4 w; w.x = cvt_pk_bf16(v0[0], v0[1]); w.y = cvt_pk_bf16(v0[2], v0[3]); w.z = cvt_pk_bf16(v1[0], v1[1]); w.w = cvt_pk_bf16(v1[2], v1[3]);
                        *(u32x4*)(rowp + bj * HALF) = w; } } }
    }
};
}

__device__ __forceinline__ void tr_load(const float* W, int ld, int k0, int n0, float (&v)[32], int lane) {
#pragma unroll
    for (int i = 0; i < 32; ++i) v[i] = W[(size_t)(k0 + 2 * i + (lane >> 5)) * ld + n0 + (lane & 31)];
}
__device__ __forceinline__ void tr_put(const float (&v)[32], int k0, int n0, const float* kscale, bf16* WT, int Kd, int koff, int drow0, int mode, LAS float* scr, int lane) {
#pragma unroll
    for (int i = 0; i < 32; ++i) { const int kk = 2 * i + (lane >> 5); float x = v[i]; if (kscale) x *= kscale[k0 + kk]; scr[kk * 33 + (lane & 31)] = x; }
    asm volatile("s_waitcnt lgkmcnt(0)" ::: "memory");
    const int c = lane & 7;
#pragma unroll
    for (int j = 0; j < 4; ++j) { const int n = (lane >> 3) + 8 * j; const LAS float* s = scr + (8 * c) * 33 + n;
        u32x4 o; o.x = pk2(s[0 * 33], s[1 * 33]); o.y = pk2(s[2 * 33], s[3 * 33]); o.z = pk2(s[4 * 33], s[5 * 33]); o.w = pk2(s[6 * 33], s[7 * 33]);
        const int nn = n0 + n; const int drow = (mode == 0) ? (drow0 + nn) : (drow0 + 8 * (nn >> 2) + (nn & 3) + (mode == 2 ? 4 : 0));
        *(u32x4*)(WT + (size_t)drow * Kd + koff + k0 + 8 * c) = o; }
    asm volatile("s_waitcnt lgkmcnt(0)" ::: "memory");
}
__device__ __forceinline__ void tr_item(const float* W, int ld, int k0, int n0, const float* kscale, bf16* WT, int Kd, int koff, int drow0, int mode, LAS float* scr, int lane) {
    float v[32]; tr_load(W, ld, k0, n0, v, lane); tr_put(v, k0, n0, kscale, WT, Kd, koff, drow0, mode, scr, lane);
}
__device__ __forceinline__ int tr_matrix(int item_base, int gw, int NGW, const float* W, int ld, int Ks, int Ns, const float* kscale, bf16* WT, int Kd, int koff, int drow0, int mode, LAS float* scr, int lane) {
    const int nblk = Ns / 32, nit = (Ks / 64) * nblk;
    int first = gw - (item_base % NGW); if (first < 0) first += NGW;
    for (int it = first; it < nit; it += NGW) tr_item(W, ld, 64 * (it / nblk), 32 * (it % nblk), kscale, WT, Kd, koff, drow0, mode, scr, lane);
    return item_base + nit;
}
struct MoeItem { const float* W; bf16* WT; int ld, k0, n0, Kd, mode; };
__device__ __forceinline__ MoeItem moe_item(int it, const float* wg, const float* wu, const float* wd, bf16* gut, bf16* dnt) {
    const int e = it / 768, r = it % 768; MoeItem m;
    if (r < 512) { const int q = r & 255; m.W = (r < 256 ? wg : wu) + (size_t)e * D * DE; m.ld = DE; m.k0 = 64 * (q / 16); m.n0 = 32 * (q % 16); m.WT = gut + (size_t)e * D * D; m.Kd = D; m.mode = r < 256 ? 1 : 2; }
    else { const int q = r - 512; m.W = wd + (size_t)e * DE * D; m.ld = D; m.k0 = 64 * (q / 32); m.n0 = 32 * (q % 32); m.WT = dnt + (size_t)e * D * DE; m.Kd = DE; m.mode = 0; }
    return m;
}
__device__ __forceinline__ void convert_moe(const float* wg, const float* wu, const float* wd, bf16* gut, bf16* dnt, int gw, int NGW, LAS float* scr, int lane) {
    float va[32], vb[32];
    int it = gw;
    if (it < NE * 768) { const MoeItem m = moe_item(it, wg, wu, wd, gut, dnt); tr_load(m.W, m.ld, m.k0, m.n0, va, lane); }
    while (it < NE * 768) {
        const MoeItem ma = moe_item(it, wg, wu, wd, gut, dnt);
        const int itb = it + NGW;
        if (itb < NE * 768) { const MoeItem m = moe_item(itb, wg, wu, wd, gut, dnt); tr_load(m.W, m.ld, m.k0, m.n0, vb, lane); }
        tr_put(va, ma.k0, ma.n0, nullptr, ma.WT, ma.Kd, 0, 0, ma.mode, scr, lane);
        if (itb >= NE * 768) break;
        const MoeItem mb = moe_item(itb, wg, wu, wd, gut, dnt);
        const int itc = itb + NGW;
        if (itc < NE * 768) { const MoeItem m = moe_item(itc, wg, wu, wd, gut, dnt); tr_load(m.W, m.ld, m.k0, m.n0, va, lane); }
        tr_put(vb, mb.k0, mb.n0, nullptr, mb.WT, mb.Kd, 0, 0, mb.mode, scr, lane);
        it = itc;
    }
}
constexpr int CNT_STRIDE = 64;
constexpr int RT = 2;
template <int CTRL> __device__ __forceinline__ float dppx(float v) { return __int_as_float(__builtin_amdgcn_update_dpp(0, __float_as_int(v), CTRL, 0xF, 0xF, false)); }
__device__ __forceinline__ float red8(float v) { v += dppx<0xB1>(v); v += dppx<0x4E>(v); v += dppx<0x141>(v); return v; }
__device__ __forceinline__ float red16(float v) { v = red8(v); v += dppx<0x140>(v); return v; }
__device__ __forceinline__ float red64(float v, int lane) { v = red16(v); v += shx(v, 16, lane); v += shx(v, 32, lane); return v; }
__device__ __forceinline__ void ln_rowsN(f32x4 (&v)[RT][4], const float* g, const float* b, int lane) {
    float s[RT];
#pragma unroll
    for (int t = 0; t < RT; ++t) { s[t] = 0.f;
#pragma unroll
        for (int j = 0; j < 4; ++j) s[t] += (v[t][j].x + v[t][j].y) + (v[t][j].z + v[t][j].w); }
#pragma unroll
    for (int t = 0; t < RT; ++t) s[t] = red64(s[t], lane);
    float s2[RT];
#pragma unroll
    for (int t = 0; t < RT; ++t) { const float mean = s[t] * (1.f / D); s2[t] = 0.f;
#pragma unroll
        for (int j = 0; j < 4; ++j) { v[t][j] = v[t][j] - mean; s2[t] += (v[t][j].x * v[t][j].x + v[t][j].y * v[t][j].y) + (v[t][j].z * v[t][j].z + v[t][j].w * v[t][j].w); } }
#pragma unroll
    for (int t = 0; t < RT; ++t) s2[t] = red64(s2[t], lane);
#pragma unroll
    for (int j = 0; j < 4; ++j) {
        const f32x4 gg = *(const f32x4*)(g + 4 * lane + 256 * j), bb = *(const f32x4*)(b + 4 * lane + 256 * j);
#pragma unroll
        for (int t = 0; t < RT; ++t) { const float rstd = rsqrtf(s2[t] * (1.f / D) + LN_EPS); v[t][j] = v[t][j] * rstd * gg + bb; }
    }
}
__device__ __forceinline__ void stage_w16(const float* Wm, int ldw, f32x4* wl, int tid) {
    for (int i = tid; i < 4096; i += 512) { const int c = i >> 2, e4 = i & 3, jq = (c >> 8) * 4 + (c & 3), ln = (c & 255) >> 2;
        wl[(jq * 4 + e4) * 64 + ln] = *(const f32x4*)(Wm + (size_t)c * ldw + 4 * e4); }
}
__device__ __forceinline__ float rowsN_dot16(const f32x4 (&v)[RT][4], const f32x4* wl, int lane) {
    float a[RT * 16];
#pragma unroll
    for (int i = 0; i < RT * 16; ++i) a[i] = 0.f;
    int lw = lane;
#pragma unroll
    for (int idx = 0; idx < 16; ++idx) {
        const int j = idx >> 2, q = idx & 3;
        if ((idx & 3) == 0) {
#pragma unroll
            for (int t = 0; t < RT; ++t)
                asm volatile("" : "+v"(lw), "+v"(a[t * 16 + 0]), "+v"(a[t * 16 + 1]), "+v"(a[t * 16 + 2]), "+v"(a[t * 16 + 3]), "+v"(a[t * 16 + 4]), "+v"(a[t * 16 + 5]), "+v"(a[t * 16 + 6]), "+v"(a[t * 16 + 7]),
                             "+v"(a[t * 16 + 8]), "+v"(a[t * 16 + 9]), "+v"(a[t * 16 + 10]), "+v"(a[t * 16 + 11]), "+v"(a[t * 16 + 12]), "+v"(a[t * 16 + 13]), "+v"(a[t * 16 + 14]), "+v"(a[t * 16 + 15]));
        }
        const f32x4 w0 = wl[(idx * 4 + 0) * 64 + lw], w1 = wl[(idx * 4 + 1) * 64 + lw], w2 = wl[(idx * 4 + 2) * 64 + lw], w3 = wl[(idx * 4 + 3) * 64 + lw];
#pragma unroll
        for (int t = 0; t < RT; ++t) {
            const float hv = q == 0 ? v[t][j].x : (q == 1 ? v[t][j].y : (q == 2 ? v[t][j].z : v[t][j].w));
            a[t * 16 + 0] += hv * w0.x; a[t * 16 + 1] += hv * w0.y; a[t * 16 + 2] += hv * w0.z; a[t * 16 + 3] += hv * w0.w;
            a[t * 16 + 4] += hv * w1.x; a[t * 16 + 5] += hv * w1.y; a[t * 16 + 6] += hv * w1.z; a[t * 16 + 7] += hv * w1.w;
            a[t * 16 + 8] += hv * w2.x; a[t * 16 + 9] += hv * w2.y; a[t * 16 + 10] += hv * w2.z; a[t * 16 + 11] += hv * w2.w;
            a[t * 16 + 12] += hv * w3.x; a[t * 16 + 13] += hv * w3.y; a[t * 16 + 14] += hv * w3.z; a[t * 16 + 15] += hv * w3.w;
        }
    }
#define TRED(o, n) do { const bool up_ = (lane & (o)) != 0; _Pragma("unroll") for (int i = 0; i < (n); ++i) { const float keep_ = up_ ? a[i + (n)] : a[i]; const float send_ = up_ ? a[i] : a[i + (n)]; a[i] = keep_ + shx(send_, (o), lane); } } while (0)
#pragma unroll
    for (int i = 0; i < RT * 16; ++i) a[i] += shx(a[i], 32, lane);
    if constexpr (RT == 1) {
#pragma unroll
        for (int i = 0; i < 16; ++i) a[i] += shx(a[i], 16, lane);
    } else { TRED(16, 16); }
    TRED(8, 8); TRED(4, 4); TRED(2, 2); TRED(1, 1);
#undef TRED
    return a[0];
}
__device__ __forceinline__ void store_rowsN(const f32x4 (&v)[RT][4], float* h, bf16* hb, int tok0, int lane) {
#pragma unroll
    for (int t = 0; t < RT; ++t)
#pragma unroll
        for (int j = 0; j < 4; ++j) {
            if (h) *(f32x4*)(h + (size_t)(tok0 + t) * D + 4 * lane + 256 * j) = v[t][j];
            if (hb) { u32x2 o; o.x = pk2(v[t][j].x, v[t][j].y); o.y = pk2(v[t][j].z, v[t][j].w);
                *(u32x2*)(hb + (size_t)(tok0 + t) * D + 4 * lane + 256 * j) = o; }
        }
}
__device__ __forceinline__ f32x4 ld_bf4(const bf16* p) { const u32x2 a = *(const u32x2*)p; return (f32x4){bf2f(a.x & 0xffff), bf2f(a.x >> 16), bf2f(a.y & 0xffff), bf2f(a.y >> 16)}; }

struct LnRouteP { const bf16* pin; bf16* hb; const float* g; const float* b; const unsigned char* wfg; const float* rbias; int* counts; int* rtok; float* rgate; int* slot; };
__device__ __forceinline__ void build_router_frags(const float* g, const float* b, const float* rw, unsigned char* out, unsigned char* lds, int tid) {
    float* prt = (float*)(lds + 6400);
    u32x4* WFo = (u32x4*)out; float* csc0 = (float*)(out + 65536);
    __syncthreads();
    for (int f = tid; f < 2048; f += 512) { const int kk = f >> 6, l = f & 63, e = l & 15, k0 = 32 * kk + 8 * (l >> 4);
        float wv8[8]; unsigned hi[4], lo[4];
#pragma unroll
        for (int q = 0; q < 8; ++q) wv8[q] = g[k0 + q] * rw[(size_t)(k0 + q) * NE + e];
#pragma unroll
        for (int q = 0; q < 4; ++q) { hi[q] = pk2(wv8[2 * q], wv8[2 * q + 1]); lo[q] = pk2(wv8[2 * q] - bf2f(hi[q] & 0xffff), wv8[2 * q + 1] - bf2f(hi[q] >> 16)); }
        u32x4 h4 = {hi[0], hi[1], hi[2], hi[3]}, l4 = {lo[0], lo[1], lo[2], lo[3]};
        WFo[(kk * 2 + 0) * 64 + l] = h4; WFo[(kk * 2 + 1) * 64 + l] = l4; }
    {   const int e = tid & 15, part = tid >> 4; float a0 = 0.f, a1 = 0.f;
#pragma unroll 8
        for (int q = 0; q < 32; ++q) { const int k = 32 * part + q; const float r = rw[(size_t)k * NE + e]; a0 += g[k] * r; a1 += b[k] * r; }
        prt[part * 16 + e] = a0; prt[512 + part * 16 + e] = a1; }
    __syncthreads();
    if (tid < 32) { const int e = tid & 15, which = tid >> 4; float a = 0.f;
#pragma unroll 8
        for (int q = 0; q < 32; ++q) a += prt[which * 512 + q * 16 + e];
        csc0[which * 16 + e] = a; }
    __syncthreads();
}
__device__ __forceinline__ void ph_ln_route(const LnRouteP& p, unsigned char* lds, const int wv_s) {
    const int tid = opaque_tid(wv_s); const int lane = tid & 63, wv = tid >> 6;
    int* sel_e = (int*)lds;
    float* sel_g = (float*)(lds + 512);
    int* lrank = (int*)(lds + 1024);
    int* lcnt = (int*)(lds + 1536);
    int* lbase = (int*)(lds + 1600);
    float* cs = (float*)(lds + 1664);
    float* c0 = (float*)(lds + 1728);
    float* st = (float*)(lds + 1792);
    float* lg = (float*)(lds + 2304);
    float* prt = (float*)(lds + 6400);
    bf16x8* WF = (bf16x8*)(lds + 16384);
    {
        const u32x4* wsrc = (const u32x4*)p.wfg; u32x4 tmp[8];
#pragma unroll
        for (int i = 0; i < 8; ++i) tmp[i] = wsrc[tid + 512 * i];
#pragma unroll
        for (int i = 0; i < 8; ++i) *(u32x4*)&WF[tid + 512 * i] = tmp[i];
        if (tid < 32) { const float x = ((const float*)(p.wfg + 65536))[tid]; if (tid < 16) cs[tid] = x; else c0[tid - 16] = x; }
        __syncthreads();
    }
    for (int tb = blockIdx.x * 64; tb < M; tb += gridDim.x * 64) {
        { const int tid0 = opaque_tid(wv_s); if (tid0 < 16) lcnt[tid0] = 0; }
        u32x2 raw[64 / (8 * RT)][RT][4];
#pragma unroll
        for (int rd = 0; rd < 64 / (8 * RT); ++rd)
#pragma unroll
            for (int t = 0; t < RT; ++t)
#pragma unroll
                for (int j = 0; j < 4; ++j) raw[rd][t][j] = *(const u32x2*)(p.pin + (size_t)(tb + rd * 8 * RT + wv * RT + t) * D + 4 * lane + 256 * j);
#pragma unroll
        for (int rd = 0; rd < 64 / (8 * RT); ++rd) {
            const int tl0 = rd * 8 * RT + wv * RT, tok0 = tb + tl0;
            int lane_r = lane; asm volatile("" : "+v"(lane_r));
            f32x4 v[RT][4];
#pragma unroll
            for (int t = 0; t < RT; ++t)
#pragma unroll
                for (int j = 0; j < 4; ++j) { const u32x2 a = raw[rd][t][j]; v[t][j] = (f32x4){bf2f(a.x & 0xffff), bf2f(a.x >> 16), bf2f(a.y & 0xffff), bf2f(a.y >> 16)}; }
            float s1[RT], s2[RT];
#pragma unroll
            for (int t = 0; t < RT; ++t) { float a = 0.f;
#pragma unroll
                for (int j = 0; j < 4; ++j) a += (v[t][j].x + v[t][j].y) + (v[t][j].z + v[t][j].w);
                s1[t] = red64(a, lane_r) * (1.f / D); }
#pragma unroll
            for (int t = 0; t < RT; ++t) { float a = 0.f;
#pragma unroll
                for (int j = 0; j < 4; ++j) { v[t][j] = v[t][j] - s1[t]; a += (v[t][j].x * v[t][j].x + v[t][j].y * v[t][j].y) + (v[t][j].z * v[t][j].z + v[t][j].w * v[t][j].w); }
                s2[t] = rsqrtf(red64(a, lane_r) * (1.f / D) + LN_EPS); }
#pragma unroll
            for (int j = 0; j < 4; ++j) {
                const f32x4 gg = *(const f32x4*)(p.g + 4 * lane_r + 256 * j), bb = *(const f32x4*)(p.b + 4 * lane_r + 256 * j);
#pragma unroll
                for (int t = 0; t < RT; ++t) v[t][j] = v[t][j] * s2[t] * gg + bb;
            }
            store_rowsN(v, nullptr, p.hb, tok0, lane_r);
            if (lane_r == 0) {
#pragma unroll
                for (int t = 0; t < RT; ++t) { st[2 * (tl0 + t)] = s1[t]; st[2 * (tl0 + t) + 1] = s2[t]; } }
        }
        if (wv < 4) {
            int lane_r = lane; asm volatile("" : "+v"(lane_r));
            const int fr = lane_r & 15, fq = lane_r >> 4;
            const bf16* arow = p.pin + (size_t)(tb + 16 * wv + fr) * D + 8 * fq;
            f32x4 acc = (f32x4){0.f, 0.f, 0.f, 0.f};
#pragma unroll 8
            for (int kk = 0; kk < 32; ++kk) {
                const bf16x8 a = *(const bf16x8*)(arow + 32 * kk);
                acc = __builtin_amdgcn_mfma_f32_16x16x32_bf16(a, WF[(kk * 2 + 0) * 64 + lane_r], acc, 0, 0, 0);
                acc = __builtin_amdgcn_mfma_f32_16x16x32_bf16(a, WF[(kk * 2 + 1) * 64 + lane_r], acc, 0, 0, 0);
            }
#pragma unroll
            for (int i = 0; i < 4; ++i) lg[(16 * wv + 4 * fq + i) * 16 + fr] = acc[i];
        }
        __syncthreads();
        {
            const int tid2 = opaque_tid(wv_s);
            if (tid2 < 64) {
                const float mu = st[2 * tid2], rstd = st[2 * tid2 + 1];
                float s[16], ss[16];
#pragma unroll
                for (int e4 = 0; e4 < 4; ++e4) { const f32x4 raw = *(const f32x4*)&lg[tid2 * 16 + 4 * e4];
#pragma unroll
                    for (int q = 0; q < 4; ++q) { const int e = 4 * e4 + q; const float r = q == 0 ? raw.x : (q == 1 ? raw.y : (q == 2 ? raw.z : raw.w));
                        const float lgt = rstd * (r - mu * cs[e]) + c0[e]; s[e] = sigmoidf_(lgt); ss[e] = s[e] + p.rbias[e]; } }
                int gbest = 0; float gscore = -INFINITY; int l1b = 0, l2b = 1;
#pragma unroll
                for (int g = 0; g < 4; ++g) {
                    float v1 = ss[4 * g], v2 = -INFINITY; int i1 = 0, i2 = -1;
#pragma unroll
                    for (int i = 1; i < 4; ++i) {
                        const float x = ss[4 * g + i];
                        if (x > v1) { v2 = v1; i2 = i1; v1 = x; i1 = i; }
                        else if (x > v2) { v2 = x; i2 = i; }
                    }
                    const float sc = v1 + v2;
                    if (sc > gscore) { gscore = sc; gbest = g; l1b = i1; l2b = i2; }
                }
                const int e0 = 4 * gbest + l1b, e1 = 4 * gbest + l2b;
                float s0 = 0.f, s1v = 0.f;
#pragma unroll
                for (int e = 0; e < 16; ++e) { s0 = (e == e0) ? s[e] : s0; s1v = (e == e1) ? s[e] : s1v; }
                const float inv = 1.0f / (s0 + s1v);
                sel_e[2 * tid2] = e0; sel_e[2 * tid2 + 1] = e1; sel_g[2 * tid2] = s0 * inv; sel_g[2 * tid2 + 1] = s1v * inv;
                lrank[2 * tid2] = atomicAdd(&lcnt[e0], 1); lrank[2 * tid2 + 1] = atomicAdd(&lcnt[e1], 1);
            }
            __syncthreads();
            if (tid2 < 16) lbase[tid2] = atomicAdd(p.counts + tid2 * CNT_STRIDE, lcnt[tid2]);
            __syncthreads();
            if (tid2 < 128) {
                const int tl = tid2 >> 1, k = tid2 & 1, e = sel_e[2 * tl + k], r = lbase[e] + lrank[2 * tl + k];
                p.rtok[e * CAP + r] = tb + tl; p.rgate[e * CAP + r] = sel_g[2 * tl + k]; p.slot[2 * (tb + tl) + k] = e * CAP + r;
            }
            __syncthreads();
        }
    }
}

struct LnCombP { bf16* hb; const bf16* y; const int* slot; const int* counts; const float* g; const float* b; const float* wf; const float* bf; float* logf; float* outp; int do_f; int pad; };
__device__ __forceinline__ void ph_ln_comb(const LnCombP& p, unsigned char* lds, const int wv_s) {
    const int tid = opaque_tid(wv_s); const int lane = tid & 63, wv = tid >> 6;
    int* pstart = (int*)lds;
    f32x4* wl = (f32x4*)(lds + 2048);
    if (p.do_f) stage_w16(p.wf, NW_IN, wl, tid);
    if (tid == 0) { int acc = 0; for (int e = 0; e < NE; ++e) { pstart[e] = acc; acc += ((p.counts[e * CNT_STRIDE] + 255) >> 8) * 256; } }
    __syncthreads();
    u32x2 hr[RT][4], ya[RT][4], yb[RT][4];
#define LC_ISSUE(tk_, ln_) do { _Pragma("unroll") for (int t = 0; t < RT; ++t) { \
        const int sl0 = p.slot[2 * ((tk_) + t)], sl1 = p.slot[2 * ((tk_) + t) + 1]; \
        const int c0 = pstart[sl0 / CAP] + (sl0 % CAP), c1 = pstart[sl1 / CAP] + (sl1 % CAP); \
        _Pragma("unroll") for (int j = 0; j < 4; ++j) { hr[t][j] = *(const u32x2*)(p.hb + (size_t)((tk_) + t) * D + 4 * (ln_) + 256 * j); \
            ya[t][j] = *(const u32x2*)(p.y + (size_t)c0 * D + 4 * (ln_) + 256 * j); yb[t][j] = *(const u32x2*)(p.y + (size_t)c1 * D + 4 * (ln_) + 256 * j); } } } while (0)
    const int tok_first = (blockIdx.x * 8 + wv) * RT, tok_step = gridDim.x * 8 * RT;
    if (tok_first < M) LC_ISSUE(tok_first, lane);
#pragma unroll 1
    for (int tok0 = tok_first; tok0 < M; tok0 += tok_step) {
        int lane_r = lane; asm volatile("" : "+v"(lane_r));
        f32x4 v[RT][4];
#pragma unroll
        for (int t = 0; t < RT; ++t)
#pragma unroll
            for (int j = 0; j < 4; ++j) { const u32x2 h2 = hr[t][j], a = ya[t][j], bq = yb[t][j];
                v[t][j].x = ALPHA * bf2f(h2.x & 0xffff) + (bf2f(a.x & 0xffff) + bf2f(bq.x & 0xffff));
                v[t][j].y = ALPHA * bf2f(h2.x >> 16) + (bf2f(a.x >> 16) + bf2f(bq.x >> 16));
                v[t][j].z = ALPHA * bf2f(h2.y & 0xffff) + (bf2f(a.y & 0xffff) + bf2f(bq.y & 0xffff));
                v[t][j].w = ALPHA * bf2f(h2.y >> 16) + (bf2f(a.y >> 16) + bf2f(bq.y >> 16)); }
        if (tok0 + tok_step < M) LC_ISSUE(tok0 + tok_step, lane_r);
        ln_rowsN(v, p.g, p.b, lane_r);
        store_rowsN(v, p.outp, p.outp ? nullptr : p.hb, tok0, lane_r);
        if (p.do_f) {
            const float f = rowsN_dot16(v, wl, lane_r);
            if (lane_r < 16 * RT) p.logf[(size_t)(tok0 + (lane_r >> 4)) * 16 + (lane_r & 15)] = -softplusf_(-(f + p.bf[lane_r & 15]));
        }
    }
#undef LC_ISSUE
}

struct ScanP { const bf16* r; const bf16* k; const bf16* v; const _Float16* lw; const bf16* a; const bf16* g; bf16* yg;
               const float* kk; const float* ka; const float* rk; const float* gng; const float* gnb; };
__device__ __forceinline__ void ph_scan(const ScanP& p, unsigned char* lds, int nscan, const int wv_s) {
    typedef float (*arr64)[64];
    arr64 s_r = (arr64)lds, s_kk = (arr64)(lds + 8192), s_b = (arr64)(lds + 16384), s_w = (arr64)(lds + 24576), s_k = (arr64)(lds + 32768), s_v = (arr64)(lds + 40960), s_y = (arr64)(lds + 49152);
    float* s_bonus = (float*)(lds + 57344);
    const int tid = opaque_tid(wv_s);
    const int i = tid >> 3, jq = tid & 7;
    const int lt = tid >> 4, c4 = (tid & 15) * 4;
    for (int unit = blockIdx.x; unit < NB * H; unit += nscan) {
        const int b = unit / H, h = unit % H;
        f32x2 S[4];
#pragma unroll
        for (int j = 0; j < 4; ++j) S[j] = (f32x2){0.f, 0.f};
        const f32x4 kkp = *(const f32x4*)(p.kk + h * HD + c4), kap = *(const f32x4*)(p.ka + h * HD + c4), rkp = *(const f32x4*)(p.rk + h * HD + c4);
        const f32x4 gng = *(const f32x4*)(p.gng + h * HD + c4), gnb = *(const f32x4*)(p.gnb + h * HD + c4);
        typedef _Float16 h4 __attribute__((ext_vector_type(4)));
        size_t base = (size_t)(b * T + lt) * D + h * HD + c4;
        u32x2 r2 = *(const u32x2*)(p.r + base), k2 = *(const u32x2*)(p.k + base), v2 = *(const u32x2*)(p.v + base), a2 = *(const u32x2*)(p.a + base), g2 = *(const u32x2*)(p.g + base);
        h4 lwh = *(const h4*)(p.lw + base);
        for (int blk = 0; blk < T / 32; ++blk) {
            const size_t obase = base;
            const u32x2 g2c = g2;
            {
                const f32x4 lw4 = {(float)lwh[0], (float)lwh[1], (float)lwh[2], (float)lwh[3]};
                const f32x4 rr = {bf2f(r2.x & 0xffff), bf2f(r2.x >> 16), bf2f(r2.y & 0xffff), bf2f(r2.y >> 16)};
                const f32x4 kr = {bf2f(k2.x & 0xffff), bf2f(k2.x >> 16), bf2f(k2.y & 0xffff), bf2f(k2.y >> 16)};
                const f32x4 vv = {bf2f(v2.x & 0xffff), bf2f(v2.x >> 16), bf2f(v2.y & 0xffff), bf2f(v2.y >> 16)};
                const f32x4 aa = {bf2f(a2.x & 0xffff), bf2f(a2.x >> 16), bf2f(a2.y & 0xffff), bf2f(a2.y >> 16)};
                const f32x4 kkn = kr * kkp;
                const float ss = red16((kkn.x * kkn.x + kkn.y * kkn.y) + (kkn.z * kkn.z + kkn.w * kkn.w));
                const float inv = fminf(__builtin_amdgcn_rsqf(ss), 1e12f);
                const f32x4 kkv = kkn * inv;
                const f32x4 km = kr * (1.0f + (aa - 1.0f) * kap);
                const f32x4 bb = kkv * aa;
                f32x4 wd; wd.x = __expf(lw4.x); wd.y = __expf(lw4.y); wd.z = __expf(lw4.z); wd.w = __expf(lw4.w);
                const f32x4 bt = rr * km * rkp;
                const float bo = red16((bt.x + bt.y) + (bt.z + bt.w));
                *(f32x4*)&s_r[lt][c4] = rr; *(f32x4*)&s_kk[lt][c4] = kkv; *(f32x4*)&s_b[lt][c4] = bb; *(f32x4*)&s_w[lt][c4] = wd;
                *(f32x4*)&s_k[lt][c4] = km; *(f32x4*)&s_v[lt][c4] = vv;
                if ((tid & 15) == 0) s_bonus[lt] = bo;
            }
            __syncthreads();
            if (blk + 1 < T / 32) {
                base += (size_t)32 * D;
                r2 = *(const u32x2*)(p.r + base); k2 = *(const u32x2*)(p.k + base); v2 = *(const u32x2*)(p.v + base); a2 = *(const u32x2*)(p.a + base); g2 = *(const u32x2*)(p.g + base);
                lwh = *(const h4*)(p.lw + base);
            }
#define SC_LOAD(X, tt_) do { X##k0 = *(const f32x4*)&s_kk[tt_][8 * jq]; X##k1 = *(const f32x4*)&s_kk[tt_][8 * jq + 4]; X##w0 = *(const f32x4*)&s_w[tt_][8 * jq]; X##w1 = *(const f32x4*)&s_w[tt_][8 * jq + 4]; \
                X##b0 = *(const f32x4*)&s_b[tt_][8 * jq]; X##b1 = *(const f32x4*)&s_b[tt_][8 * jq + 4]; X##q0 = *(const f32x4*)&s_k[tt_][8 * jq]; X##q1 = *(const f32x4*)&s_k[tt_][8 * jq + 4]; \
                X##r0 = *(const f32x4*)&s_r[tt_][8 * jq]; X##r1 = *(const f32x4*)&s_r[tt_][8 * jq + 4]; X##vi = s_v[tt_][i]; } while (0)
#define SC_STEP(X, tt_) do { \
                const f32x2 d_ = S[0] * (f32x2){X##k0.x, X##k0.y} + S[1] * (f32x2){X##k0.z, X##k0.w} + S[2] * (f32x2){X##k1.x, X##k1.y} + S[3] * (f32x2){X##k1.z, X##k1.w}; \
                const float sa_ = red8(d_.x + d_.y); \
                S[0] = S[0] * (f32x2){X##w0.x, X##w0.y} - sa_ * (f32x2){X##b0.x, X##b0.y} + X##vi * (f32x2){X##q0.x, X##q0.y}; \
                S[1] = S[1] * (f32x2){X##w0.z, X##w0.w} - sa_ * (f32x2){X##b0.z, X##b0.w} + X##vi * (f32x2){X##q0.z, X##q0.w}; \
                S[2] = S[2] * (f32x2){X##w1.x, X##w1.y} - sa_ * (f32x2){X##b1.x, X##b1.y} + X##vi * (f32x2){X##q1.x, X##q1.y}; \
                S[3] = S[3] * (f32x2){X##w1.z, X##w1.w} - sa_ * (f32x2){X##b1.z, X##b1.w} + X##vi * (f32x2){X##q1.z, X##q1.w}; \
                const f32x2 e_ = S[0] * (f32x2){X##r0.x, X##r0.y} + S[1] * (f32x2){X##r0.z, X##r0.w} + S[2] * (f32x2){X##r1.x, X##r1.y} + S[3] * (f32x2){X##r1.z, X##r1.w}; \
                const float y_ = red8(e_.x + e_.y); \
                if (jq == 0) s_y[tt_][i] = y_; } while (0)
            f32x4 Ak0, Ak1, Aw0, Aw1, Ab0, Ab1, Aq0, Aq1, Ar0, Ar1, Bk0, Bk1, Bw0, Bw1, Bb0, Bb1, Bq0, Bq1, Br0, Br1; float Avi, Bvi;
            SC_LOAD(A, 0);
            for (int tt = 0; tt < 32; tt += 2) {
                SC_LOAD(B, tt + 1);
                SC_STEP(A, tt);
                { const int tn = (tt + 2) & 31; SC_LOAD(A, tn); }
                SC_STEP(B, tt + 1);
            }
#undef SC_LOAD
#undef SC_STEP
            __syncthreads();
            {
                const f32x4 y4 = *(const f32x4*)&s_y[lt][c4];
                const float mu = red16((y4.x + y4.y) + (y4.z + y4.w)) * (1.f / 64.f);
                const f32x4 dd = y4 - mu;
                const float rstd = rsqrtf(red16((dd.x * dd.x + dd.y * dd.y) + (dd.z * dd.z + dd.w * dd.w)) * (1.f / 64.f) + GN_EPS);
                const f32x4 vv = *(const f32x4*)&s_v[lt][c4];
                const float bo = s_bonus[lt];
                const f32x4 gg = {bf2f(g2c.x & 0xffff), bf2f(g2c.x >> 16), bf2f(g2c.y & 0xffff), bf2f(g2c.y >> 16)};
                const f32x4 o = (dd * rstd * gng + gnb + bo * vv) * gg;
                u32x2 ob; ob.x = pk2(o.x, o.y); ob.y = pk2(o.z, o.w);
                *(u32x2*)(p.yg + obase) = ob;
            }
            __syncthreads();
        }
    }
}

namespace sc {
constexpr int GLD = 64;
__device__ __forceinline__ int swz(int row, int col) { return row * GLD + ((((col >> 3) ^ row) & 7) << 3) + (col & 7); }
constexpr int BUFB = 64 * GLD * 2;
constexpr int B_KKD = 0, B_RD = 1, B_BINV = 2, B_KINV = 3, B_VT = 4, B_KDT = 5, B_NBDT = 6, B_SB = 7, B_M = 8, B_NQ = 9;
constexpr int B_XT = B_KKD, B_N = B_BINV, B_P = B_KINV;
constexpr int MS = 68;
constexpr int F_M = 10 * BUFB, F_R = F_M + 64 * MS * 4, PART = F_R + 64 * 65 * 4, GT = PART + 2 * 8 * 64 * 4, BON = GT + 256, SCR = BON + 256, END = SCR + 4 * 4096;
constexpr int LD16 = 24, O_XR = 0, O_XT = 768, O_TR = 1536, O_RT = 2304, O_TD = 3072;
static_assert(END <= 147392, "scan LDS");
__device__ __forceinline__ bf16* buf(unsigned char* lds, int i) { return (bf16*)(lds + i * BUFB); }
__device__ __forceinline__ bf16* xtb(unsigned char* lds) { return (bf16*)(lds + SCR); }
__device__ __forceinline__ void tile_mma(f32x4& acc, const bf16* A, int arow0, const bf16* Bt, int brow0, int fr, int fq) {
#pragma unroll
    for (int kk = 0; kk < 2; ++kk) {
        const bf16x8 a = *(const bf16x8*)&A[swz(arow0 + fr, kk * 32 + 8 * fq)];
        const bf16x8 b = *(const bf16x8*)&Bt[swz(brow0 + fr, kk * 32 + 8 * fq)];
        acc = __builtin_amdgcn_mfma_f32_16x16x32_bf16(a, b, acc, 0, 0, 0);
    }
}
__device__ __forceinline__ unsigned cvtpk(float lo, float hi);
__device__ __forceinline__ bf16 cvt1(float x);
__device__ __forceinline__ void mm16(f32x4& acc, const bf16* A, const bf16* Bt, int fr, int fq) {
    bf16x8 a = (bf16x8){0, 0, 0, 0, 0, 0, 0, 0}, b = a;
    if (fq < 2) { a = *(const bf16x8*)&A[fr * LD16 + 8 * fq]; b = *(const bf16x8*)&Bt[fr * LD16 + 8 * fq]; }
    acc = __builtin_amdgcn_mfma_f32_16x16x32_bf16(a, b, acc, 0, 0, 0);
}
__device__ __forceinline__ void wr_rm(bf16* R, const f32x4 v, int fr, int fq) {
#pragma unroll
    for (int i = 0; i < 4; ++i) R[(4 * fq + i) * LD16 + fr] = cvt1(v[i]);
}
__device__ __forceinline__ void wr_tr(bf16* Tt, const f32x4 v, int fr, int fq) { u32x2 o; o.x = cvtpk(v[0], v[1]); o.y = cvtpk(v[2], v[3]); *(u32x2*)&Tt[fr * LD16 + 4 * fq] = o; }
#define SC_LWAIT() asm volatile("s_waitcnt lgkmcnt(0)" ::: "memory")
typedef short s16x4 __attribute__((ext_vector_type(4)));
__device__ __forceinline__ s16x4 pk4(const f32x4 v) { u32x2 o; o.x = cvtpk(v[0], v[1]); o.y = cvtpk(v[2], v[3]); return __builtin_bit_cast(s16x4, o); }
__device__ __forceinline__ f32x4 mm16k(const s16x4 a, const s16x4 b, const f32x4 c) { return __builtin_amdgcn_mfma_f32_16x16x16bf16_1k(a, b, c, 0, 0, 0); }
constexpr int MP = 20, MDS = 16 * MP;
constexpr int PRM = F_M + 8192;
__device__ __forceinline__ void cvt8(const u32x4 v, float (&o)[8]) {
    o[0] = bf2f(v.x & 0xffff); o[1] = bf2f(v.x >> 16); o[2] = bf2f(v.y & 0xffff); o[3] = bf2f(v.y >> 16);
    o[4] = bf2f(v.z & 0xffff); o[5] = bf2f(v.z >> 16); o[6] = bf2f(v.w & 0xffff); o[7] = bf2f(v.w >> 16);
}
typedef __bf16 bf16x2_hw __attribute__((ext_vector_type(2)));
__device__ __forceinline__ unsigned cvtpk(float lo, float hi) { const f32x2 v = {lo, hi}; const bf16x2_hw b = __builtin_convertvector(v, bf16x2_hw); return __builtin_bit_cast(unsigned, b); }
__device__ __forceinline__ bf16 cvt1(float x) { return (bf16)(cvtpk(x, x) & 0xffffu); }
__device__ __forceinline__ u32x4 pack8(const float (&x)[8]) { u32x4 o; o.x = cvtpk(x[0], x[1]); o.y = cvtpk(x[2], x[3]); o.z = cvtpk(x[4], x[5]); o.w = cvtpk(x[6], x[7]); return o; }
}

__device__ __forceinline__ void ph_scan_chunk(const ScanP& p, unsigned char* lds, int nscan, const int wv_s) {
    using namespace sc;
    const int w = wv_s;
#define SC_LANES const int tid = opaque_tid(wv_s), lane = tid & 63, fr = lane & 15, fq = lane >> 4; (void)fr; (void)fq; (void)tid
    float* Mf = (float*)(lds + F_M); float* Rf = (float*)(lds + F_R); float* part = (float*)(lds + PART); float* gt = (float*)(lds + GT); float* bon = (float*)(lds + BON);
    typedef _Float16 h8 __attribute__((ext_vector_type(8)));
    for (int unit = blockIdx.x; unit < NB * H; unit += nscan) {
        const int b = unit / H, h = unit % H;
        __syncthreads();
        f32x4 Sreg[2];
        Sreg[0] = Sreg[1] = (f32x4){0.f, 0.f, 0.f, 0.f};
        size_t base;
        { SC_LANES; base = (size_t)(b * T + lane) * D + h * HD + 8 * w;
        for (int z = tid; z < BUFB / 4; z += 512) ((unsigned*)buf(lds, B_SB))[z] = 0u;
        }
        float* prm = (float*)(lds + PRM);
        size_t ob;
        { SC_LANES; const int n8 = (tid & 7) * 8;
          if (tid < 64) { prm[tid] = p.kk[h * HD + tid]; prm[64 + tid] = p.ka[h * HD + tid]; prm[128 + tid] = p.rk[h * HD + tid]; prm[192 + tid] = p.gng[h * HD + tid]; prm[256 + tid] = p.gnb[h * HD + tid]; }
          ob = (size_t)(b * T + (tid >> 3)) * D + h * HD + n8; }
        u32x4 vg, gg8;
        u32x4 r8 = *(const u32x4*)(p.r + base), k8 = *(const u32x4*)(p.k + base), v8 = *(const u32x4*)(p.v + base), a8 = *(const u32x4*)(p.a + base);
        h8 lw8 = *(const h8*)(p.lw + base);
        __syncthreads();
        for (int ch = 0; ch < T / 64; ++ch) {
            {   SC_LANES;
            float rr[8], kr[8], aa[8], lwf[8];
            cvt8(r8, rr); cvt8(k8, kr); cvt8(a8, aa);
#pragma unroll
            for (int q = 0; q < 8; ++q) lwf[q] = (float)lw8[q];
            float kkn[8], km[8]; float ssp = 0.f, bop = 0.f;
#pragma unroll
            for (int q = 0; q < 8; ++q) { const float kkp = prm[8 * w + q], kap = prm[64 + 8 * w + q], rkp = prm[128 + 8 * w + q];
                kkn[q] = kr[q] * kkp; ssp += kkn[q] * kkn[q]; km[q] = kr[q] * (1.0f + (aa[q] - 1.0f) * kap); bop += rr[q] * km[q] * rkp; }
            part[w * 64 + lane] = ssp; part[512 + w * 64 + lane] = bop;
            float cum[8];
#pragma unroll
            for (int q = 0; q < 8; ++q) cum[q] = lwf[q];
#define SC_DPP8(ctl) "v_add_f32_dpp %0, %0, %0 " ctl "\n\tv_add_f32_dpp %1, %1, %1 " ctl "\n\tv_add_f32_dpp %2, %2, %2 " ctl "\n\tv_add_f32_dpp %3, %3, %3 " ctl "\n\t" \
                     "v_add_f32_dpp %4, %4, %4 " ctl "\n\tv_add_f32_dpp %5, %5, %5 " ctl "\n\tv_add_f32_dpp %6, %6, %6 " ctl "\n\tv_add_f32_dpp %7, %7, %7 " ctl "\n\t"
            asm volatile("s_nop 1\n\t"
                         SC_DPP8("row_shr:1 row_mask:0xf bank_mask:0xf bound_ctrl:1") SC_DPP8("row_shr:2 row_mask:0xf bank_mask:0xf bound_ctrl:1")
                         SC_DPP8("row_shr:4 row_mask:0xf bank_mask:0xf bound_ctrl:1") SC_DPP8("row_shr:8 row_mask:0xf bank_mask:0xf bound_ctrl:1")
                         SC_DPP8("row_bcast:15 row_mask:0xa bank_mask:0xf") SC_DPP8("row_bcast:31 row_mask:0xc bank_mask:0xf")
                         : "+v"(cum[0]), "+v"(cum[1]), "+v"(cum[2]), "+v"(cum[3]), "+v"(cum[4]), "+v"(cum[5]), "+v"(cum[6]), "+v"(cum[7]));
#undef SC_DPP8
            __syncthreads();
            float ss = 0.f, bo = 0.f;
#pragma unroll
            for (int q = 0; q < 8; ++q) { ss += part[q * 64 + lane]; bo += part[512 + q * 64 + lane]; }
            const float inv = fminf(__builtin_amdgcn_rsqf(ss), 1e12f);
            {
                float o_kkd[8], o_rd[8], o_binv[8], o_kinv[8];
                bf16* bVT = buf(lds, B_VT); bf16* bKDT = buf(lds, B_KDT); bf16* bNBDT = buf(lds, B_NBDT);
#pragma unroll
                for (int q = 0; q < 8; ++q) {
                    const float kkv = kkn[q] * inv, bb = kkv * aa[q];
                    const float e_c = __builtin_amdgcn_exp2f(cum[q]), e_n = __builtin_amdgcn_exp2f(-cum[q]);
                    const float e_tot = __int_as_float(__builtin_amdgcn_readlane(__float_as_int(e_c), 63));
                    const float e_x = __int_as_float(__builtin_amdgcn_update_dpp(0x3f800000, __float_as_int(e_c), 0x138, 0xF, 0xF, false));
                    const float e_t = e_tot * e_n;
                    o_kkd[q] = kkv * e_x; o_rd[q] = rr[q] * e_c; o_binv[q] = bb * e_n; o_kinv[q] = km[q] * e_n;
                    bVT[swz(8 * w + q, lane)] = (bf16)((q & 1) ? (v8[q >> 1] >> 16) : (v8[q >> 1] & 0xffffu));
                    const unsigned kb = cvtpk(km[q] * e_t, -bb * e_t);
                    bKDT[swz(8 * w + q, lane)] = (bf16)(kb & 0xffffu);
                    bNBDT[swz(8 * w + q, lane)] = (bf16)(kb >> 16);
                    if (lane == 0) gt[8 * w + q] = e_tot;
                }
                *(u32x4*)&buf(lds, B_KKD)[swz(lane, 8 * w)] = pack8(o_kkd); *(u32x4*)&buf(lds, B_RD)[swz(lane, 8 * w)] = pack8(o_rd);
                *(u32x4*)&buf(lds, B_BINV)[swz(lane, 8 * w)] = pack8(o_binv); *(u32x4*)&buf(lds, B_KINV)[swz(lane, 8 * w)] = pack8(o_kinv);
                if (w == 0) bon[lane] = bo;
            }
            }
            __syncthreads();
            {   SC_LANES;
                const int m = w >> 1;
                const bf16* A = buf(lds, (m & 1) ? B_KINV : B_BINV); const bf16* Bt = buf(lds, m < 2 ? B_KKD : B_RD);
                f32x4 acc[8];
#pragma unroll
                for (int q = 0; q < 8; ++q) { const int tt = (w & 1) * 2 + (q >> 2), st = q & 3; acc[q] = (f32x4){0.f, 0.f, 0.f, 0.f}; tile_mma(acc[q], A, 16 * st, Bt, 16 * tt, fr, fq); }
                __syncthreads();
                {
                    const float sgn = (m == 2) ? -1.f : 1.f;
                    bf16* dst = buf(lds, m == 0 ? B_M : (m == 1 ? B_N : (m == 2 ? B_NQ : B_P)));
#pragma unroll
                    for (int q = 0; q < 8; ++q) { const int tt = (w & 1) * 2 + (q >> 2), st = q & 3; const int t = 16 * tt + fr, s0 = 16 * st + 4 * fq;
                        f32x4 val;
#pragma unroll
                        for (int i = 0; i < 4; ++i) { const int s = s0 + i; const float keep = (m < 2) ? ((s < t) ? 1.f : 0.f) : ((s <= t) ? sgn : 0.f); val[i] = acc[q][i] * keep; }
                        if (m == 0) { if (st == tt) *(f32x4*)&Mf[tt * MDS + fr * MP + 4 * fq] = val; val = -val; }
                        u32x2 o; o.x = cvtpk(val[0], val[1]); o.y = cvtpk(val[2], val[3]);
                        *(u32x2*)&dst[swz(t, s0)] = o; }
                }
            }
            __syncthreads();
            vg = *(const u32x4*)(p.v + ob); gg8 = *(const u32x4*)(p.g + ob);
            if (ch + 1 < T / 64) { base += (size_t)64 * D; r8 = *(const u32x4*)(p.r + base); k8 = *(const u32x4*)(p.k + base); v8 = *(const u32x4*)(p.v + base); a8 = *(const u32x4*)(p.a + base); lw8 = *(const h8*)(p.lw + base); }
#define SC_LD2(dst, img, row0) { dst[0] = *(const bf16x8*)&(img)[swz((row0) + fr, 8 * fq)]; dst[1] = *(const bf16x8*)&(img)[swz((row0) + fr, 32 + 8 * fq)]; }
#define SC_MM(acc, a, b) acc = __builtin_amdgcn_mfma_f32_16x16x32_bf16(a, b, acc, 0, 0, 0)
            f32x4 yacc[4];
            {   SC_LANES;
                const f32x4 z4 = (f32x4){0.f, 0.f, 0.f, 0.f};
                if (w < 4) {
                    bf16x8 bS[2], bV[2], aK[4][2], aN[4][2];
                    SC_LD2(bS, buf(lds, B_SB), 16 * w); SC_LD2(bV, buf(lds, B_VT), 16 * w);
#pragma unroll
                    for (int mt = 0; mt < 4; ++mt) { SC_LD2(aK[mt], buf(lds, B_KKD), 16 * mt); SC_LD2(aN[mt], buf(lds, B_N), 16 * mt); }
                    f32x4 cX[4], cXt[4], cTt[4];
#pragma unroll
                    for (int d = 0; d < 4; ++d) { const float* Md = Mf + d * MDS; cXt[d] = *(const f32x4*)&Md[fr * MP + 4 * fq];
#pragma unroll
                        for (int i = 0; i < 4; ++i) cX[d][i] = Md[(4 * fq + i) * MP + fr]; }
                    s16x4 nM[6];
#pragma unroll
                    for (int e = 0; e < 6; ++e) { const int bc = e < 3 ? 0 : (e < 5 ? 1 : 2), br = e < 3 ? e + 1 : (e < 5 ? e - 1 : 3);
                        nM[e] = *(const s16x4*)&buf(lds, B_M)[swz(16 * br + fr, 16 * bc + 4 * fq)]; }
                    SC_LWAIT();
                    f32x4 racc[4];
#pragma unroll
                    for (int mt = 0; mt < 4; ++mt) { racc[mt] = z4; SC_MM(racc[mt], aK[mt][0], bS[0]); }
#pragma unroll
                    for (int mt = 0; mt < 4; ++mt) SC_MM(racc[mt], aK[mt][1], bS[1]);
#pragma unroll
                    for (int mt = 0; mt < 4; ++mt) SC_MM(racc[mt], aN[mt][0], bV[0]);
#pragma unroll
                    for (int mt = 0; mt < 4; ++mt) SC_MM(racc[mt], aN[mt][1], bV[1]);
                    s16x4 pA[4], pAt[4], TT[4];
                    f32x4 XA[4], XB[4];
#pragma unroll
                    for (int d = 0; d < 4; ++d) { pA[d] = pk4(cX[d]); pAt[d] = pk4(cXt[d]);
#pragma unroll
                        for (int i = 0; i < 4; ++i) cTt[d][i] = ((4 * fq + i) == fr ? 1.f : 0.f) - cXt[d][i]; }
#pragma unroll
                    for (int st = 0; st < 3; ++st) {
#pragma unroll
                        for (int d = 0; d < 4; ++d) XA[d] = mm16k(pAt[d], pA[d], z4);
                        if (st < 2) {
#pragma unroll
                            for (int d = 0; d < 4; ++d) XB[d] = mm16k(pA[d], pAt[d], z4);
                        }
#pragma unroll
                        for (int d = 0; d < 4; ++d) TT[d] = pk4(cTt[d]);
#pragma unroll
                        for (int d = 0; d < 4; ++d) pA[d] = pk4(XA[d]);
#pragma unroll
                        for (int d = 0; d < 4; ++d) cTt[d] = mm16k(pA[d], TT[d], cTt[d]);
                        if (st < 2) {
#pragma unroll
                            for (int d = 0; d < 4; ++d) pAt[d] = pk4(XB[d]);
                        }
                    }
#pragma unroll
                    for (int d = 0; d < 4; ++d) TT[d] = pk4(cTt[d]);
#pragma unroll
                    for (int blk = 0; blk < 4; ++blk) {
                        const f32x4 xx = mm16k(TT[blk], pk4(racc[blk]), z4);
                        const s16x4 pxx = pk4(xx);
                        *(s16x4*)&xtb(lds)[swz(16 * w + fr, 16 * blk + 4 * fq)] = pxx;
#pragma unroll
                        for (int br = blk + 1; br < 4; ++br) { const int e = blk == 0 ? br - 1 : (blk == 1 ? br + 1 : 5); racc[br] = mm16k(nM[e], pxx, racc[br]); }
                    }
                } else {
                    const int mt = w - 4;
                    bf16x8 aR[2], aP[2], bS[4][2], bV[4][2];
                    SC_LD2(aR, buf(lds, B_RD), 16 * mt); SC_LD2(aP, buf(lds, B_P), 16 * mt);
#pragma unroll
                    for (int nt = 0; nt < 4; ++nt) { SC_LD2(bS[nt], buf(lds, B_SB), 16 * nt); SC_LD2(bV[nt], buf(lds, B_VT), 16 * nt); }
                    asm volatile("s_waitcnt lgkmcnt(0)" : "+v"(aR[0]), "+v"(aR[1]), "+v"(aP[0]), "+v"(aP[1]), "+v"(bS[0][0]), "+v"(bS[0][1]), "+v"(bS[1][0]), "+v"(bS[1][1]), "+v"(bS[2][0]), "+v"(bS[2][1]),
                                 "+v"(bS[3][0]), "+v"(bS[3][1]), "+v"(bV[0][0]), "+v"(bV[0][1]), "+v"(bV[1][0]), "+v"(bV[1][1]), "+v"(bV[2][0]), "+v"(bV[2][1]), "+v"(bV[3][0]), "+v"(bV[3][1]) :: "memory");
#pragma unroll
                    for (int nt = 0; nt < 4; ++nt) { yacc[nt] = z4; SC_MM(yacc[nt], aR[0], bS[nt][0]); }
#pragma unroll
                    for (int nt = 0; nt < 4; ++nt) SC_MM(yacc[nt], aR[1], bS[nt][1]);
#pragma unroll
                    for (int nt = 0; nt < 4; ++nt) SC_MM(yacc[nt], aP[0], bV[nt][0]);
#pragma unroll
                    for (int nt = 0; nt < 4; ++nt) SC_MM(yacc[nt], aP[1], bV[nt][1]);
                }
            }
            __syncthreads();
            {   SC_LANES;
                const int mt6 = w >> 1, nt6 = 2 * (w & 1);
                bf16x8 aV[2], aX[2], bK[2][2], bB[2][2], aQ[2], bX[4][2];
                SC_LD2(aV, buf(lds, B_VT), 16 * mt6); SC_LD2(aX, xtb(lds), 16 * mt6);
#pragma unroll
                for (int q = 0; q < 2; ++q) { SC_LD2(bK[q], buf(lds, B_KDT), 16 * (nt6 + q)); SC_LD2(bB[q], buf(lds, B_NBDT), 16 * (nt6 + q)); }
                const float g0 = gt[16 * nt6 + fr], g1 = gt[16 * nt6 + 16 + fr];
                if (w >= 4) {
                    SC_LD2(aQ, buf(lds, B_NQ), 16 * (w - 4));
#pragma unroll
                    for (int nt = 0; nt < 4; ++nt) SC_LD2(bX[nt], xtb(lds), 16 * nt);
                }
                SC_LWAIT();
                if (w >= 4) {
#pragma unroll
                    for (int nt = 0; nt < 4; ++nt) SC_MM(yacc[nt], aQ[0], bX[nt][0]);
#pragma unroll
                    for (int nt = 0; nt < 4; ++nt) SC_MM(yacc[nt], aQ[1], bX[nt][1]);
                }
                f32x4 s0 = Sreg[0] * g0, s1 = Sreg[1] * g1;
                SC_MM(s0, aV[0], bK[0][0]); SC_MM(s1, aV[0], bK[1][0]); SC_MM(s0, aV[1], bK[0][1]); SC_MM(s1, aV[1], bK[1][1]);
                SC_MM(s0, aX[0], bB[0][0]); SC_MM(s1, aX[0], bB[1][0]); SC_MM(s0, aX[1], bB[0][1]); SC_MM(s1, aX[1], bB[1][1]);
                Sreg[0] = s0; Sreg[1] = s1;
                if (w >= 4) {
#pragma unroll
                    for (int nt = 0; nt < 4; ++nt) {
#pragma unroll
                        for (int i = 0; i < 4; ++i) Rf[(16 * (w - 4) + 4 * fq + i) * 65 + 16 * nt + fr] = yacc[nt][i]; }
                }
#pragma unroll
                for (int i = 0; i < 4; ++i) { buf(lds, B_SB)[swz(16 * mt6 + 4 * fq + i, 16 * nt6 + fr)] = cvt1(s0[i]); buf(lds, B_SB)[swz(16 * mt6 + 4 * fq + i, 16 * nt6 + 16 + fr)] = cvt1(s1[i]); }
            }
            __syncthreads();
#undef SC_LD2
#undef SC_MM
            {   SC_LANES;
                const int t = tid >> 3, n8 = (tid & 7) * 8;
                float y[8], vf[8], gf[8]; cvt8(vg, vf); cvt8(gg8, gf);
                float sm = 0.f;
#pragma unroll
                for (int q = 0; q < 8; ++q) { y[q] = Rf[t * 65 + n8 + q]; sm += y[q]; }
                const float mu = red8(sm) * (1.f / 64.f);
                float vs = 0.f;
#pragma unroll
                for (int q = 0; q < 8; ++q) { y[q] -= mu; vs += y[q] * y[q]; }
                const float rstd = rsqrtf(red8(vs) * (1.f / 64.f) + GN_EPS);
                const float bo2 = bon[t];
                float o[8];
#pragma unroll
                for (int q = 0; q < 8; ++q) o[q] = (y[q] * rstd * prm[192 + n8 + q] + prm[256 + n8 + q] + bo2 * vf[q]) * gf[q];
                *(u32x4*)(p.yg + ob) = pack8(o);
                ob += (size_t)64 * D;
            }
        }
    }
#undef SC_LANES
}
namespace sc2 {
using namespace sc;
constexpr int IMG = 8192;
constexpr int O_KKD = 0, O_RD = 1, O_N = 2, O_P = 3, O_VT = 4, O_KDT = 5, O_NBDT = 6, O_NQ = 7;
constexpr int O_MC = 8 * IMG, O_TT = O_MC + 3072, O_GT = O_TT + 2048, O_BON = O_GT + 256, SETB = O_BON + 256;
constexpr int RFP = 68;
constexpr int RF = 2 * SETB, PARTO = RF + 64 * RFP * 4, PRMO = PARTO + 2048, END2 = PRMO + 1280;
constexpr int SYNCO = END2;
static_assert(SYNCO + 64 <= 163776, "scan LDS");
__device__ __forceinline__ bf16* img(unsigned char* lds, int setb, int i) { return (bf16*)(lds + setb + i * IMG); }
__device__ __forceinline__ bf16x8 ld128(const bf16* im, int row, int col) { return *(const bf16x8*)&im[swz(row, col)]; }
__device__ __forceinline__ s16x4 ld64(const bf16* im, int row, int col) { return *(const s16x4*)&im[swz(row, col)]; }
__device__ __forceinline__ f32x4 mm32(const bf16x8 a, const bf16x8 b, const f32x4 c) { return __builtin_amdgcn_mfma_f32_16x16x32_bf16(a, b, c, 0, 0, 0); }
__device__ __forceinline__ void grp_sync(LAS unsigned* cnt, unsigned target, int lane) {
    asm volatile("s_waitcnt lgkmcnt(0)" ::: "memory");
    if (lane == 0) (void)__hip_atomic_fetch_add(cnt, 1u, __ATOMIC_RELAXED, __HIP_MEMORY_SCOPE_WORKGROUP);
    while ((unsigned)__builtin_amdgcn_readfirstlane((int)__hip_atomic_load(cnt, __ATOMIC_RELAXED, __HIP_MEMORY_SCOPE_WORKGROUP)) < target) __builtin_amdgcn_s_sleep(1);
    asm volatile("" ::: "memory");
}
}

__device__ __forceinline__ void pc_out(const ScanP& p, const float* Rf, const float* prm, const float bo2, const u32x4 (&vg)[2], const u32x4 (&gg)[2], size_t ob, int w, int lane) {
    using namespace sc2;
    const int tc = w * 64 + lane, t = tc >> 2, qd = tc & 3;
    float y[2][8], vf[2][8], gf[2][8]; cvt8(vg[0], vf[0]); cvt8(vg[1], vf[1]); cvt8(gg[0], gf[0]); cvt8(gg[1], gf[1]);
    float sm = 0.f;
#pragma unroll
    for (int j = 0; j < 4; ++j) { const f32x4 yy = *(const f32x4*)&Rf[t * RFP + 16 * qd + 4 * j]; y[j >> 1][4 * (j & 1)] = yy[0]; y[j >> 1][4 * (j & 1) + 1] = yy[1]; y[j >> 1][4 * (j & 1) + 2] = yy[2]; y[j >> 1][4 * (j & 1) + 3] = yy[3];
        sm += (yy[0] + yy[1]) + (yy[2] + yy[3]); }
    sm += dppx<0xB1>(sm); sm += dppx<0x4E>(sm);
    const float mu = sm * (1.f / 64.f);
    float vs = 0.f;
#pragma unroll
    for (int q = 0; q < 16; ++q) { y[q >> 3][q & 7] -= mu; vs += y[q >> 3][q & 7] * y[q >> 3][q & 7]; }
    vs += dppx<0xB1>(vs); vs += dppx<0x4E>(vs);
    const float rstd = rsqrtf(vs * (1.f / 64.f) + GN_EPS);
    float o[2][8];
#pragma unroll
    for (int q = 0; q < 16; ++q) o[q >> 3][q & 7] = (y[q >> 3][q & 7] * rstd * prm[192 + 16 * qd + q] + prm[256 + 16 * qd + q] + bo2 * vf[q >> 3][q & 7]) * gf[q >> 3][q & 7];
    *(u32x4*)(p.yg + ob) = pack8(o[0]); *(u32x4*)(p.yg + ob + 512) = pack8(o[1]);
}

__device__ __forceinline__ void ph_scan_pc(const ScanP& p, unsigned char* lds, int nscan, const int wv_s) {
    using namespace sc2;
    const int w = wv_s;
#define SC_LANES const int tid = opaque_tid(wv_s), lane = tid & 63, fr = lane & 15, fq = lane >> 4; (void)fr; (void)fq; (void)tid
    typedef _Float16 h8 __attribute__((ext_vector_type(8)));
    float* Rf = (float*)(lds + RF); float* part = (float*)(lds + PARTO); float* prm = (float*)(lds + PRMO);
    const f32x4 z4 = (f32x4){0.f, 0.f, 0.f, 0.f};
    for (int unit = blockIdx.x; unit < NB * H; unit += nscan) {
        const int b = unit / H, h = unit % H;
        __syncthreads();
        { SC_LANES; if (tid == 0) { ((LAS unsigned*)(lds + SYNCO))[0] = 0u; ((LAS unsigned*)(lds + SYNCO))[1] = 0u; }
          if (tid < 64) { prm[tid] = p.kk[h * HD + tid]; prm[64 + tid] = p.ka[h * HD + tid]; prm[128 + tid] = p.rk[h * HD + tid]; prm[192 + tid] = p.gng[h * HD + tid]; prm[256 + tid] = p.gnb[h * HD + tid]; } }
        f32x4 ST[4]; ST[0] = ST[1] = ST[2] = ST[3] = z4;
        s16x4 pxx[4];
        u32x4 vg[2], gg[2];
        float bo_out = 0.f;
        u32x4 r8[2], k8[2], v8[2], a8[2]; h8 lw8[2];
        size_t pbase = 0, sbase = 0, ob = 0, vb = 0, yb = 0;
        { SC_LANES;
          if (w >= 4) { pbase = (size_t)(b * T + lane) * D + h * HD + 16 * (w - 4);
              sbase = pg8::scan_idx(b * T + lane, h * HD + 16 * (w - 4));
#pragma unroll
              for (int o = 0; o < 2; ++o) { r8[o] = *(const u32x4*)(p.r + sbase + 512 * o); k8[o] = *(const u32x4*)(p.k + sbase + 512 * o); v8[o] = *(const u32x4*)(p.v + sbase + 512 * o);
                  a8[o] = *(const u32x4*)(p.a + sbase + 512 * o); lw8[o] = *(const h8*)(p.lw + sbase + 512 * o); } }
          else { ob = (size_t)(b * T + ((w * 64 + lane) >> 2)) * D + h * HD + 16 * (lane & 3); vb = pg8::scan_idx(b * T + ((w * 64 + lane) >> 2), h * HD + 16 * (lane & 3)); yb = vb; } }
        __syncthreads();
        for (int ch = -1; ch < T / 64; ++ch) {
            if (w >= 4) {
                if (ch + 1 < T / 64) {
                    const int pw = w - 4, setb = ((ch + 1) & 1) * SETB;
                    float rr[2][8], aa[2][8], kkn[2][8], km[2][8], cum[2][8];
                    {   SC_LANES;
                        float ssp = 0.f, bop = 0.f;
#pragma unroll
                        for (int o = 0; o < 2; ++o) {
                            float kr[8]; cvt8(r8[o], rr[o]); cvt8(k8[o], kr); cvt8(a8[o], aa[o]);
#pragma unroll
                            for (int q = 0; q < 8; ++q) { const int c = 16 * pw + 8 * o + q; const float kkp = prm[c], kap = prm[64 + c], rkp = prm[128 + c];
                                kkn[o][q] = kr[q] * kkp; ssp += kkn[o][q] * kkn[o][q]; km[o][q] = kr[q] * (1.0f + (aa[o][q] - 1.0f) * kap); bop += rr[o][q] * km[o][q] * rkp; cum[o][q] = (float)lw8[o][q]; }
                        }
                        part[pw * 64 + lane] = ssp; part[256 + pw * 64 + lane] = bop;
                        if (ch + 2 < T / 64) { pbase += (size_t)64 * D; sbase += 4096;
#pragma unroll
                            for (int o = 0; o < 2; ++o) { r8[o] = *(const u32x4*)(p.r + sbase + 512 * o); k8[o] = *(const u32x4*)(p.k + sbase + 512 * o);
                                a8[o] = *(const u32x4*)(p.a + sbase + 512 * o); lw8[o] = *(const h8*)(p.lw + sbase + 512 * o); } }
#define SC_DPP8(ctl) "v_add_f32_dpp %0, %0, %0 " ctl "\n\tv_add_f32_dpp %1, %1, %1 " ctl "\n\tv_add_f32_dpp %2, %2, %2 " ctl "\n\tv_add_f32_dpp %3, %3, %3 " ctl "\n\t" \
                     "v_add_f32_dpp %4, %4, %4 " ctl "\n\tv_add_f32_dpp %5, %5, %5 " ctl "\n\tv_add_f32_dpp %6, %6, %6 " ctl "\n\tv_add_f32_dpp %7, %7, %7 " ctl "\n\t"
#pragma unroll
                        for (int o = 0; o < 2; ++o)
                            asm volatile("s_nop 1\n\t"
                                         SC_DPP8("row_shr:1 row_mask:0xf bank_mask:0xf bound_ctrl:1") SC_DPP8("row_shr:2 row_mask:0xf bank_mask:0xf bound_ctrl:1")
                                         SC_DPP8("row_shr:4 row_mask:0xf bank_mask:0xf bound_ctrl:1") SC_DPP8("row_shr:8 row_mask:0xf bank_mask:0xf bound_ctrl:1")
                                         SC_DPP8("row_bcast:15 row_mask:0xa bank_mask:0xf") SC_DPP8("row_bcast:31 row_mask:0xc bank_mask:0xf")
                                         : "+v"(cum[o][0]), "+v"(cum[o][1]), "+v"(cum[o][2]), "+v"(cum[o][3]), "+v"(cum[o][4]), "+v"(cum[o][5]), "+v"(cum[o][6]), "+v"(cum[o][7]));
#undef SC_DPP8
                    }
                    { SC_LANES; grp_sync((LAS unsigned*)(lds + SYNCO), 4u * (3u * (unsigned)(ch + 1) + 1u), lane); }
                    {   SC_LANES;
                        float ss = 0.f, bo = 0.f;
#pragma unroll
                        for (int q = 0; q < 4; ++q) { ss += part[q * 64 + lane]; bo += part[256 + q * 64 + lane]; }
                        const float inv = fminf(__builtin_amdgcn_rsqf(ss), 1e12f);
                        bf16* bVT = img(lds, setb, O_VT); bf16* bKDT = img(lds, setb, O_KDT); bf16* bNBDT = img(lds, setb, O_NBDT);
                        float* gt = (float*)(lds + setb + O_GT); float* bon = (float*)(lds + setb + O_BON);
#pragma unroll
                        for (int o = 0; o < 2; ++o) {
                            const int cb = 16 * pw + 8 * o;
                            float o_kkd[8], o_rd[8], o_binv[8], o_kinv[8];
#pragma unroll
                            for (int q = 0; q < 8; ++q) {
                                const float kkv = kkn[o][q] * inv, bb = kkv * aa[o][q];
                                const float e_c = __builtin_amdgcn_exp2f(cum[o][q]), e_n = __builtin_amdgcn_exp2f(-cum[o][q]);
                                const float e_tot = __int_as_float(__builtin_amdgcn_readlane(__float_as_int(e_c), 63));
                                const float e_x = __int_as_float(__builtin_amdgcn_update_dpp(0x3f800000, __float_as_int(e_c), 0x138, 0xF, 0xF, false));
                                const float e_t = e_tot * e_n;
                                o_kkd[q] = kkv * e_x; o_rd[q] = rr[o][q] * e_c; o_binv[q] = bb * e_n; o_kinv[q] = km[o][q] * e_n;
                                bVT[swz(cb + q, lane)] = (bf16)((q & 1) ? (v8[o][q >> 1] >> 16) : (v8[o][q >> 1] & 0xffffu));
                                const unsigned kb2 = cvtpk(km[o][q] * e_t, -bb * e_t);
                                bKDT[swz(cb + q, lane)] = (bf16)(kb2 & 0xffffu);
                                bNBDT[swz(cb + q, lane)] = (bf16)(kb2 >> 16);
                                if (lane == 0) gt[cb + q] = e_tot;
                            }
                            *(u32x4*)&img(lds, setb, O_KKD)[swz(lane, cb)] = pack8(o_kkd); *(u32x4*)&img(lds, setb, O_RD)[swz(lane, cb)] = pack8(o_rd);
                            *(u32x4*)&img(lds, setb, O_N)[swz(lane, cb)] = pack8(o_binv); *(u32x4*)&img(lds, setb, O_P)[swz(lane, cb)] = pack8(o_kinv);
                        }
                        if (pw == 0) bon[lane] = bo;
                        if (ch + 2 < T / 64) { v8[0] = *(const u32x4*)(p.v + sbase); v8[1] = *(const u32x4*)(p.v + sbase + 512); }
                    }
                    { SC_LANES; grp_sync((LAS unsigned*)(lds + SYNCO), 4u * (3u * (unsigned)(ch + 1) + 2u), lane); }
                    f32x4 acc[10], cX, cXt;
                    {   SC_LANES;
                        const bf16* A = img(lds, setb, (pw & 1) ? O_P : O_N); const bf16* Bt = img(lds, setb, pw < 2 ? O_KKD : O_RD);
                        bf16x8 fa[4][2], fb[4][2], dB[2], dK[2];
#pragma unroll
                        for (int x = 0; x < 4; ++x) {
#pragma unroll
                            for (int kk = 0; kk < 2; ++kk) { fa[x][kk] = ld128(A, 16 * x + fr, 32 * kk + 8 * fq); fb[x][kk] = ld128(Bt, 16 * x + fr, 32 * kk + 8 * fq); } }
#pragma unroll
                        for (int kk = 0; kk < 2; ++kk) { dB[kk] = ld128(img(lds, setb, O_N), 16 * pw + fr, 32 * kk + 8 * fq); dK[kk] = ld128(img(lds, setb, O_KKD), 16 * pw + fr, 32 * kk + 8 * fq); }
                        int idx = 0;
#pragma unroll
                        for (int tt = 0; tt < 4; ++tt) {
#pragma unroll
                            for (int st = 0; st <= tt; ++st) { acc[idx] = mm32(fa[st][0], fb[tt][0], z4); acc[idx] = mm32(fa[st][1], fb[tt][1], acc[idx]); ++idx; } }
                        cXt = mm32(dB[0], dK[0], z4); cXt = mm32(dB[1], dK[1], cXt);
                        cX = mm32(dK[0], dB[0], z4); cX = mm32(dK[1], dB[1], cX);
                    }
                    { SC_LANES; grp_sync((LAS unsigned*)(lds + SYNCO), 4u * (3u * (unsigned)(ch + 1) + 3u), lane); }
                    {   SC_LANES;
                        f32x4 mk; const bool strict = pw < 2;
#pragma unroll
                        for (int i = 0; i < 4; ++i) { const int d = 4 * fq + i - fr; mk[i] = (strict ? (d < 0) : (d <= 0)) ? 1.f : 0.f; }
                        const unsigned sx = (pw == 0 || pw == 2) ? 0x80008000u : 0u;
                        if (pw == 0) {
#pragma unroll
                            for (int e = 0; e < 6; ++e) { const int ix = e == 0 ? 1 : (e == 1 ? 3 : (e == 2 ? 6 : (e == 3 ? 4 : (e == 4 ? 7 : 8))));
                                u32x2 o; o.x = cvtpk(acc[ix][0], acc[ix][1]) ^ sx; o.y = cvtpk(acc[ix][2], acc[ix][3]) ^ sx;
                                *(u32x2*)(lds + setb + O_MC + (e * 64 + lane) * 8) = o; }
                        } else {
                            bf16* dst = img(lds, setb, pw == 1 ? O_N : (pw == 2 ? O_NQ : O_P));
                            int idx = 0;
#pragma unroll
                            for (int tt = 0; tt < 4; ++tt) {
#pragma unroll
                                for (int st = 0; st < 4; ++st) {
                                    u32x2 o = (u32x2){0u, 0u};
                                    if (st <= tt) {
                                        f32x4 val = acc[idx]; ++idx;
                                        if (st == tt) val = val * mk;
                                        o.x = cvtpk(val[0], val[1]) ^ sx; o.y = cvtpk(val[2], val[3]) ^ sx;
                                    }
                                    *(u32x2*)&dst[swz(16 * tt + fr, 16 * st + 4 * fq)] = o;
                                } }
                        }
                        f32x4 cTt;
#pragma unroll
                        for (int i = 0; i < 4; ++i) { const int d = 4 * fq + i - fr; cXt[i] = d < 0 ? cXt[i] : 0.f; cX[i] = d > 0 ? cX[i] : 0.f; cTt[i] = (d == 0 ? 1.f : 0.f) - cXt[i]; }
                        s16x4 pA = pk4(cX), pAt = pk4(cXt);
#pragma unroll
                        for (int st = 0; st < 3; ++st) {
                            const f32x4 XA = mm16k(pAt, pA, z4);
                            f32x4 XB = z4; if (st < 2) XB = mm16k(pA, pAt, z4);
                            const s16x4 pT = pk4(cTt);
                            pA = pk4(XA);
                            cTt = mm16k(pA, pT, cTt);
                            if (st < 2) pAt = pk4(XB);
                        }
                        *(s16x4*)(lds + setb + O_TT + (pw * 64 + lane) * 8) = pk4(cTt);
                    }
                    __syncthreads();
                } else { __syncthreads(); }
            } else {
                if (ch >= 0) {
                    const int setb = (ch & 1) * SETB;
                    {   SC_LANES;
                        if (ch > 0) {
                            pc_out(p, Rf, prm, bo_out, vg, gg, yb, w, lane);
                            ob += (size_t)64 * D; yb += 4096;
                            grp_sync((LAS unsigned*)(lds + SYNCO) + 1, 4u * (unsigned)ch, lane);
                        }
                        vg[0] = *(const u32x4*)(p.v + vb); vg[1] = *(const u32x4*)(p.v + vb + 512); gg[0] = *(const u32x4*)(p.g + ob); gg[1] = *(const u32x4*)(p.g + ob + 8);
                        vb += 4096;
                        bo_out = ((const float*)(lds + setb + O_BON))[(w * 64 + lane) >> 2];
                    }
                    s16x4 pST[4]; bf16x8 bV[2];
                    {   SC_LANES;
#pragma unroll
                        for (int kb = 0; kb < 4; ++kb) pST[kb] = pk4(ST[kb]);
                        const bf16* iK = img(lds, setb, O_KKD); const bf16* iN = img(lds, setb, O_N);
                        bV[0] = ld128(img(lds, setb, O_VT), 16 * w + fr, 8 * fq); bV[1] = ld128(img(lds, setb, O_VT), 16 * w + fr, 32 + 8 * fq);
                        s16x4 aK[4][4]; bf16x8 aN[6]; s16x4 TT[4], nM[6];
#pragma unroll
                        for (int mt = 0; mt < 4; ++mt) {
#pragma unroll
                            for (int kb = 0; kb < 4; ++kb) aK[mt][kb] = ld64(iK, 16 * mt + fr, 16 * kb + 4 * fq); }
                        aN[0] = ld128(iN, fr, 8 * fq); aN[1] = ld128(iN, 16 + fr, 8 * fq); aN[2] = ld128(iN, 32 + fr, 8 * fq); aN[3] = ld128(iN, 32 + fr, 32 + 8 * fq); aN[4] = ld128(iN, 48 + fr, 8 * fq); aN[5] = ld128(iN, 48 + fr, 32 + 8 * fq);
#pragma unroll
                        for (int d = 0; d < 4; ++d) TT[d] = *(const s16x4*)(lds + setb + O_TT + (d * 64 + lane) * 8);
#pragma unroll
                        for (int e = 0; e < 6; ++e) nM[e] = *(const s16x4*)(lds + setb + O_MC + (e * 64 + lane) * 8);
                        f32x4 racc[4];
#pragma unroll
                        for (int mt = 0; mt < 4; ++mt) { racc[mt] = z4;
#pragma unroll
                            for (int kb = 0; kb < 4; ++kb) racc[mt] = mm16k(aK[mt][kb], pST[kb], racc[mt]); }
                        {
                            f32x4 r2[4];
                            r2[0] = mm32(aN[0], bV[0], z4); r2[1] = mm32(aN[1], bV[0], z4);
                            r2[2] = mm32(aN[2], bV[0], z4); r2[2] = mm32(aN[3], bV[1], r2[2]); r2[3] = mm32(aN[4], bV[0], z4); r2[3] = mm32(aN[5], bV[1], r2[3]);
#pragma unroll
                            for (int mt = 0; mt < 4; ++mt) racc[mt] = racc[mt] + r2[mt];
                        }
#pragma unroll
                        for (int blk = 0; blk < 4; ++blk) {
                            const f32x4 xx = mm16k(TT[blk], pk4(racc[blk]), z4);
                            pxx[blk] = pk4(xx);
#pragma unroll
                            for (int br = blk + 1; br < 4; ++br) { const int e = blk == 0 ? br - 1 : (blk == 1 ? br + 1 : 5); racc[br] = mm16k(nM[e], pxx[blk], racc[br]); }
                        }
                    }
                    {   SC_LANES;
                        const bf16* iR = img(lds, setb, O_RD); const bf16* iP = img(lds, setb, O_P); const bf16* iQ = img(lds, setb, O_NQ);
                        s16x4 aR[4][4], aQ[10]; bf16x8 aP[6];
#pragma unroll
                        for (int mt = 0; mt < 4; ++mt) {
#pragma unroll
                            for (int kb = 0; kb < 4; ++kb) aR[mt][kb] = ld64(iR, 16 * mt + fr, 16 * kb + 4 * fq); }
                        aP[0] = ld128(iP, fr, 8 * fq); aP[1] = ld128(iP, 16 + fr, 8 * fq); aP[2] = ld128(iP, 32 + fr, 8 * fq); aP[3] = ld128(iP, 32 + fr, 32 + 8 * fq); aP[4] = ld128(iP, 48 + fr, 8 * fq); aP[5] = ld128(iP, 48 + fr, 32 + 8 * fq);
                        { int ix = 0;
#pragma unroll
                          for (int mt = 0; mt < 4; ++mt) {
#pragma unroll
                              for (int blk = 0; blk <= mt; ++blk) { aQ[ix] = ld64(iQ, 16 * mt + fr, 16 * blk + 4 * fq); ++ix; } } }
                        f32x4 yacc[4];
#pragma unroll
                        for (int mt = 0; mt < 4; ++mt) { yacc[mt] = z4;
#pragma unroll
                            for (int kb = 0; kb < 4; ++kb) yacc[mt] = mm16k(aR[mt][kb], pST[kb], yacc[mt]); }
                        { int ix = 0;
#pragma unroll
                          for (int mt = 0; mt < 4; ++mt) {
#pragma unroll
                              for (int blk = 0; blk <= mt; ++blk) { yacc[mt] = mm16k(aQ[ix], pxx[blk], yacc[mt]); ++ix; } } }
                        {   f32x4 y2[4];
                            y2[0] = mm32(aP[0], bV[0], z4); y2[1] = mm32(aP[1], bV[0], z4);
                            y2[2] = mm32(aP[2], bV[0], z4); y2[2] = mm32(aP[3], bV[1], y2[2]); y2[3] = mm32(aP[4], bV[0], z4); y2[3] = mm32(aP[5], bV[1], y2[3]);
#pragma unroll
                            for (int mt = 0; mt < 4; ++mt) yacc[mt] = yacc[mt] + y2[mt];
                        }
#pragma unroll
                        for (int mt = 0; mt < 4; ++mt) {
#pragma unroll
                            for (int i = 0; i < 4; ++i) Rf[(16 * mt + 4 * fq + i) * RFP + 16 * w + fr] = yacc[mt][i]; }
                    }
                    {   SC_LANES;
                        const bf16* iKd = img(lds, setb, O_KDT); const bf16* iBd = img(lds, setb, O_NBDT); const float* gt = (const float*)(lds + setb + O_GT);
                        bf16x8 aKd[4][2]; s16x4 aB[4][4]; f32x4 g4[4];
#pragma unroll
                        for (int kb = 0; kb < 4; ++kb) { aKd[kb][0] = ld128(iKd, 16 * kb + fr, 8 * fq); aKd[kb][1] = ld128(iKd, 16 * kb + fr, 32 + 8 * fq); g4[kb] = *(const f32x4*)&gt[16 * kb + 4 * fq];
#pragma unroll
                            for (int blk = 0; blk < 4; ++blk) aB[kb][blk] = ld64(iBd, 16 * kb + fr, 16 * blk + 4 * fq); }
#pragma unroll
                        for (int kb = 0; kb < 4; ++kb) {
                            f32x4 s2 = mm32(aKd[kb][0], bV[0], z4); s2 = mm32(aKd[kb][1], bV[1], s2);
                            f32x4 s = z4;
#pragma unroll
                            for (int blk = 0; blk < 4; ++blk) s = mm16k(aB[kb][blk], pxx[blk], s);
                            ST[kb] = ST[kb] * g4[kb] + s2 + s; }
                    }
                    __syncthreads();
                } else { __syncthreads(); }
            }
        }
        if (w < 4) {
            SC_LANES;
            pc_out(p, Rf, prm, bo_out, vg, gg, yb, w, lane);
        }
    }
#undef SC_LANES
}
__device__ __forceinline__ void ph_cumsum(const float* logf, float* cum, const int wv_s) {
    const int tid_ = opaque_tid(wv_s); const int lane = tid_ & 63, wv = tid_ >> 6;
    for (int seq = blockIdx.x * 8 + wv; seq < NB * H; seq += gridDim.x * 8) {
        const int b = seq / H, h = seq % H;
        float loc[32]; float run = 0.f;
#pragma unroll
        for (int q = 0; q < 32; ++q) { run += logf[(size_t)(b * T + lane * 32 + q) * 16 + h]; loc[q] = run; }
        float incl = run;
#pragma unroll
        for (int o = 1; o < 64; o <<= 1) { const float t = __int_as_float(__builtin_amdgcn_ds_bpermute((lane >= o ? lane - o : lane) << 2, __float_as_int(incl))); if (lane >= o) incl += t; }
        const float excl = incl - run;
#pragma unroll
        for (int q = 0; q < 32; ++q) cum[(size_t)seq * T + lane * 32 + q] = -(excl + loc[q]) * LOG2E;
    }
}
#include <hip/hip_bf16.h>
#include <cmath>
namespace attn_body {
using bf16=__hip_bfloat16;
using bf16x8=__attribute__((ext_vector_type(8)))short;
using s16x4=__attribute__((ext_vector_type(4)))short;
using f32x16=__attribute__((ext_vector_type(16)))float;
using u32x4=__attribute__((ext_vector_type(4)))unsigned;
constexpr int BATCH=8,NHEAD=16,SEQ=2048,D=64,DM=NHEAD*D;
constexpr int NW=8,QBLK=32,QB=QBLK*NW,KVBLK=64,NQB=SEQ/QB;
constexpr int ATTN_PITCH=DM, ATTN_UNIT_ROWS=QB;
__device__ __forceinline__ int crow(int r,int hi){return (r&3)+8*(r>>2)+4*hi;}
#define SBAR() __builtin_amdgcn_sched_barrier(0)
__device__ __forceinline__ void cmask(f32x16&p0,f32x16&p1,int jb,int qrel,int hi){
  const float NEG=-INFINITY; int kb=64*jb+4*hi;
  #pragma unroll
  for(int r=0;r<16;++r){int kv=kb+(r&3)+8*(r>>2); if(kv>qrel)p0[r]=NEG; if(kv+32>qrel)p1[r]=NEG;}
}

constexpr int NSLOT=3, SLOTB=8192;
constexpr int LDS_K=0, LDS_V=NSLOT*SLOTB, LDS_WS=2*NSLOT*SLOTB, LDS_OST=LDS_WS+NW*64*4, LDS_BYTES=LDS_OST+NW*4096;
constexpr float C2=0.125f*1.4426950408889634f;
__device__ __forceinline__ void glds16(const void*gsrc,unsigned lds_dst){unsigned keep;
  asm volatile("s_mov_b32 %0, m0\n\ts_mov_b32 m0, %2\n\ts_nop 0\n\tglobal_load_lds_dwordx4 %1, off\n\ts_mov_b32 m0, %0":"=&s"(keep):"v"(gsrc),"s"(lds_dst):"memory");}
__device__ __forceinline__ float max3f(float a,float b,float c){float r;asm("v_max3_f32 %0, %1, %2, %3":"=v"(r):"v"(a),"v"(b),"v"(c));return r;}
__device__ __forceinline__ float max2f(float a,float b){float r;asm("v_max_f32_e32 %0, %1, %2":"=v"(r):"v"(a),"v"(b));return r;}
__device__ __forceinline__ float fadd_s(float a,float b){float r;asm("v_add_f32_e32 %0, %1, %2":"=v"(r):"v"(a),"v"(b));return r;}
__device__ __forceinline__ float fsub_s(float a,float b){float r;asm("v_sub_f32_e32 %0, %1, %2":"=v"(r):"v"(a),"v"(b));return r;}
typedef float f32x2_t __attribute__((ext_vector_type(2))); typedef __bf16 bf16x2_t __attribute__((ext_vector_type(2)));
__device__ __forceinline__ unsigned cvtpk_s(float lo,float hi){f32x2_t v={lo,hi};bf16x2_t b=__builtin_convertvector(v,bf16x2_t);return __builtin_bit_cast(unsigned,b);}
#define WAIT_BAR(N) asm volatile("s_waitcnt vmcnt(" #N ") lgkmcnt(0)\n\ts_barrier":::"memory")

__device__ __forceinline__ void qkt(f32x16&p0,f32x16&p1,const char*Kslot,const bf16x8*qr,const f32x16&negm,int r32,int hi){
  const char*kb=Kslot+hi*1024+r32*16;
  #pragma unroll
  for(int d0=0;d0<4;++d0){
    const bf16x8 b0=*reinterpret_cast<const bf16x8*>(kb+d0*2048);
    const bf16x8 b1=*reinterpret_cast<const bf16x8*>(kb+d0*2048+512);
    if(d0==0){p0=__builtin_amdgcn_mfma_f32_32x32x16_bf16(b0,qr[0],negm,0,0,0);p1=__builtin_amdgcn_mfma_f32_32x32x16_bf16(b1,qr[0],negm,0,0,0);}
    else{p0=__builtin_amdgcn_mfma_f32_32x32x16_bf16(b0,qr[d0],p0,0,0,0);p1=__builtin_amdgcn_mfma_f32_32x32x16_bf16(b1,qr[d0],p1,0,0,0);}}
}
typedef __attribute__((address_space(3))) const char* lds_cptr;
typedef short v4i16_t __attribute__((ext_vector_type(4)));
__device__ __forceinline__ void kload8(bf16x8*kf,lds_cptr kp){
  kf[0]=*(const __attribute__((address_space(3))) bf16x8*)(kp);      kf[1]=*(const __attribute__((address_space(3))) bf16x8*)(kp+512);
  kf[2]=*(const __attribute__((address_space(3))) bf16x8*)(kp+2048); kf[3]=*(const __attribute__((address_space(3))) bf16x8*)(kp+2560);
  kf[4]=*(const __attribute__((address_space(3))) bf16x8*)(kp+4096); kf[5]=*(const __attribute__((address_space(3))) bf16x8*)(kp+4608);
  kf[6]=*(const __attribute__((address_space(3))) bf16x8*)(kp+6144); kf[7]=*(const __attribute__((address_space(3))) bf16x8*)(kp+6656);
}
__device__ __forceinline__ void kload2(bf16x8*kf,lds_cptr kp,int j){ kf[2*j]=*(const __attribute__((address_space(3))) bf16x8*)(kp+j*2048); kf[2*j+1]=*(const __attribute__((address_space(3))) bf16x8*)(kp+j*2048+512); }
__device__ __forceinline__ s16x4 vtr(lds_cptr p){ return __builtin_bit_cast(s16x4,__builtin_amdgcn_ds_read_tr16_b64_v4i16((__attribute__((address_space(3))) v4i16_t*)p)); }
__device__ __forceinline__ float rowmax(const f32x16&p0,const f32x16&p1){
  float a=max3f(p0[0],p0[1],p1[0]),b=max3f(p0[2],p0[3],p1[1]);a=max3f(a,p1[2],p1[3]);
  #pragma unroll
  for(int r=4;r<16;r+=4){a=max3f(a,p0[r],p0[r+1]);b=max3f(b,p0[r+2],p0[r+3]);a=max3f(a,p1[r],p1[r+1]);b=max3f(b,p1[r+2],p1[r+3]);}
  const float m=max2f(a,b);
  auto rr=__builtin_amdgcn_permlane32_swap(__float_as_uint(m),__float_as_uint(m),false,false);
  return max2f(__uint_as_float(rr[0]),__uint_as_float(rr[1]));
}
__device__ __forceinline__ void pv(f32x16*o,int vb,bf16x8 pa0,bf16x8 pa1,bf16x8 pa2,bf16x8 pa3){
  #pragma unroll
  for(int d0=0;d0<2;++d0){s16x4 lo[4],hi[4];
    #pragma unroll
    for(int ks=0;ks<4;++ks){
      asm volatile("ds_read_b64_tr_b16 %0,%1 offset:%c2":"=&v"(lo[ks]):"v"(vb),"i"(d0*4096+ks*1024):"memory");
      asm volatile("ds_read_b64_tr_b16 %0,%1 offset:%c2":"=&v"(hi[ks]):"v"(vb),"i"(d0*4096+ks*1024+512):"memory");}
    asm volatile("s_waitcnt lgkmcnt(0)":::"memory");SBAR();
    #define PK(k) (bf16x8){lo[k][0],lo[k][1],lo[k][2],lo[k][3],hi[k][0],hi[k][1],hi[k][2],hi[k][3]}
    o[d0]=__builtin_amdgcn_mfma_f32_32x32x16_bf16(pa0,PK(0),o[d0],0,0,0);
    o[d0]=__builtin_amdgcn_mfma_f32_32x32x16_bf16(pa1,PK(1),o[d0],0,0,0);
    o[d0]=__builtin_amdgcn_mfma_f32_32x32x16_bf16(pa2,PK(2),o[d0],0,0,0);
    o[d0]=__builtin_amdgcn_mfma_f32_32x32x16_bf16(pa3,PK(3),o[d0],0,0,0);
    #undef PK
  }
}

#ifndef ATTN_STORE16
#define ATTN_STORE16(p,v) (*(u32x4*)(p)=(v))
#endif
typedef __attribute__((address_space(3))) const float* lds_cfptr;
typedef float f32x4b __attribute__((ext_vector_type(4)));
#define BIAS(C0,C1,t) do{ const lds_cfptr nb_=nbt+(t)*64+4*hi; \
    _Pragma("unroll") for(int g_=0;g_<4;++g_){ const f32x4b b0_=*(const __attribute__((address_space(3))) f32x4b*)(nb_+8*g_); const f32x4b b1_=*(const __attribute__((address_space(3))) f32x4b*)(nb_+32+8*g_); \
      C0[4*g_]+=b0_.x; C0[4*g_+1]+=b0_.y; C0[4*g_+2]+=b0_.z; C0[4*g_+3]+=b0_.w; C1[4*g_]+=b1_.x; C1[4*g_+1]+=b1_.y; C1[4*g_+2]+=b1_.z; C1[4*g_+3]+=b1_.w; } }while(0)
template<int THRL> __device__ __forceinline__ void attn_unit(int b,int h,int qb,const bf16*Q,const bf16*__restrict__ K,const bf16*__restrict__ V,bf16*O,char*shm,lds_cfptr nbt,const int wv_s){
  const int tid=::opaque_tid(wv_s),lane=tid&63,r32=lane&31,hi=lane>>5; const int wid=wv_s;
  const long rowbase=(long)b*SEQ; const int q0=qb*QB;
  const bf16*Qw=Q+(rowbase+q0+wid*QBLK)*DM+h*D;
  const bf16*Kh=K+rowbase*DM+h*D,*Vh=V+rowbase*DM+h*D;
  const unsigned lds0=(unsigned)(uintptr_t)shm;
  float*wsf=(float*)(shm+LDS_WS)+wid*64;
  const bf16*ksrc=Kh+(long)lane*DM+wid*8;
  const bf16*vsrc=Vh+(long)(16*(wid&3)+(lane>>2))*DM+(wid>>2)*32+(lane&3)*8;
  const unsigned kdst=lds0+LDS_K+wid*1024, vdst=lds0+LDS_V+wid*1024;
  #define DMA_K(t,slot) glds16(ksrc+(long)(t)*KVBLK*DM,(unsigned)__builtin_amdgcn_readfirstlane(kdst+(slot)))
  #define DMA_V(t,slot) glds16(vsrc+(long)(t)*KVBLK*DM,(unsigned)__builtin_amdgcn_readfirstlane(vdst+(slot)))
  const int vb0=(int)(lds0+LDS_V)+((lane>>4)&1)*32+(lane&3)*8+(4*hi+((lane&15)>>2))*64;
  const char*Kbase=shm+LDS_K; bf16x8 kf[8];
  const lds_cptr shm3=(lds_cptr)shm; const lds_cptr kp0=shm3+LDS_K+hi*1024+r32*16; const lds_cptr vp0=shm3+LDS_V+((lane>>4)&1)*32+(lane&3)*8+(4*hi+((lane&15)>>2))*64;
  const int NT=(q0+QB)/KVBLK;
  DMA_K(0,0);DMA_V(0,0);DMA_K(1,SLOTB);
  bf16x8 qr[4];
  #pragma unroll
  for(int d0=0;d0<4;++d0)qr[d0]=*reinterpret_cast<const bf16x8*>(&Qw[(long)r32*DM+d0*16+hi*8]);
  float mhat=0.f,l_reg=0.f;f32x16 o[2];o[0]=f32x16{};o[1]=f32x16{};f32x16 negm=f32x16{};asm volatile("":"+v"(negm));
  const int qrel=wid*QBLK+r32;
  #define CMASK(P0,P1,t) do{int jb_=(t)-(NT-4); if(jb_>=0)cmask(P0,P1,jb_,qrel,hi);}while(0)
  bool resc=false;
  #define START(P0,P1) do{ const float rm=rowmax(P0,P1); resc=false; \
    { const float dl=rm; mhat=fadd_s(mhat,dl); \
      _Pragma("unroll") for(int r=0;r<16;++r){P0[r]=fsub_s(P0[r],dl);P1[r]=fsub_s(P1[r],dl);} \
      _Pragma("unroll") for(int r=0;r<16;++r)negm[r]=-mhat; asm volatile("":"+v"(negm)); } \
    _Pragma("unroll") for(int r=0;r<16;++r)P0[r]=__builtin_amdgcn_exp2f(P0[r]); }while(0)
  #define RESC() do{ if(resc){ asm volatile("s_waitcnt lgkmcnt(0)":::"memory"); \
      _Pragma("unroll") for(int d_=0;d_<2;++d_) _Pragma("unroll") for(int r=0;r<16;++r)o[d_][r]*=wsf[crow(r,hi)]; } }while(0)
  f32x16 pA0,pA1,pB0,pB1;
  int sl_prev=0,sl_cur=0,sl_next=SLOTB;
  #define ROT() do{sl_prev=sl_cur;sl_cur=sl_next;sl_next=(sl_next==(NSLOT-1)*SLOTB)?0:sl_next+SLOTB;}while(0)
  DMA_K(2,2*SLOTB);
  WAIT_BAR(3);
  qkt(pA0,pA1,Kbase,qr,negm,r32,hi);asm volatile("s_nop 15\n\ts_nop 7":"+v"(pA0),"+v"(pA1));BIAS(pA0,pA1,0);CMASK(pA0,pA1,0);
  START(pA0,pA1);
  _Pragma("unroll") for(int r=0;r<16;++r)pA1[r]=__builtin_amdgcn_exp2f(pA1[r]);
  WAIT_BAR(0);
  DMA_K(3,0);DMA_V(1,SLOTB);
  ROT();
  kload8(kf,kp0+sl_cur);
  WAIT_BAR(2);
  s16x4 vlo[8],vhi[8]; u32x4 pw0,pw1,pw2,pw3;
  #define PKW(P,B) cvtpk_s(P[B],P[B+1])
  #define PAF(k) __builtin_bit_cast(bf16x8,pw##k)
  #define VFR(i) (bf16x8){vlo[i][0],vlo[i][1],vlo[i][2],vlo[i][3],vhi[i][0],vhi[i][1],vhi[i][2],vhi[i][3]}
  #define PIN(x) asm volatile("":"+v"(x))
  #define MX3(a,b,c) __builtin_fmaxf(__builtin_fmaxf((a),(b)),(c))
  #define GAPA(MF,A0,A1,A2,A3,W0,W1,PW) do{ MF; sacc+=A0; sacc+=A1; sacc+=A2; sacc+=A3; PIN(sacc); W0; W1; PIN(PW); SBAR(); }while(0)
  #define EX(v) __builtin_amdgcn_exp2f(v)
  #define GAPB(MF,X,B) do{ MF; X[B]=EX(X[B]); X[B+1]=EX(X[B+1]); X[B+2]=EX(X[B+2]); X[B+3]=EX(X[B+3]); PIN(X); SBAR(); }while(0)
  #define VRD(i) do{ vlo[i]=vtr(vp_+(((i)>>2)*4096+((i)&3)*1024)); vhi[i]=vtr(vp_+(((i)>>2)*4096+((i)&3)*1024+512)); }while(0)
  #define KRD(G,j) do{ if(G){ kload2(kf,kp0+sl_next,j); SBAR(); } }while(0)
  #define STEP(C0,C1,P0,P1,t,GK,GV,GL) do{ SBAR(); \
    const lds_cptr vp_=vp0+sl_prev; \
    VRD(0); SBAR(); float sacc=(P0[0]+P0[1]); \
    GAPA(C0=__builtin_amdgcn_mfma_f32_32x32x16_bf16(kf[0],qr[0],negm,0,0,0), P0[2],P0[3],P0[4],P0[5],     pw0[0]=PKW(P0,0), pw0[1]=PKW(P0,2), pw0); \
    VRD(4); SBAR(); GAPA(C1=__builtin_amdgcn_mfma_f32_32x32x16_bf16(kf[1],qr[0],negm,0,0,0), P0[6],P0[7],P0[8],P0[9],     pw0[2]=PKW(P0,4), pw0[3]=PKW(P0,6), pw0); \
    VRD(1); SBAR(); GAPA(C0=__builtin_amdgcn_mfma_f32_32x32x16_bf16(kf[2],qr[1],C0,0,0,0),   P0[10],P0[11],P0[12],P0[13], pw1[0]=PKW(P0,8), pw1[1]=PKW(P0,10), pw1); \
    VRD(5); SBAR(); GAPA(C1=__builtin_amdgcn_mfma_f32_32x32x16_bf16(kf[3],qr[1],C1,0,0,0),   P0[14],P0[15],P1[0],P1[1],   pw1[2]=PKW(P0,12),pw1[3]=PKW(P0,14), pw1); \
    VRD(2); SBAR(); GAPA(C0=__builtin_amdgcn_mfma_f32_32x32x16_bf16(kf[4],qr[2],C0,0,0,0),   P1[2],P1[3],P1[4],P1[5],     pw2[0]=PKW(P1,0), pw2[1]=PKW(P1,2), pw2); \
    VRD(6); SBAR(); GAPA(C1=__builtin_amdgcn_mfma_f32_32x32x16_bf16(kf[5],qr[2],C1,0,0,0),   P1[6],P1[7],P1[8],P1[9],     pw2[2]=PKW(P1,4), pw2[3]=PKW(P1,6), pw2); \
    VRD(3); SBAR(); GAPA(C0=__builtin_amdgcn_mfma_f32_32x32x16_bf16(kf[6],qr[3],C0,0,0,0),   P1[10],P1[11],P1[12],P1[13], pw3[0]=PKW(P1,8), pw3[1]=PKW(P1,10), pw3); \
    VRD(7); SBAR(); GAPA(C1=__builtin_amdgcn_mfma_f32_32x32x16_bf16(kf[7],qr[3],C1,0,0,0),   P1[14],P1[15],0.f,0.f,       pw3[2]=PKW(P1,12),pw3[3]=PKW(P1,14), pw3); \
    l_reg+=sacc; \
    if(GK){DMA_K((t)+3,sl_cur);} if(GV){DMA_V((t)+1,sl_next);} \
    BIAS(C0,C1,t); CMASK(C0,C1,t); \
    { float a=MX3(C0[0],C0[1],C1[0]),b=MX3(C0[2],C0[3],C1[1]); a=MX3(a,C1[2],C1[3]); \
      _Pragma("unroll") for(int r=4;r<16;r+=4){a=MX3(a,C0[r],C0[r+1]);b=MX3(b,C0[r+2],C0[r+3]);a=MX3(a,C1[r],C1[r+1]);b=MX3(b,C1[r+2],C1[r+3]);} \
      float rm=__builtin_fmaxf(a,b); { auto rr=__builtin_amdgcn_permlane32_swap(__float_as_uint(rm),__float_as_uint(rm),false,false); rm=__builtin_fmaxf(__uint_as_float(rr[0]),__uint_as_float(rr[1])); } \
      resc=false; \
      if(__builtin_expect(__any(rm>(float)THRL),0)){ const float dl=__builtin_fmaxf(rm,0.f); mhat+=dl; \
        _Pragma("unroll") for(int r=0;r<16;++r){C0[r]-=dl;C1[r]-=dl;} \
        _Pragma("unroll") for(int r=0;r<16;++r)negm[r]=-mhat; asm volatile("":"+v"(negm)); \
        const float f=__builtin_amdgcn_exp2f(-dl); l_reg*=f; if(hi==0)wsf[r32]=f; resc=true; } } \
    SBAR(); \
    GAPB(o[0]=__builtin_amdgcn_mfma_f32_32x32x16_bf16(PAF(0),VFR(0),o[0],0,0,0), C0,0); \
    GAPB(o[1]=__builtin_amdgcn_mfma_f32_32x32x16_bf16(PAF(0),VFR(4),o[1],0,0,0), C0,4); \
    KRD(GL,0); GAPB(o[0]=__builtin_amdgcn_mfma_f32_32x32x16_bf16(PAF(1),VFR(1),o[0],0,0,0), C0,8); \
    KRD(GL,1); GAPB(o[1]=__builtin_amdgcn_mfma_f32_32x32x16_bf16(PAF(1),VFR(5),o[1],0,0,0), C0,12); \
    KRD(GL,2); GAPB(o[0]=__builtin_amdgcn_mfma_f32_32x32x16_bf16(PAF(2),VFR(2),o[0],0,0,0), C1,0); \
    KRD(GL,3); GAPB(o[1]=__builtin_amdgcn_mfma_f32_32x32x16_bf16(PAF(2),VFR(6),o[1],0,0,0), C1,4); \
    GAPB(o[0]=__builtin_amdgcn_mfma_f32_32x32x16_bf16(PAF(3),VFR(3),o[0],0,0,0), C1,8); \
    GAPB(o[1]=__builtin_amdgcn_mfma_f32_32x32x16_bf16(PAF(3),VFR(7),o[1],0,0,0), C1,12); \
    }while(0)
  int t=1;
  #undef CMASK
  #define CMASK(P0,P1,t) do{}while(0)
  for(;t+5<NT;t+=2){
    STEP(pB0,pB1,pA0,pA1,t,true,true,true);     WAIT_BAR(2); RESC(); ROT();
    STEP(pA0,pA1,pB0,pB1,t+1,true,true,true);   WAIT_BAR(2); RESC(); ROT();
  }
  #undef CMASK
  #define CMASK(P0,P1,t) do{int jb_=(t)-(NT-4); if(jb_>=0)cmask(P0,P1,jb_,qrel,hi);}while(0)
  #define ENDW(tt) do{ if((tt)+3<NT){WAIT_BAR(2);} else if((tt)+2<NT){WAIT_BAR(1);} else {WAIT_BAR(0);} }while(0)
  for(;t+1<NT;t+=2){
    STEP(pB0,pB1,pA0,pA1,t,(t+3<NT),(t+1<NT),(t+1<NT));       ENDW(t);   RESC(); ROT();
    STEP(pA0,pA1,pB0,pB1,t+1,(t+4<NT),(t+2<NT),(t+2<NT));     ENDW(t+1); RESC(); ROT();
  }
  STEP(pB0,pB1,pA0,pA1,NT-1,false,false,false); RESC();
  { float sacc=pB0[0]+pB0[1]; _Pragma("unroll") for(int r=2;r<16;++r)sacc+=pB0[r]; _Pragma("unroll") for(int r=0;r<16;++r)sacc+=pB1[r]; l_reg+=sacc;
    pw0=(u32x4){PKW(pB0,0),PKW(pB0,2),PKW(pB0,4),PKW(pB0,6)};pw1=(u32x4){PKW(pB0,8),PKW(pB0,10),PKW(pB0,12),PKW(pB0,14)};pw2=(u32x4){PKW(pB1,0),PKW(pB1,2),PKW(pB1,4),PKW(pB1,6)};pw3=(u32x4){PKW(pB1,8),PKW(pB1,10),PKW(pB1,12),PKW(pB1,14)};
    SBAR(); pv(o,vb0+sl_cur,PAF(0),PAF(1),PAF(2),PAF(3)); }
  #undef PKW
  #undef PAF
  #undef VFR
  #undef PIN
  #undef MX3
  #undef GAPA
  #undef GAPB
  #undef EX
  #undef VRD
  #undef KRD
  #undef STEP
  #undef ENDW
  {auto rr=__builtin_amdgcn_permlane32_swap(__float_as_uint(l_reg),__float_as_uint(l_reg),false,false);l_reg=__uint_as_float(rr[0])+__uint_as_float(rr[1]);}
  if(hi==0)wsf[32+r32]=l_reg;asm volatile("s_waitcnt lgkmcnt(0)":::"memory");
  float rli[16];
  #pragma unroll
  for(int r=0;r<16;++r)rli[r]=__builtin_amdgcn_rcpf(wsf[32+crow(r,hi)]);
  bf16*Ow=O+(rowbase+q0+wid*QBLK)*DM+h*D;
  { bf16*stg=(bf16*)(shm+LDS_OST)+wid*2048;
    #pragma unroll
    for(int r=0;r<16;++r){const int orow=crow(r,hi);
      #pragma unroll
      for(int d0=0;d0<2;++d0)stg[orow*64+d0*32+r32]=__float2bfloat16(o[d0][r]*rli[r]);}
    asm volatile("s_waitcnt lgkmcnt(0)":::"memory");
    #pragma unroll
    for(int i=0;i<4;++i){const int row=i*8+(lane>>3),ch=lane&7; const u32x4 v=*(const u32x4*)(stg+row*64+ch*8); ATTN_STORE16(Ow+(long)row*DM+ch*8,v);} }
  asm volatile("s_waitcnt lgkmcnt(0)\n\ts_barrier":::"memory");
  #undef DMA_K
  #undef DMA_V
  #undef CMASK
  #undef START
  #undef RESC
  #undef ROT
}
constexpr int ATTN_LDS_BYTES=LDS_BYTES;
struct AttnTensors { const bf16* Q; const bf16* K; const bf16* V; bf16* O; };
struct AttnUnit { int bh; int qb; };
struct StaticOrder {
  int vcu, G;
  __device__ __forceinline__ explicit StaticOrder(int grid,int block):vcu((grid%8==0)?(block%8)*(grid/8)+block/8:block),G(grid){}
  __device__ __forceinline__ bool next(int i,AttnUnit&u)const{ if(G!=256||i>=4)return false; const int s=vcu&1; u.bh=vcu>>1; u.qb=(i==0)?s:(i==1)?7-s:(i==2)?3-s:4+s; return true; }
  __device__ __forceinline__ void a_ready(const AttnUnit&)const{}
  __device__ __forceinline__ void done(const AttnUnit&)const{}
};
template<class Sched,int THRL=8> __device__ __forceinline__ void attn_phase(char*lds,const AttnTensors&T,const float*nbias,const Sched&S,const int wv_s){
  AttnUnit u;
  if(!S.next(0,u))return;
  { float*tab=(float*)(lds+LDS_BYTES); const float*src=nbias+(long)u.bh*SEQ;
    for(int k=::opaque_tid(wv_s);k<SEQ;k+=NW*64)tab[k]=src[k];
    asm volatile("s_waitcnt vmcnt(0) lgkmcnt(0)\n\ts_barrier":::"memory"); }
  const lds_cfptr nbt=(lds_cfptr)(lds+LDS_BYTES);
  for(int i=0;S.next(i,u);++i){ S.a_ready(u); attn_unit<THRL>(u.bh/NHEAD,u.bh%NHEAD,u.qb,T.Q,T.K,T.V,T.O,lds,nbt,wv_s); S.done(u); }
}
#undef BIAS
#undef SBAR
#undef WAIT_BAR
}
#define XB_TMO      128
#define XB_XCNT(j)  (256  + 64 * (j))
#define XB_XSUB(j)  (1280 + 64 * (j))
#define XB_XGEN(j)  (2304 + 64 * (j))
#define XB_TOP      3328
#define XB_TOPGEN   3392
#define XCD_BAR_WORDS 3456
#define XB_SPIN_CAP (1u << 18)


__device__ __forceinline__ unsigned xb_ld(unsigned* p)              { return __hip_atomic_load(p, __ATOMIC_RELAXED, __HIP_MEMORY_SCOPE_AGENT); }
__device__ __forceinline__ unsigned xb_add(unsigned* p, unsigned v) { return __hip_atomic_fetch_add(p, v, __ATOMIC_RELAXED, __HIP_MEMORY_SCOPE_AGENT); }
__device__ __forceinline__ unsigned xb_xcc_id() { return (unsigned)__builtin_amdgcn_s_getreg((3 << 11) | 20) & 0xFu; }
#define XB_SPIN(cond, bar) do { unsigned _sp = 0; while (cond) { __builtin_amdgcn_s_sleep(1); \
    if ((++_sp & 255u) == 0u) { if (xb_ld(&(bar)[XB_TMO])) break; if (_sp > XB_SPIN_CAP) { atomicAdd(&(bar)[XB_TMO], 1u); break; } } } } while (0)

struct XcdBarrier { unsigned* bar; unsigned x; volatile LAS unsigned* st; };

__device__ __forceinline__ XcdBarrier xcd_barrier_post(unsigned* bar, volatile LAS unsigned* st) {
    XcdBarrier b; b.bar = bar; b.x = xb_xcc_id(); b.st = st;
    if (threadIdx.x == 0) (void)xb_add(&bar[XB_XCNT(b.x)], 1u);
    return b;
}
__device__ __forceinline__ void xcd_barrier_complete(unsigned* bar, unsigned x, unsigned& nloc, unsigned& nx) {
    const unsigned G = gridDim.x * gridDim.y * gridDim.z;
    unsigned sum, cnt, mine, sp = 0u;
    for (;;) {
        sum = 0u; cnt = 0u; mine = 0u;
#pragma unroll
        for (unsigned j = 0; j < 16; ++j) { const unsigned c = xb_ld(&bar[XB_XCNT(j)]); sum += c; cnt += (c > 0u) ? 1u : 0u; mine = (j == x) ? c : mine; }
        if (sum == G) break;
        __builtin_amdgcn_s_sleep(1);
        if ((++sp & 255u) == 0u) { if (xb_ld(&bar[XB_TMO])) break; if (sp > XB_SPIN_CAP) { atomicAdd(&bar[XB_TMO], 1u); break; } }
    }
    nloc = mine > 0u ? mine : 1u; nx = cnt > 0u ? cnt : 1u;
}
__device__ __forceinline__ void xcd_barrier(const XcdBarrier& b) {
    asm volatile("s_waitcnt vmcnt(0)" ::: "memory");
    __syncthreads();
    if (threadIdx.x == 0) {
        unsigned* bar = b.bar; unsigned bx = b.x; asm volatile("" : "+s"(bx));
        __builtin_amdgcn_s_waitcnt(0);
        unsigned nloc = b.st[0], nx = b.st[1];
        if (nloc == 0u) { xcd_barrier_complete(bar, bx, nloc, nx); b.st[0] = nloc; b.st[1] = nx; }
        const unsigned old = xb_add(&bar[XB_XSUB(bx)], 1u);
        const unsigned gen = old / nloc;
        if (old + 1u == (gen + 1u) * nloc) {
            __builtin_amdgcn_fence(__ATOMIC_RELEASE, "agent");
            asm volatile("s_waitcnt vmcnt(0)" ::: "memory");
            const unsigned og = xb_add(&bar[XB_TOP], 1u);
            const unsigned tg = og / nx;
            if (og + 1u == (tg + 1u) * nx) xb_add(&bar[XB_TOPGEN], 1u);
            else XB_SPIN(xb_ld(&bar[XB_TOPGEN]) == tg, bar);
            __builtin_amdgcn_fence(__ATOMIC_ACQUIRE, "agent");
            xb_add(&bar[XB_XGEN(bx)], 1u);
            asm volatile("s_waitcnt vmcnt(0)" ::: "memory");
        } else {
            XB_SPIN(xb_ld(&bar[XB_XGEN(bx)]) == gen, bar);
            __builtin_amdgcn_fence(__ATOMIC_ACQUIRE, "agent");
            asm volatile("s_waitcnt vmcnt(0)" ::: "memory");
        }
    }
    __syncthreads();
}

enum { I_X = 0, I_MIX, I_WR, I_WK, I_WV, I_WO, I_W0, I_W1, I_W2, I_A0, I_A1, I_A2, I_G1, I_G2, I_KK, I_KA, I_RK, I_GNG, I_GNB,
       I_FWIN, I_FBF, I_FWO, I_RW, I_RB, I_MG, I_MU, I_MD, I_LNG, I_LNB, N_IN };
constexpr int LDS_BYTES = 163840;
constexpr int LDS_MISC = LDS_BYTES - 64;
static_assert(CTL_BAR_OFF + XCD_BAR_WORDS * 4 <= CTL_BYTES, "ctl block");

struct Params { const float* in[N_IN]; float* out; unsigned char* ws; };

__device__ __forceinline__ void ph_xmix(const float* x, const float* mix, bf16* xcat, bf16* xr3, int gw, int NGW, int lane) {
    f32x4 mr[4], mk[4], mv[4];
#pragma unroll
    for (int j = 0; j < 4; ++j) { mr[j] = *(const f32x4*)(mix + 0 * D + 4 * lane + 256 * j); mk[j] = *(const f32x4*)(mix + 2 * D + 4 * lane + 256 * j); mv[j] = *(const f32x4*)(mix + 3 * D + 4 * lane + 256 * j); }
    for (int row = gw; row < M; row += NGW) {
        const bool hp = (row & (T - 1)) != 0;
#pragma unroll
        for (int j = 0; j < 4; ++j) {
            const int col = 4 * lane + 256 * j;
            const f32x4 c4 = *(const f32x4*)(x + (size_t)row * D + col);
            f32x4 p4 = (f32x4){0.f, 0.f, 0.f, 0.f};
            if (hp) p4 = *(const f32x4*)(x + (size_t)(row - 1) * D + col);
            const f32x4 xx = p4 - c4;
            u32x2 o;
            o.x = pk2(c4.x, c4.y); o.y = pk2(c4.z, c4.w); *(u32x2*)(xcat + (size_t)row * 2048 + col) = o;
            o.x = pk2(xx.x, xx.y); o.y = pk2(xx.z, xx.w); *(u32x2*)(xcat + (size_t)row * 2048 + 1024 + col) = o;
            f32x4 v = c4 + xx * mr[j]; o.x = pk2(v.x, v.y); o.y = pk2(v.z, v.w); *(u32x2*)(xr3 + (size_t)row * D + col) = o;
            v = c4 + xx * mk[j]; o.x = pk2(v.x, v.y); o.y = pk2(v.z, v.w); *(u32x2*)(xr3 + (size_t)M * D + (size_t)row * D + col) = o;
            v = c4 + xx * mv[j]; o.x = pk2(v.x, v.y); o.y = pk2(v.z, v.w); *(u32x2*)(xr3 + 2 * (size_t)M * D + (size_t)row * D + col) = o;
        }
    }
}

__global__ void __launch_bounds__(512, 2) fwd(Params P) {
    extern __shared__ __attribute__((aligned(16))) unsigned char lds[];
    LAS unsigned char* lds3 = (LAS unsigned char*)lds;
    volatile LAS unsigned* misc = (volatile LAS unsigned*)(lds3 + LDS_MISC);
    if (threadIdx.x < 16) misc[threadIdx.x] = 0u;
    const int wv_s = __builtin_amdgcn_readfirstlane(threadIdx.x >> 6);
    __syncthreads();
    unsigned char* ws = P.ws;
    XcdBarrier bar = xcd_barrier_post((unsigned*)(ws + WS_CTL + CTL_BAR_OFF), misc);
    const int G = gridDim.x, bid = blockIdx.x;
    float* hbuf = P.out;
    bf16* PRE = (bf16*)P.out;
    int* counts0 = (int*)(ws + WS_CTL);
    bf16* HB = (bf16*)(ws + WS_HB); bf16* R = (bf16*)(ws + WS_R); bf16* KB = (bf16*)(ws + WS_K); bf16* VB = (bf16*)(ws + WS_V);
    _Float16* LW = (_Float16*)(ws + WS_LW); bf16* AA = (bf16*)(ws + WS_AA); bf16* GG = (bf16*)(ws + WS_G); bf16* L1 = (bf16*)(ws + WS_L1);
    float* LOGF = (float*)(ws + WS_LOGF); float* CUM = (float*)(ws + WS_CUM); bf16* Y = (bf16*)(ws + WS_Y); bf16* HID = (bf16*)(ws + WS_HID);
    bf16* GUT = (bf16*)(ws + WS_MOEW); bf16* DNT = (bf16*)(ws + WS_DNT);
    bf16* GUT1 = (bf16*)((unsigned char*)P.out + 32 * MiB); bf16* DNT1 = (bf16*)(ws + WS_DNT1);
    const size_t BIG = (size_t)1 << 20;

    {
        const int tid = opaque_tid(wv_s), lane = tid & 63, wave = tid >> 6;
        const int gw = bid * 8 + wave, NGW = G * 8;
        LAS float* scr = (LAS float*)(lds3 + wave * 16384);
        bf16* WRKV = (bf16*)(ws + WS_WRKV); bf16* WO = (bf16*)(ws + WS_WO); bf16* B1T = (bf16*)(ws + WS_B1T); bf16* B2T = (bf16*)(ws + WS_B2T);
        bf16* WIN = (bf16*)(ws + WS_WIN); bf16* FWO = (bf16*)(ws + WS_FWO);
        const float* mix = P.in[I_MIX];
        int ib = 0;
        ib = tr_matrix(ib, gw, NGW, P.in[I_WR], D, D, D, nullptr, WRKV, D, 0, 0, 0, scr, lane);
        ib = tr_matrix(ib, gw, NGW, P.in[I_WK], D, D, D, nullptr, WRKV, D, 0, D, 0, scr, lane);
        ib = tr_matrix(ib, gw, NGW, P.in[I_WV], D, D, D, nullptr, WRKV, D, 0, 2 * D, 0, scr, lane);
        ib = tr_matrix(ib, gw, NGW, P.in[I_W1], 64, D, 64, nullptr, B1T, 2048, 0, 0, 0, scr, lane);
        ib = tr_matrix(ib, gw, NGW, P.in[I_W1], 64, D, 64, mix + 1 * D, B1T, 2048, 1024, 0, 0, scr, lane);
        ib = tr_matrix(ib, gw, NGW, P.in[I_A1], 64, D, 64, nullptr, B1T, 2048, 0, 64, 0, scr, lane);
        ib = tr_matrix(ib, gw, NGW, P.in[I_A1], 64, D, 64, mix + 4 * D, B1T, 2048, 1024, 64, 0, scr, lane);
        ib = tr_matrix(ib, gw, NGW, P.in[I_G1], 128, D, 128, nullptr, B1T, 2048, 0, 128, 0, scr, lane);
        ib = tr_matrix(ib, gw, NGW, P.in[I_G1], 128, D, 128, mix + 5 * D, B1T, 2048, 1024, 128, 0, scr, lane);
        ib = tr_matrix(ib, gw, NGW, P.in[I_W2], D, 64, D, nullptr, B2T, 256, 0, 0, 0, scr, lane);
        ib = tr_matrix(ib, gw, NGW, P.in[I_A2], D, 64, D, nullptr, B2T, 256, 64, 1024, 0, scr, lane);
        ib = tr_matrix(ib, gw, NGW, P.in[I_G2], D, 128, D, nullptr, B2T, 256, 128, 2048, 0, scr, lane);
        for (int ch = bid * 512 + tid; ch < 3072 * 32; ch += G * 512) {
            const int row = ch >> 5, c8 = ch & 31;
            const bool covered = row < 1024 ? (c8 < 8) : (row < 2048 ? (c8 >= 8 && c8 < 16) : (c8 >= 16));
            if (!covered) *(u32x4*)(B2T + (size_t)row * 256 + c8 * 8) = (u32x4){0u, 0u, 0u, 0u};
        }
        ph_xmix(P.in[I_X], mix, (bf16*)(ws + WS_XCAT), (bf16*)(ws + WS_XR), gw, NGW, lane);
    }
    xcd_barrier(bar);
    {
        const int G1 = G / 4, G2 = G - G1;
        pg8::DenseOrder S1; S1.init(M, 256, 2048, G1, bid < G1 ? bid : -1, ws + WS_XCAT, ws + WS_B1T, 1 << 20, 0);
        pg8::EpiBf16 E1; E1.O = L1; E1.ldc = 256; E1.split_div = 1; E1.split_stride = 0; E1.scale0 = 1.f; E1.act = 1; E1.scanlay = 0;
        pg8::gemm_phase<pg8::EpiBf16, pg8::DenseOrder, true, false>(lds3, 2048, S1, E1, wv_s);
        pg8::DenseOrder S2; S2.init(M, 3 * D, D, G2, bid >= G1 ? bid - G1 : -1, ws + WS_XR, ws + WS_WRKV, 4, (size_t)M * D * 2);
        pg8::EpiBf16 E2; E2.O = R; E2.ldc = D; E2.split_div = 4; E2.split_stride = (size_t)M * D; E2.scale0 = 1.f; E2.act = 0; E2.scanlay = 1;
        pg8::gemm_phase<pg8::EpiBf16, pg8::DenseOrder, true, false>(lds3, D, S2, E2, wv_s);
    }
    xcd_barrier(bar);
    {
        pg8::DenseOrder S; S.init(M, 3 * D, 256, G, bid, L1, ws + WS_B2T, 8, 256); S.kl = 128; S.bsel = 1;
        pg8::EpiLora2 E; E.LW = LW; E.AG = AA; E.w0 = P.in[I_W0]; E.a0 = P.in[I_A0];
        pg8::gemm_phase<pg8::EpiLora2, pg8::DenseOrder, true, false>(lds3, 256, S, E, wv_s);
    }
    xcd_barrier(bar);
    {
        const bool split = G >= 256;
        if (!split || bid < NB * H) {
            ScanP p; p.r = R; p.k = KB; p.v = VB; p.lw = LW; p.a = AA; p.g = GG; p.yg = R; p.kk = P.in[I_KK]; p.ka = P.in[I_KA]; p.rk = P.in[I_RK]; p.gng = P.in[I_GNG]; p.gnb = P.in[I_GNB];
            ph_scan_pc(p, lds, split ? NB * H : G, wv_s);
        }
        if (!split || bid >= NB * H) {
            const int tid = opaque_tid(wv_s), lane = tid & 63, wave = tid >> 6;
            __syncthreads();
            if (bid == G - 1) {
                build_router_frags(P.in[I_LNG] + 0 * D, P.in[I_LNB] + 0 * D, P.in[I_RW], ws + WS_WF, lds, tid);
                build_router_frags(P.in[I_LNG] + 2 * D, P.in[I_LNB] + 2 * D, P.in[I_RW], ws + WS_WF + WF_STRIDE, lds, tid);
            }
            {
                const int gw = split ? (bid - NB * H) * 8 + wave : bid * 8 + wave, NGW = split ? (G - NB * H) * 8 : G * 8; LAS float* scr = (LAS float*)(lds3 + wave * 16384); int ib = 0;
                ib = tr_matrix(ib, gw, NGW, P.in[I_WO], D, D, D, nullptr, (bf16*)(ws + WS_WO), D, 0, 0, 0, scr, lane);
                ib = tr_matrix(ib, gw, NGW, P.in[I_FWIN], NW_IN, D, 3 * D, nullptr, (bf16*)(ws + WS_WIN), D, 0, 0, 0, scr, lane);
                ib = tr_matrix(ib, gw, NGW, P.in[I_FWO], D, D, D, nullptr, (bf16*)(ws + WS_FWO), D, 0, 0, 0, scr, lane);
            }
            convert_moe(P.in[I_MG], P.in[I_MU], P.in[I_MD], GUT, DNT, split ? (bid - NB * H) * 8 + wave : bid * 8 + wave, split ? (G - NB * H) * 8 : G * 8, (LAS float*)(lds3 + wave * 16384), lane);
            convert_moe(P.in[I_MG] + (size_t)NE * D * DE, P.in[I_MU] + (size_t)NE * D * DE, P.in[I_MD] + (size_t)NE * DE * D, GUT1, DNT1, split ? (bid - NB * H) * 8 + wave : bid * 8 + wave, split ? (G - NB * H) * 8 : G * 8, (LAS float*)(lds3 + wave * 16384), lane);
            if (split) {
                const float* xs = P.in[I_X]; float accd = 0.f;
                const size_t nline = (size_t)M * D / 32, stride = (size_t)(G - NB * H) * 512;
#pragma unroll 8
                for (size_t i = (size_t)(bid - NB * H) * 512 + tid; i < nline; i += stride) accd += xs[i * 32];
                if (accd == 1.2345e38f) ((float*)(ws + WS_CTL))[8191] = accd;
            }
        }
    }
    xcd_barrier(bar);
    {
        pg8::DenseOrder S; S.init(M, D, D, G, bid, R, ws + WS_WO, 1 << 20, 0); S.ascan = 1;
        pg8::EpiPre E; E.hin32 = P.in[I_X]; E.hin16 = nullptr; E.out = PRE;
        pg8::gemm_phase<pg8::EpiPre, pg8::DenseOrder, true, false>(lds3, D, S, E, wv_s);
    }
    xcd_barrier(bar);
    for (int layer = 0; layer < 2; ++layer) {
        if (layer == 1) {
            ph_cumsum(LOGF, CUM, wv_s);
            {
                pg8::DenseOrder S; S.init(M, 3 * D, D, G, bid, HB, ws + WS_WIN, 1 << 20, 0);
                pg8::EpiBf16 E; E.O = R; E.ldc = D; E.split_div = 4; E.split_stride = (size_t)M * D; E.scale0 = attn_body::C2; E.act = 0; E.scanlay = 0;
                pg8::gemm_phase<pg8::EpiBf16, pg8::DenseOrder, true, false>(lds3, D, S, E, wv_s);
            }
            xcd_barrier(bar);
            {   const attn_body::AttnTensors AT{(const attn_body::bf16*)R, (const attn_body::bf16*)KB, (const attn_body::bf16*)VB, (attn_body::bf16*)R};
                const attn_body::StaticOrder S(G, bid);
                attn_body::attn_phase<attn_body::StaticOrder, 30>((char*)lds, AT, CUM, S, wv_s); }
            xcd_barrier(bar);
            {
                pg8::DenseOrder S; S.init(M, D, D, G, bid, R, ws + WS_FWO, 1 << 20, 0);
                pg8::EpiPre E; E.hin32 = nullptr; E.hin16 = HB; E.out = PRE;
                pg8::gemm_phase<pg8::EpiPre, pg8::DenseOrder, true, false>(lds3, D, S, E, wv_s);
            }
            xcd_barrier(bar);
        }
        int* counts = counts0 + 16 * CNT_STRIDE * layer;
        int* rtok = (int*)(ws + WS_RTOK) + (size_t)layer * NE * CAP; float* rgate = (float*)(ws + WS_RGATE) + (size_t)layer * NE * CAP; int* slot = (int*)(ws + WS_SLOT) + (size_t)layer * M * 2;
        {   LnRouteP p; p.pin = PRE; p.hb = HB; p.g = P.in[I_LNG] + (layer * 2 + 0) * D; p.b = P.in[I_LNB] + (layer * 2 + 0) * D; p.wfg = ws + WS_WF + (size_t)layer * WF_STRIDE; p.rbias = P.in[I_RB];
            p.counts = counts; p.rtok = rtok; p.rgate = rgate; p.slot = slot;
            ph_ln_route(p, lds, wv_s); }
        xcd_barrier(bar);
        {
            int total = 0; for (int e = 0; e < NE; ++e) total += (counts[e * CNT_STRIDE] + 255) >> 8;
            total *= 4;
            const int n3 = total > 512 ? total - 512 : 0, early = total < 512 ? total : 512;
            unsigned* gu3 = (unsigned*)(ws + WS_CTL + 36864) + 64 * layer;
            pg8::EpiGU EG; EG.hid = HID;
            pg8::EpiDN ED; ED.y = Y; ED.rgate = rgate;
            pg8::MoeOrder SG; SG.counts = counts; SG.rtok = rtok; SG.A = (const char*)HB; SG.B = (const char*)(layer == 0 ? GUT : GUT1); SG.bexp_stride = (size_t)D * D * 2; SG.nN = 4; SG.K = D; SG.gather = 1; SG.load_counts();
            pg8::MoeOrder SD; SD.counts = counts; SD.rtok = rtok; SD.A = (const char*)HID; SD.B = (const char*)(layer == 0 ? DNT : DNT1); SD.bexp_stride = (size_t)D * DE * 2; SD.nN = 4; SD.K = DE; SD.gather = 0; SD.load_counts();
            SG.base = bid; SG.stride = G; SG.hi = early;
            pg8::gemm_phase<pg8::EpiGU, pg8::MoeOrder, true, true>(lds3, D, SG, EG, wv_s);
            xcd_barrier(bar);
            int late_idx = -1;
            if (bid < n3) {
                SG.base = 512 + bid; SG.stride = 1 << 20; SG.hi = total;
                pg8::gemm_phase<pg8::EpiGU, pg8::MoeOrder, true, true>(lds3, D, SG, EG, wv_s);
                __syncthreads();
                if (opaque_tid(wv_s) == 0) { __builtin_amdgcn_fence(__ATOMIC_RELEASE, "agent"); asm volatile("s_waitcnt vmcnt(0)" ::: "memory"); __hip_atomic_fetch_add(gu3, 1u, __ATOMIC_RELAXED, __HIP_MEMORY_SCOPE_AGENT); }
                SD.base = bid; SD.stride = 1 << 20; SD.hi = early;
            } else {
                const int d = bid - n3, W = G - n3;
                SD.base = n3 + d; SD.stride = W; SD.hi = early;
                int idx = n3 + d; while (idx < 512) idx += W;
                if (idx < total) late_idx = idx;
            }
            pg8::gemm_phase<pg8::EpiDN, pg8::MoeOrder, true, false>(lds3, DE, SD, ED, wv_s);
            if (late_idx >= 0) {
                if (opaque_tid(wv_s) == 0) {
                    unsigned sp = 0; while (__hip_atomic_load(gu3, __ATOMIC_RELAXED, __HIP_MEMORY_SCOPE_AGENT) < (unsigned)n3) { __builtin_amdgcn_s_sleep(2); if (++sp > (1u << 22)) break; }
                    __builtin_amdgcn_fence(__ATOMIC_ACQUIRE, "agent"); asm volatile("s_waitcnt vmcnt(0)" ::: "memory");
                }
                __syncthreads();
                SD.base = late_idx; SD.stride = 1 << 20; SD.hi = total;
                pg8::gemm_phase<pg8::EpiDN, pg8::MoeOrder, true, false>(lds3, DE, SD, ED, wv_s);
            }
        }
        xcd_barrier(bar);
        {   LnCombP p; p.hb = HB; p.y = Y; p.slot = slot; p.counts = counts; p.g = P.in[I_LNG] + (layer * 2 + 1) * D; p.b = P.in[I_LNB] + (layer * 2 + 1) * D;
            p.wf = P.in[I_FWIN] + 3 * D; p.bf = P.in[I_FBF]; p.logf = LOGF; p.outp = (layer == 1) ? hbuf : nullptr; p.do_f = (layer == 0) ? 1 : 0; p.pad = 0;
            ph_ln_comb(p, lds, wv_s); }
        if (layer == 0) {
            xcd_barrier(bar);
        }
    }
}

extern "C" void kernel_launch(void* const* d_in, const int* in_sizes, int n_in, void* d_out, int out_size, void* d_ws, size_t ws_size, hipStream_t stream) {
    static int grid = 0;
    if (grid == 0) {
        if (n_in != N_IN || out_size != M * D || ws_size < WS_END) { fprintf(stderr, "kernel_launch: unexpected problem (n_in %d out %d ws %zu, need %zu)\n", n_in, out_size, ws_size, (size_t)WS_END); grid = -1; return; }
        int dev = 0, cus = 0;
        if (hipGetDevice(&dev) != hipSuccess || hipDeviceGetAttribute(&cus, hipDeviceAttributeMultiprocessorCount, dev) != hipSuccess) { grid = -1; return; }
        if (hipFuncSetAttribute((const void*)fwd, hipFuncAttributeMaxDynamicSharedMemorySize, LDS_BYTES) != hipSuccess) { fprintf(stderr, "kernel_launch: hipFuncSetAttribute failed\n"); grid = -1; return; }
        int per_cu = 0;
        if (hipOccupancyMaxActiveBlocksPerMultiprocessor(&per_cu, (const void*)fwd, 512, LDS_BYTES) != hipSuccess || per_cu < 1) { fprintf(stderr, "kernel_launch: occupancy query says %d\n", per_cu); (void)hipGetLastError(); }
        grid = cus;
    }
    if (grid < 0) return;
    (void)hipMemsetAsync((char*)d_ws + WS_CTL, 0, CTL_BYTES, stream);
    Params P{};
    for (int i = 0; i < N_IN; ++i) P.in[i] = (const float*)d_in[i];
    P.out = (float*)d_out; P.ws = (unsigned char*)d_ws;
    hipLaunchKernelGGL(fwd, dim3(grid), dim3(512), LDS_BYTES, stream, P);
}
```

```cpp
#include <hip/hip_runtime.h>
#include <stdint.h>
#include <stdio.h>

typedef unsigned short bf16;
typedef short bf16x8 __attribute__((ext_vector_type(8)));
typedef float f32x4 __attribute__((ext_vector_type(4)));
typedef float f32x2 __attribute__((ext_vector_type(2)));
typedef unsigned u32x4 __attribute__((ext_vector_type(4)));
typedef unsigned u32x2 __attribute__((ext_vector_type(2)));
#define LAS __attribute__((address_space(3)))

constexpr int NB = 8, T = 2048, D = 1024, H = 16, HD = 64, M = NB * T;
constexpr int NE = 16, DE = 512, CAP = 16384, MAXROWS = 36864;
constexpr int NW_IN = 3 * D + H;
constexpr float ALPHA = 1.4142135623730951f;
constexpr float LN_EPS = 1e-5f, GN_EPS = 64e-5f;
constexpr float LOG2E = 1.4426950408889634f;

constexpr size_t MiB = 1u << 20;
constexpr size_t WS_CTL = 0;
constexpr size_t CTL_BYTES = 65536;
constexpr size_t CTL_BAR_OFF = 16384;
constexpr size_t WS_RTOK = 1 * MiB;
constexpr size_t WS_RGATE = 3 * MiB;
constexpr size_t WS_SLOT = 5 * MiB;
constexpr size_t WS_WRKV = 6 * MiB;
constexpr size_t WS_WO = 12 * MiB;
constexpr size_t WS_B1T = 14 * MiB;
constexpr size_t WS_B2T = 15 * MiB;
constexpr size_t WS_WIN = 17 * MiB;
constexpr size_t WS_FWO = 23 * MiB;
constexpr size_t WS_X0 = 25 * MiB;
constexpr size_t WS_XCAT = WS_X0;
constexpr size_t WS_XR = WS_X0 + 64 * MiB;
constexpr size_t WS_MOEW = WS_X0;
constexpr size_t WS_DNT = WS_MOEW + 32 * MiB;
constexpr size_t WS_LW = WS_X0 + 48 * MiB;
constexpr size_t WS_HB = WS_X0 + 48 * MiB;
constexpr size_t WS_AA = WS_X0 + 80 * MiB;
constexpr size_t WS_G = WS_X0 + 112 * MiB;
constexpr size_t WS_DNT1 = WS_X0 + 144 * MiB;
constexpr size_t WS_HID = WS_X0 + 80 * MiB;
constexpr size_t WS_R = WS_X0 + 160 * MiB;
constexpr size_t WS_K = WS_R + 32 * MiB;
constexpr size_t WS_V = WS_R + 64 * MiB;
constexpr size_t WS_Y = WS_R;
constexpr size_t WS_L1 = WS_R + 96 * MiB;
constexpr size_t WS_LOGF = WS_L1;
constexpr size_t WS_CUM = WS_L1 + 1 * MiB;
constexpr size_t WS_WF = WS_L1 + 4 * MiB;
constexpr size_t WF_STRIDE = 65536 + 256;
constexpr size_t WS_END = WS_L1 + 8 * MiB;
static_assert(WS_END == 289 * MiB, "map");

__device__ __forceinline__ unsigned f2bf(float f) { unsigned u = __float_as_uint(f); return (u + 0x7fffu + ((u >> 16) & 1u)) >> 16; }
__device__ __forceinline__ float bf2f(unsigned b) { return __uint_as_float(b << 16); }
typedef __bf16 bf16x2_t_ __attribute__((ext_vector_type(2)));
__device__ __forceinline__ unsigned pk2(float lo, float hi) { const f32x2 v = {lo, hi}; const bf16x2_t_ b = __builtin_convertvector(v, bf16x2_t_); return __builtin_bit_cast(unsigned, b); }
__device__ __forceinline__ float sigmoidf_(float x) { return 1.0f / (1.0f + __expf(-x)); }
__device__ __forceinline__ float sigmoid_fast(float x) { return __builtin_amdgcn_rcpf(1.0f + __expf(-x)); }
__device__ __forceinline__ float tanh_fast(float x) { return 2.0f * sigmoid_fast(2.0f * x) - 1.0f; }
__device__ __forceinline__ float softplusf_(float x) { return fmaxf(x, 0.f) + __logf(1.0f + __expf(-fabsf(x))); }
__device__ __forceinline__ float shx(float v, int o, int lane) { return __int_as_float(__builtin_amdgcn_ds_bpermute((lane ^ o) << 2, __float_as_int(v))); }
__device__ __forceinline__ float wave_sum(float v, int lane) {
#pragma unroll
    for (int o = 1; o < 64; o <<= 1) v += shx(v, o, lane);
    return v;
}
__device__ __forceinline__ int opaque_tid(int wv_s) { int l; asm volatile("v_mbcnt_lo_u32_b32 %0, -1, 0\n\tv_mbcnt_hi_u32_b32 %0, -1, %0" : "=v"(l)); return wv_s * 64 + l; }

namespace pg8 {
constexpr int BM = 256, BK = 64, HALF = 128, HTB = HALF * BK * 2, STAGE_BYTES = 8 * HTB, NXCD = 8, WGM = 8;
__host__ __device__ __forceinline__ int lds_byte(int r, int c) { const int st = (r >> 4) * 2 + (c >> 5), rr = r & 15, cc = c & 31, ob = rr * 64 + cc * 2; return st * 1024 + (ob ^ (((ob >> 9) & 1) << 5)); }
__host__ __device__ __forceinline__ void stage_rc(int b, int& R, int& C) { const int st = b / 1024, sb = b % 1024, swz = sb ^ (((sb >> 9) & 1) << 5); R = (st >> 1) * 16 + swz / 64; C = (st & 1) * 32 + (swz % 64) / 2; }
__host__ __device__ __forceinline__ int perm32(int rho) { const int n = rho >> 4, i = rho & 15; return 8 * (i >> 2) + 4 * n + (i & 3); }

struct Unit { int pm, pn; const char* A; const char* B; int e, r0, nvalid, pad; };

typedef __bf16 bf16x2_cv __attribute__((ext_vector_type(2)));
__device__ __forceinline__ unsigned cvt_pk_bf16(float lo, float hi) { const f32x2 v = {lo, hi}; const bf16x2_cv b = __builtin_convertvector(v, bf16x2_cv); return __builtin_bit_cast(unsigned, b); }

template <class Epi, class Sched, bool ALIGN_EPI, bool GATHER>
__device__ __forceinline__ void gemm_phase(LAS unsigned char* lds, const int K_in, const Sched& S, const Epi& E, const int wv_s) {
    int K = K_in; asm volatile("" : "+s"(K));
    const int tid = opaque_tid(wv_s), wid = wv_s, lane = tid & 63, wr = wid >> 2, wc = wid & 3, fr = lane & 15, fq = lane >> 4;
    const int nt = S.kloop(K) / BK;
    int Rr[2], Cc[2]; unsigned voffB[2];
#pragma unroll
    for (int i = 0; i < 2; ++i) { int R, C; stage_rc(tid * 16 + i * 8192, R, C); Rr[i] = R; Cc[i] = C; const int Rb = Epi::PERM ? ((R & ~31) + perm32(R & 31)) : R; voffB[i] = (unsigned)(Rb * K + C) * 2u; }
    const size_t kstep = (size_t)(BK * 2);
    const size_t kstepA = S.kstepA();
    const size_t hstep = (size_t)HALF * K * 2;
    const unsigned ldsw = (unsigned)wid * 1024u;
    const int aoff = lds_byte(wr * 64 + fr, fq * 8), boff = lds_byte(wc * 32 + fr, fq * 8);
#define PG8_SA(b, h) (((b) * 2 + (h)) * HTB)
#define PG8_SB(b, h) ((4 + (b) * 2 + (h)) * HTB)
#define PG8_STAGE(bufoff, gbase, voff) do { _Pragma("unroll") for (int _i = 0; _i < 2; ++_i) \
        __builtin_amdgcn_global_load_lds((const unsigned*)((const char*)(gbase) + (voff)[_i]), (LAS unsigned*)(lds + (bufoff) + ldsw + _i * 8192), 16, 0, 0); } while (0)
#define PG8_LDA(dst, b, h) do { _Pragma("unroll") for (int m = 0; m < 4; ++m) _Pragma("unroll") for (int k = 0; k < 2; ++k) dst[m][k] = *(const LAS bf16x8*)(lds + PG8_SA(b, h) + aoff + m * 2048 + k * 1024); } while (0)
#define PG8_LDB(dst, b, h) do { _Pragma("unroll") for (int n = 0; n < 2; ++n) _Pragma("unroll") for (int k = 0; k < 2; ++k) dst[n][k] = *(const LAS bf16x8*)(lds + PG8_SB(b, h) + boff + n * 2048 + k * 1024); } while (0)
#define PG8_MMA(ai, bj, At, Bt) do { __builtin_amdgcn_s_setprio(1); _Pragma("unroll") for (int m = 0; m < 4; ++m) _Pragma("unroll") for (int n = 0; n < 2; ++n) _Pragma("unroll") for (int k = 0; k < 2; ++k) \
        acc[ai][bj][m][n] = __builtin_amdgcn_mfma_f32_16x16x32_bf16(Bt[n][k], At[m][k], acc[ai][bj][m][n], 0, 0, 0); __builtin_amdgcn_s_setprio(0); } while (0)
#define PG8_WAIT_V(n) asm volatile("s_waitcnt vmcnt(" #n ")" ::: "memory")
#define PG8_WAIT_L(n) asm volatile("s_waitcnt lgkmcnt(" #n ")" ::: "memory")
#define PG8_BAR __builtin_amdgcn_s_barrier()
#define PG8_SCHED __builtin_amdgcn_sched_barrier(0)
    Unit cur, nxt; int ui = 0;
    if (!S.next(0, cur)) return;
    f32x4 acc[2][2][4][2];
#pragma unroll
    for (int a = 0; a < 2; ++a)
#pragma unroll
        for (int b = 0; b < 2; ++b)
#pragma unroll
            for (int m = 0; m < 4; ++m)
#pragma unroll
                for (int n = 0; n < 2; ++n) acc[a][b][m][n] = (f32x4){0.f, 0.f, 0.f, 0.f};
    bf16x8 At[4][2], B0[2][2], B1[2][2];
    unsigned cv[2][2], nv[2][2];
    S.fill(cur, Rr, Cc, K, cv);
    const char* cA = cur.A; const char* cB = cur.B;
    PG8_STAGE(PG8_SB(0, 0), cB, voffB); PG8_STAGE(PG8_SB(0, 1), cB + hstep, voffB); PG8_STAGE(PG8_SA(0, 0), cA, cv[0]); PG8_STAGE(PG8_SA(0, 1), cA, cv[1]);
    if (wr == 1) PG8_BAR;
    PG8_WAIT_V(2); PG8_BAR;
    PG8_STAGE(PG8_SB(1, 0), cB + kstep, voffB); PG8_STAGE(PG8_SA(1, 0), cA + kstepA, cv[0]); PG8_STAGE(PG8_SB(1, 1), cB + hstep + kstep, voffB);
    PG8_WAIT_V(6); PG8_BAR;
    for (;;) {
        const bool has_next = S.next(ui + 1, nxt);
        const char* nA = has_next ? nxt.A : cA; const char* nB = has_next ? nxt.B : cB;
        if (GATHER) { if (has_next) S.fill(nxt, Rr, Cc, K, nv); else { nv[0][0] = cv[0][0]; nv[0][1] = cv[0][1]; nv[1][0] = cv[1][0]; nv[1][1] = cv[1][1]; } }
        for (int t = 0; t < nt; t += 2) {
            const bool last = (t == nt - 2);
            const char* a1 = cA + (size_t)(t + 1) * kstepA;
            const char* a2 = last ? nA : cA + (size_t)(t + 2) * kstepA; const char* b2 = last ? nB : cB + (size_t)(t + 2) * kstep;
            const char* a3 = a2 + kstepA; const char* b3 = b2 + kstep;
            unsigned v2[2][2];
            if (GATHER) { v2[0][0] = last ? nv[0][0] : cv[0][0]; v2[0][1] = last ? nv[0][1] : cv[0][1]; v2[1][0] = last ? nv[1][0] : cv[1][0]; v2[1][1] = last ? nv[1][1] : cv[1][1]; }
            else { v2[0][0] = cv[0][0]; v2[0][1] = cv[0][1]; v2[1][0] = cv[1][0]; v2[1][1] = cv[1][1]; }
            PG8_LDB(B0, 0, 0); PG8_LDB(B1, 0, 1); PG8_SCHED; PG8_LDA(At, 0, 0); PG8_STAGE(PG8_SA(1, 1), a1, cv[1]);
            PG8_WAIT_V(8); PG8_WAIT_L(0); PG8_BAR; PG8_MMA(0, 0, At, B0); PG8_MMA(0, 1, At, B1); PG8_BAR; PG8_SCHED;
            PG8_LDA(At, 0, 1); PG8_STAGE(PG8_SB(0, 0), b2, voffB); PG8_STAGE(PG8_SB(0, 1), b2 + hstep, voffB); PG8_STAGE(PG8_SA(0, 0), a2, v2[0]);
            PG8_WAIT_V(8); PG8_WAIT_L(0); PG8_BAR; PG8_MMA(1, 0, At, B0); PG8_MMA(1, 1, At, B1); PG8_BAR; PG8_SCHED;
            PG8_LDB(B0, 1, 0); PG8_LDB(B1, 1, 1); PG8_SCHED; PG8_LDA(At, 1, 0); PG8_STAGE(PG8_SA(0, 1), a2, v2[1]);
            PG8_WAIT_V(8); PG8_WAIT_L(0); PG8_BAR; PG8_MMA(0, 0, At, B0); PG8_MMA(0, 1, At, B1); PG8_BAR; PG8_SCHED;
            PG8_LDA(At, 1, 1); PG8_STAGE(PG8_SB(1, 0), b3, voffB); PG8_STAGE(PG8_SB(1, 1), b3 + hstep, voffB); PG8_STAGE(PG8_SA(1, 0), a3, v2[0]);
            PG8_WAIT_V(8); PG8_WAIT_L(0); PG8_BAR; PG8_MMA(1, 0, At, B0); PG8_MMA(1, 1, At, B1); PG8_BAR; PG8_SCHED;
        }
        if constexpr (ALIGN_EPI) { if (wr == 0) PG8_BAR; }
        { int fr_ = fr, fq_ = fq; asm volatile("" : "+v"(fr_), "+v"(fq_));
          E(acc, cur, wr, wc, fr_, fq_); }
        if (!has_next) break;
#pragma unroll
        for (int a = 0; a < 2; ++a)
#pragma unroll
            for (int b = 0; b < 2; ++b)
#pragma unroll
                for (int m = 0; m < 4; ++m)
#pragma unroll
                    for (int n = 0; n < 2; ++n) acc[a][b][m][n] = (f32x4){0.f, 0.f, 0.f, 0.f};
        cur = nxt; cA = nA; cB = nB; ++ui;
        if (GATHER) { cv[0][0] = nv[0][0]; cv[0][1] = nv[0][1]; cv[1][0] = nv[1][0]; cv[1][1] = nv[1][1]; }
        if constexpr (ALIGN_EPI) { if (wr == 1) PG8_BAR; }
    }
    PG8_WAIT_V(0);
    if constexpr (!ALIGN_EPI) { if (wr == 0) PG8_BAR; }
    PG8_BAR;
#undef PG8_SA
#undef PG8_SB
#undef PG8_STAGE
#undef PG8_LDA
#undef PG8_LDB
#undef PG8_MMA
#undef PG8_WAIT_V
#undef PG8_WAIT_L
#undef PG8_BAR
#undef PG8_SCHED
}

struct DenseOrder {
    int nM, nN, nwg, G, c, K;
    int kl, bsel;
    const char* A; const char* B; size_t asel_stride; int asel_div, ascan;
    __device__ void init(int M_, int N_, int K_, int G_, int c_, const void* A_, const void* B_, int asel_div_, size_t asel_stride_) {
        nM = M_ / BM; nN = N_ / BM; nwg = nM * nN; G = G_; c = c_; K = K_; A = (const char*)A_; B = (const char*)B_; asel_div = asel_div_; asel_stride = asel_stride_; ascan = 0; kl = 0; bsel = 0; }
    __device__ __forceinline__ bool next(int i, Unit& u) const {
        if (c < 0 || c >= G) return false;
        const long L = (long)i * G + c; if (L >= nwg) return false;
        int wgid = (int)L; { const int q = nwg / NXCD, r = nwg % NXCD, xcd = wgid % NXCD, off = wgid / NXCD; wgid = (xcd < r ? xcd * (q + 1) : r * (q + 1) + (xcd - r) * q) + off; }
        const int nig = WGM * nN, gid = wgid / nig, fm = gid * WGM, gsz = (nM - fm) < WGM ? (nM - fm) : WGM;
        u.pm = fm + ((wgid % nig) % gsz); u.pn = (wgid % nig) / gsz;
        u.A = ascan ? A + 2 * ((size_t)(u.pm >> 3) * 2097152 + (size_t)((u.pm * 4) & 31) * 4096) : A + (size_t)(u.pn / asel_div) * asel_stride + (size_t)u.pm * BM * K * 2;
        u.B = B + (size_t)u.pn * BM * K * 2 + (bsel ? (size_t)(u.pn / asel_div) * asel_stride : (size_t)0);
        u.e = 0; u.r0 = 0; u.nvalid = BM; u.pad = 0; return true;
    }
    __device__ __forceinline__ void fill(const Unit&, const int (&R)[2], const int (&C)[2], int K_, unsigned (&v)[2][2]) const {
#pragma unroll
        for (int h = 0; h < 2; ++h)
#pragma unroll
            for (int i = 0; i < 2; ++i) { const int lr = h * HALF + R[i]; v[h][i] = ascan ? (unsigned)((lr >> 6) * 4096 + (lr & 63) * 8 + (C[i] >> 3) * 512) * 2u : (unsigned)(lr * K_ + C[i]) * 2u; }
    }
    __device__ __forceinline__ size_t kstepA() const { return ascan ? (size_t)262144 : (size_t)(BK * 2); }
    __device__ __forceinline__ int kloop(int K_) const { return kl ? kl : K_; }
};
struct MoeOrder {
    const int* counts; const int* rtok; const char* A; const char* B; size_t bexp_stride;
    int nN, K, gather, base, stride, hi;
    int cnt[NE];
    __device__ __forceinline__ void load_counts() {
#pragma unroll
        for (int e = 0; e < NE; ++e) cnt[e] = counts[e * 64];
    }
    __device__ __forceinline__ bool next(int i, Unit& u) const {
        const int L = base + i * stride; if (L >= hi) return false;
        const int rt = L / nN; int acc = 0, es = -1, accs = 0, cnts = 0;
#pragma unroll
        for (int e = 0; e < NE; ++e) {
            const int ntile = (cnt[e] + 255) >> 8;
            const bool hit = (es < 0) && (rt < acc + ntile);
            es = hit ? e : es; accs = hit ? acc : accs; cnts = hit ? cnt[e] : cnts;
            acc += ntile;
        }
        if (es < 0) return false;
        u.pm = rt; u.pn = L % nN; u.e = es; u.r0 = (rt - accs) * 256; u.nvalid = min(256, cnts - u.r0); u.pad = 0;
        u.A = gather ? A : A + (size_t)rt * BM * K * 2; u.B = B + (size_t)es * bexp_stride + (size_t)u.pn * BM * K * 2; return true;
    }
    __device__ __forceinline__ void fill(const Unit& u, const int (&R)[2], const int (&C)[2], int K_, unsigned (&v)[2][2]) const {
#pragma unroll
        for (int h = 0; h < 2; ++h)
#pragma unroll
            for (int i = 0; i < 2; ++i) {
                const int rl = h * HALF + R[i];
                if (gather) { const int tok = (rl < u.nvalid) ? rtok[u.e * CAP + u.r0 + rl] : 0; v[h][i] = (unsigned)(tok * K_ + C[i]) * 2u; }
                else v[h][i] = (unsigned)(rl * K_ + C[i]) * 2u;
            }
    }
    __device__ __forceinline__ size_t kstepA() const { return (size_t)(BK * 2); }
    __device__ __forceinline__ int kloop(int K_) const { return K_; }
};

__device__ __forceinline__ size_t scan_idx(int row, int col) { return ((size_t)((((row >> 11) * H + (col >> 6)) * 32 + ((row >> 6) & 31)) * 8 + ((col >> 3) & 7)) * 64 + (row & 63)) * 8 + (col & 7); }
struct EpiBf16 {
    static constexpr bool PERM = true;
    bf16* O; int ldc, split_div; size_t split_stride; float scale0; int act, scanlay;
    __device__ __forceinline__ void operator()(const f32x4 (&acc)[2][2][4][2], const Unit& u, int wr, int wc, int fr, int fq) const {
        const int t = u.pn / split_div; bf16* base = O + (size_t)t * split_stride;
        const int colt = (u.pn - t * split_div) * BM;
        const float sc = (t == 0) ? scale0 : 1.f;
        const int row0 = u.pm * BM + wr * 64 + fr, col0 = colt + wc * 32 + 8 * fq;
#pragma unroll
        for (int ai = 0; ai < 2; ++ai)
#pragma unroll
            for (int m = 0; m < 4; ++m) { const int row = row0 + ai * HALF + m * 16; bf16* rowp = base + (size_t)row * ldc + col0;
#pragma unroll
                for (int bj = 0; bj < 2; ++bj) { f32x4 v0 = acc[ai][bj][m][0] * sc, v1 = acc[ai][bj][m][1] * sc;
                    if (act == 1) {
                        if (bj == 0 && wc < 2) { v0.x = tanh_fast(v0.x); v0.y = tanh_fast(v0.y); v0.z = tanh_fast(v0.z); v0.w = tanh_fast(v0.w); v1.x = tanh_fast(v1.x); v1.y = tanh_fast(v1.y); v1.z = tanh_fast(v1.z); v1.w = tanh_fast(v1.w); }
                        else if (bj == 1) { v0.x = sigmoid_fast(v0.x); v0.y = sigmoid_fast(v0.y); v0.z = sigmoid_fast(v0.z); v0.w = sigmoid_fast(v0.w); v1.x = sigmoid_fast(v1.x); v1.y = sigmoid_fast(v1.y); v1.z = sigmoid_fast(v1.z); v1.w = sigmoid_fast(v1.w); }
                    }
                    u32x4 w; w.x = cvt_pk_bf16(v0[0], v0[1]); w.y = cvt_pk_bf16(v0[2], v0[3]); w.z = cvt_pk_bf16(v1[0], v1[1]); w.w = cvt_pk_bf16(v1[2], v1[3]);
                    bf16* dst = (scanlay != 0) ? base + scan_idx(row, col0 + bj * HALF) : rowp + bj * HALF;
                    *(u32x4*)dst = w; } }
    }
};
struct EpiLora2 {
    static constexpr bool PERM = true;
    _Float16* LW; bf16* AG; const float* w0; const float* a0; int pm0, pn0;
    __device__ __forceinline__ void operator()(const f32x4 (&acc)[2][2][4][2], const Unit& u, int wr, int wc, int fr, int fq) const {
        const int pn = u.pn + pn0; const int t = pn >> 2, colt = (pn & 3) * BM;
        const int row0 = (u.pm + pm0) * BM + wr * 64 + fr, col0 = colt + wc * 32 + 8 * fq;
        if (t == 0) {
#pragma unroll
            for (int bj = 0; bj < 2; ++bj) {
                const f32x4 b0 = *(const f32x4*)(w0 + col0 + bj * HALF), b1 = *(const f32x4*)(w0 + col0 + bj * HALF + 4);
#pragma unroll
                for (int ai = 0; ai < 2; ++ai)
#pragma unroll
                    for (int m = 0; m < 4; ++m) {
                        const size_t o = scan_idx(row0 + ai * HALF + m * 16, col0 + bj * HALF);
                        const f32x4 v0 = acc[ai][bj][m][0] + b0, v1 = acc[ai][bj][m][1] + b1;
                        typedef _Float16 h8 __attribute__((ext_vector_type(8)));
                        h8 hv;
                        hv[0] = (_Float16)(-0.87503877f * sigmoid_fast(v0.x)); hv[1] = (_Float16)(-0.87503877f * sigmoid_fast(v0.y));
                        hv[2] = (_Float16)(-0.87503877f * sigmoid_fast(v0.z)); hv[3] = (_Float16)(-0.87503877f * sigmoid_fast(v0.w));
                        hv[4] = (_Float16)(-0.87503877f * sigmoid_fast(v1.x)); hv[5] = (_Float16)(-0.87503877f * sigmoid_fast(v1.y));
                        hv[6] = (_Float16)(-0.87503877f * sigmoid_fast(v1.z)); hv[7] = (_Float16)(-0.87503877f * sigmoid_fast(v1.w));
                        *(h8*)(LW + o) = hv;
                    }
            }
        } else if (t == 1) {
#pragma unroll
            for (int bj = 0; bj < 2; ++bj) {
                const f32x4 b0 = *(const f32x4*)(a0 + col0 + bj * HALF), b1 = *(const f32x4*)(a0 + col0 + bj * HALF + 4);
#pragma unroll
                for (int ai = 0; ai < 2; ++ai)
#pragma unroll
                    for (int m = 0; m < 4; ++m) {
                        const size_t o = scan_idx(row0 + ai * HALF + m * 16, col0 + bj * HALF);
                        const f32x4 v0 = acc[ai][bj][m][0] + b0, v1 = acc[ai][bj][m][1] + b1;
                        u32x4 w; w.x = cvt_pk_bf16(sigmoid_fast(v0.x), sigmoid_fast(v0.y)); w.y = cvt_pk_bf16(sigmoid_fast(v0.z), sigmoid_fast(v0.w));
                        w.z = cvt_pk_bf16(sigmoid_fast(v1.x), sigmoid_fast(v1.y)); w.w = cvt_pk_bf16(sigmoid_fast(v1.z), sigmoid_fast(v1.w));
                        *(u32x4*)(AG + o) = w;
                    }
            }
        } else {
#pragma unroll
            for (int bj = 0; bj < 2; ++bj)
#pragma unroll
                for (int ai = 0; ai < 2; ++ai)
#pragma unroll
                    for (int m = 0; m < 4; ++m) {
                        const size_t o = (size_t)M * D + (size_t)(row0 + ai * HALF + m * 16) * D + col0 + bj * HALF;
                        const f32x4 v0 = acc[ai][bj][m][0], v1 = acc[ai][bj][m][1];
                        u32x4 w; w.x = cvt_pk_bf16(v0.x, v0.y); w.y = cvt_pk_bf16(v0.z, v0.w); w.z = cvt_pk_bf16(v1.x, v1.y); w.w = cvt_pk_bf16(v1.z, v1.w);
                        *(u32x4*)(AG + o) = w;
                    }
        }
    }
};
struct EpiPre {
    static constexpr bool PERM = true;
    const float* hin32; const bf16* hin16; bf16* out;
    __device__ __forceinline__ void operator()(const f32x4 (&acc)[2][2][4][2], const Unit& u, int wr, int wc, int fr, int fq) const {
        const int row0 = u.pm * BM + wr * 64 + fr, col0 = u.pn * BM + wc * 32 + 8 * fq;
#pragma unroll
        for (int ai = 0; ai < 2; ++ai)
#pragma unroll
            for (int m = 0; m < 4; ++m) { const size_t ro = (size_t)(row0 + ai * HALF + m * 16) * D + col0;
#pragma unroll
                for (int bj = 0; bj < 2; ++bj) { const size_t o = ro + bj * HALF;
                    f32x4 h0, h1;
                    if (hin32) { h0 = *(const f32x4*)(hin32 + o); h1 = *(const f32x4*)(hin32 + o + 4); }
                    else { const u32x4 hv = *(const u32x4*)(hin16 + o); h0 = (f32x4){bf2f(hv.x & 0xffff), bf2f(hv.x >> 16), bf2f(hv.y & 0xffff), bf2f(hv.y >> 16)}; h1 = (f32x4){bf2f(hv.z & 0xffff), bf2f(hv.z >> 16), bf2f(hv.w & 0xffff), bf2f(hv.w >> 16)}; }
                    const f32x4 v0 = h0 * ALPHA + acc[ai][bj][m][0], v1 = h1 * ALPHA + acc[ai][bj][m][1];
                    u32x4 w; w.x = cvt_pk_bf16(v0[0], v0[1]); w.y = cvt_pk_bf16(v0[2], v0[3]); w.z = cvt_pk_bf16(v1[0], v1[1]); w.w = cvt_pk_bf16(v1[2], v1[3]);
                    *(u32x4*)(out + o) = w; } }
    }
};
struct EpiGU {
    static constexpr bool PERM = true;
    bf16* hid;
    __device__ __forceinline__ void operator()(const f32x4 (&acc)[2][2][4][2], const Unit& u, int wr, int wc, int fr, int fq) const {
        const int row0 = u.pm * BM + wr * 64 + fr, col0 = u.pn * 128 + wc * 16 + 4 * fq;
#pragma unroll
        for (int ai = 0; ai < 2; ++ai)
#pragma unroll
            for (int m = 0; m < 4; ++m) { bf16* rowp = hid + (size_t)(row0 + ai * HALF + m * 16) * DE + col0;
#pragma unroll
                for (int bj = 0; bj < 2; ++bj) { const f32x4 g = acc[ai][bj][m][0], uu = acc[ai][bj][m][1];
                    u32x2 w; w.x = cvt_pk_bf16(g.x * sigmoid_fast(g.x) * uu.x, g.y * sigmoid_fast(g.y) * uu.y); w.y = cvt_pk_bf16(g.z * sigmoid_fast(g.z) * uu.z, g.w * sigmoid_fast(g.w) * uu.w);
                    *(u32x2*)(rowp + bj * 64) = w; } }
    }
};
struct EpiDN {
    static constexpr bool PERM = true;
    bf16* y; const float* rgate;
    __device__ __forceinline__ void operator()(const f32x4 (&acc)[2][2][4][2], const Unit& u, int wr, int wc, int fr, int fq) const {
        const int col0 = u.pn * BM + wc * 32 + 8 * fq;
#pragma unroll
        for (int ai = 0; ai < 2; ++ai)
#pragma unroll
            for (int m = 0; m < 4; ++m) { const int rl = ai * HALF + wr * 64 + m * 16 + fr;
                if (rl < u.nvalid) { const float gt = rgate[u.e * CAP + u.r0 + rl]; bf16* rowp = y + (size_t)(u.pm * BM + rl) * D + col0;
#pragma unroll
                    for (int bj = 0; bj < 2; ++bj) { const f32x4 v0 = acc[ai][bj][m][0] * gt, v1 = acc[ai][bj][m][1] * gt;
                        u32x4 w; w.x = cvt_pk_bf16(v0[0], v0[1]); w.y = cvt_pk_bf16(v0[2], v0[3]); w.z = cvt_pk_bf16(v1[0], v1[1]); w.w = cvt_pk_bf16(v1[2], v1[3]);
                        *(u32x4*)(rowp + bj * HALF) = w; } } }
    }
};
}

__device__ __forceinline__ void tr_load(const float* W, int ld, int k0, int n0, float (&v)[32], int lane) {
#pragma unroll
    for (int i = 0; i < 32; ++i) v[i] = W[(size_t)(k0 + 2 * i + (lane >> 5)) * ld + n0 + (lane & 31)];
}
__device__ __forceinline__ void tr_put(const float (&v)[32], int k0, int n0, const float* kscale, bf16* WT, int Kd, int koff, int drow0, int mode, LAS float* scr, int lane) {
#pragma unroll
    for (int i = 0; i < 32; ++i) { const int kk = 2 * i + (lane >> 5); float x = v[i]; if (kscale) x *= kscale[k0 + kk]; scr[kk * 33 + (lane & 31)] = x; }
    asm volatile("s_waitcnt lgkmcnt(0)" ::: "memory");
    const int c = lane & 7;
#pragma unroll
    for (int j = 0; j < 4; ++j) { const int n = (lane >> 3) + 8 * j; const LAS float* s = scr + (8 * c) * 33 + n;
        u32x4 o; o.x = pk2(s[0 * 33], s[1 * 33]); o.y = pk2(s[2 * 33], s[3 * 33]); o.z = pk2(s[4 * 33], s[5 * 33]); o.w = pk2(s[6 * 33], s[7 * 33]);
        const int nn = n0 + n; const int drow = (mode == 0) ? (drow0 + nn) : (drow0 + 8 * (nn >> 2) + (nn & 3) + (mode == 2 ? 4 : 0));
        *(u32x4*)(WT + (size_t)drow * Kd + koff + k0 + 8 * c) = o; }
    asm volatile("s_waitcnt lgkmcnt(0)" ::: "memory");
}
__device__ __forceinline__ void tr_item(const float* W, int ld, int k0, int n0, const float* kscale, bf16* WT, int Kd, int koff, int drow0, int mode, LAS float* scr, int lane) {
    float v[32]; tr_load(W, ld, k0, n0, v, lane); tr_put(v, k0, n0, kscale, WT, Kd, koff, drow0, mode, scr, lane);
}
__device__ __forceinline__ int tr_matrix(int item_base, int gw, int NGW, const float* W, int ld, int Ks, int Ns, const float* kscale, bf16* WT, int Kd, int koff, int drow0, int mode, LAS float* scr, int lane) {
    const int nblk = Ns / 32, nit = (Ks / 64) * nblk;
    int first = gw - (item_base % NGW); if (first < 0) first += NGW;
    for (int it = first; it < nit; it += NGW) tr_item(W, ld, 64 * (it / nblk), 32 * (it % nblk), kscale, WT, Kd, koff, drow0, mode, scr, lane);
    return item_base + nit;
}
struct MoeItem { const float* W; bf16* WT; int ld, k0, n0, Kd, mode; };
__device__ __forceinline__ MoeItem moe_item(int it, const float* wg, const float* wu, const float* wd, bf16* gut, bf16* dnt) {
    const int e = it / 768, r = it % 768; MoeItem m;
    if (r < 512) { const int q = r & 255; m.W = (r < 256 ? wg : wu) + (size_t)e * D * DE; m.ld = DE; m.k0 = 64 * (q / 16); m.n0 = 32 * (q % 16); m.WT = gut + (size_t)e * D * D; m.Kd = D; m.mode = r < 256 ? 1 : 2; }
    else { const int q = r - 512; m.W = wd + (size_t)e * DE * D; m.ld = D; m.k0 = 64 * (q / 32); m.n0 = 32 * (q % 32); m.WT = dnt + (size_t)e * D * DE; m.Kd = DE; m.mode = 0; }
    return m;
}
__device__ __forceinline__ void convert_moe(const float* wg, const float* wu, const float* wd, bf16* gut, bf16* dnt, int gw, int NGW, LAS float* scr, int lane) {
    float va[32], vb[32];
    int it = gw;
    if (it < NE * 768) { const MoeItem m = moe_item(it, wg, wu, wd, gut, dnt); tr_load(m.W, m.ld, m.k0, m.n0, va, lane); }
    while (it < NE * 768) {
        const MoeItem ma = moe_item(it, wg, wu, wd, gut, dnt);
        const int itb = it + NGW;
        if (itb < NE * 768) { const MoeItem m = moe_item(itb, wg, wu, wd, gut, dnt); tr_load(m.W, m.ld, m.k0, m.n0, vb, lane); }
        tr_put(va, ma.k0, ma.n0, nullptr, ma.WT, ma.Kd, 0, 0, ma.mode, scr, lane);
        if (itb >= NE * 768) break;
        const MoeItem mb = moe_item(itb, wg, wu, wd, gut, dnt);
        const int itc = itb + NGW;
        if (itc < NE * 768) { const MoeItem m = moe_item(itc, wg, wu, wd, gut, dnt); tr_load(m.W, m.ld, m.k0, m.n0, va, lane); }
        tr_put(vb, mb.k0, mb.n0, nullptr, mb.WT, mb.Kd, 0, 0, mb.mode, scr, lane);
        it = itc;
    }
}
constexpr int CNT_STRIDE = 64;
constexpr int RT = 2;
template <int CTRL> __device__ __forceinline__ float dppx(float v) { return __int_as_float(__builtin_amdgcn_update_dpp(0, __float_as_int(v), CTRL, 0xF, 0xF, false)); }
__device__ __forceinline__ float red8(float v) { v += dppx<0xB1>(v); v += dppx<0x4E>(v); v += dppx<0x141>(v); return v; }
__device__ __forceinline__ float red16(float v) { v = red8(v); v += dppx<0x140>(v); return v; }
__device__ __forceinline__ float red64(float v, int lane) { v = red16(v); v += shx(v, 16, lane); v += shx(v, 32, lane); return v; }
__device__ __forceinline__ void ln_rowsN(f32x4 (&v)[RT][4], const float* g, const float* b, int lane) {
    float s[RT];
#pragma unroll
    for (int t = 0; t < RT; ++t) { s[t] = 0.f;
#pragma unroll
        for (int j = 0; j < 4; ++j) s[t] += (v[t][j].x + v[t][j].y) + (v[t][j].z + v[t][j].w); }
#pragma unroll
    for (int t = 0; t < RT; ++t) s[t] = red64(s[t], lane);
    float s2[RT];
#pragma unroll
    for (int t = 0; t < RT; ++t) { const float mean = s[t] * (1.f / D); s2[t] = 0.f;
#pragma unroll
        for (int j = 0; j < 4; ++j) { v[t][j] = v[t][j] - mean; s2[t] += (v[t][j].x * v[t][j].x + v[t][j].y * v[t][j].y) + (v[t][j].z * v[t][j].z + v[t][j].w * v[t][j].w); } }
#pragma unroll
    for (int t = 0; t < RT; ++t) s2[t] = red64(s2[t], lane);
#pragma unroll
    for (int j = 0; j < 4; ++j) {
        const f32x4 gg = *(const f32x4*)(g + 4 * lane + 256 * j), bb = *(const f32x4*)(b + 4 * lane + 256 * j);
#pragma unroll
        for (int t = 0; t < RT; ++t) { const float rstd = rsqrtf(s2[t] * (1.f / D) + LN_EPS); v[t][j] = v[t][j] * rstd * gg + bb; }
    }
}
__device__ __forceinline__ void stage_w16(const float* Wm, int ldw, f32x4* wl, int tid) {
    for (int i = tid; i < 4096; i += 512) { const int c = i >> 2, e4 = i & 3, jq = (c >> 8) * 4 + (c & 3), ln = (c & 255) >> 2;
        wl[(jq * 4 + e4) * 64 + ln] = *(const f32x4*)(Wm + (size_t)c * ldw + 4 * e4); }
}
__device__ __forceinline__ float rowsN_dot16(const f32x4 (&v)[RT][4], const f32x4* wl, int lane) {
    float a[RT * 16];
#pragma unroll
    for (int i = 0; i < RT * 16; ++i) a[i] = 0.f;
    int lw = lane;
#pragma unroll
    for (int idx = 0; idx < 16; ++idx) {
        const int j = idx >> 2, q = idx & 3;
        if ((idx & 3) == 0) {
#pragma unroll
            for (int t = 0; t < RT; ++t)
                asm volatile("" : "+v"(lw), "+v"(a[t * 16 + 0]), "+v"(a[t * 16 + 1]), "+v"(a[t * 16 + 2]), "+v"(a[t * 16 + 3]), "+v"(a[t * 16 + 4]), "+v"(a[t * 16 + 5]), "+v"(a[t * 16 + 6]), "+v"(a[t * 16 + 7]),
                             "+v"(a[t * 16 + 8]), "+v"(a[t * 16 + 9]), "+v"(a[t * 16 + 10]), "+v"(a[t * 16 + 11]), "+v"(a[t * 16 + 12]), "+v"(a[t * 16 + 13]), "+v"(a[t * 16 + 14]), "+v"(a[t * 16 + 15]));
        }
        const f32x4 w0 = wl[(idx * 4 + 0) * 64 + lw], w1 = wl[(idx * 4 + 1) * 64 + lw], w2 = wl[(idx * 4 + 2) * 64 + lw], w3 = wl[(idx * 4 + 3) * 64 + lw];
#pragma unroll
        for (int t = 0; t < RT; ++t) {
            const float hv = q == 0 ? v[t][j].x : (q == 1 ? v[t][j].y : (q == 2 ? v[t][j].z : v[t][j].w));
            a[t * 16 + 0] += hv * w0.x; a[t * 16 + 1] += hv * w0.y; a[t * 16 + 2] += hv * w0.z; a[t * 16 + 3] += hv * w0.w;
            a[t * 16 + 4] += hv * w1.x; a[t * 16 + 5] += hv * w1.y; a[t * 16 + 6] += hv * w1.z; a[t * 16 + 7] += hv * w1.w;
            a[t * 16 + 8] += hv * w2.x; a[t * 16 + 9] += hv * w2.y; a[t * 16 + 10] += hv * w2.z; a[t * 16 + 11] += hv * w2.w;
            a[t * 16 + 12] += hv * w3.x; a[t * 16 + 13] += hv * w3.y; a[t * 16 + 14] += hv * w3.z; a[t * 16 + 15] += hv * w3.w;
        }
    }
#define TRED(o, n) do { const bool up_ = (lane & (o)) != 0; _Pragma("unroll") for (int i = 0; i < (n); ++i) { const float keep_ = up_ ? a[i + (n)] : a[i]; const float send_ = up_ ? a[i] : a[i + (n)]; a[i] = keep_ + shx(send_, (o), lane); } } while (0)
#pragma unroll
    for (int i = 0; i < RT * 16; ++i) a[i] += shx(a[i], 32, lane);
    if constexpr (RT == 1) {
#pragma unroll
        for (int i = 0; i < 16; ++i) a[i] += shx(a[i], 16, lane);
    } else { TRED(16, 16); }
    TRED(8, 8); TRED(4, 4); TRED(2, 2); TRED(1, 1);
#undef TRED
    return a[0];
}
__device__ __forceinline__ void store_rowsN(const f32x4 (&v)[RT][4], float* h, bf16* hb, int tok0, int lane) {
#pragma unroll
    for (int t = 0; t < RT; ++t)
#pragma unroll
        for (int j = 0; j < 4; ++j) {
            if (h) *(f32x4*)(h + (size_t)(tok0 + t) * D + 4 * lane + 256 * j) = v[t][j];
            if (hb) { u32x2 o; o.x = pk2(v[t][j].x, v[t][j].y); o.y = pk2(v[t][j].z, v[t][j].w);
                *(u32x2*)(hb + (size_t)(tok0 + t) * D + 4 * lane + 256 * j) = o; }
        }
}
__device__ __forceinline__ f32x4 ld_bf4(const bf16* p) { const u32x2 a = *(const u32x2*)p; return (f32x4){bf2f(a.x & 0xffff), bf2f(a.x >> 16), bf2f(a.y & 0xffff), bf2f(a.y >> 16)}; }

struct LnRouteP { const bf16* pin; bf16* hb; const float* g; const float* b; const unsigned char* wfg; const float* rbias; int* counts; int* rtok; float* rgate; int* slot; };
__device__ __forceinline__ void build_router_frags(const float* g, const float* b, const float* rw, unsigned char* out, unsigned char* lds, int tid) {
    float* prt = (float*)(lds + 6400);
    u32x4* WFo = (u32x4*)out; float* csc0 = (float*)(out + 65536);
    __syncthreads();
    for (int f = tid; f < 2048; f += 512) { const int kk = f >> 6, l = f & 63, e = l & 15, k0 = 32 * kk + 8 * (l >> 4);
        float wv8[8]; unsigned hi[4], lo[4];
#pragma unroll
        for (int q = 0; q < 8; ++q) wv8[q] = g[k0 + q] * rw[(size_t)(k0 + q) * NE + e];
#pragma unroll
        for (int q = 0; q < 4; ++q) { hi[q] = pk2(wv8[2 * q], wv8[2 * q + 1]); lo[q] = pk2(wv8[2 * q] - bf2f(hi[q] & 0xffff), wv8[2 * q + 1] - bf2f(hi[q] >> 16)); }
        u32x4 h4 = {hi[0], hi[1], hi[2], hi[3]}, l4 = {lo[0], lo[1], lo[2], lo[3]};
        WFo[(kk * 2 + 0) * 64 + l] = h4; WFo[(kk * 2 + 1) * 64 + l] = l4; }
    {   const int e = tid & 15, part = tid >> 4; float a0 = 0.f, a1 = 0.f;
#pragma unroll 8
        for (int q = 0; q < 32; ++q) { const int k = 32 * part + q; const float r = rw[(size_t)k * NE + e]; a0 += g[k] * r; a1 += b[k] * r; }
        prt[part * 16 + e] = a0; prt[512 + part * 16 + e] = a1; }
    __syncthreads();
    if (tid < 32) { const int e = tid & 15, which = tid >> 4; float a = 0.f;
#pragma unroll 8
        for (int q = 0; q < 32; ++q) a += prt[which * 512 + q * 16 + e];
        csc0[which * 16 + e] = a; }
    __syncthreads();
}
__device__ __forceinline__ void ph_ln_route(const LnRouteP& p, unsigned char* lds, const int wv_s) {
    const int tid = opaque_tid(wv_s); const int lane = tid & 63, wv = tid >> 6;
    int* sel_e = (int*)lds;
    float* sel_g = (float*)(lds + 512);
    int* lrank = (int*)(lds + 1024);
    int* lcnt = (int*)(lds + 1536);
    int* lbase = (int*)(lds + 1600);
    float* cs = (float*)(lds + 1664);
    float* c0 = (float*)(lds + 1728);
    float* st = (float*)(lds + 1792);
    float* lg = (float*)(lds + 2304);
    float* prt = (float*)(lds + 6400);
    bf16x8* WF = (bf16x8*)(lds + 16384);
    {
        const u32x4* wsrc = (const u32x4*)p.wfg; u32x4 tmp[8];
#pragma unroll
        for (int i = 0; i < 8; ++i) tmp[i] = wsrc[tid + 512 * i];
#pragma unroll
        for (int i = 0; i < 8; ++i) *(u32x4*)&WF[tid + 512 * i] = tmp[i];
        if (tid < 32) { const float x = ((const float*)(p.wfg + 65536))[tid]; if (tid < 16) cs[tid] = x; else c0[tid - 16] = x; }
        __syncthreads();
    }
    for (int tb = blockIdx.x * 64; tb < M; tb += gridDim.x * 64) {
        { const int tid0 = opaque_tid(wv_s); if (tid0 < 16) lcnt[tid0] = 0; }
        u32x2 raw[64 / (8 * RT)][RT][4];
#pragma unroll
        for (int rd = 0; rd < 64 / (8 * RT); ++rd)
#pragma unroll
            for (int t = 0; t < RT; ++t)
#pragma unroll
                for (int j = 0; j < 4; ++j) raw[rd][t][j] = *(const u32x2*)(p.pin + (size_t)(tb + rd * 8 * RT + wv * RT + t) * D + 4 * lane + 256 * j);
#pragma unroll
        for (int rd = 0; rd < 64 / (8 * RT); ++rd) {
            const int tl0 = rd * 8 * RT + wv * RT, tok0 = tb + tl0;
            int lane_r = lane; asm volatile("" : "+v"(lane_r));
            f32x4 v[RT][4];
#pragma unroll
            for (int t = 0; t < RT; ++t)
#pragma unroll
                for (int j = 0; j < 4; ++j) { const u32x2 a = raw[rd][t][j]; v[t][j] = (f32x4){bf2f(a.x & 0xffff), bf2f(a.x >> 16), bf2f(a.y & 0xffff), bf2f(a.y >> 16)}; }
            float s1[RT], s2[RT];
#pragma unroll
            for (int t = 0; t < RT; ++t) { float a = 0.f;
#pragma unroll
                for (int j = 0; j < 4; ++j) a += (v[t][j].x + v[t][j].y) + (v[t][j].z + v[t][j].w);
                s1[t] = red64(a, lane_r) * (1.f / D); }
#pragma unroll
            for (int t = 0; t < RT; ++t) { float a = 0.f;
#pragma unroll
                for (int j = 0; j < 4; ++j) { v[t][j] = v[t][j] - s1[t]; a += (v[t][j].x * v[t][j].x + v[t][j].y * v[t][j].y) + (v[t][j].z * v[t][j].z + v[t][j].w * v[t][j].w); }
                s2[t] = rsqrtf(red64(a, lane_r) * (1.f / D) + LN_EPS); }
#pragma unroll
            for (int j = 0; j < 4; ++j) {
                const f32x4 gg = *(const f32x4*)(p.g + 4 * lane_r + 256 * j), bb = *(const f32x4*)(p.b + 4 * lane_r + 256 * j);
#pragma unroll
                for (int t = 0; t < RT; ++t) v[t][j] = v[t][j] * s2[t] * gg + bb;
            }
            store_rowsN(v, nullptr, p.hb, tok0, lane_r);
            if (lane_r == 0) {
#pragma unroll
                for (int t = 0; t < RT; ++t) { st[2 * (tl0 + t)] = s1[t]; st[2 * (tl0 + t) + 1] = s2[t]; } }
        }
        if (wv < 4) {
            int lane_r = lane; asm volatile("" : "+v"(lane_r));
            const int fr = lane_r & 15, fq = lane_r >> 4;
            const bf16* arow = p.pin + (size_t)(tb + 16 * wv + fr) * D + 8 * fq;
            f32x4 acc = (f32x4){0.f, 0.f, 0.f, 0.f};
#pragma unroll 8
            for (int kk = 0; kk < 32; ++kk) {
                const bf16x8 a = *(const bf16x8*)(arow + 32 * kk);
                acc = __builtin_amdgcn_mfma_f32_16x16x32_bf16(a, WF[(kk * 2 + 0) * 64 + lane_r], acc, 0, 0, 0);
                acc = __builtin_amdgcn_mfma_f32_16x16x32_bf16(a, WF[(kk * 2 + 1) * 64 + lane_r], acc, 0, 0, 0);
            }
#pragma unroll
            for (int i = 0; i < 4; ++i) lg[(16 * wv + 4 * fq + i) * 16 + fr] = acc[i];
        }
        __syncthreads();
        {
            const int tid2 = opaque_tid(wv_s);
            if (tid2 < 64) {
                const float mu = st[2 * tid2], rstd = st[2 * tid2 + 1];
                float s[16], ss[16];
#pragma unroll
                for (int e4 = 0; e4 < 4; ++e4) { const f32x4 raw = *(const f32x4*)&lg[tid2 * 16 + 4 * e4];
#pragma unroll
                    for (int q = 0; q < 4; ++q) { const int e = 4 * e4 + q; const float r = q == 0 ? raw.x : (q == 1 ? raw.y : (q == 2 ? raw.z : raw.w));
                        const float lgt = rstd * (r - mu * cs[e]) + c0[e]; s[e] = sigmoidf_(lgt); ss[e] = s[e] + p.rbias[e]; } }
                int gbest = 0; float gscore = -INFINITY; int l1b = 0, l2b = 1;
#pragma unroll
                for (int g = 0; g < 4; ++g) {
                    float v1 = ss[4 * g], v2 = -INFINITY; int i1 = 0, i2 = -1;
#pragma unroll
                    for (int i = 1; i < 4; ++i) {
                        const float x = ss[4 * g + i];
                        if (x > v1) { v2 = v1; i2 = i1; v1 = x; i1 = i; }
                        else if (x > v2) { v2 = x; i2 = i; }
                    }
                    const float sc = v1 + v2;
                    if (sc > gscore) { gscore = sc; gbest = g; l1b = i1; l2b = i2; }
                }
                const int e0 = 4 * gbest + l1b, e1 = 4 * gbest + l2b;
                float s0 = 0.f, s1v = 0.f;
#pragma unroll
                for (int e = 0; e < 16; ++e) { s0 = (e == e0) ? s[e] : s0; s1v = (e == e1) ? s[e] : s1v; }
                const float inv = 1.0f / (s0 + s1v);
                sel_e[2 * tid2] = e0; sel_e[2 * tid2 + 1] = e1; sel_g[2 * tid2] = s0 * inv; sel_g[2 * tid2 + 1] = s1v * inv;
                lrank[2 * tid2] = atomicAdd(&lcnt[e0], 1); lrank[2 * tid2 + 1] = atomicAdd(&lcnt[e1], 1);
            }
            __syncthreads();
            if (tid2 < 16) lbase[tid2] = atomicAdd(p.counts + tid2 * CNT_STRIDE, lcnt[tid2]);
            __syncthreads();
            if (tid2 < 128) {
                const int tl = tid2 >> 1, k = tid2 & 1, e = sel_e[2 * tl + k], r = lbase[e] + lrank[2 * tl + k];
                p.rtok[e * CAP + r] = tb + tl; p.rgate[e * CAP + r] = sel_g[2 * tl + k]; p.slot[2 * (tb + tl) + k] = e * CAP + r;
            }
            __syncthreads();
        }
    }
}

struct LnCombP { bf16* hb; const bf16* y; const int* slot; const int* counts; const float* g; const float* b; const float* wf; const float* bf; float* logf; float* outp; int do_f; int pad; };
__device__ __forceinline__ void ph_ln_comb(const LnCombP& p, unsigned char* lds, const int wv_s) {
    const int tid = opaque_tid(wv_s); const int lane = tid & 63, wv = tid >> 6;
    int* pstart = (int*)lds;
    f32x4* wl = (f32x4*)(lds + 2048);
    if (p.do_f) stage_w16(p.wf, NW_IN, wl, tid);
    if (tid == 0) { int acc = 0; for (int e = 0; e < NE; ++e) { pstart[e] = acc; acc += ((p.counts[e * CNT_STRIDE] + 255) >> 8) * 256; } }
    __syncthreads();
    u32x2 hr[RT][4], ya[RT][4], yb[RT][4];
    int nsl[RT][2];
#define LC_SLOTS(tk_) do { _Pragma("unroll") for (int t = 0; t < RT; ++t) { nsl[t][0] = p.slot[2 * ((tk_) + t)]; nsl[t][1] = p.slot[2 * ((tk_) + t) + 1]; } } while (0)
#define LC_ISSUE(tk_, ln_) do { _Pragma("unroll") for (int t = 0; t < RT; ++t) { \
        const int sl0 = nsl[t][0], sl1 = nsl[t][1]; \
        const int c0 = pstart[sl0 / CAP] + (sl0 % CAP), c1 = pstart[sl1 / CAP] + (sl1 % CAP); \
        _Pragma("unroll") for (int j = 0; j < 4; ++j) { hr[t][j] = *(const u32x2*)(p.hb + (size_t)((tk_) + t) * D + 4 * (ln_) + 256 * j); \
            ya[t][j] = *(const u32x2*)(p.y + (size_t)c0 * D + 4 * (ln_) + 256 * j); yb[t][j] = *(const u32x2*)(p.y + (size_t)c1 * D + 4 * (ln_) + 256 * j); } } } while (0)
    const int tok_first = (blockIdx.x * 8 + wv) * RT, tok_step = gridDim.x * 8 * RT;
    if (tok_first < M) { LC_SLOTS(tok_first); LC_ISSUE(tok_first, lane); if (tok_first + tok_step < M) LC_SLOTS(tok_first + tok_step); }
#pragma unroll 1
    for (int tok0 = tok_first; tok0 < M; tok0 += tok_step) {
        int lane_r = lane; asm volatile("" : "+v"(lane_r));
        f32x4 v[RT][4];
#pragma unroll
        for (int t = 0; t < RT; ++t)
#pragma unroll
            for (int j = 0; j < 4; ++j) { const u32x2 h2 = hr[t][j], a = ya[t][j], bq = yb[t][j];
                v[t][j].x = ALPHA * bf2f(h2.x & 0xffff) + (bf2f(a.x & 0xffff) + bf2f(bq.x & 0xffff));
                v[t][j].y = ALPHA * bf2f(h2.x >> 16) + (bf2f(a.x >> 16) + bf2f(bq.x >> 16));
                v[t][j].z = ALPHA * bf2f(h2.y & 0xffff) + (bf2f(a.y & 0xffff) + bf2f(bq.y & 0xffff));
                v[t][j].w = ALPHA * bf2f(h2.y >> 16) + (bf2f(a.y >> 16) + bf2f(bq.y >> 16)); }
        if (tok0 + tok_step < M) { LC_ISSUE(tok0 + tok_step, lane_r); if (tok0 + 2 * tok_step < M) LC_SLOTS(tok0 + 2 * tok_step); }
        ln_rowsN(v, p.g, p.b, lane_r);
        store_rowsN(v, p.outp, p.outp ? nullptr : p.hb, tok0, lane_r);
        if (p.do_f) {
            const float f = rowsN_dot16(v, wl, lane_r);
            if (lane_r < 16 * RT) p.logf[(size_t)(tok0 + (lane_r >> 4)) * 16 + (lane_r & 15)] = -softplusf_(-(f + p.bf[lane_r & 15]));
        }
    }
#undef LC_ISSUE
#undef LC_SLOTS
}

struct ScanP { const bf16* r; const bf16* k; const bf16* v; const _Float16* lw; const bf16* a; const bf16* g; bf16* yg;
               const float* kk; const float* ka; const float* rk; const float* gng; const float* gnb; };
__device__ __forceinline__ void ph_scan(const ScanP& p, unsigned char* lds, int nscan, const int wv_s) {
    typedef float (*arr64)[64];
    arr64 s_r = (arr64)lds, s_kk = (arr64)(lds + 8192), s_b = (arr64)(lds + 16384), s_w = (arr64)(lds + 24576), s_k = (arr64)(lds + 32768), s_v = (arr64)(lds + 40960), s_y = (arr64)(lds + 49152);
    float* s_bonus = (float*)(lds + 57344);
    const int tid = opaque_tid(wv_s);
    const int i = tid >> 3, jq = tid & 7;
    const int lt = tid >> 4, c4 = (tid & 15) * 4;
    for (int unit = blockIdx.x; unit < NB * H; unit += nscan) {
        const int b = unit / H, h = unit % H;
        f32x2 S[4];
#pragma unroll
        for (int j = 0; j < 4; ++j) S[j] = (f32x2){0.f, 0.f};
        const f32x4 kkp = *(const f32x4*)(p.kk + h * HD + c4), kap = *(const f32x4*)(p.ka + h * HD + c4), rkp = *(const f32x4*)(p.rk + h * HD + c4);
        const f32x4 gng = *(const f32x4*)(p.gng + h * HD + c4), gnb = *(const f32x4*)(p.gnb + h * HD + c4);
        typedef _Float16 h4 __attribute__((ext_vector_type(4)));
        size_t base = (size_t)(b * T + lt) * D + h * HD + c4;
        u32x2 r2 = *(const u32x2*)(p.r + base), k2 = *(const u32x2*)(p.k + base), v2 = *(const u32x2*)(p.v + base), a2 = *(const u32x2*)(p.a + base), g2 = *(const u32x2*)(p.g + base);
        h4 lwh = *(const h4*)(p.lw + base);
        for (int blk = 0; blk < T / 32; ++blk) {
            const size_t obase = base;
            const u32x2 g2c = g2;
            {
                const f32x4 lw4 = {(float)lwh[0], (float)lwh[1], (float)lwh[2], (float)lwh[3]};
                const f32x4 rr = {bf2f(r2.x & 0xffff), bf2f(r2.x >> 16), bf2f(r2.y & 0xffff), bf2f(r2.y >> 16)};
                const f32x4 kr = {bf2f(k2.x & 0xffff), bf2f(k2.x >> 16), bf2f(k2.y & 0xffff), bf2f(k2.y >> 16)};
                const f32x4 vv = {bf2f(v2.x & 0xffff), bf2f(v2.x >> 16), bf2f(v2.y & 0xffff), bf2f(v2.y >> 16)};
                const f32x4 aa = {bf2f(a2.x & 0xffff), bf2f(a2.x >> 16), bf2f(a2.y & 0xffff), bf2f(a2.y >> 16)};
                const f32x4 kkn = kr * kkp;
                const float ss = red16((kkn.x * kkn.x + kkn.y * kkn.y) + (kkn.z * kkn.z + kkn.w * kkn.w));
                const float inv = fminf(__builtin_amdgcn_rsqf(ss), 1e12f);
                const f32x4 kkv = kkn * inv;
                const f32x4 km = kr * (1.0f + (aa - 1.0f) * kap);
                const f32x4 bb = kkv * aa;
                f32x4 wd; wd.x = __expf(lw4.x); wd.y = __expf(lw4.y); wd.z = __expf(lw4.z); wd.w = __expf(lw4.w);
                const f32x4 bt = rr * km * rkp;
                const float bo = red16((bt.x + bt.y) + (bt.z + bt.w));
                *(f32x4*)&s_r[lt][c4] = rr; *(f32x4*)&s_kk[lt][c4] = kkv; *(f32x4*)&s_b[lt][c4] = bb; *(f32x4*)&s_w[lt][c4] = wd;
                *(f32x4*)&s_k[lt][c4] = km; *(f32x4*)&s_v[lt][c4] = vv;
                if ((tid & 15) == 0) s_bonus[lt] = bo;
            }
            __syncthreads();
            if (blk + 1 < T / 32) {
                base += (size_t)32 * D;
                r2 = *(const u32x2*)(p.r + base); k2 = *(const u32x2*)(p.k + base); v2 = *(const u32x2*)(p.v + base); a2 = *(const u32x2*)(p.a + base); g2 = *(const u32x2*)(p.g + base);
                lwh = *(const h4*)(p.lw + base);
            }
#define SC_LOAD(X, tt_) do { X##k0 = *(const f32x4*)&s_kk[tt_][8 * jq]; X##k1 = *(const f32x4*)&s_kk[tt_][8 * jq + 4]; X##w0 = *(const f32x4*)&s_w[tt_][8 * jq]; X##w1 = *(const f32x4*)&s_w[tt_][8 * jq + 4]; \
                X##b0 = *(const f32x4*)&s_b[tt_][8 * jq]; X##b1 = *(const f32x4*)&s_b[tt_][8 * jq + 4]; X##q0 = *(const f32x4*)&s_k[tt_][8 * jq]; X##q1 = *(const f32x4*)&s_k[tt_][8 * jq + 4]; \
                X##r0 = *(const f32x4*)&s_r[tt_][8 * jq]; X##r1 = *(const f32x4*)&s_r[tt_][8 * jq + 4]; X##vi = s_v[tt_][i]; } while (0)
#define SC_STEP(X, tt_) do { \
                const f32x2 d_ = S[0] * (f32x2){X##k0.x, X##k0.y} + S[1] * (f32x2){X##k0.z, X##k0.w} + S[2] * (f32x2){X##k1.x, X##k1.y} + S[3] * (f32x2){X##k1.z, X##k1.w}; \
                const float sa_ = red8(d_.x + d_.y); \
                S[0] = S[0] * (f32x2){X##w0.x, X##w0.y} - sa_ * (f32x2){X##b0.x, X##b0.y} + X##vi * (f32x2){X##q0.x, X##q0.y}; \
                S[1] = S[1] * (f32x2){X##w0.z, X##w0.w} - sa_ * (f32x2){X##b0.z, X##b0.w} + X##vi * (f32x2){X##q0.z, X##q0.w}; \
                S[2] = S[2] * (f32x2){X##w1.x, X##w1.y} - sa_ * (f32x2){X##b1.x, X##b1.y} + X##vi * (f32x2){X##q1.x, X##q1.y}; \
                S[3] = S[3] * (f32x2){X##w1.z, X##w1.w} - sa_ * (f32x2){X##b1.z, X##b1.w} + X##vi * (f32x2){X##q1.z, X##q1.w}; \
                const f32x2 e_ = S[0] * (f32x2){X##r0.x, X##r0.y} + S[1] * (f32x2){X##r0.z, X##r0.w} + S[2] * (f32x2){X##r1.x, X##r1.y} + S[3] * (f32x2){X##r1.z, X##r1.w}; \
                const float y_ = red8(e_.x + e_.y); \
                if (jq == 0) s_y[tt_][i] = y_; } while (0)
            f32x4 Ak0, Ak1, Aw0, Aw1, Ab0, Ab1, Aq0, Aq1, Ar0, Ar1, Bk0, Bk1, Bw0, Bw1, Bb0, Bb1, Bq0, Bq1, Br0, Br1; float Avi, Bvi;
            SC_LOAD(A, 0);
            for (int tt = 0; tt < 32; tt += 2) {
                SC_LOAD(B, tt + 1);
                SC_STEP(A, tt);
                { const int tn = (tt + 2) & 31; SC_LOAD(A, tn); }
                SC_STEP(B, tt + 1);
            }
#undef SC_LOAD
#undef SC_STEP
            __syncthreads();
            {
                const f32x4 y4 = *(const f32x4*)&s_y[lt][c4];
                const float mu = red16((y4.x + y4.y) + (y4.z + y4.w)) * (1.f / 64.f);
                const f32x4 dd = y4 - mu;
                const float rstd = rsqrtf(red16((dd.x * dd.x + dd.y * dd.y) + (dd.z * dd.z + dd.w * dd.w)) * (1.f / 64.f) + GN_EPS);
                const f32x4 vv = *(const f32x4*)&s_v[lt][c4];
                const float bo = s_bonus[lt];
                const f32x4 gg = {bf2f(g2c.x & 0xffff), bf2f(g2c.x >> 16), bf2f(g2c.y & 0xffff), bf2f(g2c.y >> 16)};
                const f32x4 o = (dd * rstd * gng + gnb + bo * vv) * gg;
                u32x2 ob; ob.x = pk2(o.x, o.y); ob.y = pk2(o.z, o.w);
                *(u32x2*)(p.yg + obase) = ob;
            }
            __syncthreads();
        }
    }
}

namespace sc {
constexpr int GLD = 64;
__device__ __forceinline__ int swz(int row, int col) { return row * GLD + ((((col >> 3) ^ row) & 7) << 3) + (col & 7); }
constexpr int BUFB = 64 * GLD * 2;
constexpr int B_KKD = 0, B_RD = 1, B_BINV = 2, B_KINV = 3, B_VT = 4, B_KDT = 5, B_NBDT = 6, B_SB = 7, B_M = 8, B_NQ = 9;
constexpr int B_XT = B_KKD, B_N = B_BINV, B_P = B_KINV;
constexpr int MS = 68;
constexpr int F_M = 10 * BUFB, F_R = F_M + 64 * MS * 4, PART = F_R + 64 * 65 * 4, GT = PART + 2 * 8 * 64 * 4, BON = GT + 256, SCR = BON + 256, END = SCR + 4 * 4096;
constexpr int LD16 = 24, O_XR = 0, O_XT = 768, O_TR = 1536, O_RT = 2304, O_TD = 3072;
static_assert(END <= 147392, "scan LDS");
__device__ __forceinline__ bf16* buf(unsigned char* lds, int i) { return (bf16*)(lds + i * BUFB); }
__device__ __forceinline__ bf16* xtb(unsigned char* lds) { return (bf16*)(lds + SCR); }
__device__ __forceinline__ void tile_mma(f32x4& acc, const bf16* A, int arow0, const bf16* Bt, int brow0, int fr, int fq) {
#pragma unroll
    for (int kk = 0; kk < 2; ++kk) {
        const bf16x8 a = *(const bf16x8*)&A[swz(arow0 + fr, kk * 32 + 8 * fq)];
        const bf16x8 b = *(const bf16x8*)&Bt[swz(brow0 + fr, kk * 32 + 8 * fq)];
        acc = __builtin_amdgcn_mfma_f32_16x16x32_bf16(a, b, acc, 0, 0, 0);
    }
}
__device__ __forceinline__ unsigned cvtpk(float lo, float hi);
__device__ __forceinline__ bf16 cvt1(float x);
__device__ __forceinline__ void mm16(f32x4& acc, const bf16* A, const bf16* Bt, int fr, int fq) {
    bf16x8 a = (bf16x8){0, 0, 0, 0, 0, 0, 0, 0}, b = a;
    if (fq < 2) { a = *(const bf16x8*)&A[fr * LD16 + 8 * fq]; b = *(const bf16x8*)&Bt[fr * LD16 + 8 * fq]; }
    acc = __builtin_amdgcn_mfma_f32_16x16x32_bf16(a, b, acc, 0, 0, 0);
}
__device__ __forceinline__ void wr_rm(bf16* R, const f32x4 v, int fr, int fq) {
#pragma unroll
    for (int i = 0; i < 4; ++i) R[(4 * fq + i) * LD16 + fr] = cvt1(v[i]);
}
__device__ __forceinline__ void wr_tr(bf16* Tt, const f32x4 v, int fr, int fq) { u32x2 o; o.x = cvtpk(v[0], v[1]); o.y = cvtpk(v[2], v[3]); *(u32x2*)&Tt[fr * LD16 + 4 * fq] = o; }
#define SC_LWAIT() asm volatile("s_waitcnt lgkmcnt(0)" ::: "memory")
typedef short s16x4 __attribute__((ext_vector_type(4)));
__device__ __forceinline__ s16x4 pk4(const f32x4 v) { u32x2 o; o.x = cvtpk(v[0], v[1]); o.y = cvtpk(v[2], v[3]); return __builtin_bit_cast(s16x4, o); }
__device__ __forceinline__ f32x4 mm16k(const s16x4 a, const s16x4 b, const f32x4 c) { return __builtin_amdgcn_mfma_f32_16x16x16bf16_1k(a, b, c, 0, 0, 0); }
constexpr int MP = 20, MDS = 16 * MP;
constexpr int PRM = F_M + 8192;
__device__ __forceinline__ void cvt8(const u32x4 v, float (&o)[8]) {
    o[0] = bf2f(v.x & 0xffff); o[1] = bf2f(v.x >> 16); o[2] = bf2f(v.y & 0xffff); o[3] = bf2f(v.y >> 16);
    o[4] = bf2f(v.z & 0xffff); o[5] = bf2f(v.z >> 16); o[6] = bf2f(v.w & 0xffff); o[7] = bf2f(v.w >> 16);
}
typedef __bf16 bf16x2_hw __attribute__((ext_vector_type(2)));
__device__ __forceinline__ unsigned cvtpk(float lo, float hi) { const f32x2 v = {lo, hi}; const bf16x2_hw b = __builtin_convertvector(v, bf16x2_hw); return __builtin_bit_cast(unsigned, b); }
__device__ __forceinline__ bf16 cvt1(float x) { return (bf16)(cvtpk(x, x) & 0xffffu); }
__device__ __forceinline__ u32x4 pack8(const float (&x)[8]) { u32x4 o; o.x = cvtpk(x[0], x[1]); o.y = cvtpk(x[2], x[3]); o.z = cvtpk(x[4], x[5]); o.w = cvtpk(x[6], x[7]); return o; }
}

__device__ __forceinline__ void ph_scan_chunk(const ScanP& p, unsigned char* lds, int nscan, const int wv_s) {
    using namespace sc;
    const int w = wv_s;
#define SC_LANES const int tid = opaque_tid(wv_s), lane = tid & 63, fr = lane & 15, fq = lane >> 4; (void)fr; (void)fq; (void)tid
    float* Mf = (float*)(lds + F_M); float* Rf = (float*)(lds + F_R); float* part = (float*)(lds + PART); float* gt = (float*)(lds + GT); float* bon = (float*)(lds + BON);
    typedef _Float16 h8 __attribute__((ext_vector_type(8)));
    for (int unit = blockIdx.x; unit < NB * H; unit += nscan) {
        const int b = unit / H, h = unit % H;
        __syncthreads();
        f32x4 Sreg[2];
        Sreg[0] = Sreg[1] = (f32x4){0.f, 0.f, 0.f, 0.f};
        size_t base;
        { SC_LANES; base = (size_t)(b * T + lane) * D + h * HD + 8 * w;
        for (int z = tid; z < BUFB / 4; z += 512) ((unsigned*)buf(lds, B_SB))[z] = 0u;
        }
        float* prm = (float*)(lds + PRM);
        size_t ob;
        { SC_LANES; const int n8 = (tid & 7) * 8;
          if (tid < 64) { prm[tid] = p.kk[h * HD + tid]; prm[64 + tid] = p.ka[h * HD + tid]; prm[128 + tid] = p.rk[h * HD + tid]; prm[192 + tid] = p.gng[h * HD + tid]; prm[256 + tid] = p.gnb[h * HD + tid]; }
          ob = (size_t)(b * T + (tid >> 3)) * D + h * HD + n8; }
        u32x4 vg, gg8;
        u32x4 r8 = *(const u32x4*)(p.r + base), k8 = *(const u32x4*)(p.k + base), v8 = *(const u32x4*)(p.v + base), a8 = *(const u32x4*)(p.a + base);
        h8 lw8 = *(const h8*)(p.lw + base);
        __syncthreads();
        for (int ch = 0; ch < T / 64; ++ch) {
            {   SC_LANES;
            float rr[8], kr[8], aa[8], lwf[8];
            cvt8(r8, rr); cvt8(k8, kr); cvt8(a8, aa);
#pragma unroll
            for (int q = 0; q < 8; ++q) lwf[q] = (float)lw8[q];
            float kkn[8], km[8]; float ssp = 0.f, bop = 0.f;
#pragma unroll
            for (int q = 0; q < 8; ++q) { const float kkp = prm[8 * w + q], kap = prm[64 + 8 * w + q], rkp = prm[128 + 8 * w + q];
                kkn[q] = kr[q] * kkp; ssp += kkn[q] * kkn[q]; km[q] = kr[q] * (1.0f + (aa[q] - 1.0f) * kap); bop += rr[q] * km[q] * rkp; }
            part[w * 64 + lane] = ssp; part[512 + w * 64 + lane] = bop;
            float cum[8];
#pragma unroll
            for (int q = 0; q < 8; ++q) cum[q] = lwf[q];
#define SC_DPP8(ctl) "v_add_f32_dpp %0, %0, %0 " ctl "\n\tv_add_f32_dpp %1, %1, %1 " ctl "\n\tv_add_f32_dpp %2, %2, %2 " ctl "\n\tv_add_f32_dpp %3, %3, %3 " ctl "\n\t" \
                     "v_add_f32_dpp %4, %4, %4 " ctl "\n\tv_add_f32_dpp %5, %5, %5 " ctl "\n\tv_add_f32_dpp %6, %6, %6 " ctl "\n\tv_add_f32_dpp %7, %7, %7 " ctl "\n\t"
            asm volatile("s_nop 1\n\t"
                         SC_DPP8("row_shr:1 row_mask:0xf bank_mask:0xf bound_ctrl:1") SC_DPP8("row_shr:2 row_mask:0xf bank_mask:0xf bound_ctrl:1")
                         SC_DPP8("row_shr:4 row_mask:0xf bank_mask:0xf bound_ctrl:1") SC_DPP8("row_shr:8 row_mask:0xf bank_mask:0xf bound_ctrl:1")
                         SC_DPP8("row_bcast:15 row_mask:0xa bank_mask:0xf") SC_DPP8("row_bcast:31 row_mask:0xc bank_mask:0xf")
                         : "+v"(cum[0]), "+v"(cum[1]), "+v"(cum[2]), "+v"(cum[3]), "+v"(cum[4]), "+v"(cum[5]), "+v"(cum[6]), "+v"(cum[7]));
#undef SC_DPP8
            __syncthreads();
            float ss = 0.f, bo = 0.f;
#pragma unroll
            for (int q = 0; q < 8; ++q) { ss += part[q * 64 + lane]; bo += part[512 + q * 64 + lane]; }
            const float inv = fminf(__builtin_amdgcn_rsqf(ss), 1e12f);
            {
                float o_kkd[8], o_rd[8], o_binv[8], o_kinv[8];
                bf16* bVT = buf(lds, B_VT); bf16* bKDT = buf(lds, B_KDT); bf16* bNBDT = buf(lds, B_NBDT);
#pragma unroll
                for (int q = 0; q < 8; ++q) {
                    const float kkv = kkn[q] * inv, bb = kkv * aa[q];
                    const float e_c = __builtin_amdgcn_exp2f(cum[q]), e_n = __builtin_amdgcn_exp2f(-cum[q]);
                    const float e_tot = __int_as_float(__builtin_amdgcn_readlane(__float_as_int(e_c), 63));
                    const float e_x = __int_as_float(__builtin_amdgcn_update_dpp(0x3f800000, __float_as_int(e_c), 0x138, 0xF, 0xF, false));
                    const float e_t = e_tot * e_n;
                    o_kkd[q] = kkv * e_x; o_rd[q] = rr[q] * e_c; o_binv[q] = bb * e_n; o_kinv[q] = km[q] * e_n;
                    bVT[swz(8 * w + q, lane)] = (bf16)((q & 1) ? (v8[q >> 1] >> 16) : (v8[q >> 1] & 0xffffu));
                    const unsigned kb = cvtpk(km[q] * e_t, -bb * e_t);
                    bKDT[swz(8 * w + q, lane)] = (bf16)(kb & 0xffffu);
                    bNBDT[swz(8 * w + q, lane)] = (bf16)(kb >> 16);
                    if (lane == 0) gt[8 * w + q] = e_tot;
                }
                *(u32x4*)&buf(lds, B_KKD)[swz(lane, 8 * w)] = pack8(o_kkd); *(u32x4*)&buf(lds, B_RD)[swz(lane, 8 * w)] = pack8(o_rd);
                *(u32x4*)&buf(lds, B_BINV)[swz(lane, 8 * w)] = pack8(o_binv); *(u32x4*)&buf(lds, B_KINV)[swz(lane, 8 * w)] = pack8(o_kinv);
                if (w == 0) bon[lane] = bo;
            }
            }
            __syncthreads();
            {   SC_LANES;
                const int m = w >> 1;
                const bf16* A = buf(lds, (m & 1) ? B_KINV : B_BINV); const bf16* Bt = buf(lds, m < 2 ? B_KKD : B_RD);
                f32x4 acc[8];
#pragma unroll
                for (int q = 0; q < 8; ++q) { const int tt = (w & 1) * 2 + (q >> 2), st = q & 3; acc[q] = (f32x4){0.f, 0.f, 0.f, 0.f}; tile_mma(acc[q], A, 16 * st, Bt, 16 * tt, fr, fq); }
                __syncthreads();
                {
                    const float sgn = (m == 2) ? -1.f : 1.f;
                    bf16* dst = buf(lds, m == 0 ? B_M : (m == 1 ? B_N : (m == 2 ? B_NQ : B_P)));
#pragma unroll
                    for (int q = 0; q < 8; ++q) { const int tt = (w & 1) * 2 + (q >> 2), st = q & 3; const int t = 16 * tt + fr, s0 = 16 * st + 4 * fq;
                        f32x4 val;
#pragma unroll
                        for (int i = 0; i < 4; ++i) { const int s = s0 + i; const float keep = (m < 2) ? ((s < t) ? 1.f : 0.f) : ((s <= t) ? sgn : 0.f); val[i] = acc[q][i] * keep; }
                        if (m == 0) { if (st == tt) *(f32x4*)&Mf[tt * MDS + fr * MP + 4 * fq] = val; val = -val; }
                        u32x2 o; o.x = cvtpk(val[0], val[1]); o.y = cvtpk(val[2], val[3]);
                        *(u32x2*)&dst[swz(t, s0)] = o; }
                }
            }
            __syncthreads();
            vg = *(const u32x4*)(p.v + ob); gg8 = *(const u32x4*)(p.g + ob);
            if (ch + 1 < T / 64) { base += (size_t)64 * D; r8 = *(const u32x4*)(p.r + base); k8 = *(const u32x4*)(p.k + base); v8 = *(const u32x4*)(p.v + base); a8 = *(const u32x4*)(p.a + base); lw8 = *(const h8*)(p.lw + base); }
#define SC_LD2(dst, img, row0) { dst[0] = *(const bf16x8*)&(img)[swz((row0) + fr, 8 * fq)]; dst[1] = *(const bf16x8*)&(img)[swz((row0) + fr, 32 + 8 * fq)]; }
#define SC_MM(acc, a, b) acc = __builtin_amdgcn_mfma_f32_16x16x32_bf16(a, b, acc, 0, 0, 0)
            f32x4 yacc[4];
            {   SC_LANES;
                const f32x4 z4 = (f32x4){0.f, 0.f, 0.f, 0.f};
                if (w < 4) {
                    bf16x8 bS[2], bV[2], aK[4][2], aN[4][2];
                    SC_LD2(bS, buf(lds, B_SB), 16 * w); SC_LD2(bV, buf(lds, B_VT), 16 * w);
#pragma unroll
                    for (int mt = 0; mt < 4; ++mt) { SC_LD2(aK[mt], buf(lds, B_KKD), 16 * mt); SC_LD2(aN[mt], buf(lds, B_N), 16 * mt); }
                    f32x4 cX[4], cXt[4], cTt[4];
#pragma unroll
                    for (int d = 0; d < 4; ++d) { const float* Md = Mf + d * MDS; cXt[d] = *(const f32x4*)&Md[fr * MP + 4 * fq];
#pragma unroll
                        for (int i = 0; i < 4; ++i) cX[d][i] = Md[(4 * fq + i) * MP + fr]; }
                    s16x4 nM[6];
#pragma unroll
                    for (int e = 0; e < 6; ++e) { const int bc = e < 3 ? 0 : (e < 5 ? 1 : 2), br = e < 3 ? e + 1 : (e < 5 ? e - 1 : 3);
                        nM[e] = *(const s16x4*)&buf(lds, B_M)[swz(16 * br + fr, 16 * bc + 4 * fq)]; }
                    SC_LWAIT();
                    f32x4 racc[4];
#pragma unroll
                    for (int mt = 0; mt < 4; ++mt) { racc[mt] = z4; SC_MM(racc[mt], aK[mt][0], bS[0]); }
#pragma unroll
                    for (int mt = 0; mt < 4; ++mt) SC_MM(racc[mt], aK[mt][1], bS[1]);
#pragma unroll
                    for (int mt = 0; mt < 4; ++mt) SC_MM(racc[mt], aN[mt][0], bV[0]);
#pragma unroll
                    for (int mt = 0; mt < 4; ++mt) SC_MM(racc[mt], aN[mt][1], bV[1]);
                    s16x4 pA[4], pAt[4], TT[4];
                    f32x4 XA[4], XB[4];
#pragma unroll
                    for (int d = 0; d < 4; ++d) { pA[d] = pk4(cX[d]); pAt[d] = pk4(cXt[d]);
#pragma unroll
                        for (int i = 0; i < 4; ++i) cTt[d][i] = ((4 * fq + i) == fr ? 1.f : 0.f) - cXt[d][i]; }
#pragma unroll
                    for (int st = 0; st < 3; ++st) {
#pragma unroll
                        for (int d = 0; d < 4; ++d) XA[d] = mm16k(pAt[d], pA[d], z4);
                        if (st < 2) {
#pragma unroll
                            for (int d = 0; d < 4; ++d) XB[d] = mm16k(pA[d], pAt[d], z4);
                        }
#pragma unroll
                        for (int d = 0; d < 4; ++d) TT[d] = pk4(cTt[d]);
#pragma unroll
                        for (int d = 0; d < 4; ++d) pA[d] = pk4(XA[d]);
#pragma unroll
                        for (int d = 0; d < 4; ++d) cTt[d] = mm16k(pA[d], TT[d], cTt[d]);
                        if (st < 2) {
#pragma unroll
                            for (int d = 0; d < 4; ++d) pAt[d] = pk4(XB[d]);
                        }
                    }
#pragma unroll
                    for (int d = 0; d < 4; ++d) TT[d] = pk4(cTt[d]);
#pragma unroll
                    for (int blk = 0; blk < 4; ++blk) {
                        const f32x4 xx = mm16k(TT[blk], pk4(racc[blk]), z4);
                        const s16x4 pxx = pk4(xx);
                        *(s16x4*)&xtb(lds)[swz(16 * w + fr, 16 * blk + 4 * fq)] = pxx;
#pragma unroll
                        for (int br = blk + 1; br < 4; ++br) { const int e = blk == 0 ? br - 1 : (blk == 1 ? br + 1 : 5); racc[br] = mm16k(nM[e], pxx, racc[br]); }
                    }
                } else {
                    const int mt = w - 4;
                    bf16x8 aR[2], aP[2], bS[4][2], bV[4][2];
                    SC_LD2(aR, buf(lds, B_RD), 16 * mt); SC_LD2(aP, buf(lds, B_P), 16 * mt);
#pragma unroll
                    for (int nt = 0; nt < 4; ++nt) { SC_LD2(bS[nt], buf(lds, B_SB), 16 * nt); SC_LD2(bV[nt], buf(lds, B_VT), 16 * nt); }
                    asm volatile("s_waitcnt lgkmcnt(0)" : "+v"(aR[0]), "+v"(aR[1]), "+v"(aP[0]), "+v"(aP[1]), "+v"(bS[0][0]), "+v"(bS[0][1]), "+v"(bS[1][0]), "+v"(bS[1][1]), "+v"(bS[2][0]), "+v"(bS[2][1]),
                                 "+v"(bS[3][0]), "+v"(bS[3][1]), "+v"(bV[0][0]), "+v"(bV[0][1]), "+v"(bV[1][0]), "+v"(bV[1][1]), "+v"(bV[2][0]), "+v"(bV[2][1]), "+v"(bV[3][0]), "+v"(bV[3][1]) :: "memory");
#pragma unroll
                    for (int nt = 0; nt < 4; ++nt) { yacc[nt] = z4; SC_MM(yacc[nt], aR[0], bS[nt][0]); }
#pragma unroll
                    for (int nt = 0; nt < 4; ++nt) SC_MM(yacc[nt], aR[1], bS[nt][1]);
#pragma unroll
                    for (int nt = 0; nt < 4; ++nt) SC_MM(yacc[nt], aP[0], bV[nt][0]);
#pragma unroll
                    for (int nt = 0; nt < 4; ++nt) SC_MM(yacc[nt], aP[1], bV[nt][1]);
                }
            }
            __syncthreads();
            {   SC_LANES;
                const int mt6 = w >> 1, nt6 = 2 * (w & 1);
                bf16x8 aV[2], aX[2], bK[2][2], bB[2][2], aQ[2], bX[4][2];
                SC_LD2(aV, buf(lds, B_VT), 16 * mt6); SC_LD2(aX, xtb(lds), 16 * mt6);
#pragma unroll
                for (int q = 0; q < 2; ++q) { SC_LD2(bK[q], buf(lds, B_KDT), 16 * (nt6 + q)); SC_LD2(bB[q], buf(lds, B_NBDT), 16 * (nt6 + q)); }
                const float g0 = gt[16 * nt6 + fr], g1 = gt[16 * nt6 + 16 + fr];
                if (w >= 4) {
                    SC_LD2(aQ, buf(lds, B_NQ), 16 * (w - 4));
#pragma unroll
                    for (int nt = 0; nt < 4; ++nt) SC_LD2(bX[nt], xtb(lds), 16 * nt);
                }
                SC_LWAIT();
                if (w >= 4) {
#pragma unroll
                    for (int nt = 0; nt < 4; ++nt) SC_MM(yacc[nt], aQ[0], bX[nt][0]);
#pragma unroll
                    for (int nt = 0; nt < 4; ++nt) SC_MM(yacc[nt], aQ[1], bX[nt][1]);
                }
                f32x4 s0 = Sreg[0] * g0, s1 = Sreg[1] * g1;
                SC_MM(s0, aV[0], bK[0][0]); SC_MM(s1, aV[0], bK[1][0]); SC_MM(s0, aV[1], bK[0][1]); SC_MM(s1, aV[1], bK[1][1]);
                SC_MM(s0, aX[0], bB[0][0]); SC_MM(s1, aX[0], bB[1][0]); SC_MM(s0, aX[1], bB[0][1]); SC_MM(s1, aX[1], bB[1][1]);
                Sreg[0] = s0; Sreg[1] = s1;
                if (w >= 4) {
#pragma unroll
                    for (int nt = 0; nt < 4; ++nt) {
#pragma unroll
                        for (int i = 0; i < 4; ++i) Rf[(16 * (w - 4) + 4 * fq + i) * 65 + 16 * nt + fr] = yacc[nt][i]; }
                }
#pragma unroll
                for (int i = 0; i < 4; ++i) { buf(lds, B_SB)[swz(16 * mt6 + 4 * fq + i, 16 * nt6 + fr)] = cvt1(s0[i]); buf(lds, B_SB)[swz(16 * mt6 + 4 * fq + i, 16 * nt6 + 16 + fr)] = cvt1(s1[i]); }
            }
            __syncthreads();
#undef SC_LD2
#undef SC_MM
            {   SC_LANES;
                const int t = tid >> 3, n8 = (tid & 7) * 8;
                float y[8], vf[8], gf[8]; cvt8(vg, vf); cvt8(gg8, gf);
                float sm = 0.f;
#pragma unroll
                for (int q = 0; q < 8; ++q) { y[q] = Rf[t * 65 + n8 + q]; sm += y[q]; }
                const float mu = red8(sm) * (1.f / 64.f);
                float vs = 0.f;
#pragma unroll
                for (int q = 0; q < 8; ++q) { y[q] -= mu; vs += y[q] * y[q]; }
                const float rstd = rsqrtf(red8(vs) * (1.f / 64.f) + GN_EPS);
                const float bo2 = bon[t];
                float o[8];
#pragma unroll
                for (int q = 0; q < 8; ++q) o[q] = (y[q] * rstd * prm[192 + n8 + q] + prm[256 + n8 + q] + bo2 * vf[q]) * gf[q];
                *(u32x4*)(p.yg + ob) = pack8(o);
                ob += (size_t)64 * D;
            }
        }
    }
#undef SC_LANES
}
namespace sc2 {
using namespace sc;
constexpr int IMG = 8192;
constexpr int O_KKD = 0, O_RD = 1, O_N = 2, O_P = 3, O_VT = 4, O_KDT = 5, O_NBDT = 6, O_NQ = 7;
constexpr int O_MC = 8 * IMG, O_TT = O_MC + 3072, O_GT = O_TT + 2048, O_BON = O_GT + 256, SETB = O_BON + 256;
constexpr int RFP = 68;
constexpr int RF = 2 * SETB, PARTO = RF + 64 * RFP * 4, PRMO = PARTO + 2048, END2 = PRMO + 1280;
constexpr int SYNCO = END2;
static_assert(SYNCO + 64 <= 163776, "scan LDS");
__device__ __forceinline__ bf16* img(unsigned char* lds, int setb, int i) { return (bf16*)(lds + setb + i * IMG); }
__device__ __forceinline__ bf16x8 ld128(const bf16* im, int row, int col) { return *(const bf16x8*)&im[swz(row, col)]; }
__device__ __forceinline__ s16x4 ld64(const bf16* im, int row, int col) { return *(const s16x4*)&im[swz(row, col)]; }
__device__ __forceinline__ f32x4 mm32(const bf16x8 a, const bf16x8 b, const f32x4 c) { return __builtin_amdgcn_mfma_f32_16x16x32_bf16(a, b, c, 0, 0, 0); }
__device__ __forceinline__ void grp_arrive(LAS unsigned* cnt, int lane) {
    asm volatile("s_waitcnt lgkmcnt(0)" ::: "memory");
    if (lane == 0) (void)__hip_atomic_fetch_add(cnt, 1u, __ATOMIC_RELAXED, __HIP_MEMORY_SCOPE_WORKGROUP);
    asm volatile("" ::: "memory");
}
__device__ __forceinline__ void grp_wait(LAS unsigned* cnt, unsigned target) {
    while ((unsigned)__builtin_amdgcn_readfirstlane((int)__hip_atomic_load(cnt, __ATOMIC_RELAXED, __HIP_MEMORY_SCOPE_WORKGROUP)) < target) __builtin_amdgcn_s_sleep(1);
    asm volatile("" ::: "memory");
}
__device__ __forceinline__ void grp_sync(LAS unsigned* cnt, unsigned target, int lane) {
    asm volatile("s_waitcnt lgkmcnt(0)" ::: "memory");
    if (lane == 0) (void)__hip_atomic_fetch_add(cnt, 1u, __ATOMIC_RELAXED, __HIP_MEMORY_SCOPE_WORKGROUP);
    while ((unsigned)__builtin_amdgcn_readfirstlane((int)__hip_atomic_load(cnt, __ATOMIC_RELAXED, __HIP_MEMORY_SCOPE_WORKGROUP)) < target) __builtin_amdgcn_s_sleep(1);
    asm volatile("" ::: "memory");
}
}

__device__ __forceinline__ void pc_out(const ScanP& p, const float* Rf, const float* prm, const float bo2, const u32x4 (&vg)[2], const u32x4 (&gg)[2], size_t ob, int w, int lane) {
    using namespace sc2;
    const int tc = w * 64 + lane, t = tc >> 2, qd = tc & 3;
    float y[2][8], vf[2][8], gf[2][8]; cvt8(vg[0], vf[0]); cvt8(vg[1], vf[1]); cvt8(gg[0], gf[0]); cvt8(gg[1], gf[1]);
    float sm = 0.f;
#pragma unroll
    for (int j = 0; j < 4; ++j) { const f32x4 yy = *(const f32x4*)&Rf[t * RFP + 16 * qd + 4 * j]; y[j >> 1][4 * (j & 1)] = yy[0]; y[j >> 1][4 * (j & 1) + 1] = yy[1]; y[j >> 1][4 * (j & 1) + 2] = yy[2]; y[j >> 1][4 * (j & 1) + 3] = yy[3];
        sm += (yy[0] + yy[1]) + (yy[2] + yy[3]); }
    sm += dppx<0xB1>(sm); sm += dppx<0x4E>(sm);
    const float mu = sm * (1.f / 64.f);
    float vs = 0.f;
#pragma unroll
    for (int q = 0; q < 16; ++q) { y[q >> 3][q & 7] -= mu; vs += y[q >> 3][q & 7] * y[q >> 3][q & 7]; }
    vs += dppx<0xB1>(vs); vs += dppx<0x4E>(vs);
    const float rstd = rsqrtf(vs * (1.f / 64.f) + GN_EPS);
    float o[2][8];
#pragma unroll
    for (int q = 0; q < 16; ++q) o[q >> 3][q & 7] = (y[q >> 3][q & 7] * rstd * prm[192 + 16 * qd + q] + prm[256 + 16 * qd + q] + bo2 * vf[q >> 3][q & 7]) * gf[q >> 3][q & 7];
    *(u32x4*)(p.yg + ob) = pack8(o[0]); *(u32x4*)(p.yg + ob + 512) = pack8(o[1]);
}

__device__ __forceinline__ void ph_scan_pc(const ScanP& p, unsigned char* lds, int nscan, const int wv_s) {
    using namespace sc2;
    const int w = wv_s;
#define SC_LANES const int tid = opaque_tid(wv_s), lane = tid & 63, fr = lane & 15, fq = lane >> 4; (void)fr; (void)fq; (void)tid
    typedef _Float16 h8 __attribute__((ext_vector_type(8)));
    float* Rf = (float*)(lds + RF); float* part = (float*)(lds + PARTO); float* prm = (float*)(lds + PRMO);
    const f32x4 z4 = (f32x4){0.f, 0.f, 0.f, 0.f};
    (void)nscan;
    {   const int unit = blockIdx.x;
        const int b = unit / H, h = unit % H;
        __syncthreads();
        { SC_LANES; if (tid == 0) { ((LAS unsigned*)(lds + SYNCO))[0] = 0u; ((LAS unsigned*)(lds + SYNCO))[1] = 0u; }
          if (tid < 64) { prm[tid] = p.kk[h * HD + tid]; prm[64 + tid] = p.ka[h * HD + tid]; prm[128 + tid] = p.rk[h * HD + tid]; prm[192 + tid] = p.gng[h * HD + tid]; prm[256 + tid] = p.gnb[h * HD + tid]; } }
        f32x4 ST[4]; ST[0] = ST[1] = ST[2] = ST[3] = z4;
        s16x4 pxx[4];
        u32x4 vg[2], gg[2];
        float bo_out = 0.f;
        u32x4 r8[2], k8[2], v8[2], v8n[2], a8[2]; h8 lw8[2];
        size_t pbase = 0, sbase = 0, ob = 0, vb = 0, yb = 0;
        { SC_LANES;
          if (w >= 4) { pbase = (size_t)(b * T + lane) * D + h * HD + 16 * (w - 4);
              sbase = pg8::scan_idx(b * T + lane, h * HD + 16 * (w - 4));
#pragma unroll
              for (int o = 0; o < 2; ++o) { r8[o] = *(const u32x4*)(p.r + sbase + 512 * o); k8[o] = *(const u32x4*)(p.k + sbase + 512 * o); v8n[o] = *(const u32x4*)(p.v + sbase + 512 * o);
                  a8[o] = *(const u32x4*)(p.a + sbase + 512 * o); lw8[o] = *(const h8*)(p.lw + sbase + 512 * o); } }
          else { ob = (size_t)(b * T + ((w * 64 + lane) >> 2)) * D + h * HD + 16 * (lane & 3); vb = pg8::scan_idx(b * T + ((w * 64 + lane) >> 2), h * HD + 16 * (lane & 3)); yb = vb; } }
        __syncthreads();
        float rr[2][8], aa[2][8], kkn[2][8], km[2][8], cum[2][8];
        if (w >= 4) __builtin_amdgcn_s_setprio(3);
        if (w >= 4) {
          for (int ch = -2; ch < T / 64; ++ch) {
            {
                const int pw = w - 4;
                if (ch + 1 >= 0 && ch + 1 < T / 64) {
                    const int setb = ((ch + 1) & 1) * SETB;
                    {   sbase += (ch + 2 < T / 64) ? 4096 : 0;
#pragma unroll
                        for (int o = 0; o < 2; ++o) { r8[o] = *(const u32x4*)(p.r + sbase + 512 * o); k8[o] = *(const u32x4*)(p.k + sbase + 512 * o); v8n[o] = *(const u32x4*)(p.v + sbase + 512 * o);
                            a8[o] = *(const u32x4*)(p.a + sbase + 512 * o); lw8[o] = *(const h8*)(p.lw + sbase + 512 * o); } }
                    {   SC_LANES;
                        float ss = 0.f, bo = 0.f;
#pragma unroll
                        for (int q = 0; q < 4; ++q) { ss += part[q * 64 + lane]; bo += part[256 + q * 64 + lane]; }
                        const float inv = fminf(__builtin_amdgcn_rsqf(ss), 1e12f);
                        bf16* bVT = img(lds, setb, O_VT); bf16* bKDT = img(lds, setb, O_KDT); bf16* bNBDT = img(lds, setb, O_NBDT);
                        float* gt = (float*)(lds + setb + O_GT); float* bon = (float*)(lds + setb + O_BON);
#pragma unroll
                        for (int o = 0; o < 2; ++o) {
                            const int cb = 16 * pw + 8 * o;
                            float o_kkd[8], o_rd[8], o_binv[8], o_kinv[8];
#pragma unroll
                            for (int q = 0; q < 8; ++q) {
                                const float kkv = kkn[o][q] * inv, bb = kkv * aa[o][q];
                                const float e_c = __builtin_amdgcn_exp2f(cum[o][q]), e_n = __builtin_amdgcn_exp2f(-cum[o][q]);
                                const float e_tot = __int_as_float(__builtin_amdgcn_readlane(__float_as_int(e_c), 63));
                                const float e_x = __int_as_float(__builtin_amdgcn_update_dpp(0x3f800000, __float_as_int(e_c), 0x138, 0xF, 0xF, false));
                                const float e_t = e_tot * e_n;
                                o_kkd[q] = kkv * e_x; o_rd[q] = rr[o][q] * e_c; o_binv[q] = bb * e_n; o_kinv[q] = km[o][q] * e_n;
                                bVT[swz(cb + q, lane)] = (bf16)((q & 1) ? (v8[o][q >> 1] >> 16) : (v8[o][q >> 1] & 0xffffu));
                                const unsigned kb2 = cvtpk(km[o][q] * e_t, -bb * e_t);
                                bKDT[swz(cb + q, lane)] = (bf16)(kb2 & 0xffffu);
                                bNBDT[swz(cb + q, lane)] = (bf16)(kb2 >> 16);
                                if (lane == 0) gt[cb + q] = e_tot;
                            }
                            *(u32x4*)&img(lds, setb, O_KKD)[swz(lane, cb)] = pack8(o_kkd); *(u32x4*)&img(lds, setb, O_RD)[swz(lane, cb)] = pack8(o_rd);
                            *(u32x4*)&img(lds, setb, O_N)[swz(lane, cb)] = pack8(o_binv); *(u32x4*)&img(lds, setb, O_P)[swz(lane, cb)] = pack8(o_kinv);
                        }
                        if (pw == 0) bon[lane] = bo;
                    }
                    { SC_LANES; __builtin_amdgcn_s_setprio(0); grp_sync((LAS unsigned*)(lds + SYNCO), 4u * (2u * (unsigned)(ch + 1) + 1u), lane); __builtin_amdgcn_s_setprio(3); }
                    f32x4 acc[10], cX, cXt;
                    {   SC_LANES;
                        const bf16* A = img(lds, setb, (pw & 1) ? O_P : O_N); const bf16* Bt = img(lds, setb, pw < 2 ? O_KKD : O_RD);
                        bf16x8 fa[4][2], fb[4][2], dB[2], dK[2];
#pragma unroll
                        for (int x = 0; x < 4; ++x) {
#pragma unroll
                            for (int kk = 0; kk < 2; ++kk) { fa[x][kk] = ld128(A, 16 * x + fr, 32 * kk + 8 * fq); fb[x][kk] = ld128(Bt, 16 * x + fr, 32 * kk + 8 * fq); } }
#pragma unroll
                        for (int kk = 0; kk < 2; ++kk) { dB[kk] = ld128(img(lds, setb, O_N), 16 * pw + fr, 32 * kk + 8 * fq); dK[kk] = ld128(img(lds, setb, O_KKD), 16 * pw + fr, 32 * kk + 8 * fq); }
                        int idx = 0;
#pragma unroll
                        for (int tt = 0; tt < 4; ++tt) {
#pragma unroll
                            for (int st = 0; st <= tt; ++st) { acc[idx] = mm32(fa[st][0], fb[tt][0], z4); acc[idx] = mm32(fa[st][1], fb[tt][1], acc[idx]); ++idx; } }
                        cXt = mm32(dB[0], dK[0], z4); cXt = mm32(dB[1], dK[1], cXt);
                        cX = mm32(dK[0], dB[0], z4); cX = mm32(dK[1], dB[1], cX);
                    }
                    { SC_LANES; __builtin_amdgcn_s_setprio(0); grp_sync((LAS unsigned*)(lds + SYNCO), 4u * (2u * (unsigned)(ch + 1) + 2u), lane); __builtin_amdgcn_s_setprio(3); }
                    {   SC_LANES;
                        f32x4 mk; const bool strict = pw < 2;
#pragma unroll
                        for (int i = 0; i < 4; ++i) { const int d = 4 * fq + i - fr; mk[i] = (strict ? (d < 0) : (d <= 0)) ? 1.f : 0.f; }
                        const unsigned sx = (pw == 0 || pw == 2) ? 0x80008000u : 0u;
                        if (pw == 0) {
#pragma unroll
                            for (int e = 0; e < 6; ++e) { const int ix = e == 0 ? 1 : (e == 1 ? 3 : (e == 2 ? 6 : (e == 3 ? 4 : (e == 4 ? 7 : 8))));
                                u32x2 o; o.x = cvtpk(acc[ix][0], acc[ix][1]) ^ sx; o.y = cvtpk(acc[ix][2], acc[ix][3]) ^ sx;
                                *(u32x2*)(lds + setb + O_MC + (e * 64 + lane) * 8) = o; }
                        } else {
                            bf16* dst = img(lds, setb, pw == 1 ? O_N : (pw == 2 ? O_NQ : O_P));
                            int idx = 0;
#pragma unroll
                            for (int tt = 0; tt < 4; ++tt) {
#pragma unroll
                                for (int st = 0; st < 4; ++st) {
                                    u32x2 o = (u32x2){0u, 0u};
                                    if (st <= tt) {
                                        f32x4 val = acc[idx]; ++idx;
                                        if (st == tt) val = val * mk;
                                        o.x = cvtpk(val[0], val[1]) ^ sx; o.y = cvtpk(val[2], val[3]) ^ sx;
                                    }
                                    *(u32x2*)&dst[swz(16 * tt + fr, 16 * st + 4 * fq)] = o;
                                } }
                        }
                        f32x4 cTt;
#pragma unroll
                        for (int i = 0; i < 4; ++i) { const int d = 4 * fq + i - fr; cXt[i] = d < 0 ? cXt[i] : 0.f; cX[i] = d > 0 ? cX[i] : 0.f; cTt[i] = (d == 0 ? 1.f : 0.f) - cXt[i]; }
                        s16x4 pA = pk4(cX), pAt = pk4(cXt);
#pragma unroll
                        for (int st = 0; st < 3; ++st) {
                            const f32x4 XA = mm16k(pAt, pA, z4);
                            f32x4 XB = z4; if (st < 2) XB = mm16k(pA, pAt, z4);
                            const s16x4 pT = pk4(cTt);
                            pA = pk4(XA);
                            cTt = mm16k(pA, pT, cTt);
                            if (st < 2) pAt = pk4(XB);
                        }
                        *(s16x4*)(lds + setb + O_TT + (pw * 64 + lane) * 8) = pk4(cTt);
                    }
                }
                if (ch + 2 < T / 64) {
                    {   SC_LANES;
                        float ssp = 0.f, bop = 0.f;
#pragma unroll
                        for (int o = 0; o < 2; ++o) {
                            float kr[8]; cvt8(r8[o], rr[o]); cvt8(k8[o], kr); cvt8(a8[o], aa[o]);
#pragma unroll
                            for (int q = 0; q < 8; ++q) { const int c = 16 * pw + 8 * o + q; const float kkp = prm[c], kap = prm[64 + c], rkp = prm[128 + c];
                                kkn[o][q] = kr[q] * kkp; ssp += kkn[o][q] * kkn[o][q]; km[o][q] = kr[q] * (1.0f + (aa[o][q] - 1.0f) * kap); bop += rr[o][q] * km[o][q] * rkp; cum[o][q] = (float)lw8[o][q]; }
                        }
                        part[pw * 64 + lane] = ssp; part[256 + pw * 64 + lane] = bop;
                        v8[0] = v8n[0]; v8[1] = v8n[1];
#define SC_DPP8(ctl) "v_add_f32_dpp %0, %0, %0 " ctl "\n\tv_add_f32_dpp %1, %1, %1 " ctl "\n\tv_add_f32_dpp %2, %2, %2 " ctl "\n\tv_add_f32_dpp %3, %3, %3 " ctl "\n\t" \
                     "v_add_f32_dpp %4, %4, %4 " ctl "\n\tv_add_f32_dpp %5, %5, %5 " ctl "\n\tv_add_f32_dpp %6, %6, %6 " ctl "\n\tv_add_f32_dpp %7, %7, %7 " ctl "\n\t"
#pragma unroll
                        for (int o = 0; o < 2; ++o)
                            asm volatile("s_nop 1\n\t"
                                         SC_DPP8("row_shr:1 row_mask:0xf bank_mask:0xf bound_ctrl:1") SC_DPP8("row_shr:2 row_mask:0xf bank_mask:0xf bound_ctrl:1")
                                         SC_DPP8("row_shr:4 row_mask:0xf bank_mask:0xf bound_ctrl:1") SC_DPP8("row_shr:8 row_mask:0xf bank_mask:0xf bound_ctrl:1")
                                         SC_DPP8("row_bcast:15 row_mask:0xa bank_mask:0xf") SC_DPP8("row_bcast:31 row_mask:0xc bank_mask:0xf")
                                         : "+v"(cum[o][0]), "+v"(cum[o][1]), "+v"(cum[o][2]), "+v"(cum[o][3]), "+v"(cum[o][4]), "+v"(cum[o][5]), "+v"(cum[o][6]), "+v"(cum[o][7]));
#undef SC_DPP8
                    }
                }
                __syncthreads();
            }
          }
        } else {
          for (int ch = -2; ch < T / 64; ++ch) {
            {
                if (ch >= 0) {
                    const int setb = (ch & 1) * SETB;
                    s16x4 pST[4]; bf16x8 bV[2];
                    {   SC_LANES;
#pragma unroll
                        for (int kb = 0; kb < 4; ++kb) pST[kb] = pk4(ST[kb]);
                        const bf16* iK = img(lds, setb, O_KKD); const bf16* iN = img(lds, setb, O_N);
                        bV[0] = ld128(img(lds, setb, O_VT), 16 * w + fr, 8 * fq); bV[1] = ld128(img(lds, setb, O_VT), 16 * w + fr, 32 + 8 * fq);
                        s16x4 aK[4][4]; bf16x8 aN[6]; s16x4 TT[4], nM[6];
#pragma unroll
                        for (int mt = 0; mt < 4; ++mt) {
#pragma unroll
                            for (int kb = 0; kb < 4; ++kb) aK[mt][kb] = ld64(iK, 16 * mt + fr, 16 * kb + 4 * fq); }
                        aN[0] = ld128(iN, fr, 8 * fq); aN[1] = ld128(iN, 16 + fr, 8 * fq); aN[2] = ld128(iN, 32 + fr, 8 * fq); aN[3] = ld128(iN, 32 + fr, 32 + 8 * fq); aN[4] = ld128(iN, 48 + fr, 8 * fq); aN[5] = ld128(iN, 48 + fr, 32 + 8 * fq);
#pragma unroll
                        for (int d = 0; d < 4; ++d) TT[d] = *(const s16x4*)(lds + setb + O_TT + (d * 64 + lane) * 8);
#pragma unroll
                        for (int e = 0; e < 6; ++e) nM[e] = *(const s16x4*)(lds + setb + O_MC + (e * 64 + lane) * 8);
                        f32x4 racc[4];
#pragma unroll
                        for (int mt = 0; mt < 4; ++mt) { racc[mt] = z4;
#pragma unroll
                            for (int kb = 0; kb < 4; ++kb) racc[mt] = mm16k(aK[mt][kb], pST[kb], racc[mt]); }
                        {
                            f32x4 r2[4];
                            r2[0] = mm32(aN[0], bV[0], z4); r2[1] = mm32(aN[1], bV[0], z4);
                            r2[2] = mm32(aN[2], bV[0], z4); r2[2] = mm32(aN[3], bV[1], r2[2]); r2[3] = mm32(aN[4], bV[0], z4); r2[3] = mm32(aN[5], bV[1], r2[3]);
#pragma unroll
                            for (int mt = 0; mt < 4; ++mt) racc[mt] = racc[mt] + r2[mt];
                        }
#pragma unroll
                        for (int blk = 0; blk < 4; ++blk) {
                            const f32x4 xx = mm16k(TT[blk], pk4(racc[blk]), z4);
                            pxx[blk] = pk4(xx);
#pragma unroll
                            for (int br = blk + 1; br < 4; ++br) { const int e = blk == 0 ? br - 1 : (blk == 1 ? br + 1 : 5); racc[br] = mm16k(nM[e], pxx[blk], racc[br]); }
                        }
                    }
                    {   SC_LANES;
                        if (ch > 0) {
                            pc_out(p, Rf, prm, bo_out, vg, gg, yb, w, lane);
                            ob += (size_t)64 * D; yb += 4096;
                            grp_arrive((LAS unsigned*)(lds + SYNCO) + 1, lane);
                        }
                        vg[0] = *(const u32x4*)(p.v + vb); vg[1] = *(const u32x4*)(p.v + vb + 512); gg[0] = *(const u32x4*)(p.g + ob); gg[1] = *(const u32x4*)(p.g + ob + 8);
                        vb += 4096;
                        bo_out = ((const float*)(lds + setb + O_BON))[(w * 64 + lane) >> 2];
                    }
                    {   SC_LANES;
                        const bf16* iR = img(lds, setb, O_RD); const bf16* iP = img(lds, setb, O_P); const bf16* iQ = img(lds, setb, O_NQ);
                        s16x4 aR[4][4], aQ[10]; bf16x8 aP[6];
#pragma unroll
                        for (int mt = 0; mt < 4; ++mt) {
#pragma unroll
                            for (int kb = 0; kb < 4; ++kb) aR[mt][kb] = ld64(iR, 16 * mt + fr, 16 * kb + 4 * fq); }
                        aP[0] = ld128(iP, fr, 8 * fq); aP[1] = ld128(iP, 16 + fr, 8 * fq); aP[2] = ld128(iP, 32 + fr, 8 * fq); aP[3] = ld128(iP, 32 + fr, 32 + 8 * fq); aP[4] = ld128(iP, 48 + fr, 8 * fq); aP[5] = ld128(iP, 48 + fr, 32 + 8 * fq);
                        { int ix = 0;
#pragma unroll
                          for (int mt = 0; mt < 4; ++mt) {
#pragma unroll
                              for (int blk = 0; blk <= mt; ++blk) { aQ[ix] = ld64(iQ, 16 * mt + fr, 16 * blk + 4 * fq); ++ix; } } }
                        f32x4 yacc[4];
#pragma unroll
                        for (int mt = 0; mt < 4; ++mt) { yacc[mt] = z4;
#pragma unroll
                            for (int kb = 0; kb < 4; ++kb) yacc[mt] = mm16k(aR[mt][kb], pST[kb], yacc[mt]); }
                        { int ix = 0;
#pragma unroll
                          for (int mt = 0; mt < 4; ++mt) {
#pragma unroll
                              for (int blk = 0; blk <= mt; ++blk) { yacc[mt] = mm16k(aQ[ix], pxx[blk], yacc[mt]); ++ix; } } }
                        {   f32x4 y2[4];
                            y2[0] = mm32(aP[0], bV[0], z4); y2[1] = mm32(aP[1], bV[0], z4);
                            y2[2] = mm32(aP[2], bV[0], z4); y2[2] = mm32(aP[3], bV[1], y2[2]); y2[3] = mm32(aP[4], bV[0], z4); y2[3] = mm32(aP[5], bV[1], y2[3]);
#pragma unroll
                            for (int mt = 0; mt < 4; ++mt) yacc[mt] = yacc[mt] + y2[mt];
                        }
                        if (ch > 0) grp_wait((LAS unsigned*)(lds + SYNCO) + 1, 4u * (unsigned)ch);
#pragma unroll
                        for (int mt = 0; mt < 4; ++mt) {
#pragma unroll
                            for (int i = 0; i < 4; ++i) Rf[(16 * mt + 4 * fq + i) * RFP + 16 * w + fr] = yacc[mt][i]; }
                    }
                    {   SC_LANES;
                        const bf16* iKd = img(lds, setb, O_KDT); const bf16* iBd = img(lds, setb, O_NBDT); const float* gt = (const float*)(lds + setb + O_GT);
                        bf16x8 aKd[4][2]; s16x4 aB[4][4]; f32x4 g4[4];
#pragma unroll
                        for (int kb = 0; kb < 4; ++kb) { aKd[kb][0] = ld128(iKd, 16 * kb + fr, 8 * fq); aKd[kb][1] = ld128(iKd, 16 * kb + fr, 32 + 8 * fq); g4[kb] = *(const f32x4*)&gt[16 * kb + 4 * fq];
#pragma unroll
                            for (int blk = 0; blk < 4; ++blk) aB[kb][blk] = ld64(iBd, 16 * kb + fr, 16 * blk + 4 * fq); }
#pragma unroll
                        for (int kb = 0; kb < 4; ++kb) {
                            f32x4 s2 = mm32(aKd[kb][0], bV[0], z4); s2 = mm32(aKd[kb][1], bV[1], s2);
                            f32x4 s = z4;
#pragma unroll
                            for (int blk = 0; blk < 4; ++blk) s = mm16k(aB[kb][blk], pxx[blk], s);
                            ST[kb] = ST[kb] * g4[kb] + s2 + s; }
                    }
                    __syncthreads();
                } else { __syncthreads(); }
            }
          }
        }
        __builtin_amdgcn_s_setprio(0);
        if (w < 4) {
            SC_LANES;
            pc_out(p, Rf, prm, bo_out, vg, gg, yb, w, lane);
        }
    }
#undef SC_LANES
}
__device__ __forceinline__ void ph_cumsum(const float* logf, float* cum, const int wv_s) {
    const int tid_ = opaque_tid(wv_s); const int lane = tid_ & 63, wv = tid_ >> 6;
    for (int seq = blockIdx.x + gridDim.x * wv; seq < NB * H; seq += gridDim.x * 8) {
        const int b = seq / H, h = seq % H;
        float loc[32]; float run = 0.f;
#pragma unroll
        for (int q = 0; q < 32; ++q) { run += logf[(size_t)(b * T + lane * 32 + q) * 16 + h]; loc[q] = run; }
        float incl = run;
#pragma unroll
        for (int o = 1; o < 64; o <<= 1) { const float t = __int_as_float(__builtin_amdgcn_ds_bpermute((lane >= o ? lane - o : lane) << 2, __float_as_int(incl))); if (lane >= o) incl += t; }
        const float excl = incl - run;
#pragma unroll
        for (int q = 0; q < 32; ++q) cum[(size_t)seq * T + lane * 32 + q] = -(excl + loc[q]) * LOG2E;
    }
}
#include <hip/hip_bf16.h>
#include <cmath>
namespace attn_body {
using bf16=__hip_bfloat16;
using bf16x8=__attribute__((ext_vector_type(8)))short;
using s16x4=__attribute__((ext_vector_type(4)))short;
using f32x16=__attribute__((ext_vector_type(16)))float;
using u32x4=__attribute__((ext_vector_type(4)))unsigned;
constexpr int BATCH=8,NHEAD=16,SEQ=2048,D=64,DM=NHEAD*D;
constexpr int NW=8,QBLK=32,QB=QBLK*NW,KVBLK=64,NQB=SEQ/QB;
constexpr int ATTN_PITCH=DM, ATTN_UNIT_ROWS=QB;
__device__ __forceinline__ int crow(int r,int hi){return (r&3)+8*(r>>2)+4*hi;}
#define SBAR() __builtin_amdgcn_sched_barrier(0)
__device__ __forceinline__ void cmask(f32x16&p0,f32x16&p1,int jb,int qrel,int hi){
  const float NEG=-INFINITY; int kb=64*jb+4*hi;
  #pragma unroll
  for(int r=0;r<16;++r){int kv=kb+(r&3)+8*(r>>2); if(kv>qrel)p0[r]=NEG; if(kv+32>qrel)p1[r]=NEG;}
}

constexpr int NSLOT=3, SLOTB=8192;
constexpr int LDS_K=0, LDS_V=NSLOT*SLOTB, LDS_WS=2*NSLOT*SLOTB, LDS_OST=LDS_WS+NW*64*4, LDS_BYTES=LDS_OST+NW*4096;
constexpr float C2=0.125f*1.4426950408889634f;
__device__ __forceinline__ void glds16(const void*gsrc,unsigned lds_dst){unsigned keep;
  asm volatile("s_mov_b32 %0, m0\n\ts_mov_b32 m0, %2\n\ts_nop 0\n\tglobal_load_lds_dwordx4 %1, off\n\ts_mov_b32 m0, %0":"=&s"(keep):"v"(gsrc),"s"(lds_dst):"memory");}
__device__ __forceinline__ float max3f(float a,float b,float c){float r;asm("v_max3_f32 %0, %1, %2, %3":"=v"(r):"v"(a),"v"(b),"v"(c));return r;}
__device__ __forceinline__ float max2f(float a,float b){float r;asm("v_max_f32_e32 %0, %1, %2":"=v"(r):"v"(a),"v"(b));return r;}
__device__ __forceinline__ float fadd_s(float a,float b){float r;asm("v_add_f32_e32 %0, %1, %2":"=v"(r):"v"(a),"v"(b));return r;}
__device__ __forceinline__ float fsub_s(float a,float b){float r;asm("v_sub_f32_e32 %0, %1, %2":"=v"(r):"v"(a),"v"(b));return r;}
typedef float f32x2_t __attribute__((ext_vector_type(2))); typedef __bf16 bf16x2_t __attribute__((ext_vector_type(2)));
__device__ __forceinline__ unsigned cvtpk_s(float lo,float hi){f32x2_t v={lo,hi};bf16x2_t b=__builtin_convertvector(v,bf16x2_t);return __builtin_bit_cast(unsigned,b);}
#define WAIT_BAR(N) asm volatile("s_waitcnt vmcnt(" #N ") lgkmcnt(0)\n\ts_barrier":::"memory")

__device__ __forceinline__ void qkt(f32x16&p0,f32x16&p1,const char*Kslot,const bf16x8*qr,const f32x16&negm,int r32,int hi){
  const char*kb=Kslot+hi*1024+r32*16;
  #pragma unroll
  for(int d0=0;d0<4;++d0){
    const bf16x8 b0=*reinterpret_cast<const bf16x8*>(kb+d0*2048);
    const bf16x8 b1=*reinterpret_cast<const bf16x8*>(kb+d0*2048+512);
    if(d0==0){p0=__builtin_amdgcn_mfma_f32_32x32x16_bf16(b0,qr[0],negm,0,0,0);p1=__builtin_amdgcn_mfma_f32_32x32x16_bf16(b1,qr[0],negm,0,0,0);}
    else{p0=__builtin_amdgcn_mfma_f32_32x32x16_bf16(b0,qr[d0],p0,0,0,0);p1=__builtin_amdgcn_mfma_f32_32x32x16_bf16(b1,qr[d0],p1,0,0,0);}}
}
typedef __attribute__((address_space(3))) const char* lds_cptr;
typedef short v4i16_t __attribute__((ext_vector_type(4)));
__device__ __forceinline__ void kload8(bf16x8*kf,lds_cptr kp){
  kf[0]=*(const __attribute__((address_space(3))) bf16x8*)(kp);      kf[1]=*(const __attribute__((address_space(3))) bf16x8*)(kp+512);
  kf[2]=*(const __attribute__((address_space(3))) bf16x8*)(kp+2048); kf[3]=*(const __attribute__((address_space(3))) bf16x8*)(kp+2560);
  kf[4]=*(const __attribute__((address_space(3))) bf16x8*)(kp+4096); kf[5]=*(const __attribute__((address_space(3))) bf16x8*)(kp+4608);
  kf[6]=*(const __attribute__((address_space(3))) bf16x8*)(kp+6144); kf[7]=*(const __attribute__((address_space(3))) bf16x8*)(kp+6656);
}
__device__ __forceinline__ void kload2(bf16x8*kf,lds_cptr kp,int j){ kf[2*j]=*(const __attribute__((address_space(3))) bf16x8*)(kp+j*2048); kf[2*j+1]=*(const __attribute__((address_space(3))) bf16x8*)(kp+j*2048+512); }
__device__ __forceinline__ s16x4 vtr(lds_cptr p){ return __builtin_bit_cast(s16x4,__builtin_amdgcn_ds_read_tr16_b64_v4i16((__attribute__((address_space(3))) v4i16_t*)p)); }
__device__ __forceinline__ float rowmax(const f32x16&p0,const f32x16&p1){
  float a=max3f(p0[0],p0[1],p1[0]),b=max3f(p0[2],p0[3],p1[1]);a=max3f(a,p1[2],p1[3]);
  #pragma unroll
  for(int r=4;r<16;r+=4){a=max3f(a,p0[r],p0[r+1]);b=max3f(b,p0[r+2],p0[r+3]);a=max3f(a,p1[r],p1[r+1]);b=max3f(b,p1[r+2],p1[r+3]);}
  const float m=max2f(a,b);
  auto rr=__builtin_amdgcn_permlane32_swap(__float_as_uint(m),__float_as_uint(m),false,false);
  return max2f(__uint_as_float(rr[0]),__uint_as_float(rr[1]));
}
__device__ __forceinline__ void pv(f32x16*o,int vb,bf16x8 pa0,bf16x8 pa1,bf16x8 pa2,bf16x8 pa3){
  #pragma unroll
  for(int d0=0;d0<2;++d0){s16x4 lo[4],hi[4];
    #pragma unroll
    for(int ks=0;ks<4;++ks){
      asm volatile("ds_read_b64_tr_b16 %0,%1 offset:%c2":"=&v"(lo[ks]):"v"(vb),"i"(d0*4096+ks*1024):"memory");
      asm volatile("ds_read_b64_tr_b16 %0,%1 offset:%c2":"=&v"(hi[ks]):"v"(vb),"i"(d0*4096+ks*1024+512):"memory");}
    asm volatile("s_waitcnt lgkmcnt(0)":::"memory");SBAR();
    #define PK(k) (bf16x8){lo[k][0],lo[k][1],lo[k][2],lo[k][3],hi[k][0],hi[k][1],hi[k][2],hi[k][3]}
    o[d0]=__builtin_amdgcn_mfma_f32_32x32x16_bf16(pa0,PK(0),o[d0],0,0,0);
    o[d0]=__builtin_amdgcn_mfma_f32_32x32x16_bf16(pa1,PK(1),o[d0],0,0,0);
    o[d0]=__builtin_amdgcn_mfma_f32_32x32x16_bf16(pa2,PK(2),o[d0],0,0,0);
    o[d0]=__builtin_amdgcn_mfma_f32_32x32x16_bf16(pa3,PK(3),o[d0],0,0,0);
    #undef PK
  }
}

#ifndef ATTN_STORE16
#define ATTN_STORE16(p,v) (*(u32x4*)(p)=(v))
#endif
typedef __attribute__((address_space(3))) const float* lds_cfptr;
typedef float f32x4b __attribute__((ext_vector_type(4)));
#define BIAS(C0,C1,t) do{ const lds_cfptr nb_=nbt+(t)*64+4*hi; \
    _Pragma("unroll") for(int g_=0;g_<4;++g_){ const f32x4b b0_=*(const __attribute__((address_space(3))) f32x4b*)(nb_+8*g_); const f32x4b b1_=*(const __attribute__((address_space(3))) f32x4b*)(nb_+32+8*g_); \
      C0[4*g_]+=b0_.x; C0[4*g_+1]+=b0_.y; C0[4*g_+2]+=b0_.z; C0[4*g_+3]+=b0_.w; C1[4*g_]+=b1_.x; C1[4*g_+1]+=b1_.y; C1[4*g_+2]+=b1_.z; C1[4*g_+3]+=b1_.w; } }while(0)
template<int THRL> __device__ __forceinline__ void attn_unit(int b,int h,int qb,const bf16*Q,const bf16*__restrict__ K,const bf16*__restrict__ V,bf16*O,char*shm,lds_cfptr nbt,const int wv_s){
  const int tid=::opaque_tid(wv_s),lane=tid&63,r32=lane&31,hi=lane>>5; const int wid=wv_s;
  const long rowbase=(long)b*SEQ; const int q0=qb*QB;
  const bf16*Qw=Q+(rowbase+q0+wid*QBLK)*DM+h*D;
  const bf16*Kh=K+rowbase*DM+h*D,*Vh=V+rowbase*DM+h*D;
  const unsigned lds0=(unsigned)(uintptr_t)shm;
  float*wsf=(float*)(shm+LDS_WS)+wid*64;
  const bf16*ksrc=Kh+(long)lane*DM+wid*8;
  const bf16*vsrc=Vh+(long)(16*(wid&3)+(lane>>2))*DM+(wid>>2)*32+(lane&3)*8;
  const unsigned kdst=lds0+LDS_K+wid*1024, vdst=lds0+LDS_V+wid*1024;
  #define DMA_K(t,slot) glds16(ksrc+(long)(t)*KVBLK*DM,(unsigned)__builtin_amdgcn_readfirstlane(kdst+(slot)))
  #define DMA_V(t,slot) glds16(vsrc+(long)(t)*KVBLK*DM,(unsigned)__builtin_amdgcn_readfirstlane(vdst+(slot)))
  const int vb0=(int)(lds0+LDS_V)+((lane>>4)&1)*32+(lane&3)*8+(4*hi+((lane&15)>>2))*64;
  const char*Kbase=shm+LDS_K; bf16x8 kf[8];
  const lds_cptr shm3=(lds_cptr)shm; const lds_cptr kp0=shm3+LDS_K+hi*1024+r32*16; const lds_cptr vp0=shm3+LDS_V+((lane>>4)&1)*32+(lane&3)*8+(4*hi+((lane&15)>>2))*64;
  const int NT=(q0+QB)/KVBLK;
  DMA_K(0,0);DMA_V(0,0);DMA_K(1,SLOTB);
  bf16x8 qr[4];
  #pragma unroll
  for(int d0=0;d0<4;++d0)qr[d0]=*reinterpret_cast<const bf16x8*>(&Qw[(long)r32*DM+d0*16+hi*8]);
  float mhat=0.f,l_reg=0.f;f32x16 o[2];o[0]=f32x16{};o[1]=f32x16{};f32x16 negm=f32x16{};asm volatile("":"+v"(negm));
  const int qrel=wid*QBLK+r32;
  #define CMASK(P0,P1,t) do{int jb_=(t)-(NT-4); if(jb_>=0)cmask(P0,P1,jb_,qrel,hi);}while(0)
  bool resc=false;
  #define START(P0,P1) do{ const float rm=rowmax(P0,P1); resc=false; \
    { const float dl=rm; mhat=fadd_s(mhat,dl); \
      _Pragma("unroll") for(int r=0;r<16;++r){P0[r]=fsub_s(P0[r],dl);P1[r]=fsub_s(P1[r],dl);} \
      _Pragma("unroll") for(int r=0;r<16;++r)negm[r]=-mhat; asm volatile("":"+v"(negm)); } \
    _Pragma("unroll") for(int r=0;r<16;++r)P0[r]=__builtin_amdgcn_exp2f(P0[r]); }while(0)
  #define RESC() do{ if(resc){ asm volatile("s_waitcnt lgkmcnt(0)":::"memory"); \
      _Pragma("unroll") for(int d_=0;d_<2;++d_) _Pragma("unroll") for(int r=0;r<16;++r)o[d_][r]*=wsf[crow(r,hi)]; } }while(0)
  f32x16 pA0,pA1,pB0,pB1;
  int sl_prev=0,sl_cur=0,sl_next=SLOTB;
  #define ROT() do{sl_prev=sl_cur;sl_cur=sl_next;sl_next=(sl_next==(NSLOT-1)*SLOTB)?0:sl_next+SLOTB;}while(0)
  DMA_K(2,2*SLOTB);
  WAIT_BAR(3);
  qkt(pA0,pA1,Kbase,qr,negm,r32,hi);asm volatile("s_nop 15\n\ts_nop 7":"+v"(pA0),"+v"(pA1));BIAS(pA0,pA1,0);CMASK(pA0,pA1,0);
  START(pA0,pA1);
  _Pragma("unroll") for(int r=0;r<16;++r)pA1[r]=__builtin_amdgcn_exp2f(pA1[r]);
  WAIT_BAR(0);
  DMA_K(3,0);DMA_V(1,SLOTB);
  ROT();
  kload8(kf,kp0+sl_cur);
  WAIT_BAR(2);
  s16x4 vlo[8],vhi[8]; u32x4 pw0,pw1,pw2,pw3;
  #define PKW(P,B) cvtpk_s(P[B],P[B+1])
  #define PAF(k) __builtin_bit_cast(bf16x8,pw##k)
  #define VFR(i) (bf16x8){vlo[i][0],vlo[i][1],vlo[i][2],vlo[i][3],vhi[i][0],vhi[i][1],vhi[i][2],vhi[i][3]}
  #define PIN(x) asm volatile("":"+v"(x))
  #define MX3(a,b,c) __builtin_fmaxf(__builtin_fmaxf((a),(b)),(c))
  #define GAPA(MF,A0,A1,A2,A3,W0,W1,PW) do{ MF; sacc+=A0; sacc+=A1; sacc+=A2; sacc+=A3; PIN(sacc); W0; W1; PIN(PW); SBAR(); }while(0)
  #define EX(v) __builtin_amdgcn_exp2f(v)
  #define GAPB(MF,X,B) do{ MF; X[B]=EX(X[B]); X[B+1]=EX(X[B+1]); X[B+2]=EX(X[B+2]); X[B+3]=EX(X[B+3]); PIN(X); SBAR(); }while(0)
  #define VRD(i) do{ vlo[i]=vtr(vp_+(((i)>>2)*4096+((i)&3)*1024)); vhi[i]=vtr(vp_+(((i)>>2)*4096+((i)&3)*1024+512)); }while(0)
  #define KRD(G,j) do{ if(G){ kload2(kf,kp0+sl_next,j); SBAR(); } }while(0)
  #define STEP(C0,C1,P0,P1,t,GK,GV,GL) do{ SBAR(); \
    const lds_cptr vp_=vp0+sl_prev; \
    VRD(0); SBAR(); float sacc=(P0[0]+P0[1]); \
    GAPA(C0=__builtin_amdgcn_mfma_f32_32x32x16_bf16(kf[0],qr[0],negm,0,0,0), P0[2],P0[3],P0[4],P0[5],     pw0[0]=PKW(P0,0), pw0[1]=PKW(P0,2), pw0); \
    VRD(4); SBAR(); GAPA(C1=__builtin_amdgcn_mfma_f32_32x32x16_bf16(kf[1],qr[0],negm,0,0,0), P0[6],P0[7],P0[8],P0[9],     pw0[2]=PKW(P0,4), pw0[3]=PKW(P0,6), pw0); \
    VRD(1); SBAR(); GAPA(C0=__builtin_amdgcn_mfma_f32_32x32x16_bf16(kf[2],qr[1],C0,0,0,0),   P0[10],P0[11],P0[12],P0[13], pw1[0]=PKW(P0,8), pw1[1]=PKW(P0,10), pw1); \
    VRD(5); SBAR(); GAPA(C1=__builtin_amdgcn_mfma_f32_32x32x16_bf16(kf[3],qr[1],C1,0,0,0),   P0[14],P0[15],P1[0],P1[1],   pw1[2]=PKW(P0,12),pw1[3]=PKW(P0,14), pw1); \
    VRD(2); SBAR(); GAPA(C0=__builtin_amdgcn_mfma_f32_32x32x16_bf16(kf[4],qr[2],C0,0,0,0),   P1[2],P1[3],P1[4],P1[5],     pw2[0]=PKW(P1,0), pw2[1]=PKW(P1,2), pw2); \
    VRD(6); SBAR(); GAPA(C1=__builtin_amdgcn_mfma_f32_32x32x16_bf16(kf[5],qr[2],C1,0,0,0),   P1[6],P1[7],P1[8],P1[9],     pw2[2]=PKW(P1,4), pw2[3]=PKW(P1,6), pw2); \
    VRD(3); SBAR(); GAPA(C0=__builtin_amdgcn_mfma_f32_32x32x16_bf16(kf[6],qr[3],C0,0,0,0),   P1[10],P1[11],P1[12],P1[13], pw3[0]=PKW(P1,8), pw3[1]=PKW(P1,10), pw3); \
    VRD(7); SBAR(); GAPA(C1=__builtin_amdgcn_mfma_f32_32x32x16_bf16(kf[7],qr[3],C1,0,0,0),   P1[14],P1[15],0.f,0.f,       pw3[2]=PKW(P1,12),pw3[3]=PKW(P1,14), pw3); \
    l_reg+=sacc; \
    if(GK){DMA_K((t)+3,sl_cur);} if(GV){DMA_V((t)+1,sl_next);} \
    BIAS(C0,C1,t); CMASK(C0,C1,t); \
    { float a=MX3(C0[0],C0[1],C1[0]),b=MX3(C0[2],C0[3],C1[1]); a=MX3(a,C1[2],C1[3]); \
      _Pragma("unroll") for(int r=4;r<16;r+=4){a=MX3(a,C0[r],C0[r+1]);b=MX3(b,C0[r+2],C0[r+3]);a=MX3(a,C1[r],C1[r+1]);b=MX3(b,C1[r+2],C1[r+3]);} \
      float rm=__builtin_fmaxf(a,b); { auto rr=__builtin_amdgcn_permlane32_swap(__float_as_uint(rm),__float_as_uint(rm),false,false); rm=__builtin_fmaxf(__uint_as_float(rr[0]),__uint_as_float(rr[1])); } \
      resc=false; \
      if(__builtin_expect(__any(rm>(float)THRL),0)){ const float dl=__builtin_fmaxf(rm,0.f); mhat+=dl; \
        _Pragma("unroll") for(int r=0;r<16;++r){C0[r]-=dl;C1[r]-=dl;} \
        _Pragma("unroll") for(int r=0;r<16;++r)negm[r]=-mhat; asm volatile("":"+v"(negm)); \
        const float f=__builtin_amdgcn_exp2f(-dl); l_reg*=f; if(hi==0)wsf[r32]=f; resc=true; } } \
    SBAR(); \
    GAPB(o[0]=__builtin_amdgcn_mfma_f32_32x32x16_bf16(PAF(0),VFR(0),o[0],0,0,0), C0,0); \
    GAPB(o[1]=__builtin_amdgcn_mfma_f32_32x32x16_bf16(PAF(0),VFR(4),o[1],0,0,0), C0,4); \
    KRD(GL,0); GAPB(o[0]=__builtin_amdgcn_mfma_f32_32x32x16_bf16(PAF(1),VFR(1),o[0],0,0,0), C0,8); \
    KRD(GL,1); GAPB(o[1]=__builtin_amdgcn_mfma_f32_32x32x16_bf16(PAF(1),VFR(5),o[1],0,0,0), C0,12); \
    KRD(GL,2); GAPB(o[0]=__builtin_amdgcn_mfma_f32_32x32x16_bf16(PAF(2),VFR(2),o[0],0,0,0), C1,0); \
    KRD(GL,3); GAPB(o[1]=__builtin_amdgcn_mfma_f32_32x32x16_bf16(PAF(2),VFR(6),o[1],0,0,0), C1,4); \
    GAPB(o[0]=__builtin_amdgcn_mfma_f32_32x32x16_bf16(PAF(3),VFR(3),o[0],0,0,0), C1,8); \
    GAPB(o[1]=__builtin_amdgcn_mfma_f32_32x32x16_bf16(PAF(3),VFR(7),o[1],0,0,0), C1,12); \
    }while(0)
  int t=1;
  #undef CMASK
  #define CMASK(P0,P1,t) do{}while(0)
  for(;t+5<NT;t+=2){
    STEP(pB0,pB1,pA0,pA1,t,true,true,true);     WAIT_BAR(2); RESC(); ROT();
    STEP(pA0,pA1,pB0,pB1,t+1,true,true,true);   WAIT_BAR(2); RESC(); ROT();
  }
  #undef CMASK
  #define CMASK(P0,P1,t) do{int jb_=(t)-(NT-4); if(jb_>=0)cmask(P0,P1,jb_,qrel,hi);}while(0)
  #define ENDW(tt) do{ if((tt)+3<NT){WAIT_BAR(2);} else if((tt)+2<NT){WAIT_BAR(1);} else {WAIT_BAR(0);} }while(0)
  for(;t+1<NT;t+=2){
    STEP(pB0,pB1,pA0,pA1,t,(t+3<NT),(t+1<NT),(t+1<NT));       ENDW(t);   RESC(); ROT();
    STEP(pA0,pA1,pB0,pB1,t+1,(t+4<NT),(t+2<NT),(t+2<NT));     ENDW(t+1); RESC(); ROT();
  }
  STEP(pB0,pB1,pA0,pA1,NT-1,false,false,false); RESC();
  { float sacc=pB0[0]+pB0[1]; _Pragma("unroll") for(int r=2;r<16;++r)sacc+=pB0[r]; _Pragma("unroll") for(int r=0;r<16;++r)sacc+=pB1[r]; l_reg+=sacc;
    pw0=(u32x4){PKW(pB0,0),PKW(pB0,2),PKW(pB0,4),PKW(pB0,6)};pw1=(u32x4){PKW(pB0,8),PKW(pB0,10),PKW(pB0,12),PKW(pB0,14)};pw2=(u32x4){PKW(pB1,0),PKW(pB1,2),PKW(pB1,4),PKW(pB1,6)};pw3=(u32x4){PKW(pB1,8),PKW(pB1,10),PKW(pB1,12),PKW(pB1,14)};
    SBAR(); pv(o,vb0+sl_cur,PAF(0),PAF(1),PAF(2),PAF(3)); }
  #undef PKW
  #undef PAF
  #undef VFR
  #undef PIN
  #undef MX3
  #undef GAPA
  #undef GAPB
  #undef EX
  #undef VRD
  #undef KRD
  #undef STEP
  #undef ENDW
  {auto rr=__builtin_amdgcn_permlane32_swap(__float_as_uint(l_reg),__float_as_uint(l_reg),false,false);l_reg=__uint_as_float(rr[0])+__uint_as_float(rr[1]);}
  if(hi==0)wsf[32+r32]=l_reg;asm volatile("s_waitcnt lgkmcnt(0)":::"memory");
  float rli[16];
  #pragma unroll
  for(int r=0;r<16;++r)rli[r]=__builtin_amdgcn_rcpf(wsf[32+crow(r,hi)]);
  bf16*Ow=O+(rowbase+q0+wid*QBLK)*DM+h*D;
  { bf16*stg=(bf16*)(shm+LDS_OST)+wid*2048;
    #pragma unroll
    for(int r=0;r<16;++r){const int orow=crow(r,hi);
      #pragma unroll
      for(int d0=0;d0<2;++d0)stg[orow*64+d0*32+r32]=__float2bfloat16(o[d0][r]*rli[r]);}
    asm volatile("s_waitcnt lgkmcnt(0)":::"memory");
    #pragma unroll
    for(int i=0;i<4;++i){const int row=i*8+(lane>>3),ch=lane&7; const u32x4 v=*(const u32x4*)(stg+row*64+ch*8); ATTN_STORE16(Ow+(long)row*DM+ch*8,v);} }
  asm volatile("s_waitcnt lgkmcnt(0)\n\ts_barrier":::"memory");
  #undef DMA_K
  #undef DMA_V
  #undef CMASK
  #undef START
  #undef RESC
  #undef ROT
}
constexpr int ATTN_LDS_BYTES=LDS_BYTES;
struct AttnTensors { const bf16* Q; const bf16* K; const bf16* V; bf16* O; };
struct AttnUnit { int bh; int qb; };
struct StaticOrder {
  int vcu, G;
  __device__ __forceinline__ explicit StaticOrder(int grid,int block):vcu((grid%8==0)?(block%8)*(grid/8)+block/8:block),G(grid){}
  __device__ __forceinline__ bool next(int i,AttnUnit&u)const{ if(G!=256||i>=4)return false; const int s=vcu&1; u.bh=vcu>>1; u.qb=(i==0)?s:(i==1)?7-s:(i==2)?3-s:4+s; return true; }
  __device__ __forceinline__ void a_ready(const AttnUnit&)const{}
  __device__ __forceinline__ void done(const AttnUnit&)const{}
};
template<class Sched,int THRL=8> __device__ __forceinline__ void attn_phase(char*lds,const AttnTensors&T,const float*nbias,const Sched&S,const int wv_s){
  AttnUnit u;
  if(!S.next(0,u))return;
  { float*tab=(float*)(lds+LDS_BYTES); const float*src=nbias+(long)u.bh*SEQ;
    for(int k=::opaque_tid(wv_s);k<SEQ;k+=NW*64)tab[k]=src[k];
    asm volatile("s_waitcnt vmcnt(0) lgkmcnt(0)\n\ts_barrier":::"memory"); }
  const lds_cfptr nbt=(lds_cfptr)(lds+LDS_BYTES);
  for(int i=0;S.next(i,u);++i){ S.a_ready(u); attn_unit<THRL>(u.bh/NHEAD,u.bh%NHEAD,u.qb,T.Q,T.K,T.V,T.O,lds,nbt,wv_s); S.done(u); }
}
#undef BIAS
#undef SBAR
#undef WAIT_BAR
}
#define XB_TMO      128
#define XB_XCNT(j)  (256  + 64 * (j))
#define XB_XSUB(j)  (1280 + 64 * (j))
#define XB_XGEN(j)  (2304 + 64 * (j))
#define XB_TOP      3328
#define XB_TOPGEN   3392
#define XCD_BAR_WORDS 3456
#define XB_SPIN_CAP (1u << 18)


__device__ __forceinline__ unsigned xb_ld(unsigned* p)              { return __hip_atomic_load(p, __ATOMIC_RELAXED, __HIP_MEMORY_SCOPE_AGENT); }
__device__ __forceinline__ unsigned xb_add(unsigned* p, unsigned v) { return __hip_atomic_fetch_add(p, v, __ATOMIC_RELAXED, __HIP_MEMORY_SCOPE_AGENT); }
__device__ __forceinline__ unsigned xb_xcc_id() { return (unsigned)__builtin_amdgcn_s_getreg((3 << 11) | 20) & 0xFu; }
#define XB_SPIN(cond, bar) do { unsigned _sp = 0; while (cond) { __builtin_amdgcn_s_sleep(1); \
    if ((++_sp & 255u) == 0u) { if (xb_ld(&(bar)[XB_TMO])) break; if (_sp > XB_SPIN_CAP) { atomicAdd(&(bar)[XB_TMO], 1u); break; } } } } while (0)

struct XcdBarrier { unsigned* bar; unsigned x; volatile LAS unsigned* st; };

__device__ __forceinline__ XcdBarrier xcd_barrier_post(unsigned* bar, volatile LAS unsigned* st) {
    XcdBarrier b; b.bar = bar; b.x = xb_xcc_id(); b.st = st;
    if (threadIdx.x == 0) (void)xb_add(&bar[XB_XCNT(b.x)], 1u);
    return b;
}
__device__ __forceinline__ void xcd_barrier_complete(unsigned* bar, unsigned x, unsigned& nloc, unsigned& nx) {
    const unsigned G = gridDim.x * gridDim.y * gridDim.z;
    unsigned sum, cnt, mine, sp = 0u;
    for (;;) {
        sum = 0u; cnt = 0u; mine = 0u;
#pragma unroll
        for (unsigned j = 0; j < 16; ++j) { const unsigned c = xb_ld(&bar[XB_XCNT(j)]); sum += c; cnt += (c > 0u) ? 1u : 0u; mine = (j == x) ? c : mine; }
        if (sum == G) break;
        __builtin_amdgcn_s_sleep(1);
        if ((++sp & 255u) == 0u) { if (xb_ld(&bar[XB_TMO])) break; if (sp > XB_SPIN_CAP) { atomicAdd(&bar[XB_TMO], 1u); break; } }
    }
    nloc = mine > 0u ? mine : 1u; nx = cnt > 0u ? cnt : 1u;
}
__device__ __forceinline__ void xcd_barrier(const XcdBarrier& b) {
    asm volatile("s_waitcnt vmcnt(0)" ::: "memory");
    __syncthreads();
    if (threadIdx.x == 0) {
        unsigned* bar = b.bar; unsigned bx = b.x; asm volatile("" : "+s"(bx));
        __builtin_amdgcn_s_waitcnt(0);
        unsigned nloc = b.st[0], nx = b.st[1];
        if (nloc == 0u) { xcd_barrier_complete(bar, bx, nloc, nx); b.st[0] = nloc; b.st[1] = nx; }
        const unsigned old = xb_add(&bar[XB_XSUB(bx)], 1u);
        const unsigned gen = old / nloc;
        if (old + 1u == (gen + 1u) * nloc) {
            __builtin_amdgcn_fence(__ATOMIC_RELEASE, "agent");
            asm volatile("s_waitcnt vmcnt(0)" ::: "memory");
            const unsigned og = xb_add(&bar[XB_TOP], 1u);
            const unsigned tg = og / nx;
            if (og + 1u == (tg + 1u) * nx) xb_add(&bar[XB_TOPGEN], 1u);
            else XB_SPIN(xb_ld(&bar[XB_TOPGEN]) == tg, bar);
            __builtin_amdgcn_fence(__ATOMIC_ACQUIRE, "agent");
            asm volatile("s_waitcnt vmcnt(0)" ::: "memory");
        } else {
            XB_SPIN(xb_ld(&bar[XB_TOPGEN]) == gen, bar);
            __builtin_amdgcn_fence(__ATOMIC_ACQUIRE, "agent");
            asm volatile("s_waitcnt vmcnt(0)" ::: "memory");
        }
    }
    __syncthreads();
}

enum { I_X = 0, I_MIX, I_WR, I_WK, I_WV, I_WO, I_W0, I_W1, I_W2, I_A0, I_A1, I_A2, I_G1, I_G2, I_KK, I_KA, I_RK, I_GNG, I_GNB,
       I_FWIN, I_FBF, I_FWO, I_RW, I_RB, I_MG, I_MU, I_MD, I_LNG, I_LNB, N_IN };
constexpr int LDS_BYTES = 163840;
constexpr int LDS_MISC = LDS_BYTES - 64;
static_assert(CTL_BAR_OFF + XCD_BAR_WORDS * 4 <= CTL_BYTES, "ctl block");

struct Params { const float* in[N_IN]; float* out; unsigned char* ws; };

__device__ __forceinline__ void ph_xmix(const float* x, const float* mix, bf16* xcat, bf16* xr3, int gw, int NGW, int lane) {
    f32x4 mr[4], mk[4], mv[4];
#pragma unroll
    for (int j = 0; j < 4; ++j) { mr[j] = *(const f32x4*)(mix + 0 * D + 4 * lane + 256 * j); mk[j] = *(const f32x4*)(mix + 2 * D + 4 * lane + 256 * j); mv[j] = *(const f32x4*)(mix + 3 * D + 4 * lane + 256 * j); }
    for (int row = gw; row < M; row += NGW) {
        const bool hp = (row & (T - 1)) != 0;
#pragma unroll
        for (int j = 0; j < 4; ++j) {
            const int col = 4 * lane + 256 * j;
            const f32x4 c4 = *(const f32x4*)(x + (size_t)row * D + col);
            f32x4 p4 = (f32x4){0.f, 0.f, 0.f, 0.f};
            if (hp) p4 = *(const f32x4*)(x + (size_t)(row - 1) * D + col);
            const f32x4 xx = p4 - c4;
            u32x2 o;
            o.x = pk2(c4.x, c4.y); o.y = pk2(c4.z, c4.w); *(u32x2*)(xcat + (size_t)row * 2048 + col) = o;
            o.x = pk2(xx.x, xx.y); o.y = pk2(xx.z, xx.w); *(u32x2*)(xcat + (size_t)row * 2048 + 1024 + col) = o;
            f32x4 v = c4 + xx * mr[j]; o.x = pk2(v.x, v.y); o.y = pk2(v.z, v.w); *(u32x2*)(xr3 + (size_t)row * D + col) = o;
            v = c4 + xx * mk[j]; o.x = pk2(v.x, v.y); o.y = pk2(v.z, v.w); *(u32x2*)(xr3 + (size_t)M * D + (size_t)row * D + col) = o;
            v = c4 + xx * mv[j]; o.x = pk2(v.x, v.y); o.y = pk2(v.z, v.w); *(u32x2*)(xr3 + 2 * (size_t)M * D + (size_t)row * D + col) = o;
        }
    }
}

__global__ void __launch_bounds__(512, 2) fwd(Params P) {
    extern __shared__ __attribute__((aligned(16))) unsigned char lds[];
    LAS unsigned char* lds3 = (LAS unsigned char*)lds;
    volatile LAS unsigned* misc = (volatile LAS unsigned*)(lds3 + LDS_MISC);
    if (threadIdx.x < 16) misc[threadIdx.x] = 0u;
    const int wv_s = __builtin_amdgcn_readfirstlane(threadIdx.x >> 6);
    __syncthreads();
    unsigned char* ws = P.ws;
    XcdBarrier bar = xcd_barrier_post((unsigned*)(ws + WS_CTL + CTL_BAR_OFF), misc);
    const int G = gridDim.x, bid = blockIdx.x;
    float* hbuf = P.out;
    bf16* PRE = (bf16*)P.out;
    int* counts0 = (int*)(ws + WS_CTL);
    bf16* HB = (bf16*)(ws + WS_HB); bf16* R = (bf16*)(ws + WS_R); bf16* KB = (bf16*)(ws + WS_K); bf16* VB = (bf16*)(ws + WS_V);
    _Float16* LW = (_Float16*)P.out;
    bf16* AA = (bf16*)(ws + WS_AA); bf16* GG = (bf16*)(ws + WS_G); bf16* L1 = (bf16*)(ws + WS_L1);
    float* LOGF = (float*)(ws + WS_LOGF); float* CUM = (float*)(ws + WS_CUM); bf16* Y = (bf16*)(ws + WS_Y); bf16* HID = (bf16*)(ws + WS_HID);
    bf16* GUT = (bf16*)(ws + WS_MOEW); bf16* DNT = (bf16*)(ws + WS_DNT);
    bf16* GUT1 = (bf16*)((unsigned char*)P.out + 32 * MiB); bf16* DNT1 = (bf16*)(ws + WS_DNT1);
    const size_t BIG = (size_t)1 << 20;

    {
        const int tid = opaque_tid(wv_s), lane = tid & 63, wave = tid >> 6;
        const int gw = bid * 8 + wave, NGW = G * 8;
        LAS float* scr = (LAS float*)(lds3 + wave * 16384);
        bf16* WRKV = (bf16*)(ws + WS_WRKV); bf16* WO = (bf16*)(ws + WS_WO); bf16* B1T = (bf16*)(ws + WS_B1T); bf16* B2T = (bf16*)(ws + WS_B2T);
        bf16* WIN = (bf16*)(ws + WS_WIN); bf16* FWO = (bf16*)(ws + WS_FWO);
        const float* mix = P.in[I_MIX];
        int ib = 0;
        ib = tr_matrix(ib, gw, NGW, P.in[I_WR], D, D, D, nullptr, WRKV, D, 0, 0, 0, scr, lane);
        ib = tr_matrix(ib, gw, NGW, P.in[I_WK], D, D, D, nullptr, WRKV, D, 0, D, 0, scr, lane);
        ib = tr_matrix(ib, gw, NGW, P.in[I_WV], D, D, D, nullptr, WRKV, D, 0, 2 * D, 0, scr, lane);
        ib = tr_matrix(ib, gw, NGW, P.in[I_W1], 64, D, 64, nullptr, B1T, 2048, 0, 0, 0, scr, lane);
        ib = tr_matrix(ib, gw, NGW, P.in[I_W1], 64, D, 64, mix + 1 * D, B1T, 2048, 1024, 0, 0, scr, lane);
        ib = tr_matrix(ib, gw, NGW, P.in[I_A1], 64, D, 64, nullptr, B1T, 2048, 0, 64, 0, scr, lane);
        ib = tr_matrix(ib, gw, NGW, P.in[I_A1], 64, D, 64, mix + 4 * D, B1T, 2048, 1024, 64, 0, scr, lane);
        ib = tr_matrix(ib, gw, NGW, P.in[I_G1], 128, D, 128, nullptr, B1T, 2048, 0, 128, 0, scr, lane);
        ib = tr_matrix(ib, gw, NGW, P.in[I_G1], 128, D, 128, mix + 5 * D, B1T, 2048, 1024, 128, 0, scr, lane);
        ib = tr_matrix(ib, gw, NGW, P.in[I_W2], D, 64, D, nullptr, B2T, 256, 0, 0, 0, scr, lane);
        ib = tr_matrix(ib, gw, NGW, P.in[I_A2], D, 64, D, nullptr, B2T, 256, 64, 1024, 0, scr, lane);
        ib = tr_matrix(ib, gw, NGW, P.in[I_G2], D, 128, D, nullptr, B2T, 256, 128, 2048, 0, scr, lane);
        for (int ch = bid * 512 + tid; ch < 3072 * 32; ch += G * 512) {
            const int row = ch >> 5, c8 = ch & 31;
            const bool covered = row < 1024 ? (c8 < 8) : (row < 2048 ? (c8 >= 8 && c8 < 16) : (c8 >= 16));
            if (!covered) *(u32x4*)(B2T + (size_t)row * 256 + c8 * 8) = (u32x4){0u, 0u, 0u, 0u};
        }
        ph_xmix(P.in[I_X], mix, (bf16*)(ws + WS_XCAT), (bf16*)(ws + WS_XR), gw, NGW, lane);
    }
    xcd_barrier(bar);
    {
        const int G1 = G / 4, G2 = G - G1;
        pg8::DenseOrder S1; S1.init(M, 256, 2048, G1, bid < G1 ? bid : -1, ws + WS_XCAT, ws + WS_B1T, 1 << 20, 0);
        pg8::EpiBf16 E1; E1.O = L1; E1.ldc = 256; E1.split_div = 1; E1.split_stride = 0; E1.scale0 = 1.f; E1.act = 1; E1.scanlay = 0;
        pg8::gemm_phase<pg8::EpiBf16, pg8::DenseOrder, true, false>(lds3, 2048, S1, E1, wv_s);
        if (bid < G1) {
            pg8::Unit u0; (void)S1.next(0, u0);
            pg8::DenseOrder S3; S3.init(256, 4 * 256, 256, 1, 0, (const char*)L1 + (size_t)u0.pm * 256 * 256 * 2, ws + WS_B2T, 1 << 20, 0); S3.kl = 128;
            pg8::EpiLora2 E3; E3.LW = LW; E3.AG = AA; E3.w0 = P.in[I_W0]; E3.a0 = P.in[I_A0]; E3.pm0 = u0.pm; E3.pn0 = 0;
            pg8::gemm_phase<pg8::EpiLora2, pg8::DenseOrder, true, false>(lds3, 256, S3, E3, wv_s);
        }
        pg8::DenseOrder S2; S2.init(M, 3 * D, D, G2, bid >= G1 ? bid - G1 : -1, ws + WS_XR, ws + WS_WRKV, 4, (size_t)M * D * 2);
        pg8::EpiBf16 E2; E2.O = R; E2.ldc = D; E2.split_div = 4; E2.split_stride = (size_t)M * D; E2.scale0 = 1.f; E2.act = 0; E2.scanlay = 1;
        pg8::gemm_phase<pg8::EpiBf16, pg8::DenseOrder, true, false>(lds3, D, S2, E2, wv_s);
    }
    xcd_barrier(bar);
    {
        pg8::DenseOrder S; S.init(M, 2 * D, 256, G, bid, L1, ws + WS_B2T + (size_t)4 * 256 * 256 * 2, 4, 256); S.kl = 128; S.bsel = 1;
        pg8::EpiLora2 E; E.LW = LW; E.AG = AA; E.w0 = P.in[I_W0]; E.a0 = P.in[I_A0]; E.pm0 = 0; E.pn0 = 4;
        pg8::gemm_phase<pg8::EpiLora2, pg8::DenseOrder, true, false>(lds3, 256, S, E, wv_s);
    }
    xcd_barrier(bar);
    {
        const bool split = G >= 256;
        if (!split || bid < NB * H) {
            ScanP p; p.r = R; p.k = KB; p.v = VB; p.lw = LW; p.a = AA; p.g = GG; p.yg = R; p.kk = P.in[I_KK]; p.ka = P.in[I_KA]; p.rk = P.in[I_RK]; p.gng = P.in[I_GNG]; p.gnb = P.in[I_GNB];
            ph_scan_pc(p, lds, split ? NB * H : G, wv_s);
        }
        if (!split || bid >= NB * H) {
            const int tid = opaque_tid(wv_s), lane = tid & 63, wave = tid >> 6;
            __syncthreads();
            if (bid == G - 1) {
                build_router_frags(P.in[I_LNG] + 0 * D, P.in[I_LNB] + 0 * D, P.in[I_RW], ws + WS_WF, lds, tid);
                build_router_frags(P.in[I_LNG] + 2 * D, P.in[I_LNB] + 2 * D, P.in[I_RW], ws + WS_WF + WF_STRIDE, lds, tid);
            }
            {
                const int gw = split ? (bid - NB * H) * 8 + wave : bid * 8 + wave, NGW = split ? (G - NB * H) * 8 : G * 8; LAS float* scr = (LAS float*)(lds3 + wave * 16384); int ib = 0;
                ib = tr_matrix(ib, gw, NGW, P.in[I_WO], D, D, D, nullptr, (bf16*)(ws + WS_WO), D, 0, 0, 0, scr, lane);
                ib = tr_matrix(ib, gw, NGW, P.in[I_FWIN], NW_IN, D, 3 * D, nullptr, (bf16*)(ws + WS_WIN), D, 0, 0, 0, scr, lane);
                ib = tr_matrix(ib, gw, NGW, P.in[I_FWO], D, D, D, nullptr, (bf16*)(ws + WS_FWO), D, 0, 0, 0, scr, lane);
            }
            convert_moe(P.in[I_MG], P.in[I_MU], P.in[I_MD], GUT, DNT, split ? (bid - NB * H) * 8 + wave : bid * 8 + wave, split ? (G - NB * H) * 8 : G * 8, (LAS float*)(lds3 + wave * 16384), lane);
            convert_moe(P.in[I_MG] + (size_t)NE * D * DE, P.in[I_MU] + (size_t)NE * D * DE, P.in[I_MD] + (size_t)NE * DE * D, GUT1, DNT1, split ? (bid - NB * H) * 8 + wave : bid * 8 + wave, split ? (G - NB * H) * 8 : G * 8, (LAS float*)(lds3 + wave * 16384), lane);
            if (split) {
                const float* xs = P.in[I_X]; float accd = 0.f;
                const size_t nline = (size_t)M * D / 32, stride = (size_t)(G - NB * H) * 512;
#pragma unroll 8
                for (size_t i = (size_t)(bid - NB * H) * 512 + tid; i < nline; i += stride) accd += xs[i * 32];
                if (accd == 1.2345e38f) ((float*)(ws + WS_CTL))[8191] = accd;
            }
        }
    }
    xcd_barrier(bar);
    {
        pg8::DenseOrder S; S.init(M, D, D, G, bid, R, ws + WS_WO, 1 << 20, 0); S.ascan = 1;
        pg8::EpiPre E; E.hin32 = P.in[I_X]; E.hin16 = nullptr; E.out = PRE;
        pg8::gemm_phase<pg8::EpiPre, pg8::DenseOrder, true, false>(lds3, D, S, E, wv_s);
    }
    xcd_barrier(bar);
    for (int layer = 0; layer < 2; ++layer) {
        if (layer == 1) {
            ph_cumsum(LOGF, CUM, wv_s);
            {
                pg8::DenseOrder S; S.init(M, 3 * D, D, G, bid, HB, ws + WS_WIN, 1 << 20, 0);
                pg8::EpiBf16 E; E.O = R; E.ldc = D; E.split_div = 4; E.split_stride = (size_t)M * D; E.scale0 = attn_body::C2; E.act = 0; E.scanlay = 0;
                pg8::gemm_phase<pg8::EpiBf16, pg8::DenseOrder, true, false>(lds3, D, S, E, wv_s);
            }
            xcd_barrier(bar);
            {   const attn_body::AttnTensors AT{(const attn_body::bf16*)R, (const attn_body::bf16*)KB, (const attn_body::bf16*)VB, (attn_body::bf16*)R};
                const attn_body::StaticOrder S(G, bid);
                attn_body::attn_phase<attn_body::StaticOrder, 30>((char*)lds, AT, CUM, S, wv_s); }
            xcd_barrier(bar);
            {
                pg8::DenseOrder S; S.init(M, D, D, G, bid, R, ws + WS_FWO, 1 << 20, 0);
                pg8::EpiPre E; E.hin32 = nullptr; E.hin16 = HB; E.out = PRE;
                pg8::gemm_phase<pg8::EpiPre, pg8::DenseOrder, true, false>(lds3, D, S, E, wv_s);
            }
            xcd_barrier(bar);
        }
        int* counts = counts0 + 16 * CNT_STRIDE * layer;
        int* rtok = (int*)(ws + WS_RTOK) + (size_t)layer * NE * CAP; float* rgate = (float*)(ws + WS_RGATE) + (size_t)layer * NE * CAP; int* slot = (int*)(ws + WS_SLOT) + (size_t)layer * M * 2;
        {   LnRouteP p; p.pin = PRE; p.hb = HB; p.g = P.in[I_LNG] + (layer * 2 + 0) * D; p.b = P.in[I_LNB] + (layer * 2 + 0) * D; p.wfg = ws + WS_WF + (size_t)layer * WF_STRIDE; p.rbias = P.in[I_RB];
            p.counts = counts; p.rtok = rtok; p.rgate = rgate; p.slot = slot;
            ph_ln_route(p, lds, wv_s); }
        xcd_barrier(bar);
        {
            int total = 0; for (int e = 0; e < NE; ++e) total += (counts[e * CNT_STRIDE] + 255) >> 8;
            total *= 4;
            const int n3 = total > 512 ? total - 512 : 0, early = total < 512 ? total : 512;
            unsigned* gu3 = (unsigned*)(ws + WS_CTL + 36864) + 64 * layer;
            pg8::EpiGU EG; EG.hid = HID;
            pg8::EpiDN ED; ED.y = Y; ED.rgate = rgate;
            pg8::MoeOrder SG; SG.counts = counts; SG.rtok = rtok; SG.A = (const char*)HB; SG.B = (const char*)(layer == 0 ? GUT : GUT1); SG.bexp_stride = (size_t)D * D * 2; SG.nN = 4; SG.K = D; SG.gather = 1; SG.load_counts();
            pg8::MoeOrder SD; SD.counts = counts; SD.rtok = rtok; SD.A = (const char*)HID; SD.B = (const char*)(layer == 0 ? DNT : DNT1); SD.bexp_stride = (size_t)D * DE * 2; SD.nN = 4; SD.K = DE; SD.gather = 0; SD.load_counts();
            SG.base = bid; SG.stride = G; SG.hi = early;
            pg8::gemm_phase<pg8::EpiGU, pg8::MoeOrder, true, true>(lds3, D, SG, EG, wv_s);
            xcd_barrier(bar);
            int late_idx = -1;
            if (bid < n3) {
                SG.base = 512 + bid; SG.stride = 1 << 20; SG.hi = total;
                pg8::gemm_phase<pg8::EpiGU, pg8::MoeOrder, true, true>(lds3, D, SG, EG, wv_s);
                __syncthreads();
                if (opaque_tid(wv_s) == 0) { __builtin_amdgcn_fence(__ATOMIC_RELEASE, "agent"); asm volatile("s_waitcnt vmcnt(0)" ::: "memory"); __hip_atomic_fetch_add(gu3, 1u, __ATOMIC_RELAXED, __HIP_MEMORY_SCOPE_AGENT); }
                SD.base = bid; SD.stride = 1 << 20; SD.hi = early;
            } else {
                const int d = bid - n3, W = G - n3;
                SD.base = n3 + d; SD.stride = W; SD.hi = early;
                int idx = n3 + d; while (idx < 512) idx += W;
                if (idx < total) late_idx = idx;
            }
            pg8::gemm_phase<pg8::EpiDN, pg8::MoeOrder, true, false>(lds3, DE, SD, ED, wv_s);
            if (late_idx >= 0) {
                if (opaque_tid(wv_s) == 0) {
                    unsigned sp = 0; while (__hip_atomic_load(gu3, __ATOMIC_RELAXED, __HIP_MEMORY_SCOPE_AGENT) < (unsigned)n3) { __builtin_amdgcn_s_sleep(2); if (++sp > (1u << 22)) break; }
                    __builtin_amdgcn_fence(__ATOMIC_ACQUIRE, "agent"); asm volatile("s_waitcnt vmcnt(0)" ::: "memory");
                }
                __syncthreads();
                SD.base = late_idx; SD.stride = 1 << 20; SD.hi = total;
                pg8::gemm_phase<pg8::EpiDN, pg8::MoeOrder, true, false>(lds3, DE, SD, ED, wv_s);
            }
        }
        xcd_barrier(bar);
        {   LnCombP p; p.hb = HB; p.y = Y; p.slot = slot; p.counts = counts; p.g = P.in[I_LNG] + (layer * 2 + 1) * D; p.b = P.in[I_LNB] + (layer * 2 + 1) * D;
            p.wf = P.in[I_FWIN] + 3 * D; p.bf = P.in[I_FBF]; p.logf = LOGF; p.outp = (layer == 1) ? hbuf : nullptr; p.do_f = (layer == 0) ? 1 : 0; p.pad = 0;
            ph_ln_comb(p, lds, wv_s); }
        if (layer == 0) {
            xcd_barrier(bar);
        }
    }
}

extern "C" void kernel_launch(void* const* d_in, const int* in_sizes, int n_in, void* d_out, int out_size, void* d_ws, size_t ws_size, hipStream_t stream) {
    static int grid = 0;
    if (grid == 0) {
        if (n_in != N_IN || out_size != M * D || ws_size < WS_END) { fprintf(stderr, "kernel_launch: unexpected problem (n_in %d out %d ws %zu, need %zu)\n", n_in, out_size, ws_size, (size_t)WS_END); grid = -1; return; }
        int dev = 0, cus = 0;
        if (hipGetDevice(&dev) != hipSuccess || hipDeviceGetAttribute(&cus, hipDeviceAttributeMultiprocessorCount, dev) != hipSuccess) { grid = -1; return; }
        if (hipFuncSetAttribute((const void*)fwd, hipFuncAttributeMaxDynamicSharedMemorySize, LDS_BYTES) != hipSuccess) { fprintf(stderr, "kernel_launch: hipFuncSetAttribute failed\n"); grid = -1; return; }
        int per_cu = 0;
        if (hipOccupancyMaxActiveBlocksPerMultiprocessor(&per_cu, (const void*)fwd, 512, LDS_BYTES) != hipSuccess || per_cu < 1) { fprintf(stderr, "kernel_launch: occupancy query says %d\n", per_cu); (void)hipGetLastError(); }
        if (cus < 2 * NB * H) { fprintf(stderr, "kernel_launch: needs >= %d CUs\n", 2 * NB * H); grid = -1; return; }
        grid = cus;
    }
    if (grid < 0) return;
    (void)hipMemsetAsync((char*)d_ws + WS_CTL, 0, CTL_BYTES, stream);
    Params P{};
    for (int i = 0; i < N_IN; ++i) P.in[i] = (const float*)d_in[i];
    P.out = (float*)d_out; P.ws = (unsigned char*)d_ws;
    hipLaunchKernelGGL(fwd, dim3(grid), dim3(512), LDS_BYTES, stream, P);
}
```
